# Optimizing an MI355X kernel written in HIP

```python
import math
import jax, jax.numpy as jnp
from jax import lax
import numpy as np

D_MODEL = 2048
BATCH = 16
SEQ = 2048
DEPTH = 2

D_MIX = D_MODEL
GLA_WIDTH = D_MIX // 2
DIFF_WIDTH = D_MIX - GLA_WIDTH
GLA_HEADS = 4
GLA_KEY_WIDTH = GLA_WIDTH // 2
GLA_HEAD_K = GLA_KEY_WIDTH // GLA_HEADS
GLA_HEAD_V = GLA_WIDTH // GLA_HEADS
GLA_GATE_RANK = 16
GLA_GATE_TAU = 16.0
GLA_CHUNK = 64
DIFF_HEAD_DIM = 128
DIFF_HEADS = DIFF_WIDTH // (2 * DIFF_HEAD_DIM)
Q_BLOCK = 128
ROPE_THETA = 10000.0
D_FF = 4 * D_MODEL
NORM_EPS = 1e-6
SUBLN_EPS = 1e-5

IN_SIZES = (GLA_KEY_WIDTH, GLA_KEY_WIDTH, GLA_WIDTH, GLA_WIDTH, GLA_GATE_RANK,
            DIFF_HEADS * 2 * DIFF_HEAD_DIM, DIFF_HEADS * 2 * DIFF_HEAD_DIM, DIFF_WIDTH)
IN_COLS = sum(IN_SIZES)

kernel_name = "hymba_style_gla_diffattn_hybrid"


def rms_norm(x, w, eps):
    xf = x.astype(jnp.float32)
    y = xf * lax.rsqrt(jnp.mean(xf * xf, axis=-1, keepdims=True) + eps)
    return (y * w.astype(jnp.float32)).astype(x.dtype)


def rope_tables(positions, dim):
    inv_freq = ROPE_THETA ** (-jnp.arange(0, dim, 2, dtype=jnp.float32) / dim)
    ang = positions.astype(jnp.float32)[..., None] * inv_freq
    return jnp.cos(ang), jnp.sin(ang)


def apply_rope(t, cos, sin):
    half = t.shape[-1] // 2
    t1, t2 = t[..., :half], t[..., half:]
    c, s = cos.astype(t.dtype), sin.astype(t.dtype)
    return jnp.concatenate([t1 * c - t2 * s, t1 * s + t2 * c], axis=-1)


def lambda_init_fn(layer_idx):
    return 0.8 - 0.6 * math.exp(-0.3 * layer_idx)


def gla_mixer(q, k, v, g, gate_lr, gate_w2, gate_b, out_norm_w):
    B, S, _ = q.shape
    H, dk, dv, C = GLA_HEADS, GLA_HEAD_K, GLA_HEAD_V, GLA_CHUNK
    N = S // C
    log_alpha = jax.nn.log_sigmoid((gate_lr @ gate_w2 + gate_b).astype(jnp.float32)) / GLA_GATE_TAU

    def chunks(t, d):
        return t.reshape(B, N, C, H, d).transpose(1, 0, 3, 2, 4)

    qc = chunks(q * (dk ** -0.5), dk)
    kc = chunks(k, dk)
    vc = chunks(v, dv)
    bc = jnp.cumsum(chunks(log_alpha, dk), axis=3)
    causal = jnp.tril(jnp.ones((C, C), dtype=bool))[:, :, None]

    def step(state, inp):
        q_i, k_i, v_i, b_i = inp
        o_inter = jnp.einsum('bhcd,bhdv->bhcv', q_i * jnp.exp(b_i), state)
        rel = b_i[:, :, :, None, :] - b_i[:, :, None, :, :]
        decay = jnp.exp(jnp.where(causal, rel, -jnp.inf))
        attn = jnp.einsum('bhid,bhjd,bhijd->bhij', q_i, k_i, decay)
        o_intra = jnp.einsum('bhij,bhjv->bhiv', attn, v_i)
        b_last = b_i[:, :, -1:, :]
        k_dec = k_i * jnp.exp(b_last - b_i)
        new_state = (state * jnp.exp(b_last)[:, :, 0, :, None]
                     + jnp.einsum('bhcd,bhcv->bhdv', k_dec, v_i)).astype(jnp.float32)
        return new_state, (o_inter + o_intra).astype(jnp.float32)

    state0 = jnp.zeros((B, H, dk, dv), dtype=jnp.float32)
    _, o = lax.scan(step, state0, (qc, kc, vc, bc))
    o = o.transpose(1, 0, 3, 2, 4).reshape(B, S, H, dv)
    o = rms_norm(o, out_norm_w, NORM_EPS) * jax.nn.silu(g.reshape(B, S, H, dv).astype(jnp.float32))
    return o.reshape(B, S, H * dv).astype(v.dtype)


def diff_attention(q, k, v, cos, sin, q_norm_w, k_norm_w, lam_q1, lam_k1, lam_q2, lam_k2,
                   subln_w, lam_init):
    B, S, _ = q.shape
    H, dh = DIFF_HEADS, DIFF_HEAD_DIM
    q = rms_norm(q.reshape(B, S, H, 2, dh), q_norm_w, NORM_EPS).transpose(0, 2, 3, 1, 4)
    k = rms_norm(k.reshape(B, S, H, 2, dh), k_norm_w, NORM_EPS).transpose(0, 2, 3, 1, 4)
    q = apply_rope(q, cos, sin)
    k = apply_rope(k, cos, sin)
    v = v.reshape(B, S, H, 2 * dh).transpose(0, 2, 1, 3)
    f32 = jnp.float32
    lam = (jnp.exp(jnp.sum(lam_q1.astype(f32) * lam_k1.astype(f32)))
           - jnp.exp(jnp.sum(lam_q2.astype(f32) * lam_k2.astype(f32))) + lam_init)
    scale = dh ** -0.5
    outs = []
    for blk in range(S // Q_BLOCK):
        start = blk * Q_BLOCK
        end = start + Q_BLOCK
        s = jnp.einsum('bhcqd,bhckd->bhcqk', q[:, :, :, start:end], k[:, :, :, :end]).astype(f32) * scale
        mask = (start + jnp.arange(Q_BLOCK))[:, None] >= jnp.arange(end)[None, :]
        p = jax.nn.softmax(jnp.where(mask, s, -jnp.inf), axis=-1)
        w = p[:, :, 0] - lam * p[:, :, 1]
        outs.append(jnp.einsum('bhqk,bhkd->bhqd', w.astype(v.dtype), v[:, :, :end]))
    o = jnp.concatenate(outs, axis=2)
    o = rms_norm(o, subln_w, SUBLN_EPS) * (1.0 - lam_init)
    return o.transpose(0, 2, 1, 3).reshape(B, S, H * 2 * dh)


def setup_inputs(seed: int = 0) -> dict:
    key = jax.random.key(seed)
    ks = jax.random.split(key, 20)

    def nrm(k, shape, scale):
        return jax.random.normal(k, shape, dtype=jnp.float32) * scale

    x = nrm(ks[0], (BATCH, SEQ, D_MODEL), 1.0)
    positions = (jnp.arange(SEQ, dtype=jnp.int32)[None, :]
                 + jax.random.randint(ks[1], (BATCH, 1), 0, 1024, dtype=jnp.int32))
    return {
        "x": x,
        "positions": positions,
        "attn_norm_w": 1.0 + nrm(ks[2], (DEPTH, D_MODEL), 0.02),
        "w_in": nrm(ks[3], (DEPTH, D_MODEL, IN_COLS), D_MODEL ** -0.5),
        "gla_gate_w2": nrm(ks[4], (DEPTH, GLA_GATE_RANK, GLA_KEY_WIDTH), GLA_GATE_RANK ** -0.5),
        "gla_gate_b": nrm(ks[5], (DEPTH, GLA_KEY_WIDTH), 0.1),
        "gla_out_norm_w": 1.0 + nrm(ks[6], (DEPTH, GLA_HEAD_V), 0.02),
        "diff_q_norm_w": 1.0 + nrm(ks[7], (DEPTH, DIFF_HEAD_DIM), 0.02),
        "diff_k_norm_w": 1.0 + nrm(ks[8], (DEPTH, DIFF_HEAD_DIM), 0.02),
        "diff_lambda_q1": nrm(ks[9], (DEPTH, DIFF_HEAD_DIM), 0.1),
        "diff_lambda_k1": nrm(ks[10], (DEPTH, DIFF_HEAD_DIM), 0.1),
        "diff_lambda_q2": nrm(ks[11], (DEPTH, DIFF_HEAD_DIM), 0.1),
        "diff_lambda_k2": nrm(ks[12], (DEPTH, DIFF_HEAD_DIM), 0.1),
        "diff_subln_w": 1.0 + nrm(ks[13], (DEPTH, 2 * DIFF_HEAD_DIM), 0.02),
        "w_out": nrm(ks[14], (DEPTH, D_MIX, D_MODEL), D_MIX ** -0.5),
        "mlp_norm_w": 1.0 + nrm(ks[15], (DEPTH, D_MODEL), 0.02),
        "w_up": nrm(ks[16], (DEPTH, D_MODEL, D_FF), D_MODEL ** -0.5),
        "w_down": nrm(ks[17], (DEPTH, D_FF, D_MODEL), D_FF ** -0.5),
    }


def reference(x, positions, attn_norm_w, w_in, gla_gate_w2, gla_gate_b, gla_out_norm_w,
              diff_q_norm_w, diff_k_norm_w, diff_lambda_q1, diff_lambda_k1, diff_lambda_q2,
              diff_lambda_k2, diff_subln_w, w_out, mlp_norm_w, w_up, w_down):
    cos, sin = rope_tables(positions, DIFF_HEAD_DIM)
    cos = cos[:, None, None]
    sin = sin[:, None, None]
    split_points = np.cumsum(IN_SIZES)[:-1].tolist()
    for layer in range(DEPTH):
        n = rms_norm(x, attn_norm_w[layer], NORM_EPS)
        proj = n @ w_in[layer]
        g_q, g_k, g_v, g_g, g_lr, d_q, d_k, d_v = jnp.split(proj, split_points, axis=-1)
        y_gla = gla_mixer(g_q, g_k, g_v, g_g, g_lr, gla_gate_w2[layer], gla_gate_b[layer],
                          gla_out_norm_w[layer])
        y_diff = diff_attention(d_q, d_k, d_v, cos, sin, diff_q_norm_w[layer], diff_k_norm_w[layer],
                                diff_lambda_q1[layer], diff_lambda_k1[layer],
                                diff_lambda_q2[layer], diff_lambda_k2[layer],
                                diff_subln_w[layer], lambda_init_fn(layer))
        mixed = jnp.concatenate([y_gla, y_diff], axis=-1)
        x = x + mixed @ w_out[layer]
        n = rms_norm(x, mlp_norm_w[layer], NORM_EPS)
        x = x + jnp.square(jax.nn.relu(n @ w_up[layer])) @ w_down[layer]
    return x
```

```cpp
#include <hip/hip_runtime.h>
#include <hip/hip_bf16.h>
#include <cstdio>
#include <cstdint>
#include <cmath>
namespace pg8 {
#define PG8_LAS __attribute__((address_space(3)))
typedef unsigned short bf16_t;
typedef short bf16x8 __attribute__((ext_vector_type(8)));
typedef float f32x4 __attribute__((ext_vector_type(4)));
typedef unsigned u32x4 __attribute__((ext_vector_type(4)));
constexpr int BM = 256, BK = 64, HALF = 128, HTB = HALF * BK * 2  , STAGE_BYTES = 8 * HTB, NXCD = 8, WGM = 8;

__host__ __device__ __forceinline__ int lds_byte(int r, int c) { const int st = (r >> 4) * 2 + (c >> 5), rr = r & 15, cc = c & 31, ob = rr * 64 + cc * 2; return st * 1024 + (ob ^ (((ob >> 9) & 1) << 5)); }
__host__ __device__ __forceinline__ void stage_rc(int b, int& R, int& C) { const int st = b / 1024, sb = b % 1024, swz = sb ^ (((sb >> 9) & 1) << 5); R = (st >> 1) * 16 + swz / 64; C = (st & 1) * 32 + (swz % 64) / 2; }
__host__ __device__ __forceinline__ int perm32(int rho) { const int n = rho >> 4, i = rho & 15; return 8 * (i >> 2) + 4 * n + (i & 3); }

struct Unit { int pm, pn; };
template <int M_, int N_, int K_> struct Gemm { const bf16_t* A; const bf16_t* Bt; static constexpr int M = M_, N = N_, K = K_; };

template <int M_, int N_> struct StaticOrder {
    static constexpr int nM = M_ / BM, nN = N_ / BM, nwg = nM * nN;
    int G, c;
    __host__ __device__ void init(int G_, int c_) { G = G_; c = c_; }
    __host__ __device__ bool next(int i, Unit& u) const {
        const long L = (long)i * G + c; if (L >= nwg) return false;
        int wgid = (int)L; { constexpr int q = nwg / NXCD, r = nwg % NXCD; const int xcd = wgid % NXCD, off = wgid / NXCD; wgid = (xcd < r ? xcd * (q + 1) : r * (q + 1) + (xcd - r) * q) + off; }
        constexpr int nig = WGM * nN; const int gid = wgid / nig, fm = gid * WGM, gsz = (nM - fm) < WGM ? (nM - fm) : WGM;
        u.pm = fm + ((wgid % nig) % gsz); u.pn = (wgid % nig) / gsz; return true;
    }
    __device__ __forceinline__ void a_ready(const Unit&) const {}
    __device__ __forceinline__ void done(const Unit&) const {}
};
__device__ __forceinline__ unsigned cvt_pk_bf16(float lo, float hi) { unsigned r; asm volatile("v_cvt_pk_bf16_f32 %0, %1, %2" : "=v"(r) : "v"(lo), "v"(hi)); return r; }
typedef float f32x2 __attribute__((ext_vector_type(2)));
template <int ACT, int ldc> struct EpiBf16 {
    static constexpr bool PERM = true, AFTER_DRAIN = false;
    bf16_t* O; const float* bias;
    __device__ __forceinline__ void operator()(const f32x4 (&acc)[2][2][4][2], const Unit& u, int wr, int wc, int fr, int fq) const {
        const int row0 = u.pm * BM + wr * 64 + fr; const int col0 = u.pn * BM + wc * 32 + 8 * fq;
        f32x4 bv[2][2];
#pragma unroll
        for (int bj = 0; bj < 2; ++bj)
#pragma unroll
            for (int n = 0; n < 2; ++n) bv[bj][n] = bias ? *(const f32x4*)(bias + col0 + bj * HALF + 4 * n) : (f32x4){0.f, 0.f, 0.f, 0.f};
#pragma unroll
        for (int ai = 0; ai < 2; ++ai)
#pragma unroll
            for (int m = 0; m < 4; ++m) { bf16_t* rowp = O + (size_t)(row0 + ai * HALF + m * 16) * ldc + col0;
#pragma unroll
                for (int bj = 0; bj < 2; ++bj) { f32x4 v0 = acc[ai][bj][m][0] + bv[bj][0], v1 = acc[ai][bj][m][1] + bv[bj][1];
                    if (ACT == 2) {
#pragma unroll
                        for (int e = 0; e < 4; ++e) { const float a = fmaxf(v0[e], 0.f), b = fmaxf(v1[e], 0.f); v0[e] = a * a; v1[e] = b * b; } }
                    u32x4 w; w.x = cvt_pk_bf16(v0[0], v0[1]); w.y = cvt_pk_bf16(v0[2], v0[3]); w.z = cvt_pk_bf16(v1[0], v1[1]); w.w = cvt_pk_bf16(v1[2], v1[3]);
                    *(u32x4*)(rowp + bj * HALF) = w; } }
    }
};
template <int ldc> struct EpiResF32 {
    static constexpr bool PERM = true, AFTER_DRAIN = false;
    const float* base; float* out;
    __device__ __forceinline__ void operator()(const f32x4 (&acc)[2][2][4][2], const Unit& u, int wr, int wc, int fr, int fq) const {
        const int row0 = u.pm * BM + wr * 64 + fr; const int col0 = u.pn * BM + wc * 32 + 8 * fq;
#pragma unroll
        for (int ai = 0; ai < 2; ++ai)
#pragma unroll
            for (int m = 0; m < 4; ++m) { const size_t off = (size_t)(row0 + ai * HALF + m * 16) * ldc + col0;
                f32x4 b00 = *(const f32x4*)(base + off), b01 = *(const f32x4*)(base + off + 4), b10 = *(const f32x4*)(base + off + HALF), b11 = *(const f32x4*)(base + off + HALF + 4);
                *(f32x4*)(out + off) = b00 + acc[ai][0][m][0]; *(f32x4*)(out + off + 4) = b01 + acc[ai][0][m][1];
                *(f32x4*)(out + off + HALF) = b10 + acc[ai][1][m][0]; *(f32x4*)(out + off + HALF + 4) = b11 + acc[ai][1][m][1];
                asm volatile("" ::: "memory"); }
    }
};
template <class Epi, class Sched, class GemmT, bool ALIGN_EPI = false, bool SP2 = false>
__device__ __forceinline__ void gemm_phase(PG8_LAS unsigned char* lds, const GemmT g, const Sched& S, const Epi& E) {
    int tid_ = threadIdx.x; asm volatile("" : "+v"(tid_));
    const int tid = tid_, wid = __builtin_amdgcn_readfirstlane(tid >> 6), lane = tid & 63, wr = wid >> 2, wc = wid & 3, fr = lane & 15, fq = lane >> 4;
    constexpr int K = GemmT::K, nt = K / BK;
    unsigned voffA[2], voffB[2];
#pragma unroll
    for (int i = 0; i < 2; ++i) { int R, C; stage_rc(tid * 16 + i * 8192, R, C); const int Rb = Epi::PERM ? ((R & ~31) + perm32(R & 31)) : R;
        voffA[i] = (unsigned)(R * K + C) * 2u; voffB[i] = (unsigned)(Rb * K + C) * 2u; }
    constexpr size_t kstep = (size_t)(BK * 2);
    constexpr size_t hstep = (size_t)HALF * K * 2;
    constexpr size_t tstep = 2 * hstep;
    const unsigned ldsw = (unsigned)wid * 1024u;
    const int aoff = lds_byte(wr * 64 + fr, fq * 8), boff = lds_byte(wc * 32 + fr, fq * 8);
#define PG8_SA(b, h) (((b) * 2 + (h)) * HTB)
#define PG8_SB(b, h) ((4 + (b) * 2 + (h)) * HTB)
#define PG8_STAGE(bufoff, gbase, voff) do { _Pragma("unroll") for (int _i = 0; _i < 2; ++_i) \
        __builtin_amdgcn_global_load_lds((const unsigned*)((const char*)(gbase) + (voff)[_i]), (PG8_LAS unsigned*)(lds + (bufoff) + ldsw + _i * 8192), 16, 0, 0); } while (0)
#define PG8_LDA(dst, b, h) do { _Pragma("unroll") for (int m = 0; m < 4; ++m) _Pragma("unroll") for (int k = 0; k < 2; ++k) dst[m][k] = *(const PG8_LAS bf16x8*)(lds + PG8_SA(b, h) + aoff + m * 2048 + k * 1024); } while (0)
#define PG8_LDB(dst, b, h) do { _Pragma("unroll") for (int n = 0; n < 2; ++n) _Pragma("unroll") for (int k = 0; k < 2; ++k) dst[n][k] = *(const PG8_LAS bf16x8*)(lds + PG8_SB(b, h) + boff + n * 2048 + k * 1024); } while (0)
#define PG8_MMA(ai, bj, At, Bt) do { __builtin_amdgcn_s_setprio(1); _Pragma("unroll") for (int m = 0; m < 4; ++m) _Pragma("unroll") for (int n = 0; n < 2; ++n) _Pragma("unroll") for (int k = 0; k < 2; ++k) \
        acc[ai][bj][m][n] = __builtin_amdgcn_mfma_f32_16x16x32_bf16(Bt[n][k], At[m][k], acc[ai][bj][m][n], 0, 0, 0); __builtin_amdgcn_s_setprio(0); } while (0)
#define PG8_WAIT_V(n) asm volatile("s_waitcnt vmcnt(" #n ")" ::: "memory")
#define PG8_WAIT_L(n) asm volatile("s_waitcnt lgkmcnt(" #n ")" ::: "memory")
#define PG8_BAR __builtin_amdgcn_s_barrier()
#define PG8_SCHED __builtin_amdgcn_sched_barrier(0)
    Unit cur, nxt; int ui = 0;
    if (!S.next(0, cur)) return;
    f32x4 acc[2][2][4][2];
#pragma unroll
    for (int a = 0; a < 2; ++a)
#pragma unroll
        for (int b = 0; b < 2; ++b)
#pragma unroll
            for (int m = 0; m < 4; ++m)
#pragma unroll
                for (int n = 0; n < 2; ++n) acc[a][b][m][n] = (f32x4){0.f, 0.f, 0.f, 0.f};
    bf16x8 At[4][2], B0[2][2], B1[2][2];
    const char* cA = (const char*)g.A + (size_t)cur.pm * tstep; const char* cB = (const char*)g.Bt + (size_t)cur.pn * tstep;
    S.a_ready(cur);
    if constexpr (SP2) {
        PG8_STAGE(PG8_SB(0, 0), cB, voffB); PG8_STAGE(PG8_SB(0, 1), cB + hstep, voffB); PG8_STAGE(PG8_SA(0, 0), cA, voffA); PG8_STAGE(PG8_SA(0, 1), cA + hstep, voffA);
        if (wr == 1) PG8_BAR;
        PG8_WAIT_V(2); PG8_BAR;
        PG8_STAGE(PG8_SB(1, 0), cB + kstep, voffB); PG8_STAGE(PG8_SA(1, 0), cA + kstep, voffA); PG8_STAGE(PG8_SB(1, 1), cB + hstep + kstep, voffB);
        PG8_WAIT_V(6); PG8_BAR;
    } else {
        PG8_STAGE(PG8_SB(0, 0), cB, voffB); PG8_STAGE(PG8_SA(0, 0), cA, voffA); PG8_STAGE(PG8_SB(0, 1), cB + hstep, voffB); PG8_STAGE(PG8_SA(0, 1), cA + hstep, voffA);
        if (wr == 1) PG8_BAR;
        PG8_WAIT_V(4); PG8_BAR;
        PG8_STAGE(PG8_SB(1, 0), cB + kstep, voffB); PG8_STAGE(PG8_SA(1, 0), cA + kstep, voffA); PG8_STAGE(PG8_SB(1, 1), cB + hstep + kstep, voffB);
        PG8_WAIT_V(6); PG8_BAR;
    }
    for (;;) {
        const bool has_next = S.next(ui + 1, nxt);
        const char* nA = has_next ? (const char*)g.A + (size_t)nxt.pm * tstep : cA; const char* nB = has_next ? (const char*)g.Bt + (size_t)nxt.pn * tstep : cB;
        for (int t = 0; t < nt; t += 2) {
            const bool last = (t == nt - 2);
            const char* a1 = cA + (size_t)(t + 1) * kstep;
            const char* a2 = last ? nA : cA + (size_t)(t + 2) * kstep; const char* b2 = last ? nB : cB + (size_t)(t + 2) * kstep;
            const char* a3 = a2 + kstep; const char* b3 = b2 + kstep;
            if (last && has_next) S.a_ready(nxt);
            if constexpr (SP2) {
            PG8_LDB(B0, 0, 0); PG8_LDB(B1, 0, 1); PG8_SCHED; PG8_LDA(At, 0, 0); PG8_STAGE(PG8_SA(1, 1), a1 + hstep, voffA);
            PG8_WAIT_V(8); PG8_WAIT_L(0); PG8_BAR; PG8_MMA(0, 0, At, B0); PG8_MMA(0, 1, At, B1); PG8_BAR; PG8_SCHED;
            PG8_LDA(At, 0, 1); PG8_STAGE(PG8_SB(0, 0), b2, voffB); PG8_STAGE(PG8_SB(0, 1), b2 + hstep, voffB); PG8_STAGE(PG8_SA(0, 0), a2, voffA);
            PG8_WAIT_V(8); PG8_WAIT_L(0); PG8_BAR; PG8_MMA(1, 0, At, B0); PG8_MMA(1, 1, At, B1); PG8_BAR; PG8_SCHED;
            PG8_LDB(B0, 1, 0); PG8_LDB(B1, 1, 1); PG8_SCHED; PG8_LDA(At, 1, 0); PG8_STAGE(PG8_SA(0, 1), a2 + hstep, voffA);
            PG8_WAIT_V(8); PG8_WAIT_L(0); PG8_BAR; PG8_MMA(0, 0, At, B0); PG8_MMA(0, 1, At, B1); PG8_BAR; PG8_SCHED;
            PG8_LDA(At, 1, 1); PG8_STAGE(PG8_SB(1, 0), b3, voffB); PG8_STAGE(PG8_SB(1, 1), b3 + hstep, voffB); PG8_STAGE(PG8_SA(1, 0), a3, voffA);
            PG8_WAIT_V(8); PG8_WAIT_L(0); PG8_BAR; PG8_MMA(1, 0, At, B0); PG8_MMA(1, 1, At, B1); PG8_BAR; PG8_SCHED;
            } else {
            PG8_LDB(B0, 0, 0); PG8_SCHED; PG8_LDA(At, 0, 0); PG8_STAGE(PG8_SA(1, 1), a1 + hstep, voffA);
            PG8_WAIT_L(8); PG8_BAR; PG8_WAIT_L(0); PG8_MMA(0, 0, At, B0); PG8_BAR; PG8_SCHED;
            PG8_LDB(B1, 0, 1); PG8_STAGE(PG8_SB(0, 0), b2, voffB);
            PG8_BAR; PG8_WAIT_L(0); PG8_MMA(0, 1, At, B1); PG8_BAR;
            PG8_LDA(At, 0, 1); PG8_STAGE(PG8_SA(0, 0), a2, voffA);
            PG8_BAR; PG8_WAIT_L(0); PG8_MMA(1, 0, At, B0); PG8_BAR; PG8_SCHED;
            PG8_STAGE(PG8_SB(0, 1), b2 + hstep, voffB);
            PG8_WAIT_V(6); PG8_BAR; PG8_MMA(1, 1, At, B1); PG8_BAR;
            PG8_LDB(B0, 1, 0); PG8_SCHED; PG8_LDA(At, 1, 0); PG8_STAGE(PG8_SA(0, 1), a2 + hstep, voffA);
            PG8_WAIT_L(8); PG8_BAR; PG8_WAIT_L(0); PG8_MMA(0, 0, At, B0); PG8_BAR; PG8_SCHED;
            PG8_LDB(B1, 1, 1); PG8_STAGE(PG8_SB(1, 0), b3, voffB);
            PG8_BAR; PG8_WAIT_L(0); PG8_MMA(0, 1, At, B1); PG8_BAR;
            PG8_LDA(At, 1, 1); PG8_STAGE(PG8_SA(1, 0), a3, voffA);
            PG8_BAR; PG8_WAIT_L(0); PG8_MMA(1, 0, At, B0); PG8_BAR; PG8_SCHED;
            PG8_STAGE(PG8_SB(1, 1), b3 + hstep, voffB);
            PG8_WAIT_V(6); PG8_BAR; PG8_MMA(1, 1, At, B1); PG8_BAR;
            }
        }
        if constexpr (ALIGN_EPI) { if (wr == 0) PG8_BAR; }
        if constexpr (!Epi::AFTER_DRAIN) { E(acc, cur, wr, wc, fr, fq); S.done(cur); }
        if (!has_next) break;
#pragma unroll
        for (int a = 0; a < 2; ++a)
#pragma unroll
            for (int b = 0; b < 2; ++b)
#pragma unroll
                for (int m = 0; m < 4; ++m)
#pragma unroll
                    for (int n = 0; n < 2; ++n) acc[a][b][m][n] = (f32x4){0.f, 0.f, 0.f, 0.f};
        cur = nxt; cA = nA; cB = nB; ++ui;
        if constexpr (ALIGN_EPI) { if (wr == 1) PG8_BAR; }
    }
    PG8_WAIT_V(0);
    if constexpr (!ALIGN_EPI) { if (wr == 0) PG8_BAR; }
    PG8_BAR;
    if constexpr (Epi::AFTER_DRAIN) { E.fused(acc, cur, wr, wc, fr, fq, lds, wid, lane); S.done(cur); }
#undef PG8_SA
#undef PG8_SB
#undef PG8_STAGE
#undef PG8_LDA
#undef PG8_LDB
#undef PG8_MMA
#undef PG8_WAIT_V
#undef PG8_WAIT_L
#undef PG8_BAR
#undef PG8_SCHED
}
}
namespace swa {
constexpr int D = 128;
constexpr int KVPITCH = 6656, QPITCH = 6656, OPITCH = 2048;
constexpr float THR = 8.f;
constexpr bool WSKIP = false;
constexpr float SCALE = 0.08838834764831845f;
constexpr int NW = 8, QBLK = 32, KVBLK = 64, QB = NW * QBLK;
constexpr int SHM_V = KVBLK * D * 2, SHM_K = KVBLK * D * 2;
constexpr int LDS_BYTES = 2 * SHM_V + 2 * SHM_K + NW * 64 * 4;
using bf16 = __hip_bfloat16;
typedef short bf16x8 __attribute__((ext_vector_type(8)));
typedef short s16x4 __attribute__((ext_vector_type(4)));
typedef float f32x16 __attribute__((ext_vector_type(16)));
typedef float f32x4 __attribute__((ext_vector_type(4)));
typedef unsigned u32x4 __attribute__((ext_vector_type(4)));
template <class A, class Bt> struct same_t { static constexpr bool v = false; };
template <class A> struct same_t<A, A> { static constexpr bool v = true; };

#define KSWZ(row, colB) ((row) * 256 + ((colB) ^ (((row) & 7) << 4)))
#define SBAR() __builtin_amdgcn_sched_barrier(0)
__device__ __forceinline__ int v_st(int k, int c) { const int kk = (k & ~0xC) | ((k & 4) << 1) | ((k & 8) >> 1); return ((kk >> 3) * 4 + (c >> 5)) * 512 + ((kk & 7) * 32 + (c & 31)) * 2; }
__device__ __forceinline__ int v_rd_base(int lane) { return ((lane & 3) << 3) | (((lane >> 2) & 3) << 6) | (((lane >> 4) & 1) << 5) | (((lane >> 5) & 1) << 8); }
constexpr int v_rd_off(int d0, int ks, int half) { return d0 * 512 + ks * 4096 + half * 2048; }
__device__ __forceinline__ int crow(int r, int hi) { return (r & 3) + 8 * (r >> 2) + 4 * hi; }
__device__ __forceinline__ unsigned cvtpk(float lo, float hi) {
    unsigned r; asm volatile("v_cvt_pk_bf16_f32 %0, %1, %2" : "=v"(r) : "v"(lo), "v"(hi)); return r;
}
__device__ __forceinline__ bf16x8 pack8(f32x4 a, f32x4 b) {
    u32x4 w = {cvtpk(a[0], a[1]), cvtpk(a[2], a[3]), cvtpk(b[0], b[1]), cvtpk(b[2], b[3])};
    return *reinterpret_cast<bf16x8*>(&w);
}
template <class T> __device__ __forceinline__ bf16x8 load8(const T* p) {
    if constexpr (same_t<T, float>::v) { return pack8(*(const f32x4*)p, *(const f32x4*)(p + 4)); }
    else { return *reinterpret_cast<const bf16x8*>(p); }
}
__device__ __forceinline__ void mask_tile(f32x16& p0, f32x16& p1, int dq, unsigned W) {
    const float NEG = -__builtin_inff();
#pragma unroll
    for (int r = 0; r < 16; ++r) {
        const int c = (r & 3) + 8 * (r >> 2);
        if ((unsigned)(dq - c) >= W) p0[r] = NEG;
        if ((unsigned)(dq - c - 32) >= W) p1[r] = NEG;
    }
}
__device__ __forceinline__ void partialSM(f32x16& p0, f32x16& p1, float& m_reg, float& mn, float& alpha) {
    float pmax = p0[0]; for (int r = 1; r < 16; ++r) pmax = fmaxf(pmax, p0[r]); for (int r = 0; r < 16; ++r) pmax = fmaxf(pmax, p1[r]);
    { auto rr = __builtin_amdgcn_permlane32_swap(__float_as_uint(pmax), __float_as_uint(pmax), false, false);
      pmax = fmaxf(__uint_as_float(rr[0]), __uint_as_float(rr[1])); }
    constexpr float C2 = 1.4426950408889634f * SCALE;
    if (__builtin_expect(__all((pmax - m_reg) * SCALE <= THR), 1)) { mn = m_reg; alpha = 1.f; }
    else { mn = fmaxf(m_reg, pmax); alpha = __builtin_amdgcn_exp2f((m_reg - mn) * C2); m_reg = mn; }
    const float mnL = -mn * C2;
    for (int r = 0; r < 16; ++r) p0[r] = fmaf(p0[r], C2, mnL); for (int r = 0; r < 16; ++r) p1[r] = fmaf(p1[r], C2, mnL);
    for (int r = 0; r < 16; ++r) p0[r] = __builtin_amdgcn_exp2f(p0[r]);
}
__device__ __forceinline__ void finishSM(f32x16& p0, f32x16& p1, float alpha, float& l_reg, bf16x8& pa0, bf16x8& pa1, bf16x8& pa2, bf16x8& pa3) {
    for (int r = 0; r < 16; ++r) p1[r] = __builtin_amdgcn_exp2f(p1[r]);
    float ps = 0; for (int r = 0; r < 16; ++r) ps += p0[r]; for (int r = 0; r < 16; ++r) ps += p1[r];
    { auto rr = __builtin_amdgcn_permlane32_swap(__float_as_uint(ps), __float_as_uint(ps), false, false);
      ps = __uint_as_float(rr[0]) + __uint_as_float(rr[1]); }
    l_reg = l_reg * alpha + ps;
#define PK4(P, B_, OUT) do { unsigned a0 = cvtpk(P[B_+0], P[B_+1]), a1 = cvtpk(P[B_+2], P[B_+3]);                          \
        unsigned b0 = cvtpk(P[B_+4], P[B_+5]), b1 = cvtpk(P[B_+6], P[B_+7]);                                             \
        auto r0 = __builtin_amdgcn_permlane32_swap(a0, b0, false, false); auto r1 = __builtin_amdgcn_permlane32_swap(a1, b1, false, false); \
        u32x4 w = {r0[0], r1[0], r0[1], r1[1]}; OUT = *reinterpret_cast<bf16x8*>(&w); } while (0)
    PK4(p0, 0, pa0); PK4(p0, 8, pa1); PK4(p1, 0, pa2); PK4(p1, 8, pa3);
#undef PK4
}
template <int KB, bool SK>
__device__ __forceinline__ void qkt(f32x16& p0, f32x16& p1, const char* K_lds, int r32, int hi, const bf16x8* qr, bool act) {
    if (SK && !act) { const float NEG = -__builtin_inff();
#pragma unroll
        for (int r = 0; r < 16; ++r) { p0[r] = NEG; p1[r] = NEG; } return; }
    p0 = f32x16{}; p1 = f32x16{};
    const char* kb[4];
#pragma unroll
    for (int dd = 0; dd < 4; ++dd) kb[dd] = K_lds + KB * SHM_K + KSWZ(r32, (dd * 16 + hi * 8) * 2);
#pragma unroll
    for (int d0 = 0; d0 < 8; ++d0) { const char* a = kb[d0 & 3] + (d0 >> 2) * 128;
        bf16x8 b0 = *reinterpret_cast<const bf16x8*>(a);
        bf16x8 b1 = *reinterpret_cast<const bf16x8*>(a + 32 * 256);
        p0 = __builtin_amdgcn_mfma_f32_32x32x16_bf16(b0, qr[d0], p0, 0, 0, 0);
        p1 = __builtin_amdgcn_mfma_f32_32x32x16_bf16(b1, qr[d0], p1, 0, 0, 0); }
}
template <int VB, bool SK>
__device__ __forceinline__ void pv_tile(f32x16* o, int vb0, bf16x8 pa0, bf16x8 pa1, bf16x8 pa2, bf16x8 pa3, bool act) {
    if (SK && !act) return;
#define TRRD(dst, off) asm volatile("ds_read_b64_tr_b16 %0, %1 offset:%2" : "=&v"(dst) : "v"(vb0), "i"(off) : "memory")
#define PV_D0(d0) do { s16x4 l0, l1, l2, l3, h0, h1, h2, h3; constexpr int b_ = VB * SHM_V + v_rd_off(d0, 0, 0);     \
        TRRD(l0, b_); TRRD(h0, b_ + 2048); TRRD(l1, b_ + 4096); TRRD(h1, b_ + 6144); TRRD(l2, b_ + 8192); TRRD(h2, b_ + 10240); TRRD(l3, b_ + 12288); TRRD(h3, b_ + 14336); \
        asm volatile("s_waitcnt lgkmcnt(0)" ::: "memory"); SBAR();                 \
        o[d0] = __builtin_amdgcn_mfma_f32_32x32x16_bf16(pa0, (bf16x8){l0[0], l0[1], l0[2], l0[3], h0[0], h0[1], h0[2], h0[3]}, o[d0], 0, 0, 0);   \
        o[d0] = __builtin_amdgcn_mfma_f32_32x32x16_bf16(pa1, (bf16x8){l1[0], l1[1], l1[2], l1[3], h1[0], h1[1], h1[2], h1[3]}, o[d0], 0, 0, 0);   \
        o[d0] = __builtin_amdgcn_mfma_f32_32x32x16_bf16(pa2, (bf16x8){l2[0], l2[1], l2[2], l2[3], h2[0], h2[1], h2[2], h2[3]}, o[d0], 0, 0, 0);   \
        o[d0] = __builtin_amdgcn_mfma_f32_32x32x16_bf16(pa3, (bf16x8){l3[0], l3[1], l3[2], l3[3], h3[0], h3[1], h3[2], h3[3]}, o[d0], 0, 0, 0); } while (0)
    PV_D0(0); PV_D0(1); PV_D0(2); PV_D0(3);
#undef PV_D0
#undef TRRD
}

template <class TIn, class TOut> struct BlockRef { const TIn* Q; const TIn* K; const TIn* V; TOut* O; int P0; };
template <class TIn> struct Seam {
    bf16x8 qr[8];
    bf16x8 st_v0, st_v1, st_k0, st_k1; f32x4 sf0, sf1, sf2, sf3;
    f32x4 tq[16];
};
__device__ __forceinline__ int swa_jlo(int P0, int W) { const int lowk = P0 - W + 1; return lowk > 0 ? lowk / KVBLK : 0; }
#define ROW(p, k0, rr) ((p) + (size_t)((k0) + (rr)) * KVPITCH + sc)
#define VMW() asm volatile("s_waitcnt vmcnt(0)" ::: "memory")
#define VMWN(n) asm volatile("s_waitcnt vmcnt(%0)" :: "i"(n) : "memory")
#define SLOAD_H(Kp, Vp, k0) do { S.st_v0 = load8<TIn>(ROW(Vp, k0, sr)); S.st_v1 = load8<TIn>(ROW(Vp, k0, 32 + sr));              \
                         S.st_k0 = load8<TIn>(ROW(Kp, k0, sr)); S.st_k1 = load8<TIn>(ROW(Kp, k0, 32 + sr)); } while (0)
#define SWRITE_HK(bf) do { *(bf16x8*)(K_lds + (bf) * SHM_K + kws) = S.st_k0; *(bf16x8*)(K_lds + (bf) * SHM_K + kws + 32 * 256) = S.st_k1; } while (0)
#define SWRITE_HV(bf) do { *(bf16x8*)(V_lds + (bf) * SHM_V + vst0) = S.st_v0; *(bf16x8*)(V_lds + (bf) * SHM_V + vst1) = S.st_v1; } while (0)
#define SWRITE_H(bf) do { SWRITE_HV(bf); SWRITE_HK(bf); } while (0)
#define SLOAD_F(p, k0) do { S.sf0 = *(const f32x4*)ROW(p, k0, sr); S.sf1 = *(const f32x4*)(ROW(p, k0, sr) + 4);                \
                            S.sf2 = *(const f32x4*)ROW(p, k0, 32 + sr); S.sf3 = *(const f32x4*)(ROW(p, k0, 32 + sr) + 4); } while (0)
#define SWRITE_KF(bf) do { *(bf16x8*)(K_lds + (bf) * SHM_K + kws) = pack8(S.sf0, S.sf1); *(bf16x8*)(K_lds + (bf) * SHM_K + kws + 32 * 256) = pack8(S.sf2, S.sf3); } while (0)
#define SWRITE_VF(bf) do { *(bf16x8*)(V_lds + (bf) * SHM_V + vst0) = pack8(S.sf0, S.sf1); *(bf16x8*)(V_lds + (bf) * SHM_V + vst1) = pack8(S.sf2, S.sf3); } while (0)
template <class TIn, class TOut>
__device__ __forceinline__ void causal_swa_prime(const BlockRef<TIn, TOut>& cur, int W, char* lds, Seam<TIn>& S) {
    constexpr bool F32 = same_t<TIn, float>::v;
    int tid_ = threadIdx.x; asm volatile("" : "+v"(tid_)); const int tid = tid_, wid = __builtin_amdgcn_readfirstlane(tid >> 6), lane = tid & 63, r32 = lane & 31, hi = lane >> 5;
    const int sr = tid >> 4, sc = (tid & 15) * 8, kws = KSWZ(sr, sc * 2); char* K_lds = lds + 2 * SHM_V;
    const int kb0 = swa_jlo(cur.P0, W) * KVBLK;
    for (int d0 = 0; d0 < 8; ++d0) S.qr[d0] = load8<TIn>(cur.Q + (size_t)(wid * QBLK + r32) * QPITCH + d0 * 16 + hi * 8);
    if constexpr (F32) { SLOAD_F((const float*)cur.K, kb0); VMW(); SWRITE_KF(0); SBAR(); SLOAD_F((const float*)cur.V, kb0); }
    else { SLOAD_H(cur.K, cur.V, kb0); VMW(); SWRITE_HK(0); }
    __syncthreads();
}
template <class TIn, class TOut>
__device__ __forceinline__ void causal_swa_block(const BlockRef<TIn, TOut>& cur, const BlockRef<TIn, TOut>& nxt, int skv, int W, char* lds, Seam<TIn>& S) {
    constexpr bool F32 = same_t<TIn, float>::v;
    int tid_ = threadIdx.x; asm volatile("" : "+v"(tid_)); const int tid = tid_, wid = __builtin_amdgcn_readfirstlane(tid >> 6), lane = tid & 63, r32 = lane & 31, hi = lane >> 5;
    const int j_lo = swa_jlo(cur.P0, W);
    int j_hi = (cur.P0 + QB - 1) / KVBLK + 1; if (j_hi > skv / KVBLK) j_hi = skv / KVBLK;
    const int NT = j_hi - j_lo;
    const int kbn = swa_jlo(nxt.P0, W) * KVBLK;
    const int qlo = cur.P0 + wid * QBLK, qm = qlo + r32 - 4 * hi;
    char* V_lds = lds; char* K_lds = lds + 2 * SHM_V;
    float* ws = (float*)(lds + 2 * SHM_V + 2 * SHM_K) + wid * 64; float* li_l = ws, * al_l = ws + 32;
    float m_reg = -1e30f, l_reg = 0; f32x16 o[4] = {};
    const int sr = tid >> 4, sc = (tid & 15) * 8, vst0 = v_st(sr, sc), vst1 = v_st(32 + sr, sc), kws = KSWZ(sr, sc * 2);
    const int vb0 = (int)(uintptr_t)V_lds + v_rd_base(lane);
    const TIn* Kh = cur.K; const TIn* Vh = cur.V;
#define RESC(a) do { if (__any((a) < 1.f)) { if (hi == 0) al_l[r32] = (a); asm volatile("s_waitcnt lgkmcnt(0)" ::: "memory");              \
                     for (int d_ = 0; d_ < 4; ++d_) for (int r = 0; r < 16; ++r) o[d_][r] *= al_l[crow(r, hi)]; } } while (0)
#define KBASE(t) ((j_lo + (t)) * KVBLK)
#define ACT(t) (KBASE(t) <= qlo + QBLK - 1 && KBASE(t) + KVBLK - 1 >= qlo - W + 1)
#define MASKT(P0_, P1_, t) do { const int kb_ = KBASE(t); if ((!SK || ACT(t)) && (kb_ + KVBLK - 1 > qlo || kb_ <= qlo + QBLK - 1 - W)) mask_tile(P0_, P1_, qm - kb_, (unsigned)W); } while (0)
    constexpr int NQL = F32 ? 16 : 8;
    constexpr bool SK = WSKIP && !F32;
#define SEAM_K0() do { VMWN(NQL); if constexpr (F32) { SWRITE_KF(0); SBAR(); SLOAD_F((const float*)nxt.V, kbn); } else { SWRITE_HK(0); } SBAR(); } while (0)
    f32x16 pA0, pA1, pB0, pB1; float mnA, mnB, alA, alB; bf16x8 pa0, pa1, pa2, pa3;
    if constexpr (F32) { VMW(); SWRITE_VF(0); SBAR(); } else { SWRITE_HV(0); SBAR(); }
    if (NT > 1) { if constexpr (F32) SLOAD_F((const float*)Kh, KBASE(1)); else SLOAD_H(Kh, Vh, KBASE(1)); }
    SBAR(); qkt<0, SK>(pA0, pA1, K_lds, r32, hi, S.qr, ACT(0));
    if constexpr (F32) { if (NT > 1) { VMW(); SWRITE_KF(1); SBAR(); SLOAD_F((const float*)Vh, KBASE(1)); } }
    MASKT(pA0, pA1, 0); partialSM(pA0, pA1, m_reg, mnA, alA);
    if (NT > 1) { VMW(); if constexpr (F32) { SWRITE_VF(1); SBAR(); if (NT > 2) SLOAD_F((const float*)Kh, KBASE(2)); } else SWRITE_H(1); }
    __syncthreads();
#define HALF_STEP(PX0, PX1, mnX, alX, PY0, PY1, alY, t, KB, VB, SB) do {                                                      \
        SBAR(); qkt<KB, SK>(PX0, PX1, K_lds, r32, hi, S.qr, ACT(t));                                             \
        finishSM(PY0, PY1, alY, l_reg, pa0, pa1, pa2, pa3); SBAR();                                                           \
        if ((t) + 1 < NT) { if constexpr (F32) { VMW(); SWRITE_KF(SB); SBAR(); SLOAD_F((const float*)Vh, KBASE((t) + 1)); }  \
                            else { SLOAD_H(Kh, Vh, KBASE((t) + 1)); } SBAR(); }                                               \
        pv_tile<VB, SK>(o, vb0, pa0, pa1, pa2, pa3, ACT((t) - 1)); MASKT(PX0, PX1, (t)); partialSM(PX0, PX1, m_reg, mnX, alX);                                        \
        __syncthreads();                                                                                                      \
        if ((t) + 1 < NT) { VMW(); if constexpr (F32) { SWRITE_VF(SB); SBAR(); if ((t) + 2 < NT) SLOAD_F((const float*)Kh, KBASE((t) + 2)); } \
                            else { SWRITE_H(SB); } }                                                                          \
        RESC(alX); __syncthreads(); } while (0)
    for (int t = 1; t + 1 < NT; t += 2) {
        HALF_STEP(pB0, pB1, mnB, alB, pA0, pA1, alA, t, 1, 0, 0);
        HALF_STEP(pA0, pA1, mnA, alA, pB0, pB1, alB, t + 1, 0, 1, 1);
    }
    const bool even = (NT & 1) == 0;
    if (even) { SBAR(); qkt<1, SK>(pB0, pB1, K_lds, r32, hi, S.qr, ACT(NT - 1)); SBAR(); }
#define QROW(e) (nxt.Q + (size_t)(wid * QBLK + r32) * QPITCH + ((e) >> 1) * 16 + hi * 8 + ((e) & 1) * 4)
    if constexpr (F32) { SLOAD_F((const float*)nxt.K, kbn); SBAR();
#pragma unroll
        for (int e = 0; e < 8; ++e) S.tq[e] = *(const f32x4*)QROW(e); }
    else { SLOAD_H(nxt.K, nxt.V, kbn); SBAR();
#pragma unroll
        for (int d0 = 0; d0 < 8; ++d0) S.qr[d0] = load8<TIn>(nxt.Q + (size_t)(wid * QBLK + r32) * QPITCH + d0 * 16 + hi * 8); }
    SBAR();
    finishSM(pA0, pA1, alA, l_reg, pa0, pa1, pa2, pa3); SBAR();
    if constexpr (F32) {
#pragma unroll
        for (int e = 8; e < 16; ++e) S.tq[e] = *(const f32x4*)QROW(e); SBAR(); }
#undef QROW
    pv_tile<0, SK>(o, vb0, pa0, pa1, pa2, pa3, ACT(even ? NT - 2 : NT - 1));
    if (even) { MASKT(pB0, pB1, NT - 1); partialSM(pB0, pB1, m_reg, mnB, alB); __syncthreads(); RESC(alB);
        finishSM(pB0, pB1, alB, l_reg, pa0, pa1, pa2, pa3); SBAR(); pv_tile<1, SK>(o, vb0, pa0, pa1, pa2, pa3, ACT(NT - 1)); }
    SBAR(); SEAM_K0();
    if (hi == 0) li_l[r32] = l_reg; asm volatile("s_waitcnt lgkmcnt(0)" ::: "memory");
    float rli[16];
#pragma unroll
    for (int r = 0; r < 16; ++r) rli[r] = __builtin_amdgcn_rcpf(li_l[crow(r, hi)]);
    TOut* Ow = cur.O + (size_t)(wid * QBLK) * OPITCH;
#pragma unroll
    for (int r = 0; r < 16; ++r) { const int orow = crow(r, hi);
#pragma unroll
        for (int d0 = 0; d0 < 4; ++d0) { const float v = o[d0][r] * rli[r];
            if constexpr (same_t<TOut, float>::v) { Ow[(size_t)orow * OPITCH + d0 * 32 + r32] = v; }
            else { const float vn = __shfl_xor(v, 1);
                   if ((r32 & 1) == 0) *(unsigned*)(Ow + (size_t)orow * OPITCH + d0 * 32 + r32) = cvtpk(v, vn); } } }
    if constexpr (F32) {
#pragma unroll
        for (int d0 = 0; d0 < 8; ++d0) S.qr[d0] = pack8(S.tq[2 * d0], S.tq[2 * d0 + 1]); }
    __syncthreads();
#undef RESC
#undef KBASE
#undef ACT
#undef MASKT
#undef SEAM_K0
#undef HALF_STEP
}
#undef ROW
#undef VMW
#undef VMWN
#undef SLOAD_H
#undef SWRITE_HK
#undef SWRITE_HV
#undef SWRITE_H
#undef SLOAD_F
#undef SWRITE_KF
#undef SWRITE_VF

}
constexpr int NWAVES = 8;
#ifndef MK_SPLIT
#define MK_SPLIT 0
#endif
constexpr int BATCH = 16, SEQ = 2048, DM = 2048, M = BATCH * SEQ, DEPTH = 2, DFF = 8192;
constexpr int IN_COLS = 6160;
constexpr int NPROJ = 6656;
constexpr int C_GQ = 0, C_GK = 512, C_GV = 1024, C_GG = 2048, C_GATE = 3072, C_DQ = 3584, C_DK = 4608, C_DV = 5632;
constexpr int S_LR = 3072, S_SHIFT = 496;
constexpr int PH_PER_LAYER = 9, N_PHASES = 1 + DEPTH * PH_PER_LAYER;
constexpr float NORM_EPS = 1e-6f, SUBLN_EPS = 1e-5f;
constexpr float GLA_QSCALE = 0.08838834764831845f;

constexpr size_t MiB = 1u << 20;
constexpr size_t WS_CTL = 0, CTL_ZERO_BYTES = 1 * MiB;
constexpr size_t WS_BIAS = 1 * MiB;
constexpr size_t WS_COS = 2 * MiB, WS_SIN = 10 * MiB;
constexpr size_t WS_WIN = 18 * MiB;
constexpr size_t WS_WOUT = 70 * MiB;
constexpr size_t WS_WUP = 86 * MiB;
constexpr size_t WS_WDN = 150 * MiB;
constexpr size_t WS_XN = 214 * MiB;
constexpr size_t WS_PROJ = 342 * MiB;
constexpr size_t WS_O = 758 * MiB;
constexpr size_t WS_HID = 342 * MiB;
constexpr size_t WS_END = 1014 * MiB;
static_assert(WS_WIN + (size_t)DEPTH * NPROJ * DM * 2 <= WS_WOUT && WS_WOUT + (size_t)DEPTH * DM * DM * 2 <= WS_WUP && WS_WUP + (size_t)DEPTH * DFF * DM * 2 <= WS_WDN && WS_WDN + (size_t)DEPTH * DFF * DM * 2 <= WS_XN, "ws map: weights");
static_assert(WS_XN + (size_t)M * DM * 2 <= WS_PROJ && WS_PROJ + (size_t)M * NPROJ * 2 <= WS_O && WS_O + (size_t)M * 2048 * 4 <= WS_END && WS_HID + (size_t)M * DFF * 2 <= WS_END, "ws map: activations");
constexpr int CW_BAR = 4096;
constexpr int CW_Q = 8192;

constexpr int RING_OFF = 0, RING_BYTES = 131072;
constexpr int LDSCTL_OFF = RING_BYTES, MISC_OFF = LDSCTL_OFF + 320;
constexpr int LDS_BYTES = 147456;
static_assert(MISC_OFF + 128 <= LDS_BYTES, "LDS map");

#define GAS __attribute__((address_space(1)))
#define LAS __attribute__((address_space(3)))
#define DI __device__ __forceinline__
typedef unsigned short bf16;
typedef unsigned v4u __attribute__((ext_vector_type(4)));
typedef unsigned v2u __attribute__((ext_vector_type(2)));
typedef float f32x4 __attribute__((ext_vector_type(4)));
typedef float f32x2v __attribute__((ext_vector_type(2)));
typedef float f32x16 __attribute__((ext_vector_type(16)));
typedef short bf16x8 __attribute__((ext_vector_type(8)));
typedef short s16x4 __attribute__((ext_vector_type(4)));
typedef __bf16 bf16x2_t __attribute__((ext_vector_type(2)));
typedef GAS unsigned gu32;
#define RLX_AGENT __ATOMIC_RELAXED, __HIP_MEMORY_SCOPE_AGENT
#define LDS_WAIT() asm volatile("s_waitcnt lgkmcnt(0)" ::: "memory")
#define VM_WAIT() asm volatile("s_waitcnt vmcnt(0)" ::: "memory")
DI unsigned pk2(float lo, float hi) { f32x2v v = {lo, hi}; bf16x2_t b = __builtin_convertvector(v, bf16x2_t); return __builtin_bit_cast(unsigned, b); }
DI float bf_lo(unsigned u) { return __uint_as_float(u << 16); }
DI float bf_hi(unsigned u) { return __uint_as_float(u & 0xffff0000u); }
DI int opaque_tid() { int t = threadIdx.x; asm volatile("" : "+v"(t)); return t; }
#define PH_IDS const int tid = opaque_tid(), lane = tid & 63, wave = __builtin_amdgcn_readfirstlane(tid >> 6), gw = (int)blockIdx.x * NWAVES + wave; (void)lane; (void)gw
#define MFMA32(a, b, c) __builtin_amdgcn_mfma_f32_32x32x16_bf16((a), (b), (c), 0, 0, 0)

#define XB_TMO      128
#define XB_XCNT(j)  (256  + 64 * (j))
#define XB_XSUB(j)  (1280 + 64 * (j))
#define XB_XGEN(j)  (2304 + 64 * (j))
#define XB_TOP      3328
#define XB_TOPGEN   3392
#define XCD_BAR_WORDS 3456
#define XB_SPIN_CAP (1u << 18)

__device__ __forceinline__ unsigned xb_ld(unsigned* p)              { return __hip_atomic_load(p, __ATOMIC_RELAXED, __HIP_MEMORY_SCOPE_AGENT); }
__device__ __forceinline__ unsigned xb_add(unsigned* p, unsigned v) { return __hip_atomic_fetch_add(p, v, __ATOMIC_RELAXED, __HIP_MEMORY_SCOPE_AGENT); }
__device__ __forceinline__ unsigned xb_xcc_id() { return (unsigned)__builtin_amdgcn_s_getreg((3 << 11) | 20) & 0xFu; }
#define XB_SPIN(cond, bar) do { unsigned _sp = 0; while (cond) { __builtin_amdgcn_s_sleep(1); \
    if ((++_sp & 255u) == 0u) { if (xb_ld(&(bar)[XB_TMO])) break; if (_sp > XB_SPIN_CAP) { atomicAdd(&(bar)[XB_TMO], 1u); break; } } } } while (0)

struct XcdBarrier {
    unsigned* bar; unsigned x;
    volatile LAS unsigned* st;
};

__device__ __forceinline__ XcdBarrier xcd_barrier_post(unsigned* bar, volatile LAS unsigned* st) {
    XcdBarrier b; b.bar = bar; b.x = xb_xcc_id(); b.st = st;
    if (threadIdx.x == 0) (void)xb_add(&bar[XB_XCNT(b.x)], 1u);
    return b;
}
__device__ __forceinline__ void xcd_barrier_complete(unsigned* bar, unsigned x, unsigned& nloc, unsigned& nx) {
    const unsigned G = gridDim.x * gridDim.y * gridDim.z;
    unsigned sum, cnt, mine, sp = 0u;
    for (;;) {
        sum = 0u; cnt = 0u; mine = 0u;
#pragma unroll
        for (unsigned j = 0; j < 16; ++j) { const unsigned c = xb_ld(&bar[XB_XCNT(j)]); sum += c; cnt += (c > 0u) ? 1u : 0u; mine = (j == x) ? c : mine; }
        if (sum == G) break;
        __builtin_amdgcn_s_sleep(1);
        if ((++sp & 255u) == 0u) { if (xb_ld(&bar[XB_TMO])) break; if (sp > XB_SPIN_CAP) { atomicAdd(&bar[XB_TMO], 1u); break; } }
    }
    nloc = mine > 0u ? mine : 1u; nx = cnt > 0u ? cnt : 1u;
}

__device__ __forceinline__ void xcd_barrier(const XcdBarrier& b) {
    asm volatile("s_waitcnt vmcnt(0)" ::: "memory");
    __syncthreads();
    if (threadIdx.x == 0) {
        unsigned* bar = b.bar;
        __builtin_amdgcn_s_waitcnt(0);
        unsigned nloc = b.st[0], nx = b.st[1];
        if (nloc == 0u) { xcd_barrier_complete(bar, b.x, nloc, nx); b.st[0] = nloc; b.st[1] = nx; }
        const unsigned old = xb_add(&bar[XB_XSUB(b.x)], 1u);
        const unsigned gen = old / nloc;
        if (old + 1u == (gen + 1u) * nloc) {
            __builtin_amdgcn_fence(__ATOMIC_RELEASE, "agent");
            asm volatile("s_waitcnt vmcnt(0)" ::: "memory");
            const unsigned og = xb_add(&bar[XB_TOP], 1u);
            const unsigned tg = og / nx;
            if (og + 1u == (tg + 1u) * nx) xb_add(&bar[XB_TOPGEN], 1u);
            else XB_SPIN(xb_ld(&bar[XB_TOPGEN]) == tg, bar);
            __builtin_amdgcn_fence(__ATOMIC_ACQUIRE, "agent");
            xb_add(&bar[XB_XGEN(b.x)], 1u);
            asm volatile("s_waitcnt vmcnt(0)" ::: "memory");
        } else {
            XB_SPIN(xb_ld(&bar[XB_XGEN(b.x)]) == gen, bar);
            __builtin_amdgcn_fence(__ATOMIC_ACQUIRE, "agent");
            asm volatile("s_waitcnt vmcnt(0)" ::: "memory");
        }
    }
    __syncthreads();
}

struct Args { const void* in[18]; float* out; unsigned char* ws; int ph_lo, ph_hi; };
struct Frame {
    LAS unsigned char* lds;
    volatile LAS unsigned* MISC;
    gu32* ctl;
    int G, NGW;
    unsigned char* ws;
};
enum { I_X = 0, I_POS, I_ATTN_NW, I_WIN, I_GW2, I_GB, I_GLA_NW, I_QNW, I_KNW, I_LQ1, I_LK1, I_LQ2, I_LK2, I_SUBW, I_WOUT, I_MLP_NW, I_WUP, I_WDN };
typedef __attribute__((address_space(4))) const Args* kargs_t;
DI kargs_t kargs() { kargs_t p = (kargs_t)__builtin_amdgcn_kernarg_segment_ptr(); asm volatile("" : "+s"(p)); return p; }
#define INP(T, k) ((const T*)(const GAS T*)kargs()->in[k])
#define OUTP() ((float*)(GAS float*)kargs()->out)
DI GAS unsigned char* ws_opaque(Frame& F) { GAS unsigned char* w = (GAS unsigned char*)F.ws; asm volatile("" : "+s"(w)); return w; }
DI float wave_sum(float v) {
#pragma unroll
    for (int o = 1; o < 64; o <<= 1) v += __shfl_xor(v, o);
    return v;
}

DI void p0_write_tile(bf16* WT, int K, int drow0, int k0, LAS float* scr, int lane) {
    LDS_WAIT(); asm volatile("" ::: "memory");
    const int c = lane & 7;
#pragma unroll
    for (int j = 0; j < 4; ++j) { const int n = (lane >> 3) + 8 * j; const LAS float* s = scr + (8 * c) * 33 + n;
        v4u o; o.x = pk2(s[0 * 33], s[1 * 33]); o.y = pk2(s[2 * 33], s[3 * 33]); o.z = pk2(s[4 * 33], s[5 * 33]); o.w = pk2(s[6 * 33], s[7 * 33]);
        *(GAS v4u*)(WT + (size_t)(drow0 + n) * K + k0 + 8 * c) = o; }
    LDS_WAIT(); asm volatile("" ::: "memory");
}
DI void p0_transpose_tile(const float* W, int SP, int scol0, bf16* WT, int K, int drow0, int k0, LAS float* scr, int lane) {
#pragma unroll 8
    for (int i = 0; i < 32; ++i) { const int kk = 2 * i + (lane >> 5); scr[kk * 33 + (lane & 31)] = W[(size_t)(k0 + kk) * SP + scol0 + (lane & 31)]; }
    p0_write_tile(WT, K, drow0, k0, scr, lane);
}
DI void p0_gate_tile(const float* W, const float* w2, bf16* WT, int j0, int k0, LAS float* scr, int lane) {
    float w2r[16];
#pragma unroll
    for (int r = 0; r < 16; ++r) w2r[r] = w2[r * 512 + j0 + (lane & 31)];
#pragma unroll 4
    for (int i = 0; i < 32; ++i) { const int kk = 2 * i + (lane >> 5); const f32x4* wr = (const f32x4*)(W + (size_t)(k0 + kk) * IN_COLS + S_LR);
        float a = 0.f;
#pragma unroll
        for (int q = 0; q < 4; ++q) { const f32x4 t = wr[q]; a = fmaf(t.x, w2r[4 * q], a); a = fmaf(t.y, w2r[4 * q + 1], a); a = fmaf(t.z, w2r[4 * q + 2], a); a = fmaf(t.w, w2r[4 * q + 3], a); }
        scr[kk * 33 + (lane & 31)] = a; }
    p0_write_tile(WT, DM, C_GATE + j0, k0, scr, lane);
}
DI void sincos_red(float ang, float& s, float& c) {
    const double a = (double)ang; const double kq = __builtin_rint(a * 0.6366197723675814);
    double r = __builtin_fma(-kq, 1.5707963267948966, a); r = __builtin_fma(-kq, 6.123233995736766e-17, r);
    const float x = (float)r, x2 = x * x; const int q = (int)kq & 3;
    const float sp = x + x * x2 * (-1.6666654611e-1f + x2 * (8.3321608736e-3f + x2 * (-1.9515295891e-4f)));
    const float cp = 1.f - 0.5f * x2 + x2 * x2 * (4.166664568298827e-2f + x2 * (-1.388731625493765e-3f + x2 * 2.443315711809948e-5f));
    s = (q == 0) ? sp : (q == 1) ? cp : (q == 2) ? -sp : -cp;
    c = (q == 0) ? cp : (q == 1) ? -sp : (q == 2) ? -cp : sp;
}
DI void p0_prologue(Frame& F) {
    PH_IDS;
    LAS float* scr = (LAS float*)(F.lds + RING_OFF + wave * 16384);
    constexpr int NB_IN = NPROJ / 32, I_IN = (DM / 64) * NB_IN, I_OUT = (DM / 64) * (DM / 32), I_UP = (DM / 64) * (DFF / 32), I_DN = (DFF / 64) * (DM / 32), I_LAYER = I_IN + I_OUT + I_UP + I_DN;
    GAS unsigned char* ws = ws_opaque(F);
    bf16* WinT = (bf16*)(ws + WS_WIN); bf16* WoutT = (bf16*)(ws + WS_WOUT); bf16* WupT = (bf16*)(ws + WS_WUP); bf16* WdnT = (bf16*)(ws + WS_WDN);
    for (int it = gw; it < DEPTH * I_LAYER; it += F.NGW) {
        const int L = it / I_LAYER; int r = it - L * I_LAYER;
        if (r < I_IN) { const int kb = r / NB_IN, nb = r - kb * NB_IN, drow0 = nb * 32; const float* W = INP(float, I_WIN) + (size_t)L * DM * IN_COLS; bf16* WT = WinT + (size_t)L * NPROJ * DM;
            if (drow0 >= C_GATE && drow0 < C_DQ) p0_gate_tile(W, INP(float, I_GW2) + (size_t)L * 16 * 512, WT, drow0 - C_GATE, kb * 64, scr, lane);
            else p0_transpose_tile(W, IN_COLS, drow0 < C_GATE ? drow0 : drow0 - S_SHIFT, WT, DM, drow0, kb * 64, scr, lane);
            continue; }
        r -= I_IN;
        if (r < I_OUT) { const int kb = r / (DM / 32), nb = r % (DM / 32); p0_transpose_tile(INP(float, I_WOUT) + (size_t)L * DM * DM, DM, nb * 32, WoutT + (size_t)L * DM * DM, DM, nb * 32, kb * 64, scr, lane); continue; }
        r -= I_OUT;
        if (r < I_UP) { const int kb = r / (DFF / 32), nb = r % (DFF / 32); p0_transpose_tile(INP(float, I_WUP) + (size_t)L * DM * DFF, DFF, nb * 32, WupT + (size_t)L * DFF * DM, DM, nb * 32, kb * 64, scr, lane); continue; }
        r -= I_UP;
        { const int kb = r / (DM / 32), nb = r % (DM / 32); p0_transpose_tile(INP(float, I_WDN) + (size_t)L * DFF * DM, DM, nb * 32, WdnT + (size_t)L * DM * DFF, DFF, nb * 32, kb * 64, scr, lane); }
    }
    const int gt = gw * 64 + lane, NT = F.NGW * 64;
    float* bias = (float*)(ws + WS_BIAS); const float* gate_b = INP(float, I_GB); const int* pos = INP(int, I_POS);
    for (int i = gt; i < DEPTH * NPROJ; i += NT) { const int L = i / NPROJ, c = i - L * NPROJ; bias[i] = (c >= C_GATE && c < C_DQ) ? gate_b[L * 512 + c - C_GATE] : 0.f; }
    float* ct = (float*)(ws + WS_COS); float* st = (float*)(ws + WS_SIN);
    for (int i = gt; i < M * 64; i += NT) { const int row = i >> 6, f = i & 63;
        const float inv_freq = (float)exp2(-(double)f * (13.287712379549449 / 64.0));
        const float ang = (float)pos[row] * inv_freq; float s, c; sincos_red(ang, s, c); ct[i] = c; st[i] = s; }
}

DI void rmsnorm_phase(Frame& F, const float* x, const float* w, bf16* dst) {
    PH_IDS;
    const GAS f32x4* wr = (const GAS f32x4*)w + lane;
    for (int m = gw; m < M; m += F.NGW) {
        const GAS f32x4* xr = (const GAS f32x4*)(x + (size_t)m * DM) + lane;
        f32x4 v[8]; float s = 0.f;
#pragma unroll
        for (int j = 0; j < 8; ++j) { v[j] = xr[64 * j]; s += (v[j].x * v[j].x + v[j].y * v[j].y) + (v[j].z * v[j].z + v[j].w * v[j].w); }
        const float rstd = 1.0f / sqrtf(wave_sum(s) * (1.f / DM) + NORM_EPS);
        GAS v2u* o8 = (GAS v2u*)(dst + (size_t)m * DM) + lane;
#pragma unroll
        for (int j = 0; j < 8; ++j) { const f32x4 ww = wr[64 * j]; v2u o; o.x = pk2(v[j].x * rstd * ww.x, v[j].y * rstd * ww.y); o.y = pk2(v[j].z * rstd * ww.z, v[j].w * rstd * ww.w); o8[64 * j] = o; }
    }
}
DI void qkprep_phase(Frame& F, int L) {
    PH_IDS;
    GAS unsigned char* ws = ws_opaque(F);
    bf16* proj = (bf16*)(ws + WS_PROJ); const float* ct = (const float*)(ws + WS_COS); const float* st = (const float*)(ws + WS_SIN);
    const int ip = lane & 31, hv = lane >> 5;
    const float* qw = INP(float, I_QNW) + L * 128; const float* kw = INP(float, I_KNW) + L * 128;
    const f32x2v qw0 = *(const f32x2v*)(qw + 2 * ip), qw1 = *(const f32x2v*)(qw + 64 + 2 * ip), kw0 = *(const f32x2v*)(kw + 2 * ip), kw1 = *(const f32x2v*)(kw + 64 + 2 * ip);
    for (int m = gw; m < M; m += F.NGW) {
        bf16* p = proj + (size_t)m * NPROJ;
        const f32x2v c = *(const f32x2v*)(ct + (size_t)m * 64 + 2 * ip), s = *(const f32x2v*)(st + (size_t)m * 64 + 2 * ip);
        unsigned lo[8], hi[8];
#pragma unroll
        for (int it = 0; it < 8; ++it) { const int vi = 2 * it + hv; bf16* q = p + (it < 4 ? C_DQ + vi * 128 : C_DK + (vi - 8) * 128) + 2 * ip; lo[it] = *(const unsigned*)q; hi[it] = *(const unsigned*)(q + 64); }
#pragma unroll
        for (int it = 0; it < 8; ++it) { const int vi = 2 * it + hv; bf16* q = p + (it < 4 ? C_DQ + vi * 128 : C_DK + (vi - 8) * 128) + 2 * ip;
            const float t0 = bf_lo(lo[it]), t1 = bf_hi(lo[it]), t2 = bf_lo(hi[it]), t3 = bf_hi(hi[it]);
            float ss = (t0 * t0 + t1 * t1) + (t2 * t2 + t3 * t3);
#pragma unroll
            for (int o = 1; o < 32; o <<= 1) ss += __shfl_xor(ss, o);
            const float rstd = 1.0f / sqrtf(ss * (1.f / 128.f) + NORM_EPS);
            const f32x2v w0 = it < 4 ? qw0 : kw0, w1 = it < 4 ? qw1 : kw1;
            const float a0 = t0 * rstd * w0.x, a1 = t1 * rstd * w0.y, a2 = t2 * rstd * w1.x, a3 = t3 * rstd * w1.y;
            *(unsigned*)q = pk2(a0 * c.x - a2 * s.x, a1 * c.y - a3 * s.y);
            *(unsigned*)(q + 64) = pk2(a0 * s.x + a2 * c.x, a1 * s.y + a3 * c.y); }
    }
}
DI void combine_phase(Frame& F, int L) {
    PH_IDS;
    GAS unsigned char* ws = ws_opaque(F);
    const float* O = (const float*)(ws + WS_O); bf16* mix = (bf16*)(ws + WS_XN);
    const float* lq1 = INP(float, I_LQ1) + L * 128; const float* lk1 = INP(float, I_LK1) + L * 128; const float* lq2 = INP(float, I_LQ2) + L * 128; const float* lk2 = INP(float, I_LK2) + L * 128;
    const float lam_init = (L == 0) ? 0.2f : 0.35550906759096914f;
    float d1 = lq1[lane] * lk1[lane] + lq1[64 + lane] * lk1[64 + lane];
    float d2 = lq2[lane] * lk2[lane] + lq2[64 + lane] * lk2[64 + lane];
    const float lam = expf(wave_sum(d1)) - expf(wave_sum(d2)) + lam_init;
    const float osc = 1.0f - lam_init;
    const f32x4 sw = *(const f32x4*)(INP(float, I_SUBW) + L * 256 + 4 * lane);
    for (int it = gw; it < M * 4; it += F.NGW) { const int m = it >> 2, h = it & 3;
        const float* o = O + (size_t)m * 2048 + h * 512 + 4 * lane;
        const f32x4 a = *(const f32x4*)o, b = *(const f32x4*)(o + 256);
        const f32x4 d = a - b * lam;
        const float ss = wave_sum((d.x * d.x + d.y * d.y) + (d.z * d.z + d.w * d.w));
        const float r = osc / sqrtf(ss * (1.f / 256.f) + SUBLN_EPS);
        v2u w; w.x = pk2(d.x * r * sw.x, d.y * r * sw.y); w.y = pk2(d.z * r * sw.z, d.w * r * sw.w);
        *(v2u*)(mix + (size_t)m * DM + 1024 + h * 256 + 4 * lane) = w; }
}

constexpr int G_QT = 0, G_QP = 272, G_KT = 17408, G_KDT = 34816, G_TP = 144, G_VT = 53248, G_AT = 90112, G_DEC = 99328, G_GT = 99840, G_END = 103936, G_OB = 0, G_OP = 1040;
static_assert(G_END <= RING_BYTES && 64 * G_OP <= G_DEC, "GLA LDS map");
DI float log_sigmoid_f(float x) { return fminf(x, 0.f) - __logf(1.f + __expf(-fabsf(x))); }
DI bf16x8 lds_frag16(LAS unsigned char* p) { return *(LAS const bf16x8*)p; }
DI bf16x8 lds_frag8x2(LAS unsigned char* p, int second_off) { const s16x4 a = *(LAS const s16x4*)p, b = *(LAS const s16x4*)(p + second_off); return __builtin_shufflevector(a, b, 0, 1, 2, 3, 4, 5, 6, 7); }
DI void gla_unit(Frame& F, int L, int unit) {
    PH_IDS;
    const int b = unit >> 2, h = unit & 3, r = lane & 31, hh = lane >> 5;
    LAS unsigned char* lds = F.lds + RING_OFF;
    GAS unsigned char* ws = ws_opaque(F);
    const bf16* pbase = (const bf16*)(ws + WS_PROJ) + (size_t)b * SEQ * NPROJ;
    bf16* mix = (bf16*)(ws + WS_XN);
    const float* nw = INP(float, I_GLA_NW) + L * 256;
    f32x16 S[4];
#pragma unroll
    for (int i = 0; i < 4; ++i)
#pragma unroll
        for (int e = 0; e < 16; ++e) S[i][e] = 0.f;
#pragma unroll 1
    for (int n = 0; n < SEQ / 64; ++n) {
        const bf16* prow = pbase + (size_t)(n * 64) * NPROJ;
        {
            const int dp = tid & 63, tg = wave;
            const bf16* r0 = prow + (size_t)(8 * tg) * NPROJ + h * 128 + 2 * dp;
            unsigned qv[8], kv[8], gv[8];
#pragma unroll
            for (int i = 0; i < 8; ++i) { const bf16* rr = r0 + (size_t)i * NPROJ; qv[i] = *(const unsigned*)(rr + C_GQ); kv[i] = *(const unsigned*)(rr + C_GK); gv[i] = *(const unsigned*)(rr + C_GATE); }
            const int vp = tid & 127, tq = tid >> 7;
            const bf16* v0 = prow + (size_t)(16 * tq) * NPROJ + C_GV + h * 256 + 2 * vp;
            unsigned vv[16];
#pragma unroll
            for (int i = 0; i < 16; ++i) vv[i] = *(const unsigned*)(v0 + (size_t)i * NPROJ);
            float cs0[8], cs1[8]; float a0 = 0.f, a1 = 0.f;
#pragma unroll
            for (int i = 0; i < 8; ++i) { a0 += log_sigmoid_f(bf_lo(gv[i])) * (1.f / 16.f); a1 += log_sigmoid_f(bf_hi(gv[i])) * (1.f / 16.f); cs0[i] = a0; cs1[i] = a1; }
            *(LAS f32x2v*)(lds + G_GT + (tg * 128 + 2 * dp) * 4) = (f32x2v){a0, a1};
#pragma unroll
            for (int hf = 0; hf < 2; ++hf) { v4u lo4, hi4;
#pragma unroll
                for (int j = 0; j < 4; ++j) { const unsigned x0 = vv[8 * hf + 2 * j], x1 = vv[8 * hf + 2 * j + 1]; lo4[j] = (x0 & 0xffffu) | (x1 << 16); hi4[j] = (x0 >> 16) | (x1 & 0xffff0000u); }
                *(LAS v4u*)(lds + G_VT + (2 * vp) * G_TP + (16 * tq + 8 * hf) * 2) = lo4; *(LAS v4u*)(lds + G_VT + (2 * vp + 1) * G_TP + (16 * tq + 8 * hf) * 2) = hi4; }
            __syncthreads();
            float p0 = 0.f, p1 = 0.f, t0 = 0.f, t1 = 0.f;
#pragma unroll
            for (int g = 0; g < 8; ++g) { const f32x2v x = *(LAS const f32x2v*)(lds + G_GT + (g * 128 + 2 * dp) * 4); if (g < tg) { p0 += x.x; p1 += x.y; } t0 += x.x; t1 += x.y; }
            v4u kd0, kd1; float kx0[8], kx1[8];
#pragma unroll
            for (int i = 0; i < 8; ++i) { const float b0 = p0 + cs0[i], b1 = p1 + cs1[i];
                const float q0 = bf_lo(qv[i]) * GLA_QSCALE * __expf(b0), q1 = bf_hi(qv[i]) * GLA_QSCALE * __expf(b1);
                const float k0 = bf_lo(kv[i]), k1 = bf_hi(kv[i]);
                *(LAS unsigned*)(lds + G_QT + (8 * tg + i) * G_QP + 4 * dp) = pk2(q0, q1);
                *(LAS unsigned*)(lds + G_KT + (8 * tg + i) * G_QP + 4 * dp) = pk2(k0 * __expf(-b0), k1 * __expf(-b1));
                kx0[i] = k0 * __expf(t0 - b0); kx1[i] = k1 * __expf(t1 - b1); }
#pragma unroll
            for (int j = 0; j < 4; ++j) { kd0[j] = pk2(kx0[2 * j], kx0[2 * j + 1]); kd1[j] = pk2(kx1[2 * j], kx1[2 * j + 1]); }
            *(LAS v4u*)(lds + G_KDT + (2 * dp) * G_TP + 16 * tg) = kd0; *(LAS v4u*)(lds + G_KDT + (2 * dp + 1) * G_TP + 16 * tg) = kd1;
            if (tg == 0) *(LAS f32x2v*)(lds + G_DEC + 8 * dp) = (f32x2v){__expf(t0), __expf(t1)};
        }
        __syncthreads();
        if (wave < 3) {
            const int ib = wave ? 1 : 0, jb = wave == 2 ? 1 : 0;
            f32x16 acc;
#pragma unroll
            for (int e = 0; e < 16; ++e) acc[e] = 0.f;
#pragma unroll
            for (int ks = 0; ks < 8; ++ks) { const bf16x8 a = lds_frag16(lds + G_KT + (jb * 32 + r) * G_QP + ks * 32 + 16 * hh), bq = lds_frag16(lds + G_QT + (ib * 32 + r) * G_QP + ks * 32 + 16 * hh);
                acc = MFMA32(a, bq, acc); }
            const int ci = ib * 32 + r;
#pragma unroll
            for (int g = 0; g < 4; ++g) { const int cj0 = jb * 32 + 8 * g + 4 * hh; float v[4];
#pragma unroll
                for (int e = 0; e < 4; ++e) v[e] = (cj0 + e <= ci) ? acc[4 * g + e] : 0.f;
                *(LAS v2u*)(lds + G_AT + ci * G_TP + cj0 * 2) = (v2u){pk2(v[0], v[1]), pk2(v[2], v[3])}; }
        }
        __syncthreads();
        f32x16 o0, o1;
#pragma unroll
        for (int e = 0; e < 16; ++e) { o0[e] = 0.f; o1[e] = 0.f; }
#pragma unroll
        for (int i = 0; i < 4; ++i)
#pragma unroll
            for (int s = 0; s < 2; ++s) {
                v4u pw;
#pragma unroll
                for (int j = 0; j < 4; ++j) pw[j] = pk2(S[i][8 * s + 2 * j], S[i][8 * s + 2 * j + 1]);
                const bf16x8 sb = __builtin_bit_cast(bf16x8, pw);
                const int d0 = 32 * i + 16 * s + 4 * hh;
                const bf16x8 qa0 = lds_frag8x2(lds + G_QT + r * G_QP + d0 * 2, 16), qa1 = lds_frag8x2(lds + G_QT + (32 + r) * G_QP + d0 * 2, 16);
                o0 = MFMA32(qa0, sb, o0); o1 = MFMA32(qa1, sb, o1); }
        bf16x8 vf[4];
#pragma unroll
        for (int ks = 0; ks < 4; ++ks) vf[ks] = lds_frag16(lds + G_VT + (32 * wave + r) * G_TP + ks * 32 + 16 * hh);
#pragma unroll
        for (int ks = 0; ks < 2; ++ks) o0 = MFMA32(lds_frag16(lds + G_AT + r * G_TP + ks * 32 + 16 * hh), vf[ks], o0);
#pragma unroll
        for (int ks = 0; ks < 4; ++ks) o1 = MFMA32(lds_frag16(lds + G_AT + (32 + r) * G_TP + ks * 32 + 16 * hh), vf[ks], o1);
#pragma unroll
        for (int i = 0; i < 4; ++i) {
#pragma unroll
            for (int g = 0; g < 4; ++g) { const f32x4 dc = *(LAS const f32x4*)(lds + G_DEC + (32 * i + 8 * g + 4 * hh) * 4);
                S[i][4 * g] *= dc.x; S[i][4 * g + 1] *= dc.y; S[i][4 * g + 2] *= dc.z; S[i][4 * g + 3] *= dc.w; }
#pragma unroll
            for (int ks = 0; ks < 4; ++ks) S[i] = MFMA32(lds_frag16(lds + G_KDT + (32 * i + r) * G_TP + ks * 32 + 16 * hh), vf[ks], S[i]); }
        __syncthreads();
#pragma unroll
        for (int e = 0; e < 16; ++e) { const int c = (e & 3) + 8 * (e >> 2) + 4 * hh;
            *(LAS float*)(lds + G_OB + c * G_OP + (32 * wave + r) * 4) = o0[e]; *(LAS float*)(lds + G_OB + (32 + c) * G_OP + (32 * wave + r) * 4) = o1[e]; }
        __syncthreads();
        {
            const int c = tid >> 3, p = tid & 7;
            const bf16* gp = prow + (size_t)c * NPROJ + C_GG + h * 256 + 32 * p;
            v4u gq[4];
#pragma unroll
            for (int j = 0; j < 4; ++j) gq[j] = *(const v4u*)(gp + 8 * j);
            f32x4 ov[8]; float ss = 0.f;
#pragma unroll
            for (int j = 0; j < 8; ++j) { ov[j] = *(LAS const f32x4*)(lds + G_OB + c * G_OP + (32 * p + 4 * j) * 4); ss += (ov[j].x * ov[j].x + ov[j].y * ov[j].y) + (ov[j].z * ov[j].z + ov[j].w * ov[j].w); }
            ss += __shfl_xor(ss, 1); ss += __shfl_xor(ss, 2); ss += __shfl_xor(ss, 4);
            const float rstd = 1.0f / sqrtf(ss * (1.f / 256.f) + NORM_EPS);
            bf16* yp = mix + (size_t)(b * SEQ + n * 64 + c) * DM + h * 256 + 32 * p;
#pragma unroll
            for (int j = 0; j < 4; ++j) { const f32x4 w0 = *(const f32x4*)(nw + 32 * p + 8 * j), w1 = *(const f32x4*)(nw + 32 * p + 8 * j + 4); const f32x4 x0 = ov[2 * j], x1 = ov[2 * j + 1];
                float gf[8];
#pragma unroll
                for (int e = 0; e < 4; ++e) { gf[2 * e] = bf_lo(gq[j][e]); gf[2 * e + 1] = bf_hi(gq[j][e]); }
                float y[8];
#pragma unroll
                for (int e = 0; e < 4; ++e) { y[e] = x0[e] * rstd * w0[e]; y[4 + e] = x1[e] * rstd * w1[e]; }
#pragma unroll
                for (int e = 0; e < 8; ++e) y[e] = y[e] * gf[e] / (1.f + __expf(-gf[e]));
                *(v4u*)(yp + 8 * j) = (v4u){pk2(y[0], y[1]), pk2(y[2], y[3]), pk2(y[4], y[5]), pk2(y[6], y[7])}; }
        }
        __syncthreads();
    }
}

typedef swa::BlockRef<swa::bf16, float> ABlk;
constexpr int N_GLA = BATCH * 4, N_ATT = BATCH * 16 * (SEQ / 256), N_ITEMS = N_GLA + N_ATT;
DI ABlk attn_ref(GAS unsigned char* ws, int a) {
    const int qb = (SEQ / 256 - 1) - (a >> 8), rest = a & 255, bb = rest >> 4, vh = rest & 15, hd = vh >> 2, c = (vh >> 1) & 1, vhalf = vh & 1;
    const swa::bf16* proj = (const swa::bf16*)(ws + WS_PROJ); float* O = (float*)(ws + WS_O);
    ABlk R;
    R.Q = proj + (size_t)(bb * SEQ + qb * 256) * NPROJ + C_DQ + (hd * 2 + c) * 128;
    R.K = proj + (size_t)(bb * SEQ) * NPROJ + C_DK + (hd * 2 + c) * 128;
    R.V = proj + (size_t)(bb * SEQ) * NPROJ + C_DV + hd * 256 + vhalf * 128;
    R.O = O + (size_t)(bb * SEQ + qb * 256) * 2048 + (hd * 2 + c) * 256 + vhalf * 128;
    R.P0 = qb * 256;
    return R;
}
DI int q_next(Frame& F, gu32* head) {
    if (threadIdx.x == 0) F.MISC[16] = __hip_atomic_fetch_add(head, 1u, RLX_AGENT);
    __syncthreads(); const int v = (int)F.MISC[16]; __syncthreads();
    return __builtin_amdgcn_readfirstlane(v);
}
DI void mixer_phase(Frame& F, int L, char* lds_generic) {
    gu32* head = F.ctl + CW_Q + 64 * L;
    GAS unsigned char* ws = ws_opaque(F);
    int it = q_next(F, head);
    while (it < N_GLA) { gla_unit(F, L, it); it = q_next(F, head); }
    if (it < N_ITEMS) {
        ABlk cur = attn_ref(ws, it - N_GLA);
        swa::Seam<swa::bf16> S;
        swa::causal_swa_prime<swa::bf16, float>(cur, SEQ, lds_generic, S);
        for (;;) {
            const int nx = q_next(F, head); const bool last = nx >= N_ITEMS;
            const ABlk nxt = last ? cur : attn_ref(ws, nx - N_GLA);
            swa::causal_swa_block<swa::bf16, float>(cur, nxt, SEQ, SEQ, lds_generic, S);
            if (last) break;
            cur = nxt;
        }
    }
}

__global__ void __launch_bounds__(NWAVES * 64, 2) fwd(Args args) {
    extern __shared__ __attribute__((aligned(16))) unsigned char lds[];
    Frame F;
    F.lds = (LAS unsigned char*)lds;
    F.MISC = (volatile LAS unsigned*)(F.lds + MISC_OFF);
    F.G = gridDim.x; F.NGW = F.G * NWAVES;
    F.ws = args.ws; F.ctl = (gu32*)(args.ws + WS_CTL);
    for (int u = threadIdx.x; u < (LDS_BYTES - LDSCTL_OFF) / 4; u += NWAVES * 64) ((LAS unsigned*)(F.lds + LDSCTL_OFF))[u] = 0u;
    __syncthreads();
    XcdBarrier bar; bar.bar = (unsigned*)(F.ctl + CW_BAR); bar.x = 0; bar.st = nullptr;
    if (!MK_SPLIT) bar = xcd_barrier_post((unsigned*)(F.ctl + CW_BAR), F.MISC + 8);
#define GRID_BAR() do { if (!MK_SPLIT) { XcdBarrier b2_ = bar; GAS unsigned* bp_ = (GAS unsigned*)bar.bar; asm volatile("" : "+s"(bp_), "+s"(b2_.x)); b2_.bar = (unsigned*)bp_; xcd_barrier(b2_); } } while (0)
    const int lo = args.ph_lo, hi = args.ph_hi;
#define IN(k) (lo <= (k) && (k) < hi)
#define BOTH(k) (IN(k) && IN((k) + 1))

    if (IN(0)) { p0_prologue(F); if (BOTH(0)) GRID_BAR(); }
#pragma unroll 1
    for (int L = 0; L < DEPTH; ++L) {
        const int pb = 1 + L * PH_PER_LAYER;
        if (IN(pb + 0)) { GAS unsigned char* ws = ws_opaque(F); rmsnorm_phase(F, (L == 0) ? INP(float, I_X) : (const float*)OUTP(), INP(float, I_ATTN_NW) + L * DM, (bf16*)(ws + WS_XN)); if (BOTH(pb + 0)) GRID_BAR(); }
        if (IN(pb + 1)) {
            GAS unsigned char* ws = ws_opaque(F);
            typedef pg8::Gemm<M, NPROJ, DM> GT; typedef pg8::StaticOrder<M, NPROJ> ST; GT g{(const bf16*)(ws + WS_XN), (const bf16*)(ws + WS_WIN) + (size_t)L * NPROJ * DM}; ST S; S.init(F.G, (int)blockIdx.x);
            typedef pg8::EpiBf16<0, NPROJ> ET; ET E{(bf16*)(ws + WS_PROJ), (const float*)(ws + WS_BIAS) + L * NPROJ};
            pg8::gemm_phase<ET, ST, GT, true, true>(F.lds + RING_OFF, g, S, E);
            if (BOTH(pb + 1)) GRID_BAR();
        }
        if (IN(pb + 2)) { qkprep_phase(F, L); if (BOTH(pb + 2)) GRID_BAR(); }
        if (IN(pb + 3)) {
#ifndef DBG_NO_MIX
            mixer_phase(F, L, (char*)lds + RING_OFF);
#endif
            if (BOTH(pb + 3)) GRID_BAR(); }
        if (IN(pb + 4)) { combine_phase(F, L); if (BOTH(pb + 4)) GRID_BAR(); }
        if (IN(pb + 5)) {
            GAS unsigned char* ws = ws_opaque(F);
            typedef pg8::Gemm<M, DM, DM> GT; typedef pg8::StaticOrder<M, DM> ST; GT g{(const bf16*)(ws + WS_XN), (const bf16*)(ws + WS_WOUT) + (size_t)L * DM * DM}; ST S; S.init(F.G, (int)blockIdx.x);
            typedef pg8::EpiResF32<DM> ET; ET E{(L == 0) ? INP(float, I_X) : (const float*)OUTP(), OUTP()};
            pg8::gemm_phase<ET, ST, GT, true, true>(F.lds + RING_OFF, g, S, E);
            if (BOTH(pb + 5)) GRID_BAR();
        }
        if (IN(pb + 6)) { GAS unsigned char* ws = ws_opaque(F); rmsnorm_phase(F, (const float*)OUTP(), INP(float, I_MLP_NW) + L * DM, (bf16*)(ws + WS_XN)); if (BOTH(pb + 6)) GRID_BAR(); }
        if (IN(pb + 7)) {
            GAS unsigned char* ws = ws_opaque(F);
            typedef pg8::Gemm<M, DFF, DM> GT; typedef pg8::StaticOrder<M, DFF> ST; GT g{(const bf16*)(ws + WS_XN), (const bf16*)(ws + WS_WUP) + (size_t)L * DFF * DM}; ST S; S.init(F.G, (int)blockIdx.x);
            typedef pg8::EpiBf16<2, DFF> ET; ET E{(bf16*)(ws + WS_HID), nullptr};
            pg8::gemm_phase<ET, ST, GT, true, true>(F.lds + RING_OFF, g, S, E);
            if (BOTH(pb + 7)) GRID_BAR();
        }
        if (IN(pb + 8)) {
            GAS unsigned char* ws = ws_opaque(F);
            typedef pg8::Gemm<M, DM, DFF> GT; typedef pg8::StaticOrder<M, DM> ST; GT g{(const bf16*)(ws + WS_HID), (const bf16*)(ws + WS_WDN) + (size_t)L * DM * DFF}; ST S; S.init(F.G, (int)blockIdx.x);
            typedef pg8::EpiResF32<DM> ET; ET E{(const float*)OUTP(), OUTP()};
            pg8::gemm_phase<ET, ST, GT, true, true>(F.lds + RING_OFF, g, S, E);
            if (BOTH(pb + 8)) GRID_BAR();
        }
    }
#undef IN
#undef BOTH
}

extern "C" void kernel_launch(void* const* d_in, const int* in_sizes, int n_in, void* d_out, int out_size, void* d_ws, size_t ws_size, hipStream_t stream) {
    static int grid = 0;
    if (grid == 0) {
        if (n_in != 18 || in_sizes[0] != M * DM || out_size != M * DM || ws_size < WS_END) { fprintf(stderr, "kernel_launch: built for 18 inputs, x/out of %d floats, >= %zu bytes of workspace; got n_in %d, in0 %d, out %d, ws %zu; nothing launched\n", M * DM, (size_t)WS_END, n_in, n_in > 0 ? in_sizes[0] : -1, out_size, ws_size); grid = -1; return; }
        int dev = 0, cus = 0, per_cu = 0;
        if (hipGetDevice(&dev) != hipSuccess || hipDeviceGetAttribute(&cus, hipDeviceAttributeMultiprocessorCount, dev) != hipSuccess) { fprintf(stderr, "kernel_launch: hipGetDevice / hipDeviceGetAttribute failed; nothing launched\n"); grid = -1; return; }
        if (hipFuncSetAttribute((const void*)fwd, hipFuncAttributeMaxDynamicSharedMemorySize, LDS_BYTES) != hipSuccess) { fprintf(stderr, "kernel_launch: hipFuncSetAttribute failed\n"); grid = -1; return; }
        if (hipOccupancyMaxActiveBlocksPerMultiprocessor(&per_cu, (const void*)fwd, NWAVES * 64, LDS_BYTES) != hipSuccess || per_cu < 1) fprintf(stderr, "kernel_launch: note: occupancy query reports %d workgroups per CU\n", per_cu);
        (void)hipGetLastError();
        grid = cus;
    }
    if (grid < 0) return;
    if (hipMemsetAsync((char*)d_ws + WS_CTL, 0, CTL_ZERO_BYTES, stream) != hipSuccess) { fprintf(stderr, "kernel_launch: hipMemsetAsync failed; nothing launched\n"); return; }
    Args a{};
    for (int i = 0; i < 18; ++i) a.in[i] = d_in[i];
    a.out = (float*)d_out; a.ws = (unsigned char*)d_ws;
#if MK_SPLIT
    for (int p = 0; p < N_PHASES; ++p) { a.ph_lo = p; a.ph_hi = p + 1; hipLaunchKernelGGL(fwd, dim3(grid), dim3(NWAVES * 64), LDS_BYTES, stream, a); }
#else
    a.ph_lo = 0; a.ph_hi = N_PHASES; hipLaunchKernelGGL(fwd, dim3(grid), dim3(NWAVES * 64), LDS_BYTES, stream, a);
#endif
    const hipError_t le = hipPeekAtLastError();
    if (le != hipSuccess) fprintf(stderr, "kernel_launch: launch failed: %s\n", hipGetErrorName(le));
}
```

```cpp
#include <hip/hip_runtime.h>
#include <hip/hip_bf16.h>
#include <cstdio>
#include <cstdint>
#include <cmath>
namespace pg8 {
#define PG8_LAS __attribute__((address_space(3)))
typedef unsigned short bf16_t;
typedef short bf16x8 __attribute__((ext_vector_type(8)));
typedef float f32x4 __attribute__((ext_vector_type(4)));
typedef unsigned u32x4 __attribute__((ext_vector_type(4)));
constexpr int BM = 256, BK = 64, HALF = 128, HTB = HALF * BK * 2  , STAGE_BYTES = 8 * HTB, NXCD = 8, WGM = 8;

__host__ __device__ __forceinline__ int lds_byte(int r, int c) { const int st = (r >> 4) * 2 + (c >> 5), rr = r & 15, cc = c & 31, ob = rr * 64 + cc * 2; return st * 1024 + (ob ^ (((ob >> 9) & 1) << 5)); }
__host__ __device__ __forceinline__ void stage_rc(int b, int& R, int& C) { const int st = b / 1024, sb = b % 1024, swz = sb ^ (((sb >> 9) & 1) << 5); R = (st >> 1) * 16 + swz / 64; C = (st & 1) * 32 + (swz % 64) / 2; }
__host__ __device__ __forceinline__ int perm32(int rho) { const int n = rho >> 4, i = rho & 15; return 8 * (i >> 2) + 4 * n + (i & 3); }

struct Unit { int pm, pn; };
template <int M_, int N_, int K_> struct Gemm { const bf16_t* A; const bf16_t* Bt; static constexpr int M = M_, N = N_, K = K_; };

template <int M_, int N_> struct StaticOrder {
    static constexpr int nM = M_ / BM, nN = N_ / BM, nwg = nM * nN;
    int G, c;
    __host__ __device__ void init(int G_, int c_) { G = G_; c = c_; }
    __host__ __device__ bool next(int i, Unit& u) const {
        const long L = (long)i * G + c; if (L >= nwg) return false;
        int wgid = (int)L; { constexpr int q = nwg / NXCD, r = nwg % NXCD; const int xcd = wgid % NXCD, off = wgid / NXCD; wgid = (xcd < r ? xcd * (q + 1) : r * (q + 1) + (xcd - r) * q) + off; }
        constexpr int nig = WGM * nN; const int gid = wgid / nig, fm = gid * WGM, gsz = (nM - fm) < WGM ? (nM - fm) : WGM;
        u.pm = fm + ((wgid % nig) % gsz); u.pn = (wgid % nig) / gsz; return true;
    }
    __device__ __forceinline__ void a_ready(const Unit&) const {}
    __device__ __forceinline__ void done(const Unit&) const {}
};
__device__ __forceinline__ unsigned cvt_pk_bf16(float lo, float hi) { unsigned r; asm volatile("v_cvt_pk_bf16_f32 %0, %1, %2" : "=v"(r) : "v"(lo), "v"(hi)); return r; }
typedef float f32x2 __attribute__((ext_vector_type(2)));
template <int ACT, int ldc, int KN> struct EpiBf16 {
    static constexpr bool PERM = true, AFTER_DRAIN = false;
    bf16_t* O; const float* bias; const float* ss; float eps;
    __device__ __forceinline__ void operator()(const f32x4 (&acc)[2][2][4][2], const Unit& u, int wr, int wc, int fr, int fq) const {
        const int row0 = u.pm * BM + wr * 64 + fr; const int col0 = u.pn * BM + wc * 32 + 8 * fq;
        f32x4 bv[2][2];
#pragma unroll
        for (int bj = 0; bj < 2; ++bj)
#pragma unroll
            for (int n = 0; n < 2; ++n) bv[bj][n] = bias ? *(const f32x4*)(bias + col0 + bj * HALF + 4 * n) : (f32x4){0.f, 0.f, 0.f, 0.f};
        float rs[2][4];
#pragma unroll
        for (int ai = 0; ai < 2; ++ai)
#pragma unroll
            for (int m = 0; m < 4; ++m) { const f32x4* p = (const f32x4*)(ss + (size_t)(row0 + ai * HALF + m * 16) * 8); const f32x4 a = p[0], b = p[1]; rs[ai][m] = ((a[0] + a[1]) + (a[2] + a[3])) + ((b[0] + b[1]) + (b[2] + b[3])); }
#pragma unroll
        for (int ai = 0; ai < 2; ++ai)
#pragma unroll
            for (int m = 0; m < 4; ++m) rs[ai][m] = 1.0f / sqrtf(rs[ai][m] * (1.0f / KN) + eps);
        asm volatile("" ::: "memory");
#pragma unroll
        for (int ai = 0; ai < 2; ++ai)
#pragma unroll
            for (int m = 0; m < 4; ++m) { bf16_t* rowp = O + (size_t)(row0 + ai * HALF + m * 16) * ldc + col0;
                const float rstd = rs[ai][m];
#pragma unroll
                for (int bj = 0; bj < 2; ++bj) { f32x4 v0 = acc[ai][bj][m][0] * rstd + bv[bj][0], v1 = acc[ai][bj][m][1] * rstd + bv[bj][1];
                    if (ACT == 2) {
#pragma unroll
                        for (int e = 0; e < 4; ++e) { const float a = fmaxf(v0[e], 0.f), b = fmaxf(v1[e], 0.f); v0[e] = a * a; v1[e] = b * b; } }
                    u32x4 w; w.x = cvt_pk_bf16(v0[0], v0[1]); w.y = cvt_pk_bf16(v0[2], v0[3]); w.z = cvt_pk_bf16(v1[0], v1[1]); w.w = cvt_pk_bf16(v1[2], v1[3]);
                    *(u32x4*)(rowp + bj * HALF) = w; } }
    }
};
template <int ldc, bool FINAL> struct EpiRes {
    static constexpr bool PERM = true, AFTER_DRAIN = false;
    const bf16_t* base; float* out; bf16_t* xb; float* ss; PG8_LAS float* red;
    __device__ __forceinline__ void operator()(const f32x4 (&acc)[2][2][4][2], const Unit& u, int wr, int wc, int fr, int fq) const {
        const int row0 = u.pm * BM + wr * 64 + fr; const int col0 = u.pn * BM + wc * 32 + 8 * fq;
        u32x4 bq[2][4][2];
#pragma unroll
        for (int ai = 0; ai < 2; ++ai)
#pragma unroll
            for (int m = 0; m < 4; ++m) { const size_t off = (size_t)(row0 + ai * HALF + m * 16) * ldc + col0; bq[ai][m][0] = *(const u32x4*)(base + off); bq[ai][m][1] = *(const u32x4*)(base + off + HALF); }
        asm volatile("" ::: "memory");
#pragma unroll
        for (int ai = 0; ai < 2; ++ai)
#pragma unroll
            for (int m = 0; m < 4; ++m) { const size_t off = (size_t)(row0 + ai * HALF + m * 16) * ldc + col0;
                f32x4 x[2][2];
#pragma unroll
                for (int bj = 0; bj < 2; ++bj) { const u32x4 b = bq[ai][m][bj];
                    x[bj][0] = (f32x4){__uint_as_float(b.x << 16), __uint_as_float(b.x & 0xffff0000u), __uint_as_float(b.y << 16), __uint_as_float(b.y & 0xffff0000u)} + acc[ai][bj][m][0];
                    x[bj][1] = (f32x4){__uint_as_float(b.z << 16), __uint_as_float(b.z & 0xffff0000u), __uint_as_float(b.w << 16), __uint_as_float(b.w & 0xffff0000u)} + acc[ai][bj][m][1]; }
                if constexpr (FINAL) {
                    *(f32x4*)(out + off) = x[0][0]; *(f32x4*)(out + off + 4) = x[0][1]; *(f32x4*)(out + off + HALF) = x[1][0]; *(f32x4*)(out + off + HALF + 4) = x[1][1];
                } else {
                    u32x4 w0, w1; w0.x = cvt_pk_bf16(x[0][0][0], x[0][0][1]); w0.y = cvt_pk_bf16(x[0][0][2], x[0][0][3]); w0.z = cvt_pk_bf16(x[0][1][0], x[0][1][1]); w0.w = cvt_pk_bf16(x[0][1][2], x[0][1][3]);
                    w1.x = cvt_pk_bf16(x[1][0][0], x[1][0][1]); w1.y = cvt_pk_bf16(x[1][0][2], x[1][0][3]); w1.z = cvt_pk_bf16(x[1][1][0], x[1][1][1]); w1.w = cvt_pk_bf16(x[1][1][2], x[1][1][3]);
                    *(u32x4*)(xb + off) = w0; *(u32x4*)(xb + off + HALF) = w1;
                    const f32x4 q = x[0][0] * x[0][0] + x[0][1] * x[0][1] + x[1][0] * x[1][0] + x[1][1] * x[1][1]; float s = (q[0] + q[1]) + (q[2] + q[3]);
                    s += __shfl_xor(s, 16); s += __shfl_xor(s, 32);
                    if (fq == 0) red[(wr * 64 + fr + ai * HALF + m * 16) * 4 + wc] = s; } }
        if constexpr (!FINAL) {
            asm volatile("s_waitcnt lgkmcnt(0)" ::: "memory"); __builtin_amdgcn_s_barrier(); asm volatile("" ::: "memory");
            const int t = threadIdx.x;
            if (t < BM) { const f32x4 p = *(const PG8_LAS f32x4*)(red + t * 4); ss[(size_t)(u.pm * BM + t) * 8 + u.pn] = (p[0] + p[1]) + (p[2] + p[3]); }
        }
    }
};
template <class Epi, class Sched, class GemmT, bool ALIGN_EPI = false, bool SP2 = false>
__device__ __forceinline__ void gemm_phase(PG8_LAS unsigned char* lds, const GemmT g, const Sched& S, const Epi& E) {
    int tid_ = threadIdx.x; asm volatile("" : "+v"(tid_));
    const int tid = tid_, wid = __builtin_amdgcn_readfirstlane(tid >> 6), lane = tid & 63, wr = wid >> 2, wc = wid & 3, fr = lane & 15, fq = lane >> 4;
    constexpr int K = GemmT::K, nt = K / BK;
    unsigned voffA[2], voffB[2];
#pragma unroll
    for (int i = 0; i < 2; ++i) { int R, C; stage_rc(tid * 16 + i * 8192, R, C); const int Rb = Epi::PERM ? ((R & ~31) + perm32(R & 31)) : R;
        voffA[i] = (unsigned)(R * K + C) * 2u; voffB[i] = (unsigned)(Rb * K + C) * 2u; }
    constexpr size_t kstep = (size_t)(BK * 2);
    constexpr size_t hstep = (size_t)HALF * K * 2;
    constexpr size_t tstep = 2 * hstep;
    const unsigned ldsw = (unsigned)wid * 1024u;
    const int aoff = lds_byte(wr * 64 + fr, fq * 8), boff = lds_byte(wc * 32 + fr, fq * 8);
#define PG8_SA(b, h) (((b) * 2 + (h)) * HTB)
#define PG8_SB(b, h) ((4 + (b) * 2 + (h)) * HTB)
#define PG8_STAGE(bufoff, gbase, voff) do { _Pragma("unroll") for (int _i = 0; _i < 2; ++_i) \
        __builtin_amdgcn_global_load_lds((const unsigned*)((const char*)(gbase) + (voff)[_i]), (PG8_LAS unsigned*)(lds + (bufoff) + ldsw + _i * 8192), 16, 0, 0); } while (0)
#define PG8_LDA(dst, b, h) do { _Pragma("unroll") for (int m = 0; m < 4; ++m) _Pragma("unroll") for (int k = 0; k < 2; ++k) dst[m][k] = *(const PG8_LAS bf16x8*)(lds + PG8_SA(b, h) + aoff + m * 2048 + k * 1024); } while (0)
#define PG8_LDB(dst, b, h) do { _Pragma("unroll") for (int n = 0; n < 2; ++n) _Pragma("unroll") for (int k = 0; k < 2; ++k) dst[n][k] = *(const PG8_LAS bf16x8*)(lds + PG8_SB(b, h) + boff + n * 2048 + k * 1024); } while (0)
#define PG8_MMA(ai, bj, At, Bt) do { __builtin_amdgcn_s_setprio(1); _Pragma("unroll") for (int m = 0; m < 4; ++m) _Pragma("unroll") for (int n = 0; n < 2; ++n) _Pragma("unroll") for (int k = 0; k < 2; ++k) \
        acc[ai][bj][m][n] = __builtin_amdgcn_mfma_f32_16x16x32_bf16(Bt[n][k], At[m][k], acc[ai][bj][m][n], 0, 0, 0); __builtin_amdgcn_s_setprio(0); } while (0)
#define PG8_WAIT_V(n) asm volatile("s_waitcnt vmcnt(" #n ")" ::: "memory")
#define PG8_WAIT_L(n) asm volatile("s_waitcnt lgkmcnt(" #n ")" ::: "memory")
#define PG8_BAR __builtin_amdgcn_s_barrier()
#define PG8_SCHED __builtin_amdgcn_sched_barrier(0)
    Unit cur, nxt; int ui = 0;
    if (!S.next(0, cur)) return;
    f32x4 acc[2][2][4][2];
#pragma unroll
    for (int a = 0; a < 2; ++a)
#pragma unroll
        for (int b = 0; b < 2; ++b)
#pragma unroll
            for (int m = 0; m < 4; ++m)
#pragma unroll
                for (int n = 0; n < 2; ++n) acc[a][b][m][n] = (f32x4){0.f, 0.f, 0.f, 0.f};
    bf16x8 At[4][2], B0[2][2], B1[2][2];
    const char* cA = (const char*)g.A + (size_t)cur.pm * tstep; const char* cB = (const char*)g.Bt + (size_t)cur.pn * tstep;
    S.a_ready(cur);
    if constexpr (SP2) {
        PG8_STAGE(PG8_SB(0, 0), cB, voffB); PG8_STAGE(PG8_SB(0, 1), cB + hstep, voffB); PG8_STAGE(PG8_SA(0, 0), cA, voffA); PG8_STAGE(PG8_SA(0, 1), cA + hstep, voffA);
        if (wr == 1) PG8_BAR;
        PG8_WAIT_V(2); PG8_BAR;
        PG8_STAGE(PG8_SB(1, 0), cB + kstep, voffB); PG8_STAGE(PG8_SA(1, 0), cA + kstep, voffA); PG8_STAGE(PG8_SB(1, 1), cB + hstep + kstep, voffB);
        PG8_WAIT_V(6); PG8_BAR;
    } else {
        PG8_STAGE(PG8_SB(0, 0), cB, voffB); PG8_STAGE(PG8_SA(0, 0), cA, voffA); PG8_STAGE(PG8_SB(0, 1), cB + hstep, voffB); PG8_STAGE(PG8_SA(0, 1), cA + hstep, voffA);
        if (wr == 1) PG8_BAR;
        PG8_WAIT_V(4); PG8_BAR;
        PG8_STAGE(PG8_SB(1, 0), cB + kstep, voffB); PG8_STAGE(PG8_SA(1, 0), cA + kstep, voffA); PG8_STAGE(PG8_SB(1, 1), cB + hstep + kstep, voffB);
        PG8_WAIT_V(6); PG8_BAR;
    }
    for (;;) {
        const bool has_next = S.next(ui + 1, nxt);
        const char* nA = has_next ? (const char*)g.A + (size_t)nxt.pm * tstep : cA; const char* nB = has_next ? (const char*)g.Bt + (size_t)nxt.pn * tstep : cB;
        for (int t = 0; t < nt; t += 2) {
            const bool last = (t == nt - 2);
            const char* a1 = cA + (size_t)(t + 1) * kstep;
            const char* a2 = last ? nA : cA + (size_t)(t + 2) * kstep; const char* b2 = last ? nB : cB + (size_t)(t + 2) * kstep;
            const char* a3 = a2 + kstep; const char* b3 = b2 + kstep;
            if (last && has_next) S.a_ready(nxt);
            if constexpr (SP2) {
            PG8_LDB(B0, 0, 0); PG8_LDB(B1, 0, 1); PG8_SCHED; PG8_LDA(At, 0, 0); PG8_STAGE(PG8_SA(1, 1), a1 + hstep, voffA);
            PG8_WAIT_V(8); PG8_WAIT_L(0); PG8_BAR; PG8_MMA(0, 0, At, B0); PG8_MMA(0, 1, At, B1); PG8_BAR; PG8_SCHED;
            PG8_LDA(At, 0, 1); PG8_STAGE(PG8_SB(0, 0), b2, voffB); PG8_STAGE(PG8_SB(0, 1), b2 + hstep, voffB); PG8_STAGE(PG8_SA(0, 0), a2, voffA);
            PG8_WAIT_V(8); PG8_WAIT_L(0); PG8_BAR; PG8_MMA(1, 0, At, B0); PG8_MMA(1, 1, At, B1); PG8_BAR; PG8_SCHED;
            PG8_LDB(B0, 1, 0); PG8_LDB(B1, 1, 1); PG8_SCHED; PG8_LDA(At, 1, 0); PG8_STAGE(PG8_SA(0, 1), a2 + hstep, voffA);
            PG8_WAIT_V(8); PG8_WAIT_L(0); PG8_BAR; PG8_MMA(0, 0, At, B0); PG8_MMA(0, 1, At, B1); PG8_BAR; PG8_SCHED;
            PG8_LDA(At, 1, 1); PG8_STAGE(PG8_SB(1, 0), b3, voffB); PG8_STAGE(PG8_SB(1, 1), b3 + hstep, voffB); PG8_STAGE(PG8_SA(1, 0), a3, voffA);
            PG8_WAIT_V(8); PG8_WAIT_L(0); PG8_BAR; PG8_MMA(1, 0, At, B0); PG8_MMA(1, 1, At, B1); PG8_BAR; PG8_SCHED;
            } else {
            PG8_LDB(B0, 0, 0); PG8_SCHED; PG8_LDA(At, 0, 0); PG8_STAGE(PG8_SA(1, 1), a1 + hstep, voffA);
            PG8_WAIT_L(8); PG8_BAR; PG8_WAIT_L(0); PG8_MMA(0, 0, At, B0); PG8_BAR; PG8_SCHED;
            PG8_LDB(B1, 0, 1); PG8_STAGE(PG8_SB(0, 0), b2, voffB);
            PG8_BAR; PG8_WAIT_L(0); PG8_MMA(0, 1, At, B1); PG8_BAR;
            PG8_LDA(At, 0, 1); PG8_STAGE(PG8_SA(0, 0), a2, voffA);
            PG8_BAR; PG8_WAIT_L(0); PG8_MMA(1, 0, At, B0); PG8_BAR; PG8_SCHED;
            PG8_STAGE(PG8_SB(0, 1), b2 + hstep, voffB);
            PG8_WAIT_V(6); PG8_BAR; PG8_MMA(1, 1, At, B1); PG8_BAR;
            PG8_LDB(B0, 1, 0); PG8_SCHED; PG8_LDA(At, 1, 0); PG8_STAGE(PG8_SA(0, 1), a2 + hstep, voffA);
            PG8_WAIT_L(8); PG8_BAR; PG8_WAIT_L(0); PG8_MMA(0, 0, At, B0); PG8_BAR; PG8_SCHED;
            PG8_LDB(B1, 1, 1); PG8_STAGE(PG8_SB(1, 0), b3, voffB);
            PG8_BAR; PG8_WAIT_L(0); PG8_MMA(0, 1, At, B1); PG8_BAR;
            PG8_LDA(At, 1, 1); PG8_STAGE(PG8_SA(1, 0), a3, voffA);
            PG8_BAR; PG8_WAIT_L(0); PG8_MMA(1, 0, At, B0); PG8_BAR; PG8_SCHED;
            PG8_STAGE(PG8_SB(1, 1), b3 + hstep, voffB);
            PG8_WAIT_V(6); PG8_BAR; PG8_MMA(1, 1, At, B1); PG8_BAR;
            }
        }
        if constexpr (ALIGN_EPI) { if (wr == 0) PG8_BAR; }
        if constexpr (!Epi::AFTER_DRAIN) { E(acc, cur, wr, wc, fr, fq); S.done(cur); }
        if (!has_next) break;
#pragma unroll
        for (int a = 0; a < 2; ++a)
#pragma unroll
            for (int b = 0; b < 2; ++b)
#pragma unroll
                for (int m = 0; m < 4; ++m)
#pragma unroll
                    for (int n = 0; n < 2; ++n) acc[a][b][m][n] = (f32x4){0.f, 0.f, 0.f, 0.f};
        cur = nxt; cA = nA; cB = nB; ++ui;
        if constexpr (ALIGN_EPI) { if (wr == 1) PG8_BAR; }
    }
    PG8_WAIT_V(0);
    if constexpr (!ALIGN_EPI) { if (wr == 0) PG8_BAR; }
    PG8_BAR;
    if constexpr (Epi::AFTER_DRAIN) { E.fused(acc, cur, wr, wc, fr, fq, lds, wid, lane); S.done(cur); }
#undef PG8_SA
#undef PG8_SB
#undef PG8_STAGE
#undef PG8_LDA
#undef PG8_LDB
#undef PG8_MMA
#undef PG8_WAIT_V
#undef PG8_WAIT_L
#undef PG8_BAR
#undef PG8_SCHED
}
}
namespace swa {
constexpr int D = 128;
constexpr int KVPITCH = 6656, QPITCH = 6656, OPITCH = 2048;
constexpr float THR = 8.f;
constexpr bool WSKIP = false;
constexpr float SCALE = 0.08838834764831845f;
constexpr int NW = 8, QBLK = 32, KVBLK = 64, QB = NW * QBLK;
constexpr int SHM_V = KVBLK * D * 2, SHM_K = KVBLK * D * 2;
constexpr int LDS_BYTES = 2 * SHM_V + 2 * SHM_K + NW * 64 * 4;
using bf16 = __hip_bfloat16;
typedef short bf16x8 __attribute__((ext_vector_type(8)));
typedef short s16x4 __attribute__((ext_vector_type(4)));
typedef float f32x16 __attribute__((ext_vector_type(16)));
typedef float f32x4 __attribute__((ext_vector_type(4)));
typedef unsigned u32x4 __attribute__((ext_vector_type(4)));
template <class A, class Bt> struct same_t { static constexpr bool v = false; };
template <class A> struct same_t<A, A> { static constexpr bool v = true; };

#define KSWZ(row, colB) ((row) * 256 + ((colB) ^ (((row) & 7) << 4)))
#define SBAR() __builtin_amdgcn_sched_barrier(0)
__device__ __forceinline__ int v_st(int k, int c) { const int kk = (k & ~0xC) | ((k & 4) << 1) | ((k & 8) >> 1); return ((kk >> 3) * 4 + (c >> 5)) * 512 + ((kk & 7) * 32 + (c & 31)) * 2; }
__device__ __forceinline__ int v_rd_base(int lane) { return ((lane & 3) << 3) | (((lane >> 2) & 3) << 6) | (((lane >> 4) & 1) << 5) | (((lane >> 5) & 1) << 8); }
constexpr int v_rd_off(int d0, int ks, int half) { return d0 * 512 + ks * 4096 + half * 2048; }
__device__ __forceinline__ int crow(int r, int hi) { return (r & 3) + 8 * (r >> 2) + 4 * hi; }
__device__ __forceinline__ unsigned cvtpk(float lo, float hi) {
    unsigned r; asm volatile("v_cvt_pk_bf16_f32 %0, %1, %2" : "=v"(r) : "v"(lo), "v"(hi)); return r;
}
__device__ __forceinline__ bf16x8 pack8(f32x4 a, f32x4 b) {
    u32x4 w = {cvtpk(a[0], a[1]), cvtpk(a[2], a[3]), cvtpk(b[0], b[1]), cvtpk(b[2], b[3])};
    return *reinterpret_cast<bf16x8*>(&w);
}
template <class T> __device__ __forceinline__ bf16x8 load8(const T* p) {
    if constexpr (same_t<T, float>::v) { return pack8(*(const f32x4*)p, *(const f32x4*)(p + 4)); }
    else { return *reinterpret_cast<const bf16x8*>(p); }
}
__device__ __forceinline__ void mask_tile(f32x16& p0, f32x16& p1, int dq, unsigned W) {
    const float NEG = -__builtin_inff();
#pragma unroll
    for (int r = 0; r < 16; ++r) {
        const int c = (r & 3) + 8 * (r >> 2);
        if ((unsigned)(dq - c) >= W) p0[r] = NEG;
        if ((unsigned)(dq - c - 32) >= W) p1[r] = NEG;
    }
}
__device__ __forceinline__ void partialSM(f32x16& p0, f32x16& p1, float& m_reg, float& mn, float& alpha) {
    float pmax = p0[0]; for (int r = 1; r < 16; ++r) pmax = fmaxf(pmax, p0[r]); for (int r = 0; r < 16; ++r) pmax = fmaxf(pmax, p1[r]);
    { auto rr = __builtin_amdgcn_permlane32_swap(__float_as_uint(pmax), __float_as_uint(pmax), false, false);
      pmax = fmaxf(__uint_as_float(rr[0]), __uint_as_float(rr[1])); }
    constexpr float C2 = 1.4426950408889634f * SCALE;
    if (__builtin_expect(__all((pmax - m_reg) * SCALE <= THR), 1)) { mn = m_reg; alpha = 1.f; }
    else { mn = fmaxf(m_reg, pmax); alpha = __builtin_amdgcn_exp2f((m_reg - mn) * C2); m_reg = mn; }
    const float mnL = -mn * C2;
    for (int r = 0; r < 16; ++r) p0[r] = fmaf(p0[r], C2, mnL); for (int r = 0; r < 16; ++r) p1[r] = fmaf(p1[r], C2, mnL);
    for (int r = 0; r < 16; ++r) p0[r] = __builtin_amdgcn_exp2f(p0[r]);
}
__device__ __forceinline__ void finishSM(f32x16& p0, f32x16& p1, float alpha, float& l_reg, bf16x8& pa0, bf16x8& pa1, bf16x8& pa2, bf16x8& pa3) {
    for (int r = 0; r < 16; ++r) p1[r] = __builtin_amdgcn_exp2f(p1[r]);
    float ps = 0; for (int r = 0; r < 16; ++r) ps += p0[r]; for (int r = 0; r < 16; ++r) ps += p1[r];
    { auto rr = __builtin_amdgcn_permlane32_swap(__float_as_uint(ps), __float_as_uint(ps), false, false);
      ps = __uint_as_float(rr[0]) + __uint_as_float(rr[1]); }
    l_reg = l_reg * alpha + ps;
#define PK4(P, B_, OUT) do { unsigned a0 = cvtpk(P[B_+0], P[B_+1]), a1 = cvtpk(P[B_+2], P[B_+3]);                          \
        unsigned b0 = cvtpk(P[B_+4], P[B_+5]), b1 = cvtpk(P[B_+6], P[B_+7]);                                             \
        auto r0 = __builtin_amdgcn_permlane32_swap(a0, b0, false, false); auto r1 = __builtin_amdgcn_permlane32_swap(a1, b1, false, false); \
        u32x4 w = {r0[0], r1[0], r0[1], r1[1]}; OUT = *reinterpret_cast<bf16x8*>(&w); } while (0)
    PK4(p0, 0, pa0); PK4(p0, 8, pa1); PK4(p1, 0, pa2); PK4(p1, 8, pa3);
#undef PK4
}
template <int KB, bool SK>
__device__ __forceinline__ void qkt(f32x16& p0, f32x16& p1, const char* K_lds, int r32, int hi, const bf16x8* qr, bool act) {
    if (SK && !act) { const float NEG = -__builtin_inff();
#pragma unroll
        for (int r = 0; r < 16; ++r) { p0[r] = NEG; p1[r] = NEG; } return; }
    p0 = f32x16{}; p1 = f32x16{};
    const char* kb[4];
#pragma unroll
    for (int dd = 0; dd < 4; ++dd) kb[dd] = K_lds + KB * SHM_K + KSWZ(r32, (dd * 16 + hi * 8) * 2);
#pragma unroll
    for (int d0 = 0; d0 < 8; ++d0) { const char* a = kb[d0 & 3] + (d0 >> 2) * 128;
        bf16x8 b0 = *reinterpret_cast<const bf16x8*>(a);
        bf16x8 b1 = *reinterpret_cast<const bf16x8*>(a + 32 * 256);
        p0 = __builtin_amdgcn_mfma_f32_32x32x16_bf16(b0, qr[d0], p0, 0, 0, 0);
        p1 = __builtin_amdgcn_mfma_f32_32x32x16_bf16(b1, qr[d0], p1, 0, 0, 0); }
}
template <int VB, bool SK>
__device__ __forceinline__ void pv_tile(f32x16* o, int vb0, bf16x8 pa0, bf16x8 pa1, bf16x8 pa2, bf16x8 pa3, bool act) {
    if (SK && !act) return;
#define TRRD(dst, off) asm volatile("ds_read_b64_tr_b16 %0, %1 offset:%2" : "=&v"(dst) : "v"(vb0), "i"(off) : "memory")
#define PV_D0(d0) do { s16x4 l0, l1, l2, l3, h0, h1, h2, h3; constexpr int b_ = VB * SHM_V + v_rd_off(d0, 0, 0);     \
        TRRD(l0, b_); TRRD(h0, b_ + 2048); TRRD(l1, b_ + 4096); TRRD(h1, b_ + 6144); TRRD(l2, b_ + 8192); TRRD(h2, b_ + 10240); TRRD(l3, b_ + 12288); TRRD(h3, b_ + 14336); \
        asm volatile("s_waitcnt lgkmcnt(0)" ::: "memory"); SBAR();                 \
        o[d0] = __builtin_amdgcn_mfma_f32_32x32x16_bf16(pa0, (bf16x8){l0[0], l0[1], l0[2], l0[3], h0[0], h0[1], h0[2], h0[3]}, o[d0], 0, 0, 0);   \
        o[d0] = __builtin_amdgcn_mfma_f32_32x32x16_bf16(pa1, (bf16x8){l1[0], l1[1], l1[2], l1[3], h1[0], h1[1], h1[2], h1[3]}, o[d0], 0, 0, 0);   \
        o[d0] = __builtin_amdgcn_mfma_f32_32x32x16_bf16(pa2, (bf16x8){l2[0], l2[1], l2[2], l2[3], h2[0], h2[1], h2[2], h2[3]}, o[d0], 0, 0, 0);   \
        o[d0] = __builtin_amdgcn_mfma_f32_32x32x16_bf16(pa3, (bf16x8){l3[0], l3[1], l3[2], l3[3], h3[0], h3[1], h3[2], h3[3]}, o[d0], 0, 0, 0); } while (0)
    PV_D0(0); PV_D0(1); PV_D0(2); PV_D0(3);
#undef PV_D0
#undef TRRD
}

template <class TIn, class TOut> struct BlockRef { const TIn* Q; const TIn* K; const TIn* V; TOut* O; int P0; };
template <class TIn> struct Seam {
    bf16x8 qr[8];
    bf16x8 st_v0, st_v1, st_k0, st_k1; f32x4 sf0, sf1, sf2, sf3;
    f32x4 tq[16];
};
__device__ __forceinline__ int swa_jlo(int P0, int W) { const int lowk = P0 - W + 1; return lowk > 0 ? lowk / KVBLK : 0; }
#define ROW(p, k0, rr) ((p) + (size_t)((k0) + (rr)) * KVPITCH + sc)
#define VMW() asm volatile("s_waitcnt vmcnt(0)" ::: "memory")
#define VMWN(n) asm volatile("s_waitcnt vmcnt(%0)" :: "i"(n) : "memory")
#define SLOAD_H(Kp, Vp, k0) do { S.st_v0 = load8<TIn>(ROW(Vp, k0, sr)); S.st_v1 = load8<TIn>(ROW(Vp, k0, 32 + sr));              \
                         S.st_k0 = load8<TIn>(ROW(Kp, k0, sr)); S.st_k1 = load8<TIn>(ROW(Kp, k0, 32 + sr)); } while (0)
#define SWRITE_HK(bf) do { *(bf16x8*)(K_lds + (bf) * SHM_K + kws) = S.st_k0; *(bf16x8*)(K_lds + (bf) * SHM_K + kws + 32 * 256) = S.st_k1; } while (0)
#define SWRITE_HV(bf) do { *(bf16x8*)(V_lds + (bf) * SHM_V + vst0) = S.st_v0; *(bf16x8*)(V_lds + (bf) * SHM_V + vst1) = S.st_v1; } while (0)
#define SWRITE_H(bf) do { SWRITE_HV(bf); SWRITE_HK(bf); } while (0)
#define SLOAD_F(p, k0) do { S.sf0 = *(const f32x4*)ROW(p, k0, sr); S.sf1 = *(const f32x4*)(ROW(p, k0, sr) + 4);                \
                            S.sf2 = *(const f32x4*)ROW(p, k0, 32 + sr); S.sf3 = *(const f32x4*)(ROW(p, k0, 32 + sr) + 4); } while (0)
#define SWRITE_KF(bf) do { *(bf16x8*)(K_lds + (bf) * SHM_K + kws) = pack8(S.sf0, S.sf1); *(bf16x8*)(K_lds + (bf) * SHM_K + kws + 32 * 256) = pack8(S.sf2, S.sf3); } while (0)
#define SWRITE_VF(bf) do { *(bf16x8*)(V_lds + (bf) * SHM_V + vst0) = pack8(S.sf0, S.sf1); *(bf16x8*)(V_lds + (bf) * SHM_V + vst1) = pack8(S.sf2, S.sf3); } while (0)
template <class TIn, class TOut>
__device__ __forceinline__ void causal_swa_prime(const BlockRef<TIn, TOut>& cur, int W, char* lds, Seam<TIn>& S) {
    constexpr bool F32 = same_t<TIn, float>::v;
    int tid_ = threadIdx.x; asm volatile("" : "+v"(tid_)); const int tid = tid_, wid = __builtin_amdgcn_readfirstlane(tid >> 6), lane = tid & 63, r32 = lane & 31, hi = lane >> 5;
    const int sr = tid >> 4, sc = (tid & 15) * 8, kws = KSWZ(sr, sc * 2); char* K_lds = lds + 2 * SHM_V;
    const int kb0 = swa_jlo(cur.P0, W) * KVBLK;
    for (int d0 = 0; d0 < 8; ++d0) S.qr[d0] = load8<TIn>(cur.Q + (size_t)(wid * QBLK + r32) * QPITCH + d0 * 16 + hi * 8);
    if constexpr (F32) { SLOAD_F((const float*)cur.K, kb0); VMW(); SWRITE_KF(0); SBAR(); SLOAD_F((const float*)cur.V, kb0); }
    else { SLOAD_H(cur.K, cur.V, kb0); VMW(); SWRITE_HK(0); }
    __syncthreads();
}
template <class TIn, class TOut>
__device__ __forceinline__ void causal_swa_block(const BlockRef<TIn, TOut>& cur, const BlockRef<TIn, TOut>& nxt, int skv, int W, char* lds, Seam<TIn>& S) {
    constexpr bool F32 = same_t<TIn, float>::v;
    int tid_ = threadIdx.x; asm volatile("" : "+v"(tid_)); const int tid = tid_, wid = __builtin_amdgcn_readfirstlane(tid >> 6), lane = tid & 63, r32 = lane & 31, hi = lane >> 5;
    const int j_lo = swa_jlo(cur.P0, W);
    int j_hi = (cur.P0 + QB - 1) / KVBLK + 1; if (j_hi > skv / KVBLK) j_hi = skv / KVBLK;
    const int NT = j_hi - j_lo;
    const int kbn = swa_jlo(nxt.P0, W) * KVBLK;
    const int qlo = cur.P0 + wid * QBLK, qm = qlo + r32 - 4 * hi;
    char* V_lds = lds; char* K_lds = lds + 2 * SHM_V;
    float* ws = (float*)(lds + 2 * SHM_V + 2 * SHM_K) + wid * 64; float* li_l = ws, * al_l = ws + 32;
    float m_reg = -1e30f, l_reg = 0; f32x16 o[4] = {};
    const int sr = tid >> 4, sc = (tid & 15) * 8, vst0 = v_st(sr, sc), vst1 = v_st(32 + sr, sc), kws = KSWZ(sr, sc * 2);
    const int vb0 = (int)(uintptr_t)V_lds + v_rd_base(lane);
    const TIn* Kh = cur.K; const TIn* Vh = cur.V;
#define RESC(a) do { if (__any((a) < 1.f)) { if (hi == 0) al_l[r32] = (a); asm volatile("s_waitcnt lgkmcnt(0)" ::: "memory");              \
                     for (int d_ = 0; d_ < 4; ++d_) for (int r = 0; r < 16; ++r) o[d_][r] *= al_l[crow(r, hi)]; } } while (0)
#define KBASE(t) ((j_lo + (t)) * KVBLK)
#define ACT(t) (KBASE(t) <= qlo + QBLK - 1 && KBASE(t) + KVBLK - 1 >= qlo - W + 1)
#define MASKT(P0_, P1_, t) do { const int kb_ = KBASE(t); if ((!SK || ACT(t)) && (kb_ + KVBLK - 1 > qlo || kb_ <= qlo + QBLK - 1 - W)) mask_tile(P0_, P1_, qm - kb_, (unsigned)W); } while (0)
    constexpr int NQL = F32 ? 16 : 8;
    constexpr bool SK = WSKIP && !F32;
#define SEAM_K0() do { VMWN(NQL); if constexpr (F32) { SWRITE_KF(0); SBAR(); SLOAD_F((const float*)nxt.V, kbn); } else { SWRITE_HK(0); } SBAR(); } while (0)
    f32x16 pA0, pA1, pB0, pB1; float mnA, mnB, alA, alB; bf16x8 pa0, pa1, pa2, pa3;
    if constexpr (F32) { VMW(); SWRITE_VF(0); SBAR(); } else { SWRITE_HV(0); SBAR(); }
    if (NT > 1) { if constexpr (F32) SLOAD_F((const float*)Kh, KBASE(1)); else SLOAD_H(Kh, Vh, KBASE(1)); }
    SBAR(); qkt<0, SK>(pA0, pA1, K_lds, r32, hi, S.qr, ACT(0));
    if constexpr (F32) { if (NT > 1) { VMW(); SWRITE_KF(1); SBAR(); SLOAD_F((const float*)Vh, KBASE(1)); } }
    MASKT(pA0, pA1, 0); partialSM(pA0, pA1, m_reg, mnA, alA);
    if (NT > 1) { VMW(); if constexpr (F32) { SWRITE_VF(1); SBAR(); if (NT > 2) SLOAD_F((const float*)Kh, KBASE(2)); } else SWRITE_H(1); }
    __syncthreads();
#define HALF_STEP(PX0, PX1, mnX, alX, PY0, PY1, alY, t, KB, VB, SB) do {                                                      \
        SBAR(); qkt<KB, SK>(PX0, PX1, K_lds, r32, hi, S.qr, ACT(t));                                             \
        finishSM(PY0, PY1, alY, l_reg, pa0, pa1, pa2, pa3); SBAR();                                                           \
        if ((t) + 1 < NT) { if constexpr (F32) { VMW(); SWRITE_KF(SB); SBAR(); SLOAD_F((const float*)Vh, KBASE((t) + 1)); }  \
                            else { SLOAD_H(Kh, Vh, KBASE((t) + 1)); } SBAR(); }                                               \
        pv_tile<VB, SK>(o, vb0, pa0, pa1, pa2, pa3, ACT((t) - 1)); MASKT(PX0, PX1, (t)); partialSM(PX0, PX1, m_reg, mnX, alX);                                        \
        __syncthreads();                                                                                                      \
        if ((t) + 1 < NT) { VMW(); if constexpr (F32) { SWRITE_VF(SB); SBAR(); if ((t) + 2 < NT) SLOAD_F((const float*)Kh, KBASE((t) + 2)); } \
                            else { SWRITE_H(SB); } }                                                                          \
        RESC(alX); __syncthreads(); } while (0)
    for (int t = 1; t + 1 < NT; t += 2) {
        HALF_STEP(pB0, pB1, mnB, alB, pA0, pA1, alA, t, 1, 0, 0);
        HALF_STEP(pA0, pA1, mnA, alA, pB0, pB1, alB, t + 1, 0, 1, 1);
    }
    const bool even = (NT & 1) == 0;
    if (even) { SBAR(); qkt<1, SK>(pB0, pB1, K_lds, r32, hi, S.qr, ACT(NT - 1)); SBAR(); }
#define QROW(e) (nxt.Q + (size_t)(wid * QBLK + r32) * QPITCH + ((e) >> 1) * 16 + hi * 8 + ((e) & 1) * 4)
    if constexpr (F32) { SLOAD_F((const float*)nxt.K, kbn); SBAR();
#pragma unroll
        for (int e = 0; e < 8; ++e) S.tq[e] = *(const f32x4*)QROW(e); }
    else { SLOAD_H(nxt.K, nxt.V, kbn); SBAR();
#pragma unroll
        for (int d0 = 0; d0 < 8; ++d0) S.qr[d0] = load8<TIn>(nxt.Q + (size_t)(wid * QBLK + r32) * QPITCH + d0 * 16 + hi * 8); }
    SBAR();
    finishSM(pA0, pA1, alA, l_reg, pa0, pa1, pa2, pa3); SBAR();
    if constexpr (F32) {
#pragma unroll
        for (int e = 8; e < 16; ++e) S.tq[e] = *(const f32x4*)QROW(e); SBAR(); }
#undef QROW
    pv_tile<0, SK>(o, vb0, pa0, pa1, pa2, pa3, ACT(even ? NT - 2 : NT - 1));
    if (even) { MASKT(pB0, pB1, NT - 1); partialSM(pB0, pB1, m_reg, mnB, alB); __syncthreads(); RESC(alB);
        finishSM(pB0, pB1, alB, l_reg, pa0, pa1, pa2, pa3); SBAR(); pv_tile<1, SK>(o, vb0, pa0, pa1, pa2, pa3, ACT(NT - 1)); }
    SBAR(); SEAM_K0();
    if (hi == 0) li_l[r32] = l_reg; asm volatile("s_waitcnt lgkmcnt(0)" ::: "memory");
    float rli[16];
#pragma unroll
    for (int r = 0; r < 16; ++r) rli[r] = __builtin_amdgcn_rcpf(li_l[crow(r, hi)]);
    TOut* Ow = cur.O + (size_t)(wid * QBLK) * OPITCH;
#pragma unroll
    for (int r = 0; r < 16; ++r) { const int orow = crow(r, hi);
#pragma unroll
        for (int d0 = 0; d0 < 4; ++d0) { const float v = o[d0][r] * rli[r];
            if constexpr (same_t<TOut, float>::v) { Ow[(size_t)orow * OPITCH + d0 * 32 + r32] = v; }
            else { const float vn = __shfl_xor(v, 1);
                   if ((r32 & 1) == 0) *(unsigned*)(Ow + (size_t)orow * OPITCH + d0 * 32 + r32) = cvtpk(v, vn); } } }
    if constexpr (F32) {
#pragma unroll
        for (int d0 = 0; d0 < 8; ++d0) S.qr[d0] = pack8(S.tq[2 * d0], S.tq[2 * d0 + 1]); }
    __syncthreads();
#undef RESC
#undef KBASE
#undef ACT
#undef MASKT
#undef SEAM_K0
#undef HALF_STEP
}
#undef ROW
#undef VMW
#undef VMWN
#undef SLOAD_H
#undef SWRITE_HK
#undef SWRITE_HV
#undef SWRITE_H
#undef SLOAD_F
#undef SWRITE_KF
#undef SWRITE_VF

}
constexpr int NWAVES = 8;
#ifndef MK_SPLIT
#define MK_SPLIT 0
#endif
constexpr int BATCH = 16, SEQ = 2048, DM = 2048, M = BATCH * SEQ, DEPTH = 2, DFF = 8192;
constexpr int IN_COLS = 6160;
constexpr int NPROJ = 6656;
constexpr int C_GQ = 0, C_GK = 512, C_GV = 1024, C_GG = 2048, C_GATE = 3072, C_DQ = 3584, C_DK = 4608, C_DV = 5632;
constexpr int S_LR = 3072, S_SHIFT = 496;
constexpr int PH_PER_LAYER = 7, N_PHASES = 1 + DEPTH * PH_PER_LAYER;
constexpr float NORM_EPS = 1e-6f, SUBLN_EPS = 1e-5f;
constexpr float GLA_QSCALE = 0.08838834764831845f;

constexpr size_t MiB = 1u << 20;
constexpr size_t WS_CTL = 0, CTL_ZERO_BYTES = 1 * MiB;
constexpr size_t WS_BIAS = 1 * MiB;
constexpr size_t WS_COS = 2 * MiB, WS_SIN = 10 * MiB;
constexpr size_t WS_WIN = 18 * MiB;
constexpr size_t WS_WOUT = 70 * MiB;
constexpr size_t WS_WUP = 86 * MiB;
constexpr size_t WS_WDN = 150 * MiB;
constexpr size_t WS_XN = 214 * MiB;
constexpr size_t WS_XB2 = 342 * MiB;
constexpr size_t WS_PROJ = 342 * MiB;
constexpr size_t WS_O = 758 * MiB;
constexpr size_t WS_HID = 470 * MiB;
constexpr size_t WS_SS = 1014 * MiB;
constexpr size_t WS_END = 1019 * MiB;
static_assert(WS_WIN + (size_t)DEPTH * NPROJ * DM * 2 <= WS_WOUT && WS_WOUT + (size_t)DEPTH * DM * DM * 2 <= WS_WUP && WS_WUP + (size_t)DEPTH * DFF * DM * 2 <= WS_WDN && WS_WDN + (size_t)DEPTH * DFF * DM * 2 <= WS_XN, "ws map: weights");
static_assert(WS_XN + (size_t)M * DM * 2 <= WS_PROJ && WS_PROJ + (size_t)M * NPROJ * 2 <= WS_O && WS_O + (size_t)M * 2048 * 4 <= WS_END && WS_HID + (size_t)M * DFF * 2 <= WS_END && WS_XB2 + (size_t)M * DM * 2 <= WS_HID, "ws map: activations");
constexpr int CW_BAR = 4096;
constexpr int CW_Q = 8192;


constexpr int RING_OFF = 0, RING_BYTES = 131072;
constexpr int LDSCTL_OFF = RING_BYTES, MISC_OFF = LDSCTL_OFF + 320;
constexpr int RED_OFF = RING_BYTES + 1024;
constexpr int LDS_BYTES = 147456;
static_assert(MISC_OFF + 128 <= RED_OFF && RED_OFF + 4096 <= LDS_BYTES, "LDS map");

#define GAS __attribute__((address_space(1)))
#define LAS __attribute__((address_space(3)))
#define DI __device__ __forceinline__
typedef unsigned short bf16;
typedef unsigned v4u __attribute__((ext_vector_type(4)));
typedef unsigned v2u __attribute__((ext_vector_type(2)));
typedef float f32x4 __attribute__((ext_vector_type(4)));
typedef float f32x2v __attribute__((ext_vector_type(2)));
typedef float f32x16 __attribute__((ext_vector_type(16)));
typedef short bf16x8 __attribute__((ext_vector_type(8)));
typedef short s16x4 __attribute__((ext_vector_type(4)));
typedef __bf16 bf16x2_t __attribute__((ext_vector_type(2)));
typedef GAS unsigned gu32;
#define RLX_AGENT __ATOMIC_RELAXED, __HIP_MEMORY_SCOPE_AGENT
#define LDS_WAIT() asm volatile("s_waitcnt lgkmcnt(0)" ::: "memory")
#define VM_WAIT() asm volatile("s_waitcnt vmcnt(0)" ::: "memory")
DI unsigned pk2(float lo, float hi) { f32x2v v = {lo, hi}; bf16x2_t b = __builtin_convertvector(v, bf16x2_t); return __builtin_bit_cast(unsigned, b); }
DI float bf_lo(unsigned u) { return __uint_as_float(u << 16); }
DI float bf_hi(unsigned u) { return __uint_as_float(u & 0xffff0000u); }
DI int opaque_tid() { int t = threadIdx.x; asm volatile("" : "+v"(t)); return t; }
#define PH_IDS const int tid = opaque_tid(), lane = tid & 63, wave = __builtin_amdgcn_readfirstlane(tid >> 6), gw = (int)blockIdx.x * NWAVES + wave; (void)lane; (void)gw
#define MFMA32(a, b, c) __builtin_amdgcn_mfma_f32_32x32x16_bf16((a), (b), (c), 0, 0, 0)

#define XB_TMO      128
#define XB_XCNT(j)  (256  + 64 * (j))
#define XB_XSUB(j)  (1280 + 64 * (j))
#define XB_XGEN(j)  (2304 + 64 * (j))
#define XB_TOP      3328
#define XB_TOPGEN   3392
#define XCD_BAR_WORDS 3456
#define XB_SPIN_CAP (1u << 18)

__device__ __forceinline__ unsigned xb_ld(unsigned* p)              { return __hip_atomic_load(p, __ATOMIC_RELAXED, __HIP_MEMORY_SCOPE_AGENT); }
__device__ __forceinline__ unsigned xb_add(unsigned* p, unsigned v) { return __hip_atomic_fetch_add(p, v, __ATOMIC_RELAXED, __HIP_MEMORY_SCOPE_AGENT); }
__device__ __forceinline__ unsigned xb_xcc_id() { return (unsigned)__builtin_amdgcn_s_getreg((3 << 11) | 20) & 0xFu; }
#define XB_SPIN(cond, bar) do { unsigned _sp = 0; while (cond) { __builtin_amdgcn_s_sleep(1); \
    if ((++_sp & 255u) == 0u) { if (xb_ld(&(bar)[XB_TMO])) break; if (_sp > XB_SPIN_CAP) { atomicAdd(&(bar)[XB_TMO], 1u); break; } } } } while (0)

struct XcdBarrier {
    unsigned* bar; unsigned x;
    volatile LAS unsigned* st;
};

__device__ __forceinline__ XcdBarrier xcd_barrier_post(unsigned* bar, volatile LAS unsigned* st) {
    XcdBarrier b; b.bar = bar; b.x = xb_xcc_id(); b.st = st;
    if (threadIdx.x == 0) (void)xb_add(&bar[XB_XCNT(b.x)], 1u);
    return b;
}
__device__ __forceinline__ void xcd_barrier_complete(unsigned* bar, unsigned x, unsigned& nloc, unsigned& nx) {
    const unsigned G = gridDim.x * gridDim.y * gridDim.z;
    unsigned sum, cnt, mine, sp = 0u;
    for (;;) {
        sum = 0u; cnt = 0u; mine = 0u;
#pragma unroll
        for (unsigned j = 0; j < 16; ++j) { const unsigned c = xb_ld(&bar[XB_XCNT(j)]); sum += c; cnt += (c > 0u) ? 1u : 0u; mine = (j == x) ? c : mine; }
        if (sum == G) break;
        __builtin_amdgcn_s_sleep(1);
        if ((++sp & 255u) == 0u) { if (xb_ld(&bar[XB_TMO])) break; if (sp > XB_SPIN_CAP) { atomicAdd(&bar[XB_TMO], 1u); break; } }
    }
    nloc = mine > 0u ? mine : 1u; nx = cnt > 0u ? cnt : 1u;
}

__device__ __forceinline__ void xcd_barrier(const XcdBarrier& b) {
    asm volatile("s_waitcnt vmcnt(0)" ::: "memory");
    __syncthreads();
    if (threadIdx.x == 0) {
        unsigned* bar = b.bar;
        __builtin_amdgcn_s_waitcnt(0);
        unsigned nloc = b.st[0], nx = b.st[1];
        if (nloc == 0u) { xcd_barrier_complete(bar, b.x, nloc, nx); b.st[0] = nloc; b.st[1] = nx; }
        const unsigned old = xb_add(&bar[XB_XSUB(b.x)], 1u);
        const unsigned gen = old / nloc;
        if (old + 1u == (gen + 1u) * nloc) {
            __builtin_amdgcn_fence(__ATOMIC_RELEASE, "agent");
            asm volatile("s_waitcnt vmcnt(0)" ::: "memory");
            const unsigned og = xb_add(&bar[XB_TOP], 1u);
            const unsigned tg = og / nx;
            if (og + 1u == (tg + 1u) * nx) xb_add(&bar[XB_TOPGEN], 1u);
            else XB_SPIN(xb_ld(&bar[XB_TOPGEN]) == tg, bar);
            __builtin_amdgcn_fence(__ATOMIC_ACQUIRE, "agent");
            xb_add(&bar[XB_XGEN(b.x)], 1u);
            asm volatile("s_waitcnt vmcnt(0)" ::: "memory");
        } else {
            XB_SPIN(xb_ld(&bar[XB_XGEN(b.x)]) == gen, bar);
            __builtin_amdgcn_fence(__ATOMIC_ACQUIRE, "agent");
            asm volatile("s_waitcnt vmcnt(0)" ::: "memory");
        }
    }
    __syncthreads();
}

struct Args { const void* in[18]; float* out; unsigned char* ws; int ph_lo, ph_hi; };
struct Frame {
    LAS unsigned char* lds;
    volatile LAS unsigned* MISC;
    gu32* ctl;
    int G, NGW;
    unsigned char* ws;
};
enum { I_X = 0, I_POS, I_ATTN_NW, I_WIN, I_GW2, I_GB, I_GLA_NW, I_QNW, I_KNW, I_LQ1, I_LK1, I_LQ2, I_LK2, I_SUBW, I_WOUT, I_MLP_NW, I_WUP, I_WDN };
typedef __attribute__((address_space(4))) const Args* kargs_t;
DI kargs_t kargs() { kargs_t p = (kargs_t)__builtin_amdgcn_kernarg_segment_ptr(); asm volatile("" : "+s"(p)); return p; }
#define INP(T, k) ((const T*)(const GAS T*)kargs()->in[k])
#define OUTP() ((float*)(GAS float*)kargs()->out)
DI GAS unsigned char* ws_opaque(Frame& F) { GAS unsigned char* w = (GAS unsigned char*)F.ws; asm volatile("" : "+s"(w)); return w; }
DI float wave_sum(float v) {
#pragma unroll
    for (int o = 1; o < 64; o <<= 1) v += __shfl_xor(v, o);
    return v;
}

DI void p0_write_tile(bf16* WT, int K, int drow0, int k0, LAS float* scr, int lane, const float* rs) {
    const int c = lane & 7;
    f32x4 s0 = {1.f, 1.f, 1.f, 1.f}, s1 = s0;
    if (rs) { s0 = *(const f32x4*)(rs + k0 + 8 * c); s1 = *(const f32x4*)(rs + k0 + 8 * c + 4); }
    LDS_WAIT(); asm volatile("" ::: "memory");
#pragma unroll
    for (int j = 0; j < 4; ++j) { const int n = (lane >> 3) + 8 * j; const LAS float* s = scr + (8 * c) * 33 + n;
        v4u o; o.x = pk2(s[0 * 33] * s0[0], s[1 * 33] * s0[1]); o.y = pk2(s[2 * 33] * s0[2], s[3 * 33] * s0[3]); o.z = pk2(s[4 * 33] * s1[0], s[5 * 33] * s1[1]); o.w = pk2(s[6 * 33] * s1[2], s[7 * 33] * s1[3]);
        *(GAS v4u*)(WT + (size_t)(drow0 + n) * K + k0 + 8 * c) = o; }
    LDS_WAIT(); asm volatile("" ::: "memory");
}
DI void p0_transpose_tile(const float* W, int SP, int scol0, bf16* WT, int K, int drow0, int k0, LAS float* scr, int lane, const float* rs) {
#pragma unroll 8
    for (int i = 0; i < 32; ++i) { const int kk = 2 * i + (lane >> 5); scr[kk * 33 + (lane & 31)] = W[(size_t)(k0 + kk) * SP + scol0 + (lane & 31)]; }
    p0_write_tile(WT, K, drow0, k0, scr, lane, rs);
}
DI void p0_gate_tile(const float* W, const float* w2, bf16* WT, int j0, int k0, LAS float* scr, int lane, const float* rs) {
    float w2r[16];
#pragma unroll
    for (int r = 0; r < 16; ++r) w2r[r] = w2[r * 512 + j0 + (lane & 31)];
#pragma unroll 4
    for (int i = 0; i < 32; ++i) { const int kk = 2 * i + (lane >> 5); const f32x4* wr = (const f32x4*)(W + (size_t)(k0 + kk) * IN_COLS + S_LR);
        float a = 0.f;
#pragma unroll
        for (int q = 0; q < 4; ++q) { const f32x4 t = wr[q]; a = fmaf(t.x, w2r[4 * q], a); a = fmaf(t.y, w2r[4 * q + 1], a); a = fmaf(t.z, w2r[4 * q + 2], a); a = fmaf(t.w, w2r[4 * q + 3], a); }
        scr[kk * 33 + (lane & 31)] = a; }
    p0_write_tile(WT, DM, C_GATE + j0, k0, scr, lane, rs);
}
DI void sincos_red(float ang, float& s, float& c) {
    const double a = (double)ang; const double kq = __builtin_rint(a * 0.6366197723675814);
    double r = __builtin_fma(-kq, 1.5707963267948966, a); r = __builtin_fma(-kq, 6.123233995736766e-17, r);
    const float x = (float)r, x2 = x * x; const int q = (int)kq & 3;
    const float sp = x + x * x2 * (-1.6666654611e-1f + x2 * (8.3321608736e-3f + x2 * (-1.9515295891e-4f)));
    const float cp = 1.f - 0.5f * x2 + x2 * x2 * (4.166664568298827e-2f + x2 * (-1.388731625493765e-3f + x2 * 2.443315711809948e-5f));
    s = (q == 0) ? sp : (q == 1) ? cp : (q == 2) ? -sp : -cp;
    c = (q == 0) ? cp : (q == 1) ? -sp : (q == 2) ? -cp : sp;
}
DI void p0_prologue(Frame& F) {
    PH_IDS;
    LAS float* scr = (LAS float*)(F.lds + RING_OFF + wave * 16384);
    constexpr int NB_IN = NPROJ / 32, I_IN = (DM / 64) * NB_IN, I_OUT = (DM / 64) * (DM / 32), I_UP = (DM / 64) * (DFF / 32), I_DN = (DFF / 64) * (DM / 32), I_LAYER = I_IN + I_OUT + I_UP + I_DN;
    GAS unsigned char* ws = ws_opaque(F);
    bf16* WinT = (bf16*)(ws + WS_WIN); bf16* WoutT = (bf16*)(ws + WS_WOUT); bf16* WupT = (bf16*)(ws + WS_WUP); bf16* WdnT = (bf16*)(ws + WS_WDN);
    for (int it = gw; it < DEPTH * I_LAYER; it += F.NGW) {
        const int L = it / I_LAYER; int r = it - L * I_LAYER;
        if (r < I_IN) { const int kb = r / NB_IN, nb = r - kb * NB_IN, drow0 = nb * 32; const float* W = INP(float, I_WIN) + (size_t)L * DM * IN_COLS; bf16* WT = WinT + (size_t)L * NPROJ * DM;
            if (drow0 >= C_GATE && drow0 < C_DQ) p0_gate_tile(W, INP(float, I_GW2) + (size_t)L * 16 * 512, WT, drow0 - C_GATE, kb * 64, scr, lane, INP(float, I_ATTN_NW) + L * DM);
            else p0_transpose_tile(W, IN_COLS, drow0 < C_GATE ? drow0 : drow0 - S_SHIFT, WT, DM, drow0, kb * 64, scr, lane, INP(float, I_ATTN_NW) + L * DM);
            continue; }
        r -= I_IN;
        if (r < I_OUT) { const int kb = r / (DM / 32), nb = r % (DM / 32); p0_transpose_tile(INP(float, I_WOUT) + (size_t)L * DM * DM, DM, nb * 32, WoutT + (size_t)L * DM * DM, DM, nb * 32, kb * 64, scr, lane, nullptr); continue; }
        r -= I_OUT;
        if (r < I_UP) { const int kb = r / (DFF / 32), nb = r % (DFF / 32); p0_transpose_tile(INP(float, I_WUP) + (size_t)L * DM * DFF, DFF, nb * 32, WupT + (size_t)L * DFF * DM, DM, nb * 32, kb * 64, scr, lane, INP(float, I_MLP_NW) + L * DM); continue; }
        r -= I_UP;
        { const int kb = r / (DM / 32), nb = r % (DM / 32); p0_transpose_tile(INP(float, I_WDN) + (size_t)L * DFF * DM, DM, nb * 32, WdnT + (size_t)L * DM * DFF, DFF, nb * 32, kb * 64, scr, lane, nullptr); }
    }
    const int gt = gw * 64 + lane, NT = F.NGW * 64;
    float* bias = (float*)(ws + WS_BIAS); const float* gate_b = INP(float, I_GB); const int* pos = INP(int, I_POS);
    for (int i = gt; i < DEPTH * NPROJ; i += NT) { const int L = i / NPROJ, c = i - L * NPROJ; bias[i] = (c >= C_GATE && c < C_DQ) ? gate_b[L * 512 + c - C_GATE] : 0.f; }
    float* ct = (float*)(ws + WS_COS); float* st = (float*)(ws + WS_SIN);
    for (int i = gt; i < M * 64; i += NT) { const int row = i >> 6, f = i & 63;
        const float inv_freq = (float)exp2(-(double)f * (13.287712379549449 / 64.0));
        const float ang = (float)pos[row] * inv_freq; float s, c; sincos_red(ang, s, c); ct[i] = c; st[i] = s; }
    const float* x = INP(float, I_X); bf16* xb = (bf16*)OUTP(); GAS f32x4* ss0 = (GAS f32x4*)(ws + WS_SS);
    for (int m = gw; m < M; m += F.NGW) {
        const GAS f32x4* xr = (const GAS f32x4*)(x + (size_t)m * DM) + lane;
        f32x4 v[8]; float s = 0.f;
#pragma unroll
        for (int j = 0; j < 8; ++j) { v[j] = xr[64 * j]; s += (v[j].x * v[j].x + v[j].y * v[j].y) + (v[j].z * v[j].z + v[j].w * v[j].w); }
        s = wave_sum(s); if (lane < 2) ss0[2 * m + lane] = (f32x4){lane == 0 ? s : 0.f, 0.f, 0.f, 0.f};
        GAS v2u* o8 = (GAS v2u*)(xb + (size_t)m * DM) + lane;
#pragma unroll
        for (int j = 0; j < 8; ++j) { v2u o; o.x = pk2(v[j].x, v[j].y); o.y = pk2(v[j].z, v[j].w); o8[64 * j] = o; }
    }
}

DI void qkprep_phase(Frame& F, int L) {
    PH_IDS;
    GAS unsigned char* ws = ws_opaque(F);
    bf16* proj = (bf16*)(ws + WS_PROJ); const float* ct = (const float*)(ws + WS_COS); const float* st = (const float*)(ws + WS_SIN);
    const int ip = lane & 31, hv = lane >> 5;
    const float* qw = INP(float, I_QNW) + L * 128; const float* kw = INP(float, I_KNW) + L * 128;
    const f32x2v qw0 = *(const f32x2v*)(qw + 2 * ip), qw1 = *(const f32x2v*)(qw + 64 + 2 * ip), kw0 = *(const f32x2v*)(kw + 2 * ip), kw1 = *(const f32x2v*)(kw + 64 + 2 * ip);
    for (int m = gw; m < M; m += F.NGW) {
        bf16* p = proj + (size_t)m * NPROJ;
        const f32x2v c = *(const f32x2v*)(ct + (size_t)m * 64 + 2 * ip), s = *(const f32x2v*)(st + (size_t)m * 64 + 2 * ip);
        unsigned lo[8], hi[8];
#pragma unroll
        for (int it = 0; it < 8; ++it) { const int vi = 2 * it + hv; bf16* q = p + (it < 4 ? C_DQ + vi * 128 : C_DK + (vi - 8) * 128) + 2 * ip; lo[it] = *(const unsigned*)q; hi[it] = *(const unsigned*)(q + 64); }
#pragma unroll
        for (int it = 0; it < 8; ++it) { const int vi = 2 * it + hv; bf16* q = p + (it < 4 ? C_DQ + vi * 128 : C_DK + (vi - 8) * 128) + 2 * ip;
            const float t0 = bf_lo(lo[it]), t1 = bf_hi(lo[it]), t2 = bf_lo(hi[it]), t3 = bf_hi(hi[it]);
            float ss = (t0 * t0 + t1 * t1) + (t2 * t2 + t3 * t3);
#pragma unroll
            for (int o = 1; o < 32; o <<= 1) ss += __shfl_xor(ss, o);
            const float rstd = 1.0f / sqrtf(ss * (1.f / 128.f) + NORM_EPS);
            const f32x2v w0 = it < 4 ? qw0 : kw0, w1 = it < 4 ? qw1 : kw1;
            const float a0 = t0 * rstd * w0.x, a1 = t1 * rstd * w0.y, a2 = t2 * rstd * w1.x, a3 = t3 * rstd * w1.y;
            *(unsigned*)q = pk2(a0 * c.x - a2 * s.x, a1 * c.y - a3 * s.y);
            *(unsigned*)(q + 64) = pk2(a0 * s.x + a2 * c.x, a1 * s.y + a3 * c.y); }
    }
}
DI void combine_phase(Frame& F, int L) {
    PH_IDS;
    GAS unsigned char* ws = ws_opaque(F);
    const float* O = (const float*)(ws + WS_O); bf16* mix = (bf16*)(ws + WS_XN);
    const float* lq1 = INP(float, I_LQ1) + L * 128; const float* lk1 = INP(float, I_LK1) + L * 128; const float* lq2 = INP(float, I_LQ2) + L * 128; const float* lk2 = INP(float, I_LK2) + L * 128;
    const float lam_init = (L == 0) ? 0.2f : 0.35550906759096914f;
    float d1 = lq1[lane] * lk1[lane] + lq1[64 + lane] * lk1[64 + lane];
    float d2 = lq2[lane] * lk2[lane] + lq2[64 + lane] * lk2[64 + lane];
    const float lam = expf(wave_sum(d1)) - expf(wave_sum(d2)) + lam_init;
    const float osc = 1.0f - lam_init;
    const f32x4 sw = *(const f32x4*)(INP(float, I_SUBW) + L * 256 + 4 * lane);
    for (int it = gw; it < M * 4; it += F.NGW) { const int m = it >> 2, h = it & 3;
        const float* o = O + (size_t)m * 2048 + h * 512 + 4 * lane;
        const f32x4 a = *(const f32x4*)o, b = *(const f32x4*)(o + 256);
        const f32x4 d = a - b * lam;
        const float ss = wave_sum((d.x * d.x + d.y * d.y) + (d.z * d.z + d.w * d.w));
        const float r = osc / sqrtf(ss * (1.f / 256.f) + SUBLN_EPS);
        v2u w; w.x = pk2(d.x * r * sw.x, d.y * r * sw.y); w.y = pk2(d.z * r * sw.z, d.w * r * sw.w);
        *(v2u*)(mix + (size_t)m * DM + 1024 + h * 256 + 4 * lane) = w; }
}

constexpr int G_QT = 0, G_QP = 272, G_KT = 17408, G_KDT = 34816, G_TP = 144, G_VT = 53248, G_AT = 90112, G_DEC = 99328, G_GT = 99840, G_END = 103936, G_OB = 0, G_OP = 1040;
static_assert(G_END <= RING_BYTES && 64 * G_OP <= G_DEC, "GLA LDS map");
DI float log_sigmoid_f(float x) { return fminf(x, 0.f) - __logf(1.f + __expf(-fabsf(x))); }
DI bf16x8 lds_frag16(LAS unsigned char* p) { return *(LAS const bf16x8*)p; }
DI bf16x8 lds_frag8x2(LAS unsigned char* p, int second_off) { const s16x4 a = *(LAS const s16x4*)p, b = *(LAS const s16x4*)(p + second_off); return __builtin_shufflevector(a, b, 0, 1, 2, 3, 4, 5, 6, 7); }
DI void gla_unit(Frame& F, int L, int unit) {
    PH_IDS;
    const int b = unit >> 2, h = unit & 3, r = lane & 31, hh = lane >> 5;
    LAS unsigned char* lds = F.lds + RING_OFF;
    GAS unsigned char* ws = ws_opaque(F);
    const bf16* pbase = (const bf16*)(ws + WS_PROJ) + (size_t)b * SEQ * NPROJ;
    bf16* mix = (bf16*)(ws + WS_XN);
    const float* nw = INP(float, I_GLA_NW) + L * 256;
    f32x16 S[4];
#pragma unroll
    for (int i = 0; i < 4; ++i)
#pragma unroll
        for (int e = 0; e < 16; ++e) S[i][e] = 0.f;
#pragma unroll 1
    for (int n = 0; n < SEQ / 64; ++n) {
        const bf16* prow = pbase + (size_t)(n * 64) * NPROJ;
        {
            const int dp = tid & 63, tg = wave;
            const bf16* r0 = prow + (size_t)(8 * tg) * NPROJ + h * 128 + 2 * dp;
            unsigned qv[8], kv[8], gv[8];
#pragma unroll
            for (int i = 0; i < 8; ++i) { const bf16* rr = r0 + (size_t)i * NPROJ; qv[i] = *(const unsigned*)(rr + C_GQ); kv[i] = *(const unsigned*)(rr + C_GK); gv[i] = *(const unsigned*)(rr + C_GATE); }
            const int vp = tid & 127, tq = tid >> 7;
            const bf16* v0 = prow + (size_t)(16 * tq) * NPROJ + C_GV + h * 256 + 2 * vp;
            unsigned vv[16];
#pragma unroll
            for (int i = 0; i < 16; ++i) vv[i] = *(const unsigned*)(v0 + (size_t)i * NPROJ);
            float cs0[8], cs1[8]; float a0 = 0.f, a1 = 0.f;
#pragma unroll
            for (int i = 0; i < 8; ++i) { a0 += log_sigmoid_f(bf_lo(gv[i])) * (1.f / 16.f); a1 += log_sigmoid_f(bf_hi(gv[i])) * (1.f / 16.f); cs0[i] = a0; cs1[i] = a1; }
            *(LAS f32x2v*)(lds + G_GT + (tg * 128 + 2 * dp) * 4) = (f32x2v){a0, a1};
#pragma unroll
            for (int hf = 0; hf < 2; ++hf) { v4u lo4, hi4;
#pragma unroll
                for (int j = 0; j < 4; ++j) { const unsigned x0 = vv[8 * hf + 2 * j], x1 = vv[8 * hf + 2 * j + 1]; lo4[j] = (x0 & 0xffffu) | (x1 << 16); hi4[j] = (x0 >> 16) | (x1 & 0xffff0000u); }
                *(LAS v4u*)(lds + G_VT + (2 * vp) * G_TP + (16 * tq + 8 * hf) * 2) = lo4; *(LAS v4u*)(lds + G_VT + (2 * vp + 1) * G_TP + (16 * tq + 8 * hf) * 2) = hi4; }
            __syncthreads();
            float p0 = 0.f, p1 = 0.f, t0 = 0.f, t1 = 0.f;
#pragma unroll
            for (int g = 0; g < 8; ++g) { const f32x2v x = *(LAS const f32x2v*)(lds + G_GT + (g * 128 + 2 * dp) * 4); if (g < tg) { p0 += x.x; p1 += x.y; } t0 += x.x; t1 += x.y; }
            v4u kd0, kd1; float kx0[8], kx1[8];
#pragma unroll
            for (int i = 0; i < 8; ++i) { const float b0 = p0 + cs0[i], b1 = p1 + cs1[i];
                const float q0 = bf_lo(qv[i]) * GLA_QSCALE * __expf(b0), q1 = bf_hi(qv[i]) * GLA_QSCALE * __expf(b1);
                const float k0 = bf_lo(kv[i]), k1 = bf_hi(kv[i]);
                *(LAS unsigned*)(lds + G_QT + (8 * tg + i) * G_QP + 4 * dp) = pk2(q0, q1);
                *(LAS unsigned*)(lds + G_KT + (8 * tg + i) * G_QP + 4 * dp) = pk2(k0 * __expf(-b0), k1 * __expf(-b1));
                kx0[i] = k0 * __expf(t0 - b0); kx1[i] = k1 * __expf(t1 - b1); }
#pragma unroll
            for (int j = 0; j < 4; ++j) { kd0[j] = pk2(kx0[2 * j], kx0[2 * j + 1]); kd1[j] = pk2(kx1[2 * j], kx1[2 * j + 1]); }
            *(LAS v4u*)(lds + G_KDT + (2 * dp) * G_TP + 16 * tg) = kd0; *(LAS v4u*)(lds + G_KDT + (2 * dp + 1) * G_TP + 16 * tg) = kd1;
            if (tg == 0) *(LAS f32x2v*)(lds + G_DEC + 8 * dp) = (f32x2v){__expf(t0), __expf(t1)};
        }
        __syncthreads();
        if (wave < 3) {
            const int ib = wave ? 1 : 0, jb = wave == 2 ? 1 : 0;
            f32x16 acc;
#pragma unroll
            for (int e = 0; e < 16; ++e) acc[e] = 0.f;
#pragma unroll
            for (int ks = 0; ks < 8; ++ks) { const bf16x8 a = lds_frag16(lds + G_KT + (jb * 32 + r) * G_QP + ks * 32 + 16 * hh), bq = lds_frag16(lds + G_QT + (ib * 32 + r) * G_QP + ks * 32 + 16 * hh);
                acc = MFMA32(a, bq, acc); }
            const int ci = ib * 32 + r;
#pragma unroll
            for (int g = 0; g < 4; ++g) { const int cj0 = jb * 32 + 8 * g + 4 * hh; float v[4];
#pragma unroll
                for (int e = 0; e < 4; ++e) v[e] = (cj0 + e <= ci) ? acc[4 * g + e] : 0.f;
                *(LAS v2u*)(lds + G_AT + ci * G_TP + cj0 * 2) = (v2u){pk2(v[0], v[1]), pk2(v[2], v[3])}; }
        }
        __syncthreads();
        f32x16 o0, o1;
#pragma unroll
        for (int e = 0; e < 16; ++e) { o0[e] = 0.f; o1[e] = 0.f; }
#pragma unroll
        for (int i = 0; i < 4; ++i)
#pragma unroll
            for (int s = 0; s < 2; ++s) {
                v4u pw;
#pragma unroll
                for (int j = 0; j < 4; ++j) pw[j] = pk2(S[i][8 * s + 2 * j], S[i][8 * s + 2 * j + 1]);
                const bf16x8 sb = __builtin_bit_cast(bf16x8, pw);
                const int d0 = 32 * i + 16 * s + 4 * hh;
                const bf16x8 qa0 = lds_frag8x2(lds + G_QT + r * G_QP + d0 * 2, 16), qa1 = lds_frag8x2(lds + G_QT + (32 + r) * G_QP + d0 * 2, 16);
                o0 = MFMA32(qa0, sb, o0); o1 = MFMA32(qa1, sb, o1); }
        bf16x8 vf[4];
#pragma unroll
        for (int ks = 0; ks < 4; ++ks) vf[ks] = lds_frag16(lds + G_VT + (32 * wave + r) * G_TP + ks * 32 + 16 * hh);
#pragma unroll
        for (int ks = 0; ks < 2; ++ks) o0 = MFMA32(lds_frag16(lds + G_AT + r * G_TP + ks * 32 + 16 * hh), vf[ks], o0);
#pragma unroll
        for (int ks = 0; ks < 4; ++ks) o1 = MFMA32(lds_frag16(lds + G_AT + (32 + r) * G_TP + ks * 32 + 16 * hh), vf[ks], o1);
#pragma unroll
        for (int i = 0; i < 4; ++i) {
#pragma unroll
            for (int g = 0; g < 4; ++g) { const f32x4 dc = *(LAS const f32x4*)(lds + G_DEC + (32 * i + 8 * g + 4 * hh) * 4);
                S[i][4 * g] *= dc.x; S[i][4 * g + 1] *= dc.y; S[i][4 * g + 2] *= dc.z; S[i][4 * g + 3] *= dc.w; }
#pragma unroll
            for (int ks = 0; ks < 4; ++ks) S[i] = MFMA32(lds_frag16(lds + G_KDT + (32 * i + r) * G_TP + ks * 32 + 16 * hh), vf[ks], S[i]); }
        __syncthreads();
#pragma unroll
        for (int e = 0; e < 16; ++e) { const int c = (e & 3) + 8 * (e >> 2) + 4 * hh;
            *(LAS float*)(lds + G_OB + c * G_OP + (32 * wave + r) * 4) = o0[e]; *(LAS float*)(lds + G_OB + (32 + c) * G_OP + (32 * wave + r) * 4) = o1[e]; }
        __syncthreads();
        {
            const int c = tid >> 3, p = tid & 7;
            const bf16* gp = prow + (size_t)c * NPROJ + C_GG + h * 256 + 32 * p;
            v4u gq[4];
#pragma unroll
            for (int j = 0; j < 4; ++j) gq[j] = *(const v4u*)(gp + 8 * j);
            f32x4 ov[8]; float ss = 0.f;
#pragma unroll
            for (int j = 0; j < 8; ++j) { ov[j] = *(LAS const f32x4*)(lds + G_OB + c * G_OP + (32 * p + 4 * j) * 4); ss += (ov[j].x * ov[j].x + ov[j].y * ov[j].y) + (ov[j].z * ov[j].z + ov[j].w * ov[j].w); }
            ss += __shfl_xor(ss, 1); ss += __shfl_xor(ss, 2); ss += __shfl_xor(ss, 4);
            const float rstd = 1.0f / sqrtf(ss * (1.f / 256.f) + NORM_EPS);
            bf16* yp = mix + (size_t)(b * SEQ + n * 64 + c) * DM + h * 256 + 32 * p;
#pragma unroll
            for (int j = 0; j < 4; ++j) { const f32x4 w0 = *(const f32x4*)(nw + 32 * p + 8 * j), w1 = *(const f32x4*)(nw + 32 * p + 8 * j + 4); const f32x4 x0 = ov[2 * j], x1 = ov[2 * j + 1];
                float gf[8];
#pragma unroll
                for (int e = 0; e < 4; ++e) { gf[2 * e] = bf_lo(gq[j][e]); gf[2 * e + 1] = bf_hi(gq[j][e]); }
                float y[8];
#pragma unroll
                for (int e = 0; e < 4; ++e) { y[e] = x0[e] * rstd * w0[e]; y[4 + e] = x1[e] * rstd * w1[e]; }
#pragma unroll
                for (int e = 0; e < 8; ++e) y[e] = y[e] * gf[e] / (1.f + __expf(-gf[e]));
                *(v4u*)(yp + 8 * j) = (v4u){pk2(y[0], y[1]), pk2(y[2], y[3]), pk2(y[4], y[5]), pk2(y[6], y[7])}; }
        }
        __syncthreads();
    }
}

typedef swa::BlockRef<swa::bf16, float> ABlk;
constexpr int N_GLA = BATCH * 4, N_ATT = BATCH * 16 * (SEQ / 256), N_ITEMS = N_GLA + N_ATT;
DI ABlk attn_ref(GAS unsigned char* ws, int a) {
    const int qb = (SEQ / 256 - 1) - (a >> 8), rest = a & 255, bb = rest >> 4, vh = rest & 15, hd = vh >> 2, c = (vh >> 1) & 1, vhalf = vh & 1;
    const swa::bf16* proj = (const swa::bf16*)(ws + WS_PROJ); float* O = (float*)(ws + WS_O);
    ABlk R;
    R.Q = proj + (size_t)(bb * SEQ + qb * 256) * NPROJ + C_DQ + (hd * 2 + c) * 128;
    R.K = proj + (size_t)(bb * SEQ) * NPROJ + C_DK + (hd * 2 + c) * 128;
    R.V = proj + (size_t)(bb * SEQ) * NPROJ + C_DV + hd * 256 + vhalf * 128;
    R.O = O + (size_t)(bb * SEQ + qb * 256) * 2048 + (hd * 2 + c) * 256 + vhalf * 128;
    R.P0 = qb * 256;
    return R;
}
DI int q_next(Frame& F, gu32* head) {
    if (threadIdx.x == 0) F.MISC[16] = __hip_atomic_fetch_add(head, 1u, RLX_AGENT);
    __syncthreads(); const int v = (int)F.MISC[16]; __syncthreads();
    return __builtin_amdgcn_readfirstlane(v);
}
DI void mixer_phase(Frame& F, int qi, int L, char* lds_generic) {
    gu32* head = F.ctl + CW_Q + 64 * qi;
    GAS unsigned char* ws = ws_opaque(F);
    int it = q_next(F, head);
    while (it < N_GLA) { gla_unit(F, L, it); it = q_next(F, head); }
    if (it < N_ITEMS) {
        ABlk cur = attn_ref(ws, it - N_GLA);
        swa::Seam<swa::bf16> S;
        swa::causal_swa_prime<swa::bf16, float>(cur, SEQ, lds_generic, S);
        for (;;) {
            const int nx = q_next(F, head); const bool last = nx >= N_ITEMS;
            const ABlk nxt = last ? cur : attn_ref(ws, nx - N_GLA);
            swa::causal_swa_block<swa::bf16, float>(cur, nxt, SEQ, SEQ, lds_generic, S);
            if (last) break;
            cur = nxt;
        }
    }
}

__global__ void __launch_bounds__(NWAVES * 64, 2) fwd(Args args) {
    extern __shared__ __attribute__((aligned(16))) unsigned char lds[];
    Frame F;
    F.lds = (LAS unsigned char*)lds;
    F.MISC = (volatile LAS unsigned*)(F.lds + MISC_OFF);
    F.G = gridDim.x; F.NGW = F.G * NWAVES;
    F.ws = args.ws; F.ctl = (gu32*)(args.ws + WS_CTL);
    for (int u = threadIdx.x; u < (LDS_BYTES - LDSCTL_OFF) / 4; u += NWAVES * 64) ((LAS unsigned*)(F.lds + LDSCTL_OFF))[u] = 0u;
    __syncthreads();
    XcdBarrier bar; bar.bar = (unsigned*)(F.ctl + CW_BAR); bar.x = 0; bar.st = nullptr;
    if (!MK_SPLIT) bar = xcd_barrier_post((unsigned*)(F.ctl + CW_BAR), F.MISC + 8);
#define GRID_BAR() do { if (!MK_SPLIT) { XcdBarrier b2_ = bar; GAS unsigned* bp_ = (GAS unsigned*)bar.bar; asm volatile("" : "+s"(bp_), "+s"(b2_.x)); b2_.bar = (unsigned*)bp_; xcd_barrier(b2_); } } while (0)
    const int lo = args.ph_lo, hi = args.ph_hi;
#define IN(k) (lo <= (k) && (k) < hi)
#define BOTH(k) (IN(k) && IN((k) + 1))

#ifndef PROBE_DUP
#define PROBE_DUP 0
#endif
#define NREP(k) ((PROBE_DUP == (k)) ? 2 : 1)
#define REPLOOP(k) _Pragma("unroll 1") for (int rep = NREP(k) - 1; rep >= 0; --rep)
#define REPBAR() do { if (rep) GRID_BAR(); } while (0)
    if (IN(0)) { REPLOOP(9) { p0_prologue(F); REPBAR(); } if (BOTH(0)) GRID_BAR(); }
#pragma unroll 1
    for (int L = 0; L < DEPTH; ++L) {
        const int pb = 1 + L * PH_PER_LAYER;
        if (IN(pb + 0)) { REPLOOP(2) {
            GAS unsigned char* ws = ws_opaque(F);
            typedef pg8::Gemm<M, NPROJ, DM> GT; typedef pg8::StaticOrder<M, NPROJ> ST; GT g{(const bf16*)OUTP(), (const bf16*)(ws + WS_WIN) + (size_t)L * NPROJ * DM}; ST S; S.init(F.G, (int)blockIdx.x);
            typedef pg8::EpiBf16<0, NPROJ, DM> ET; ET E{(bf16*)(ws + WS_PROJ), (const float*)(ws + WS_BIAS) + L * NPROJ, (const float*)(ws + WS_SS) + (size_t)(2 * L) * M * 8, NORM_EPS};
            pg8::gemm_phase<ET, ST, GT, true, true>(F.lds + RING_OFF, g, S, E); REPBAR(); }
            if (BOTH(pb + 0)) GRID_BAR();
        }
        if (IN(pb + 1)) { qkprep_phase(F, L); if (BOTH(pb + 1)) GRID_BAR(); }
        if (IN(pb + 2)) {
            REPLOOP(3) { mixer_phase(F, L + 2 * rep, L, (char*)lds + RING_OFF); REPBAR(); }
            if (BOTH(pb + 2)) GRID_BAR(); }
        if (IN(pb + 3)) { REPLOOP(4) { combine_phase(F, L); REPBAR(); } if (BOTH(pb + 3)) GRID_BAR(); }
        if (IN(pb + 4)) { REPLOOP(5) {
            GAS unsigned char* ws = ws_opaque(F);
            typedef pg8::Gemm<M, DM, DM> GT; typedef pg8::StaticOrder<M, DM> ST; GT g{(const bf16*)(ws + WS_XN), (const bf16*)(ws + WS_WOUT) + (size_t)L * DM * DM}; ST S; S.init(F.G, (int)blockIdx.x);
            typedef pg8::EpiRes<DM, false> ET; ET E{(const bf16*)OUTP(), nullptr, (bf16*)(ws + (rep ? WS_HID : WS_XB2)), (float*)(ws + WS_SS) + (size_t)(rep ? 4 : 2 * L + 1) * M * 8, (LAS float*)(F.lds + RED_OFF)};
            pg8::gemm_phase<ET, ST, GT, true, true>(F.lds + RING_OFF, g, S, E); REPBAR(); }
            if (BOTH(pb + 4)) GRID_BAR();
        }
        if (IN(pb + 5)) { REPLOOP(7) {
            GAS unsigned char* ws = ws_opaque(F);
            typedef pg8::Gemm<M, DFF, DM> GT; typedef pg8::StaticOrder<M, DFF> ST; GT g{(const bf16*)(ws + WS_XB2), (const bf16*)(ws + WS_WUP) + (size_t)L * DFF * DM}; ST S; S.init(F.G, (int)blockIdx.x);
            typedef pg8::EpiBf16<2, DFF, DM> ET; ET E{(bf16*)(ws + WS_HID), nullptr, (const float*)(ws + WS_SS) + (size_t)(2 * L + 1) * M * 8, NORM_EPS};
            pg8::gemm_phase<ET, ST, GT, true, true>(F.lds + RING_OFF, g, S, E); REPBAR(); }
            if (BOTH(pb + 5)) GRID_BAR();
        }
        if (IN(pb + 6)) {
            GAS unsigned char* ws = ws_opaque(F);
            typedef pg8::Gemm<M, DM, DFF> GT; typedef pg8::StaticOrder<M, DM> ST; GT g{(const bf16*)(ws + WS_HID), (const bf16*)(ws + WS_WDN) + (size_t)L * DM * DFF}; ST S; S.init(F.G, (int)blockIdx.x);
            if (L + 1 < DEPTH) { typedef pg8::EpiRes<DM, false> ET; ET E{(const bf16*)(ws + WS_XB2), nullptr, (bf16*)OUTP(), (float*)(ws + WS_SS) + (size_t)(2 * L + 2) * M * 8, (LAS float*)(F.lds + RED_OFF)};
                pg8::gemm_phase<ET, ST, GT, true, true>(F.lds + RING_OFF, g, S, E); }
            else { typedef pg8::EpiRes<DM, true> ET; ET E{(const bf16*)(ws + WS_XB2), OUTP(), nullptr, nullptr, nullptr};
                pg8::gemm_phase<ET, ST, GT, true, true>(F.lds + RING_OFF, g, S, E); }
            if (BOTH(pb + 6)) GRID_BAR();
        }
    }
#undef IN
#undef BOTH
}

extern "C" void kernel_launch(void* const* d_in, const int* in_sizes, int n_in, void* d_out, int out_size, void* d_ws, size_t ws_size, hipStream_t stream) {
    static int grid = 0;
    if (grid == 0) {
        if (n_in != 18 || in_sizes[0] != M * DM || out_size != M * DM || ws_size < WS_END) { fprintf(stderr, "kernel_launch: built for 18 inputs, x/out of %d floats, >= %zu bytes of workspace; got n_in %d, in0 %d, out %d, ws %zu; nothing launched\n", M * DM, (size_t)WS_END, n_in, n_in > 0 ? in_sizes[0] : -1, out_size, ws_size); grid = -1; return; }
        int dev = 0, cus = 0, per_cu = 0;
        if (hipGetDevice(&dev) != hipSuccess || hipDeviceGetAttribute(&cus, hipDeviceAttributeMultiprocessorCount, dev) != hipSuccess) { fprintf(stderr, "kernel_launch: hipGetDevice / hipDeviceGetAttribute failed; nothing launched\n"); grid = -1; return; }
        if (hipFuncSetAttribute((const void*)fwd, hipFuncAttributeMaxDynamicSharedMemorySize, LDS_BYTES) != hipSuccess) { fprintf(stderr, "kernel_launch: hipFuncSetAttribute failed\n"); grid = -1; return; }
        if (hipOccupancyMaxActiveBlocksPerMultiprocessor(&per_cu, (const void*)fwd, NWAVES * 64, LDS_BYTES) != hipSuccess || per_cu < 1) fprintf(stderr, "kernel_launch: note: occupancy query reports %d workgroups per CU\n", per_cu);
        (void)hipGetLastError();
        grid = cus;
    }
    if (grid < 0) return;
    if (hipMemsetAsync((char*)d_ws + WS_CTL, 0, CTL_ZERO_BYTES, stream) != hipSuccess) { fprintf(stderr, "kernel_launch: hipMemsetAsync failed; nothing launched\n"); return; }
    Args a{};
    for (int i = 0; i < 18; ++i) a.in[i] = d_in[i];
    a.out = (float*)d_out; a.ws = (unsigned char*)d_ws;
#if MK_SPLIT
    for (int p = 0; p < N_PHASES; ++p) { a.ph_lo = p; a.ph_hi = p + 1; hipLaunchKernelGGL(fwd, dim3(grid), dim3(NWAVES * 64), LDS_BYTES, stream, a); }
#else
    a.ph_lo = 0; a.ph_hi = N_PHASES; hipLaunchKernelGGL(fwd, dim3(grid), dim3(NWAVES * 64), LDS_BYTES, stream, a);
#endif
    const hipError_t le = hipPeekAtLastError();
    if (le != hipSuccess) fprintf(stderr, "kernel_launch: launch failed: %s\n", hipGetErrorName(le));
}
```

```cpp
#include <hip/hip_runtime.h>
#include <hip/hip_bf16.h>
#include <cstdio>
#include <cstdint>
#include <cmath>
namespace pg8 {
#define PG8_LAS __attribute__((address_space(3)))
typedef unsigned short bf16_t;
typedef short bf16x8 __attribute__((ext_vector_type(8)));
typedef float f32x4 __attribute__((ext_vector_type(4)));
typedef unsigned u32x4 __attribute__((ext_vector_type(4)));
constexpr int BM = 256, BK = 64, HALF = 128, HTB = HALF * BK * 2  , STAGE_BYTES = 8 * HTB, NXCD = 8, WGM = 8;

__host__ __device__ __forceinline__ int lds_byte(int r, int c) { const int st = (r >> 4) * 2 + (c >> 5), rr = r & 15, cc = c & 31, ob = rr * 64 + cc * 2; return st * 1024 + (ob ^ (((ob >> 9) & 1) << 5)); }
__host__ __device__ __forceinline__ void stage_rc(int b, int& R, int& C) { const int st = b / 1024, sb = b % 1024, swz = sb ^ (((sb >> 9) & 1) << 5); R = (st >> 1) * 16 + swz / 64; C = (st & 1) * 32 + (swz % 64) / 2; }
__host__ __device__ __forceinline__ int perm32(int rho) { const int n = rho >> 4, i = rho & 15; return 8 * (i >> 2) + 4 * n + (i & 3); }

struct Unit { int pm, pn; };
template <int M_, int N_, int K_> struct Gemm { const bf16_t* A; const bf16_t* Bt; static constexpr int M = M_, N = N_, K = K_; };

template <int M_, int N_> struct StaticOrder {
    static constexpr int nM = M_ / BM, nN = N_ / BM, nwg = nM * nN;
    int G, c;
    __host__ __device__ void init(int G_, int c_) { G = G_; c = c_; }
    __host__ __device__ bool next(int i, Unit& u) const {
        const long L = (long)i * G + c; if (L >= nwg) return false;
        int wgid = (int)L; { constexpr int q = nwg / NXCD, r = nwg % NXCD; const int xcd = wgid % NXCD, off = wgid / NXCD; wgid = (xcd < r ? xcd * (q + 1) : r * (q + 1) + (xcd - r) * q) + off; }
        constexpr int nig = WGM * nN; const int gid = wgid / nig, fm = gid * WGM, gsz = (nM - fm) < WGM ? (nM - fm) : WGM;
        u.pm = fm + ((wgid % nig) % gsz); u.pn = (wgid % nig) / gsz; return true;
    }
    __device__ __forceinline__ void a_ready(const Unit&) const {}
    __device__ __forceinline__ void done(const Unit&) const {}
};
__device__ __forceinline__ unsigned cvt_pk_bf16(float lo, float hi) { unsigned r; asm volatile("v_cvt_pk_bf16_f32 %0, %1, %2" : "=v"(r) : "v"(lo), "v"(hi)); return r; }
typedef float f32x2 __attribute__((ext_vector_type(2)));
template <int ACT, int ldc, int KN> struct EpiBf16 {
    static constexpr bool PERM = true, AFTER_DRAIN = false;
    bf16_t* O; const float* bias; const float* ss; float eps;
    __device__ __forceinline__ void operator()(const f32x4 (&acc)[2][2][4][2], const Unit& u, int wr, int wc, int fr, int fq) const {
        const int row0 = u.pm * BM + wr * 64 + fr; const int col0 = u.pn * BM + wc * 32 + 8 * fq;
        f32x4 bv[2][2];
#pragma unroll
        for (int bj = 0; bj < 2; ++bj)
#pragma unroll
            for (int n = 0; n < 2; ++n) bv[bj][n] = bias ? *(const f32x4*)(bias + col0 + bj * HALF + 4 * n) : (f32x4){0.f, 0.f, 0.f, 0.f};
        float rs[2][4];
#pragma unroll
        for (int ai = 0; ai < 2; ++ai)
#pragma unroll
            for (int m = 0; m < 4; ++m) { const f32x4* p = (const f32x4*)(ss + (size_t)(row0 + ai * HALF + m * 16) * 8); const f32x4 a = p[0], b = p[1]; rs[ai][m] = ((a[0] + a[1]) + (a[2] + a[3])) + ((b[0] + b[1]) + (b[2] + b[3])); }
#pragma unroll
        for (int ai = 0; ai < 2; ++ai)
#pragma unroll
            for (int m = 0; m < 4; ++m) rs[ai][m] = 1.0f / sqrtf(rs[ai][m] * (1.0f / KN) + eps);
        asm volatile("" ::: "memory");
#pragma unroll
        for (int ai = 0; ai < 2; ++ai)
#pragma unroll
            for (int m = 0; m < 4; ++m) { bf16_t* rowp = O + (size_t)(row0 + ai * HALF + m * 16) * ldc + col0;
                const float rstd = rs[ai][m];
#pragma unroll
                for (int bj = 0; bj < 2; ++bj) { f32x4 v0 = acc[ai][bj][m][0] * rstd + bv[bj][0], v1 = acc[ai][bj][m][1] * rstd + bv[bj][1];
                    if (ACT == 2) {
#pragma unroll
                        for (int e = 0; e < 4; ++e) { const float a = fmaxf(v0[e], 0.f), b = fmaxf(v1[e], 0.f); v0[e] = a * a; v1[e] = b * b; } }
                    u32x4 w; w.x = cvt_pk_bf16(v0[0], v0[1]); w.y = cvt_pk_bf16(v0[2], v0[3]); w.z = cvt_pk_bf16(v1[0], v1[1]); w.w = cvt_pk_bf16(v1[2], v1[3]);
                    *(u32x4*)(rowp + bj * HALF) = w; } }
    }
};
template <int ldc, int KN, int PNQ, int PNK, int PNV> struct EpiProj {
    static constexpr bool PERM = true, AFTER_DRAIN = false;
    bf16_t* O; const float* bias; const float* ss; float eps; const float* qw; const float* kw; const float* ct; const float* st; PG8_LAS float* red;
    __device__ __forceinline__ void operator()(const f32x4 (&acc)[2][2][4][2], const Unit& u, int wr, int wc, int fr, int fq) const {
        const int row0 = u.pm * BM + wr * 64 + fr; const int col0 = u.pn * BM + wc * 32 + 8 * fq;
        float rs[2][4];
#pragma unroll
        for (int ai = 0; ai < 2; ++ai)
#pragma unroll
            for (int m = 0; m < 4; ++m) { const f32x4* p = (const f32x4*)(ss + (size_t)(row0 + ai * HALF + m * 16) * 8); const f32x4 a = p[0], b = p[1]; rs[ai][m] = ((a[0] + a[1]) + (a[2] + a[3])) + ((b[0] + b[1]) + (b[2] + b[3])); }
#pragma unroll
        for (int ai = 0; ai < 2; ++ai)
#pragma unroll
            for (int m = 0; m < 4; ++m) rs[ai][m] = 1.0f / sqrtf(rs[ai][m] * (1.0f / KN) + eps);
        if (u.pn < PNQ || u.pn >= PNV) {
            f32x4 bv[2][2];
#pragma unroll
            for (int bj = 0; bj < 2; ++bj)
#pragma unroll
                for (int n = 0; n < 2; ++n) bv[bj][n] = *(const f32x4*)(bias + col0 + bj * HALF + 4 * n);
            asm volatile("" ::: "memory");
#pragma unroll
            for (int ai = 0; ai < 2; ++ai)
#pragma unroll
                for (int m = 0; m < 4; ++m) { bf16_t* rowp = O + (size_t)(row0 + ai * HALF + m * 16) * ldc + col0; const float rstd = rs[ai][m];
#pragma unroll
                    for (int bj = 0; bj < 2; ++bj) { const f32x4 v0 = acc[ai][bj][m][0] * rstd + bv[bj][0], v1 = acc[ai][bj][m][1] * rstd + bv[bj][1];
                        u32x4 w; w.x = cvt_pk_bf16(v0[0], v0[1]); w.y = cvt_pk_bf16(v0[2], v0[3]); w.z = cvt_pk_bf16(v1[0], v1[1]); w.w = cvt_pk_bf16(v1[2], v1[3]);
                        *(u32x4*)(rowp + bj * HALF) = w; } }
        } else {
#pragma unroll
            for (int ai = 0; ai < 2; ++ai)
#pragma unroll
                for (int m = 0; m < 4; ++m)
#pragma unroll
                    for (int bj = 0; bj < 2; ++bj) { const f32x4 v0 = acc[ai][bj][m][0] * rs[ai][m], v1 = acc[ai][bj][m][1] * rs[ai][m]; const f32x4 q = v0 * v0 + v1 * v1; float s = (q[0] + q[1]) + (q[2] + q[3]);
                        s += __shfl_xor(s, 16); s += __shfl_xor(s, 32);
                        if (fq == 0) red[((wr * 64 + fr + ai * HALF + m * 16) * 2 + bj) * 4 + wc] = s; }
            const float* w = (u.pn < PNK) ? qw : kw; const int i0 = 16 * wc + 4 * fq;
            const f32x4 wlo = *(const f32x4*)(w + i0), whi = *(const f32x4*)(w + 64 + i0);
            asm volatile("s_waitcnt lgkmcnt(0)" ::: "memory"); __builtin_amdgcn_s_barrier(); asm volatile("" ::: "memory");
#pragma unroll
            for (int ai = 0; ai < 2; ++ai) {
                f32x4 c4[4], s4[4];
#pragma unroll
                for (int m = 0; m < 4; ++m) { const size_t ro = (size_t)(row0 + ai * HALF + m * 16) * 64 + i0; c4[m] = *(const f32x4*)(ct + ro); s4[m] = *(const f32x4*)(st + ro); }
                asm volatile("" ::: "memory");
#pragma unroll
                for (int m = 0; m < 4; ++m) { bf16_t* rowp = O + (size_t)(row0 + ai * HALF + m * 16) * ldc + col0; const f32x4 cc = c4[m], sn = s4[m];
#pragma unroll
                    for (int bj = 0; bj < 2; ++bj) { const f32x4 p = *(const PG8_LAS f32x4*)(red + ((wr * 64 + fr + ai * HALF + m * 16) * 2 + bj) * 4);
                        const float rh = rs[ai][m] / sqrtf(((p[0] + p[1]) + (p[2] + p[3])) * (1.0f / 128.0f) + 1e-6f);
                        const f32x4 v0 = acc[ai][bj][m][0] * rh, v1 = acc[ai][bj][m][1] * rh;
                        const float a0 = v0[0] * wlo[0], b0 = v0[1] * whi[0], a1 = v0[2] * wlo[1], b1 = v0[3] * whi[1], a2 = v1[0] * wlo[2], b2 = v1[1] * whi[2], a3 = v1[2] * wlo[3], b3 = v1[3] * whi[3];
                        u32x4 o; o.x = cvt_pk_bf16(a0 * cc[0] - b0 * sn[0], a0 * sn[0] + b0 * cc[0]); o.y = cvt_pk_bf16(a1 * cc[1] - b1 * sn[1], a1 * sn[1] + b1 * cc[1]);
                        o.z = cvt_pk_bf16(a2 * cc[2] - b2 * sn[2], a2 * sn[2] + b2 * cc[2]); o.w = cvt_pk_bf16(a3 * cc[3] - b3 * sn[3], a3 * sn[3] + b3 * cc[3]);
                        *(u32x4*)(rowp + bj * HALF) = o; } }
                asm volatile("" ::: "memory");
            }
        }
    }
};
template <int ldc, bool FINAL> struct EpiRes {
    static constexpr bool PERM = true, AFTER_DRAIN = false;
    const bf16_t* base; float* out; bf16_t* xb; float* ss; PG8_LAS float* red;
    __device__ __forceinline__ void operator()(const f32x4 (&acc)[2][2][4][2], const Unit& u, int wr, int wc, int fr, int fq) const {
        const int row0 = u.pm * BM + wr * 64 + fr; const int col0 = u.pn * BM + wc * 32 + 8 * fq;
        u32x4 bq[2][4][2];
#pragma unroll
        for (int ai = 0; ai < 2; ++ai)
#pragma unroll
            for (int m = 0; m < 4; ++m) { const size_t off = (size_t)(row0 + ai * HALF + m * 16) * ldc + col0; bq[ai][m][0] = *(const u32x4*)(base + off); bq[ai][m][1] = *(const u32x4*)(base + off + HALF); }
        asm volatile("" ::: "memory");
#pragma unroll
        for (int ai = 0; ai < 2; ++ai)
#pragma unroll
            for (int m = 0; m < 4; ++m) { const size_t off = (size_t)(row0 + ai * HALF + m * 16) * ldc + col0;
                f32x4 x[2][2];
#pragma unroll
                for (int bj = 0; bj < 2; ++bj) { const u32x4 b = bq[ai][m][bj];
                    x[bj][0] = (f32x4){__uint_as_float(b.x << 16), __uint_as_float(b.x & 0xffff0000u), __uint_as_float(b.y << 16), __uint_as_float(b.y & 0xffff0000u)} + acc[ai][bj][m][0];
                    x[bj][1] = (f32x4){__uint_as_float(b.z << 16), __uint_as_float(b.z & 0xffff0000u), __uint_as_float(b.w << 16), __uint_as_float(b.w & 0xffff0000u)} + acc[ai][bj][m][1]; }
                if constexpr (FINAL) {
                    *(f32x4*)(out + off) = x[0][0]; *(f32x4*)(out + off + 4) = x[0][1]; *(f32x4*)(out + off + HALF) = x[1][0]; *(f32x4*)(out + off + HALF + 4) = x[1][1];
                } else {
                    u32x4 w0, w1; w0.x = cvt_pk_bf16(x[0][0][0], x[0][0][1]); w0.y = cvt_pk_bf16(x[0][0][2], x[0][0][3]); w0.z = cvt_pk_bf16(x[0][1][0], x[0][1][1]); w0.w = cvt_pk_bf16(x[0][1][2], x[0][1][3]);
                    w1.x = cvt_pk_bf16(x[1][0][0], x[1][0][1]); w1.y = cvt_pk_bf16(x[1][0][2], x[1][0][3]); w1.z = cvt_pk_bf16(x[1][1][0], x[1][1][1]); w1.w = cvt_pk_bf16(x[1][1][2], x[1][1][3]);
                    *(u32x4*)(xb + off) = w0; *(u32x4*)(xb + off + HALF) = w1;
                    const f32x4 q = x[0][0] * x[0][0] + x[0][1] * x[0][1] + x[1][0] * x[1][0] + x[1][1] * x[1][1]; float s = (q[0] + q[1]) + (q[2] + q[3]);
                    s += __shfl_xor(s, 16); s += __shfl_xor(s, 32);
                    if (fq == 0) red[(wr * 64 + fr + ai * HALF + m * 16) * 4 + wc] = s; } }
        if constexpr (!FINAL) {
            asm volatile("s_waitcnt lgkmcnt(0)" ::: "memory"); __builtin_amdgcn_s_barrier(); asm volatile("" ::: "memory");
            const int t = threadIdx.x;
            if (t < BM) { const f32x4 p = *(const PG8_LAS f32x4*)(red + t * 4); ss[(size_t)(u.pm * BM + t) * 8 + u.pn] = (p[0] + p[1]) + (p[2] + p[3]); }
        }
    }
};
template <class Epi, class Sched, class GemmT, bool ALIGN_EPI = false, bool SP2 = false>
__device__ __forceinline__ void gemm_phase(PG8_LAS unsigned char* lds, const GemmT g, const Sched& S, const Epi& E) {
    int tid_ = threadIdx.x; asm volatile("" : "+v"(tid_));
    const int tid = tid_, wid = __builtin_amdgcn_readfirstlane(tid >> 6), lane = tid & 63, wr = wid >> 2, wc = wid & 3, fr = lane & 15, fq = lane >> 4;
    constexpr int K = GemmT::K, nt = K / BK;
    unsigned voffA[2], voffB[2];
#pragma unroll
    for (int i = 0; i < 2; ++i) { int R, C; stage_rc(tid * 16 + i * 8192, R, C); const int Rb = Epi::PERM ? ((R & ~31) + perm32(R & 31)) : R;
        voffA[i] = (unsigned)(R * K + C) * 2u; voffB[i] = (unsigned)(Rb * K + C) * 2u; }
    constexpr size_t kstep = (size_t)(BK * 2);
    constexpr size_t hstep = (size_t)HALF * K * 2;
    constexpr size_t tstep = 2 * hstep;
    const unsigned ldsw = (unsigned)wid * 1024u;
    const int aoff = lds_byte(wr * 64 + fr, fq * 8), boff = lds_byte(wc * 32 + fr, fq * 8);
#define PG8_SA(b, h) (((b) * 2 + (h)) * HTB)
#define PG8_SB(b, h) ((4 + (b) * 2 + (h)) * HTB)
#define PG8_STAGE(bufoff, gbase, voff) do { _Pragma("unroll") for (int _i = 0; _i < 2; ++_i) \
        __builtin_amdgcn_global_load_lds((const unsigned*)((const char*)(gbase) + (voff)[_i]), (PG8_LAS unsigned*)(lds + (bufoff) + ldsw + _i * 8192), 16, 0, 0); } while (0)
#define PG8_LDA(dst, b, h) do { _Pragma("unroll") for (int m = 0; m < 4; ++m) _Pragma("unroll") for (int k = 0; k < 2; ++k) dst[m][k] = *(const PG8_LAS bf16x8*)(lds + PG8_SA(b, h) + aoff + m * 2048 + k * 1024); } while (0)
#define PG8_LDB(dst, b, h) do { _Pragma("unroll") for (int n = 0; n < 2; ++n) _Pragma("unroll") for (int k = 0; k < 2; ++k) dst[n][k] = *(const PG8_LAS bf16x8*)(lds + PG8_SB(b, h) + boff + n * 2048 + k * 1024); } while (0)
#define PG8_MMA(ai, bj, At, Bt) do { __builtin_amdgcn_s_setprio(1); _Pragma("unroll") for (int m = 0; m < 4; ++m) _Pragma("unroll") for (int n = 0; n < 2; ++n) _Pragma("unroll") for (int k = 0; k < 2; ++k) \
        acc[ai][bj][m][n] = __builtin_amdgcn_mfma_f32_16x16x32_bf16(Bt[n][k], At[m][k], acc[ai][bj][m][n], 0, 0, 0); __builtin_amdgcn_s_setprio(0); } while (0)
#define PG8_WAIT_V(n) asm volatile("s_waitcnt vmcnt(" #n ")" ::: "memory")
#define PG8_WAIT_L(n) asm volatile("s_waitcnt lgkmcnt(" #n ")" ::: "memory")
#define PG8_BAR __builtin_amdgcn_s_barrier()
#define PG8_SCHED __builtin_amdgcn_sched_barrier(0)
    Unit cur, nxt; int ui = 0;
    if (!S.next(0, cur)) return;
    f32x4 acc[2][2][4][2];
#pragma unroll
    for (int a = 0; a < 2; ++a)
#pragma unroll
        for (int b = 0; b < 2; ++b)
#pragma unroll
            for (int m = 0; m < 4; ++m)
#pragma unroll
                for (int n = 0; n < 2; ++n) acc[a][b][m][n] = (f32x4){0.f, 0.f, 0.f, 0.f};
    bf16x8 At[4][2], B0[2][2], B1[2][2];
    const char* cA = (const char*)g.A + (size_t)cur.pm * tstep; const char* cB = (const char*)g.Bt + (size_t)cur.pn * tstep;
    S.a_ready(cur);
    if constexpr (SP2) {
        PG8_STAGE(PG8_SB(0, 0), cB, voffB); PG8_STAGE(PG8_SB(0, 1), cB + hstep, voffB); PG8_STAGE(PG8_SA(0, 0), cA, voffA); PG8_STAGE(PG8_SA(0, 1), cA + hstep, voffA);
        if (wr == 1) PG8_BAR;
        PG8_WAIT_V(2); PG8_BAR;
        PG8_STAGE(PG8_SB(1, 0), cB + kstep, voffB); PG8_STAGE(PG8_SA(1, 0), cA + kstep, voffA); PG8_STAGE(PG8_SB(1, 1), cB + hstep + kstep, voffB);
        PG8_WAIT_V(6); PG8_BAR;
    } else {
        PG8_STAGE(PG8_SB(0, 0), cB, voffB); PG8_STAGE(PG8_SA(0, 0), cA, voffA); PG8_STAGE(PG8_SB(0, 1), cB + hstep, voffB); PG8_STAGE(PG8_SA(0, 1), cA + hstep, voffA);
        if (wr == 1) PG8_BAR;
        PG8_WAIT_V(4); PG8_BAR;
        PG8_STAGE(PG8_SB(1, 0), cB + kstep, voffB); PG8_STAGE(PG8_SA(1, 0), cA + kstep, voffA); PG8_STAGE(PG8_SB(1, 1), cB + hstep + kstep, voffB);
        PG8_WAIT_V(6); PG8_BAR;
    }
    for (;;) {
        const bool has_next = S.next(ui + 1, nxt);
        const char* nA = has_next ? (const char*)g.A + (size_t)nxt.pm * tstep : cA; const char* nB = has_next ? (const char*)g.Bt + (size_t)nxt.pn * tstep : cB;
        for (int t = 0; t < nt; t += 2) {
            const bool last = (t == nt - 2);
            const char* a1 = cA + (size_t)(t + 1) * kstep;
            const char* a2 = last ? nA : cA + (size_t)(t + 2) * kstep; const char* b2 = last ? nB : cB + (size_t)(t + 2) * kstep;
            const char* a3 = a2 + kstep; const char* b3 = b2 + kstep;
            if (last && has_next) S.a_ready(nxt);
            if constexpr (SP2) {
            PG8_LDB(B0, 0, 0); PG8_LDB(B1, 0, 1); PG8_SCHED; PG8_LDA(At, 0, 0); PG8_STAGE(PG8_SA(1, 1), a1 + hstep, voffA);
            PG8_WAIT_V(8); PG8_WAIT_L(0); PG8_BAR; PG8_MMA(0, 0, At, B0); PG8_MMA(0, 1, At, B1); PG8_BAR; PG8_SCHED;
            PG8_LDA(At, 0, 1); PG8_STAGE(PG8_SB(0, 0), b2, voffB); PG8_STAGE(PG8_SB(0, 1), b2 + hstep, voffB); PG8_STAGE(PG8_SA(0, 0), a2, voffA);
            PG8_WAIT_V(8); PG8_WAIT_L(0); PG8_BAR; PG8_MMA(1, 0, At, B0); PG8_MMA(1, 1, At, B1); PG8_BAR; PG8_SCHED;
            PG8_LDB(B0, 1, 0); PG8_LDB(B1, 1, 1); PG8_SCHED; PG8_LDA(At, 1, 0); PG8_STAGE(PG8_SA(0, 1), a2 + hstep, voffA);
            PG8_WAIT_V(8); PG8_WAIT_L(0); PG8_BAR; PG8_MMA(0, 0, At, B0); PG8_MMA(0, 1, At, B1); PG8_BAR; PG8_SCHED;
            PG8_LDA(At, 1, 1); PG8_STAGE(PG8_SB(1, 0), b3, voffB); PG8_STAGE(PG8_SB(1, 1), b3 + hstep, voffB); PG8_STAGE(PG8_SA(1, 0), a3, voffA);
            PG8_WAIT_V(8); PG8_WAIT_L(0); PG8_BAR; PG8_MMA(1, 0, At, B0); PG8_MMA(1, 1, At, B1); PG8_BAR; PG8_SCHED;
            } else {
            PG8_LDB(B0, 0, 0); PG8_SCHED; PG8_LDA(At, 0, 0); PG8_STAGE(PG8_SA(1, 1), a1 + hstep, voffA);
            PG8_WAIT_L(8); PG8_BAR; PG8_WAIT_L(0); PG8_MMA(0, 0, At, B0); PG8_BAR; PG8_SCHED;
            PG8_LDB(B1, 0, 1); PG8_STAGE(PG8_SB(0, 0), b2, voffB);
            PG8_BAR; PG8_WAIT_L(0); PG8_MMA(0, 1, At, B1); PG8_BAR;
            PG8_LDA(At, 0, 1); PG8_STAGE(PG8_SA(0, 0), a2, voffA);
            PG8_BAR; PG8_WAIT_L(0); PG8_MMA(1, 0, At, B0); PG8_BAR; PG8_SCHED;
            PG8_STAGE(PG8_SB(0, 1), b2 + hstep, voffB);
            PG8_WAIT_V(6); PG8_BAR; PG8_MMA(1, 1, At, B1); PG8_BAR;
            PG8_LDB(B0, 1, 0); PG8_SCHED; PG8_LDA(At, 1, 0); PG8_STAGE(PG8_SA(0, 1), a2 + hstep, voffA);
            PG8_WAIT_L(8); PG8_BAR; PG8_WAIT_L(0); PG8_MMA(0, 0, At, B0); PG8_BAR; PG8_SCHED;
            PG8_LDB(B1, 1, 1); PG8_STAGE(PG8_SB(1, 0), b3, voffB);
            PG8_BAR; PG8_WAIT_L(0); PG8_MMA(0, 1, At, B1); PG8_BAR;
            PG8_LDA(At, 1, 1); PG8_STAGE(PG8_SA(1, 0), a3, voffA);
            PG8_BAR; PG8_WAIT_L(0); PG8_MMA(1, 0, At, B0); PG8_BAR; PG8_SCHED;
            PG8_STAGE(PG8_SB(1, 1), b3 + hstep, voffB);
            PG8_WAIT_V(6); PG8_BAR; PG8_MMA(1, 1, At, B1); PG8_BAR;
            }
        }
        if constexpr (ALIGN_EPI) { if (wr == 0) PG8_BAR; }
        if constexpr (!Epi::AFTER_DRAIN) { E(acc, cur, wr, wc, fr, fq); S.done(cur); }
        if (!has_next) break;
#pragma unroll
        for (int a = 0; a < 2; ++a)
#pragma unroll
            for (int b = 0; b < 2; ++b)
#pragma unroll
                for (int m = 0; m < 4; ++m)
#pragma unroll
                    for (int n = 0; n < 2; ++n) acc[a][b][m][n] = (f32x4){0.f, 0.f, 0.f, 0.f};
        cur = nxt; cA = nA; cB = nB; ++ui;
        if constexpr (ALIGN_EPI) { if (wr == 1) PG8_BAR; }
    }
    PG8_WAIT_V(0);
    if constexpr (!ALIGN_EPI) { if (wr == 0) PG8_BAR; }
    PG8_BAR;
    if constexpr (Epi::AFTER_DRAIN) { E.fused(acc, cur, wr, wc, fr, fq, lds, wid, lane); S.done(cur); }
#undef PG8_SA
#undef PG8_SB
#undef PG8_STAGE
#undef PG8_LDA
#undef PG8_LDB
#undef PG8_MMA
#undef PG8_WAIT_V
#undef PG8_WAIT_L
#undef PG8_BAR
#undef PG8_SCHED
}
}
namespace swa {
constexpr int D = 128;
constexpr int KVPITCH = 6656, QPITCH = 6656, OPITCH = 2048;
constexpr float THR = 8.f;
constexpr bool WSKIP = false;
constexpr float SCALE = 0.08838834764831845f;
constexpr int NW = 8, QBLK = 32, KVBLK = 64, QB = NW * QBLK;
constexpr int SHM_V = KVBLK * D * 2, SHM_K = KVBLK * D * 2;
constexpr int LDS_BYTES = 2 * SHM_V + 2 * SHM_K + NW * 64 * 4;
using bf16 = __hip_bfloat16;
typedef short bf16x8 __attribute__((ext_vector_type(8)));
typedef short s16x4 __attribute__((ext_vector_type(4)));
typedef float f32x16 __attribute__((ext_vector_type(16)));
typedef float f32x4 __attribute__((ext_vector_type(4)));
typedef unsigned u32x4 __attribute__((ext_vector_type(4)));
template <class A, class Bt> struct same_t { static constexpr bool v = false; };
template <class A> struct same_t<A, A> { static constexpr bool v = true; };

#define KSWZ(row, colB) ((row) * 256 + ((colB) ^ (((row) & 7) << 4)))
#define SBAR() __builtin_amdgcn_sched_barrier(0)
__device__ __forceinline__ int v_st(int k, int c) { const int kk = (k & ~0xC) | ((k & 4) << 1) | ((k & 8) >> 1); return ((kk >> 3) * 4 + (c >> 5)) * 512 + ((kk & 7) * 32 + (c & 31)) * 2; }
__device__ __forceinline__ int v_rd_base(int lane) { return ((lane & 3) << 3) | (((lane >> 2) & 3) << 6) | (((lane >> 4) & 1) << 5) | (((lane >> 5) & 1) << 8); }
constexpr int v_rd_off(int d0, int ks, int half) { return d0 * 512 + ks * 4096 + half * 2048; }
__device__ __forceinline__ int crow(int r, int hi) { return (r & 3) + 8 * (r >> 2) + 4 * hi; }
__device__ __forceinline__ unsigned cvtpk(float lo, float hi) {
    unsigned r; asm volatile("v_cvt_pk_bf16_f32 %0, %1, %2" : "=v"(r) : "v"(lo), "v"(hi)); return r;
}
__device__ __forceinline__ bf16x8 pack8(f32x4 a, f32x4 b) {
    u32x4 w = {cvtpk(a[0], a[1]), cvtpk(a[2], a[3]), cvtpk(b[0], b[1]), cvtpk(b[2], b[3])};
    return *reinterpret_cast<bf16x8*>(&w);
}
template <class T> __device__ __forceinline__ bf16x8 load8(const T* p) {
    if constexpr (same_t<T, float>::v) { return pack8(*(const f32x4*)p, *(const f32x4*)(p + 4)); }
    else { return *reinterpret_cast<const bf16x8*>(p); }
}
__device__ __forceinline__ void mask_tile(f32x16& p0, f32x16& p1, int dq, unsigned W) {
    const float NEG = -__builtin_inff();
#pragma unroll
    for (int r = 0; r < 16; ++r) {
        const int c = (r & 3) + 8 * (r >> 2);
        if ((unsigned)(dq - c) >= W) p0[r] = NEG;
        if ((unsigned)(dq - c - 32) >= W) p1[r] = NEG;
    }
}
__device__ __forceinline__ void partialSM(f32x16& p0, f32x16& p1, float& m_reg, float& mn, float& alpha) {
    float pmax = p0[0]; for (int r = 1; r < 16; ++r) pmax = fmaxf(pmax, p0[r]); for (int r = 0; r < 16; ++r) pmax = fmaxf(pmax, p1[r]);
    { auto rr = __builtin_amdgcn_permlane32_swap(__float_as_uint(pmax), __float_as_uint(pmax), false, false);
      pmax = fmaxf(__uint_as_float(rr[0]), __uint_as_float(rr[1])); }
    constexpr float C2 = 1.4426950408889634f * SCALE;
    if (__builtin_expect(__all((pmax - m_reg) * SCALE <= THR), 1)) { mn = m_reg; alpha = 1.f; }
    else { mn = fmaxf(m_reg, pmax); alpha = __builtin_amdgcn_exp2f((m_reg - mn) * C2); m_reg = mn; }
    const float mnL = -mn * C2;
    for (int r = 0; r < 16; ++r) p0[r] = fmaf(p0[r], C2, mnL); for (int r = 0; r < 16; ++r) p1[r] = fmaf(p1[r], C2, mnL);
    for (int r = 0; r < 16; ++r) p0[r] = __builtin_amdgcn_exp2f(p0[r]);
}
__device__ __forceinline__ void finishSM(f32x16& p0, f32x16& p1, float alpha, float& l_reg, bf16x8& pa0, bf16x8& pa1, bf16x8& pa2, bf16x8& pa3) {
    for (int r = 0; r < 16; ++r) p1[r] = __builtin_amdgcn_exp2f(p1[r]);
    float ps = 0; for (int r = 0; r < 16; ++r) ps += p0[r]; for (int r = 0; r < 16; ++r) ps += p1[r];
    { auto rr = __builtin_amdgcn_permlane32_swap(__float_as_uint(ps), __float_as_uint(ps), false, false);
      ps = __uint_as_float(rr[0]) + __uint_as_float(rr[1]); }
    l_reg = l_reg * alpha + ps;
#define PK4(P, B_, OUT) do { unsigned a0 = cvtpk(P[B_+0], P[B_+1]), a1 = cvtpk(P[B_+2], P[B_+3]);                          \
        unsigned b0 = cvtpk(P[B_+4], P[B_+5]), b1 = cvtpk(P[B_+6], P[B_+7]);                                             \
        auto r0 = __builtin_amdgcn_permlane32_swap(a0, b0, false, false); auto r1 = __builtin_amdgcn_permlane32_swap(a1, b1, false, false); \
        u32x4 w = {r0[0], r1[0], r0[1], r1[1]}; OUT = *reinterpret_cast<bf16x8*>(&w); } while (0)
    PK4(p0, 0, pa0); PK4(p0, 8, pa1); PK4(p1, 0, pa2); PK4(p1, 8, pa3);
#undef PK4
}
template <int KB, bool SK>
__device__ __forceinline__ void qkt(f32x16& p0, f32x16& p1, const char* K_lds, int r32, int hi, const bf16x8* qr, bool act) {
    if (SK && !act) { const float NEG = -__builtin_inff();
#pragma unroll
        for (int r = 0; r < 16; ++r) { p0[r] = NEG; p1[r] = NEG; } return; }
    p0 = f32x16{}; p1 = f32x16{};
    const char* kb[4];
#pragma unroll
    for (int dd = 0; dd < 4; ++dd) kb[dd] = K_lds + KB * SHM_K + KSWZ(r32, (dd * 16 + hi * 8) * 2);
#pragma unroll
    for (int d0 = 0; d0 < 8; ++d0) { const char* a = kb[d0 & 3] + (d0 >> 2) * 128;
        bf16x8 b0 = *reinterpret_cast<const bf16x8*>(a);
        bf16x8 b1 = *reinterpret_cast<const bf16x8*>(a + 32 * 256);
        p0 = __builtin_amdgcn_mfma_f32_32x32x16_bf16(b0, qr[d0], p0, 0, 0, 0);
        p1 = __builtin_amdgcn_mfma_f32_32x32x16_bf16(b1, qr[d0], p1, 0, 0, 0); }
}
template <int VB, bool SK>
__device__ __forceinline__ void pv_tile(f32x16* o, int vb0, bf16x8 pa0, bf16x8 pa1, bf16x8 pa2, bf16x8 pa3, bool act) {
    if (SK && !act) return;
#define TRRD(dst, off) asm volatile("ds_read_b64_tr_b16 %0, %1 offset:%2" : "=&v"(dst) : "v"(vb0), "i"(off) : "memory")
#define PV_D0(d0) do { s16x4 l0, l1, l2, l3, h0, h1, h2, h3; constexpr int b_ = VB * SHM_V + v_rd_off(d0, 0, 0);     \
        TRRD(l0, b_); TRRD(h0, b_ + 2048); TRRD(l1, b_ + 4096); TRRD(h1, b_ + 6144); TRRD(l2, b_ + 8192); TRRD(h2, b_ + 10240); TRRD(l3, b_ + 12288); TRRD(h3, b_ + 14336); \
        asm volatile("s_waitcnt lgkmcnt(0)" ::: "memory"); SBAR();                 \
        o[d0] = __builtin_amdgcn_mfma_f32_32x32x16_bf16(pa0, (bf16x8){l0[0], l0[1], l0[2], l0[3], h0[0], h0[1], h0[2], h0[3]}, o[d0], 0, 0, 0);   \
        o[d0] = __builtin_amdgcn_mfma_f32_32x32x16_bf16(pa1, (bf16x8){l1[0], l1[1], l1[2], l1[3], h1[0], h1[1], h1[2], h1[3]}, o[d0], 0, 0, 0);   \
        o[d0] = __builtin_amdgcn_mfma_f32_32x32x16_bf16(pa2, (bf16x8){l2[0], l2[1], l2[2], l2[3], h2[0], h2[1], h2[2], h2[3]}, o[d0], 0, 0, 0);   \
        o[d0] = __builtin_amdgcn_mfma_f32_32x32x16_bf16(pa3, (bf16x8){l3[0], l3[1], l3[2], l3[3], h3[0], h3[1], h3[2], h3[3]}, o[d0], 0, 0, 0); } while (0)
    PV_D0(0); PV_D0(1); PV_D0(2); PV_D0(3);
#undef PV_D0
#undef TRRD
}

template <class TIn, class TOut> struct BlockRef { const TIn* Q; const TIn* K; const TIn* V; TOut* O; int P0; };
template <class TIn> struct Seam {
    bf16x8 qr[8];
    bf16x8 st_v0, st_v1, st_k0, st_k1; f32x4 sf0, sf1, sf2, sf3;
    f32x4 tq[16];
};
__device__ __forceinline__ int swa_jlo(int P0, int W) { const int lowk = P0 - W + 1; return lowk > 0 ? lowk / KVBLK : 0; }
#define ROW(p, k0, rr) ((p) + (size_t)((k0) + (rr)) * KVPITCH + sc)
#define VMW() asm volatile("s_waitcnt vmcnt(0)" ::: "memory")
#define VMWN(n) asm volatile("s_waitcnt vmcnt(%0)" :: "i"(n) : "memory")
#define SLOAD_H(Kp, Vp, k0) do { S.st_v0 = load8<TIn>(ROW(Vp, k0, sr)); S.st_v1 = load8<TIn>(ROW(Vp, k0, 32 + sr));              \
                         S.st_k0 = load8<TIn>(ROW(Kp, k0, sr)); S.st_k1 = load8<TIn>(ROW(Kp, k0, 32 + sr)); } while (0)
#define SWRITE_HK(bf) do { *(bf16x8*)(K_lds + (bf) * SHM_K + kws) = S.st_k0; *(bf16x8*)(K_lds + (bf) * SHM_K + kws + 32 * 256) = S.st_k1; } while (0)
#define SWRITE_HV(bf) do { *(bf16x8*)(V_lds + (bf) * SHM_V + vst0) = S.st_v0; *(bf16x8*)(V_lds + (bf) * SHM_V + vst1) = S.st_v1; } while (0)
#define SWRITE_H(bf) do { SWRITE_HV(bf); SWRITE_HK(bf); } while (0)
#define SLOAD_F(p, k0) do { S.sf0 = *(const f32x4*)ROW(p, k0, sr); S.sf1 = *(const f32x4*)(ROW(p, k0, sr) + 4);                \
                            S.sf2 = *(const f32x4*)ROW(p, k0, 32 + sr); S.sf3 = *(const f32x4*)(ROW(p, k0, 32 + sr) + 4); } while (0)
#define SWRITE_KF(bf) do { *(bf16x8*)(K_lds + (bf) * SHM_K + kws) = pack8(S.sf0, S.sf1); *(bf16x8*)(K_lds + (bf) * SHM_K + kws + 32 * 256) = pack8(S.sf2, S.sf3); } while (0)
#define SWRITE_VF(bf) do { *(bf16x8*)(V_lds + (bf) * SHM_V + vst0) = pack8(S.sf0, S.sf1); *(bf16x8*)(V_lds + (bf) * SHM_V + vst1) = pack8(S.sf2, S.sf3); } while (0)
template <class TIn, class TOut>
__device__ __forceinline__ void causal_swa_prime(const BlockRef<TIn, TOut>& cur, int W, char* lds, Seam<TIn>& S) {
    constexpr bool F32 = same_t<TIn, float>::v;
    int tid_ = threadIdx.x; asm volatile("" : "+v"(tid_)); const int tid = tid_, wid = __builtin_amdgcn_readfirstlane(tid >> 6), lane = tid & 63, r32 = lane & 31, hi = lane >> 5;
    const int sr = tid >> 4, sc = (tid & 15) * 8, kws = KSWZ(sr, sc * 2); char* K_lds = lds + 2 * SHM_V;
    const int kb0 = swa_jlo(cur.P0, W) * KVBLK;
    for (int d0 = 0; d0 < 8; ++d0) S.qr[d0] = load8<TIn>(cur.Q + (size_t)(wid * QBLK + r32) * QPITCH + d0 * 16 + hi * 8);
    if constexpr (F32) { SLOAD_F((const float*)cur.K, kb0); VMW(); SWRITE_KF(0); SBAR(); SLOAD_F((const float*)cur.V, kb0); }
    else { SLOAD_H(cur.K, cur.V, kb0); VMW(); SWRITE_HK(0); }
    __syncthreads();
}
template <class TIn, class TOut>
__device__ __forceinline__ void causal_swa_block(const BlockRef<TIn, TOut>& cur, const BlockRef<TIn, TOut>& nxt, int skv, int W, char* lds, Seam<TIn>& S) {
    constexpr bool F32 = same_t<TIn, float>::v;
    int tid_ = threadIdx.x; asm volatile("" : "+v"(tid_)); const int tid = tid_, wid = __builtin_amdgcn_readfirstlane(tid >> 6), lane = tid & 63, r32 = lane & 31, hi = lane >> 5;
    const int j_lo = swa_jlo(cur.P0, W);
    int j_hi = (cur.P0 + QB - 1) / KVBLK + 1; if (j_hi > skv / KVBLK) j_hi = skv / KVBLK;
    const int NT = j_hi - j_lo;
    const int kbn = swa_jlo(nxt.P0, W) * KVBLK;
    const int qlo = cur.P0 + wid * QBLK, qm = qlo + r32 - 4 * hi;
    char* V_lds = lds; char* K_lds = lds + 2 * SHM_V;
    float* ws = (float*)(lds + 2 * SHM_V + 2 * SHM_K) + wid * 64; float* li_l = ws, * al_l = ws + 32;
    float m_reg = -1e30f, l_reg = 0; f32x16 o[4] = {};
    const int sr = tid >> 4, sc = (tid & 15) * 8, vst0 = v_st(sr, sc), vst1 = v_st(32 + sr, sc), kws = KSWZ(sr, sc * 2);
    const int vb0 = (int)(uintptr_t)V_lds + v_rd_base(lane);
    const TIn* Kh = cur.K; const TIn* Vh = cur.V;
#define RESC(a) do { if (__any((a) < 1.f)) { if (hi == 0) al_l[r32] = (a); asm volatile("s_waitcnt lgkmcnt(0)" ::: "memory");              \
                     for (int d_ = 0; d_ < 4; ++d_) for (int r = 0; r < 16; ++r) o[d_][r] *= al_l[crow(r, hi)]; } } while (0)
#define KBASE(t) ((j_lo + (t)) * KVBLK)
#define ACT(t) (KBASE(t) <= qlo + QBLK - 1 && KBASE(t) + KVBLK - 1 >= qlo - W + 1)
#define MASKT(P0_, P1_, t) do { const int kb_ = KBASE(t); if ((!SK || ACT(t)) && (kb_ + KVBLK - 1 > qlo || kb_ <= qlo + QBLK - 1 - W)) mask_tile(P0_, P1_, qm - kb_, (unsigned)W); } while (0)
    constexpr int NQL = F32 ? 16 : 8;
    constexpr bool SK = WSKIP && !F32;
#define SEAM_K0() do { VMWN(NQL); if constexpr (F32) { SWRITE_KF(0); SBAR(); SLOAD_F((const float*)nxt.V, kbn); } else { SWRITE_HK(0); } SBAR(); } while (0)
    f32x16 pA0, pA1, pB0, pB1; float mnA, mnB, alA, alB; bf16x8 pa0, pa1, pa2, pa3;
    if constexpr (F32) { VMW(); SWRITE_VF(0); SBAR(); } else { SWRITE_HV(0); SBAR(); }
    if (NT > 1) { if constexpr (F32) SLOAD_F((const float*)Kh, KBASE(1)); else SLOAD_H(Kh, Vh, KBASE(1)); }
    SBAR(); qkt<0, SK>(pA0, pA1, K_lds, r32, hi, S.qr, ACT(0));
    if constexpr (F32) { if (NT > 1) { VMW(); SWRITE_KF(1); SBAR(); SLOAD_F((const float*)Vh, KBASE(1)); } }
    MASKT(pA0, pA1, 0); partialSM(pA0, pA1, m_reg, mnA, alA);
    if (NT > 1) { VMW(); if constexpr (F32) { SWRITE_VF(1); SBAR(); if (NT > 2) SLOAD_F((const float*)Kh, KBASE(2)); } else SWRITE_H(1); }
    __syncthreads();
#define HALF_STEP(PX0, PX1, mnX, alX, PY0, PY1, alY, t, KB, VB, SB) do {                                                      \
        SBAR(); qkt<KB, SK>(PX0, PX1, K_lds, r32, hi, S.qr, ACT(t));                                             \
        finishSM(PY0, PY1, alY, l_reg, pa0, pa1, pa2, pa3); SBAR();                                                           \
        if ((t) + 1 < NT) { if constexpr (F32) { VMW(); SWRITE_KF(SB); SBAR(); SLOAD_F((const float*)Vh, KBASE((t) + 1)); }  \
                            else { SLOAD_H(Kh, Vh, KBASE((t) + 1)); } SBAR(); }                                               \
        pv_tile<VB, SK>(o, vb0, pa0, pa1, pa2, pa3, ACT((t) - 1)); MASKT(PX0, PX1, (t)); partialSM(PX0, PX1, m_reg, mnX, alX);                                        \
        __syncthreads();                                                                                                      \
        if ((t) + 1 < NT) { VMW(); if constexpr (F32) { SWRITE_VF(SB); SBAR(); if ((t) + 2 < NT) SLOAD_F((const float*)Kh, KBASE((t) + 2)); } \
                            else { SWRITE_H(SB); } }                                                                          \
        RESC(alX); __syncthreads(); } while (0)
    for (int t = 1; t + 1 < NT; t += 2) {
        HALF_STEP(pB0, pB1, mnB, alB, pA0, pA1, alA, t, 1, 0, 0);
        HALF_STEP(pA0, pA1, mnA, alA, pB0, pB1, alB, t + 1, 0, 1, 1);
    }
    const bool even = (NT & 1) == 0;
    if (even) { SBAR(); qkt<1, SK>(pB0, pB1, K_lds, r32, hi, S.qr, ACT(NT - 1)); SBAR(); }
#define QROW(e) (nxt.Q + (size_t)(wid * QBLK + r32) * QPITCH + ((e) >> 1) * 16 + hi * 8 + ((e) & 1) * 4)
    if constexpr (F32) { SLOAD_F((const float*)nxt.K, kbn); SBAR();
#pragma unroll
        for (int e = 0; e < 8; ++e) S.tq[e] = *(const f32x4*)QROW(e); }
    else { SLOAD_H(nxt.K, nxt.V, kbn); SBAR();
#pragma unroll
        for (int d0 = 0; d0 < 8; ++d0) S.qr[d0] = load8<TIn>(nxt.Q + (size_t)(wid * QBLK + r32) * QPITCH + d0 * 16 + hi * 8); }
    SBAR();
    finishSM(pA0, pA1, alA, l_reg, pa0, pa1, pa2, pa3); SBAR();
    if constexpr (F32) {
#pragma unroll
        for (int e = 8; e < 16; ++e) S.tq[e] = *(const f32x4*)QROW(e); SBAR(); }
#undef QROW
    pv_tile<0, SK>(o, vb0, pa0, pa1, pa2, pa3, ACT(even ? NT - 2 : NT - 1));
    if (even) { MASKT(pB0, pB1, NT - 1); partialSM(pB0, pB1, m_reg, mnB, alB); __syncthreads(); RESC(alB);
        finishSM(pB0, pB1, alB, l_reg, pa0, pa1, pa2, pa3); SBAR(); pv_tile<1, SK>(o, vb0, pa0, pa1, pa2, pa3, ACT(NT - 1)); }
    SBAR(); SEAM_K0();
    if (hi == 0) li_l[r32] = l_reg; asm volatile("s_waitcnt lgkmcnt(0)" ::: "memory");
    float rli[16];
#pragma unroll
    for (int r = 0; r < 16; ++r) rli[r] = __builtin_amdgcn_rcpf(li_l[crow(r, hi)]);
    TOut* Ow = cur.O + (size_t)(wid * QBLK) * OPITCH;
#pragma unroll
    for (int r = 0; r < 16; ++r) { const int orow = crow(r, hi);
#pragma unroll
        for (int d0 = 0; d0 < 4; ++d0) { const float v = o[d0][r] * rli[r];
            if constexpr (same_t<TOut, float>::v) { Ow[(size_t)orow * OPITCH + d0 * 32 + r32] = v; }
            else { const float vn = __shfl_xor(v, 1);
                   if ((r32 & 1) == 0) *(unsigned*)(Ow + (size_t)orow * OPITCH + d0 * 32 + r32) = cvtpk(v, vn); } } }
    if constexpr (F32) {
#pragma unroll
        for (int d0 = 0; d0 < 8; ++d0) S.qr[d0] = pack8(S.tq[2 * d0], S.tq[2 * d0 + 1]); }
    __syncthreads();
#undef RESC
#undef KBASE
#undef ACT
#undef MASKT
#undef SEAM_K0
#undef HALF_STEP
}
#undef ROW
#undef VMW
#undef VMWN
#undef SLOAD_H
#undef SWRITE_HK
#undef SWRITE_HV
#undef SWRITE_H
#undef SLOAD_F
#undef SWRITE_KF
#undef SWRITE_VF

}
constexpr int NWAVES = 8;
#ifndef MK_SPLIT
#define MK_SPLIT 0
#endif
constexpr int BATCH = 16, SEQ = 2048, DM = 2048, M = BATCH * SEQ, DEPTH = 2, DFF = 8192;
constexpr int IN_COLS = 6160;
constexpr int NPROJ = 6656;
constexpr int C_GQ = 0, C_GK = 512, C_GV = 1024, C_GG = 2048, C_GATE = 3072, C_DQ = 3584, C_DK = 4608, C_DV = 5632;
constexpr int S_LR = 3072, S_SHIFT = 496;
constexpr int PH_PER_LAYER = 6, N_PHASES = 1 + DEPTH * PH_PER_LAYER;
constexpr float NORM_EPS = 1e-6f, SUBLN_EPS = 1e-5f;
constexpr float GLA_QSCALE = 0.08838834764831845f;

constexpr size_t MiB = 1u << 20;
constexpr size_t WS_CTL = 0, CTL_ZERO_BYTES = 1 * MiB;
constexpr size_t WS_BIAS = 1 * MiB;
constexpr size_t WS_COS = 2 * MiB, WS_SIN = 10 * MiB;
constexpr size_t WS_WIN = 18 * MiB;
constexpr size_t WS_WOUT = 70 * MiB;
constexpr size_t WS_WUP = 86 * MiB;
constexpr size_t WS_WDN = 150 * MiB;
constexpr size_t WS_XN = 214 * MiB;
constexpr size_t WS_XB2 = 342 * MiB;
constexpr size_t WS_PROJ = 342 * MiB;
constexpr size_t WS_O = 758 * MiB;
constexpr size_t WS_HID = 470 * MiB;
constexpr size_t WS_SS = 1014 * MiB;
constexpr size_t WS_END = 1019 * MiB;
static_assert(WS_WIN + (size_t)DEPTH * NPROJ * DM * 2 <= WS_WOUT && WS_WOUT + (size_t)DEPTH * DM * DM * 2 <= WS_WUP && WS_WUP + (size_t)DEPTH * DFF * DM * 2 <= WS_WDN && WS_WDN + (size_t)DEPTH * DFF * DM * 2 <= WS_XN, "ws map: weights");
static_assert(WS_XN + (size_t)M * DM * 2 <= WS_PROJ && WS_PROJ + (size_t)M * NPROJ * 2 <= WS_O && WS_O + (size_t)M * 2048 * 4 <= WS_END && WS_HID + (size_t)M * DFF * 2 <= WS_END && WS_XB2 + (size_t)M * DM * 2 <= WS_HID, "ws map: activations");
constexpr int CW_BAR = 4096;
constexpr int CW_Q = 8192;


constexpr int RING_OFF = 0, RING_BYTES = 131072;
constexpr int LDSCTL_OFF = RING_BYTES, MISC_OFF = LDSCTL_OFF + 320;
constexpr int RED_OFF = RING_BYTES + 1024;
constexpr int LDS_BYTES = 147456;
static_assert(MISC_OFF + 128 <= RED_OFF && RED_OFF + 8192 <= LDS_BYTES, "LDS map");

#define GAS __attribute__((address_space(1)))
#define LAS __attribute__((address_space(3)))
#define DI __device__ __forceinline__
typedef unsigned short bf16;
typedef unsigned v4u __attribute__((ext_vector_type(4)));
typedef unsigned v2u __attribute__((ext_vector_type(2)));
typedef float f32x4 __attribute__((ext_vector_type(4)));
typedef float f32x2v __attribute__((ext_vector_type(2)));
typedef float f32x16 __attribute__((ext_vector_type(16)));
typedef short bf16x8 __attribute__((ext_vector_type(8)));
typedef short s16x4 __attribute__((ext_vector_type(4)));
typedef __bf16 bf16x2_t __attribute__((ext_vector_type(2)));
typedef GAS unsigned gu32;
#define RLX_AGENT __ATOMIC_RELAXED, __HIP_MEMORY_SCOPE_AGENT
#define LDS_WAIT() asm volatile("s_waitcnt lgkmcnt(0)" ::: "memory")
#define VM_WAIT() asm volatile("s_waitcnt vmcnt(0)" ::: "memory")
DI unsigned pk2(float lo, float hi) { f32x2v v = {lo, hi}; bf16x2_t b = __builtin_convertvector(v, bf16x2_t); return __builtin_bit_cast(unsigned, b); }
DI float bf_lo(unsigned u) { return __uint_as_float(u << 16); }
DI float bf_hi(unsigned u) { return __uint_as_float(u & 0xffff0000u); }
DI int opaque_tid() { int t = threadIdx.x; asm volatile("" : "+v"(t)); return t; }
#define PH_IDS const int tid = opaque_tid(), lane = tid & 63, wave = __builtin_amdgcn_readfirstlane(tid >> 6), gw = (int)blockIdx.x * NWAVES + wave; (void)lane; (void)gw
#define MFMA32(a, b, c) __builtin_amdgcn_mfma_f32_32x32x16_bf16((a), (b), (c), 0, 0, 0)

#define XB_TMO      128
#define XB_XCNT(j)  (256  + 64 * (j))
#define XB_XSUB(j)  (1280 + 64 * (j))
#define XB_XGEN(j)  (2304 + 64 * (j))
#define XB_TOP      3328
#define XB_TOPGEN   3392
#define XCD_BAR_WORDS 3456
#define XB_SPIN_CAP (1u << 18)

__device__ __forceinline__ unsigned xb_ld(unsigned* p)              { return __hip_atomic_load(p, __ATOMIC_RELAXED, __HIP_MEMORY_SCOPE_AGENT); }
__device__ __forceinline__ unsigned xb_add(unsigned* p, unsigned v) { return __hip_atomic_fetch_add(p, v, __ATOMIC_RELAXED, __HIP_MEMORY_SCOPE_AGENT); }
__device__ __forceinline__ unsigned xb_xcc_id() { return (unsigned)__builtin_amdgcn_s_getreg((3 << 11) | 20) & 0xFu; }
#define XB_SPIN(cond, bar) do { unsigned _sp = 0; while (cond) { __builtin_amdgcn_s_sleep(1); \
    if ((++_sp & 255u) == 0u) { if (xb_ld(&(bar)[XB_TMO])) break; if (_sp > XB_SPIN_CAP) { atomicAdd(&(bar)[XB_TMO], 1u); break; } } } } while (0)

struct XcdBarrier {
    unsigned* bar; unsigned x;
    volatile LAS unsigned* st;
};

__device__ __forceinline__ XcdBarrier xcd_barrier_post(unsigned* bar, volatile LAS unsigned* st) {
    XcdBarrier b; b.bar = bar; b.x = xb_xcc_id(); b.st = st;
    if (threadIdx.x == 0) (void)xb_add(&bar[XB_XCNT(b.x)], 1u);
    return b;
}
__device__ __forceinline__ void xcd_barrier_complete(unsigned* bar, unsigned x, unsigned& nloc, unsigned& nx) {
    const unsigned G = gridDim.x * gridDim.y * gridDim.z;
    unsigned sum, cnt, mine, sp = 0u;
    for (;;) {
        sum = 0u; cnt = 0u; mine = 0u;
#pragma unroll
        for (unsigned j = 0; j < 16; ++j) { const unsigned c = xb_ld(&bar[XB_XCNT(j)]); sum += c; cnt += (c > 0u) ? 1u : 0u; mine = (j == x) ? c : mine; }
        if (sum == G) break;
        __builtin_amdgcn_s_sleep(1);
        if ((++sp & 255u) == 0u) { if (xb_ld(&bar[XB_TMO])) break; if (sp > XB_SPIN_CAP) { atomicAdd(&bar[XB_TMO], 1u); break; } }
    }
    nloc = mine > 0u ? mine : 1u; nx = cnt > 0u ? cnt : 1u;
}

__device__ __forceinline__ void xcd_barrier(const XcdBarrier& b) {
    asm volatile("s_waitcnt vmcnt(0)" ::: "memory");
    __syncthreads();
    if (threadIdx.x == 0) {
        unsigned* bar = b.bar;
        __builtin_amdgcn_s_waitcnt(0);
        unsigned nloc = b.st[0], nx = b.st[1];
        if (nloc == 0u) { xcd_barrier_complete(bar, b.x, nloc, nx); b.st[0] = nloc; b.st[1] = nx; }
        const unsigned old = xb_add(&bar[XB_XSUB(b.x)], 1u);
        const unsigned gen = old / nloc;
        if (old + 1u == (gen + 1u) * nloc) {
            __builtin_amdgcn_fence(__ATOMIC_RELEASE, "agent");
            asm volatile("s_waitcnt vmcnt(0)" ::: "memory");
            const unsigned og = xb_add(&bar[XB_TOP], 1u);
            const unsigned tg = og / nx;
            if (og + 1u == (tg + 1u) * nx) xb_add(&bar[XB_TOPGEN], 1u);
            else XB_SPIN(xb_ld(&bar[XB_TOPGEN]) == tg, bar);
            __builtin_amdgcn_fence(__ATOMIC_ACQUIRE, "agent");
            xb_add(&bar[XB_XGEN(b.x)], 1u);
            asm volatile("s_waitcnt vmcnt(0)" ::: "memory");
        } else {
            XB_SPIN(xb_ld(&bar[XB_XGEN(b.x)]) == gen, bar);
            __builtin_amdgcn_fence(__ATOMIC_ACQUIRE, "agent");
            asm volatile("s_waitcnt vmcnt(0)" ::: "memory");
        }
    }
    __syncthreads();
}

struct Args { const void* in[18]; float* out; unsigned char* ws; int ph_lo, ph_hi; };
struct Frame {
    LAS unsigned char* lds;
    volatile LAS unsigned* MISC;
    gu32* ctl;
    int G, NGW;
    unsigned char* ws;
};
enum { I_X = 0, I_POS, I_ATTN_NW, I_WIN, I_GW2, I_GB, I_GLA_NW, I_QNW, I_KNW, I_LQ1, I_LK1, I_LQ2, I_LK2, I_SUBW, I_WOUT, I_MLP_NW, I_WUP, I_WDN };
typedef __attribute__((address_space(4))) const Args* kargs_t;
DI kargs_t kargs() { kargs_t p = (kargs_t)__builtin_amdgcn_kernarg_segment_ptr(); asm volatile("" : "+s"(p)); return p; }
#define INP(T, k) ((const T*)(const GAS T*)kargs()->in[k])
#define OUTP() ((float*)(GAS float*)kargs()->out)
DI GAS unsigned char* ws_opaque(Frame& F) { GAS unsigned char* w = (GAS unsigned char*)F.ws; asm volatile("" : "+s"(w)); return w; }
DI float wave_sum(float v) {
#pragma unroll
    for (int o = 1; o < 64; o <<= 1) v += __shfl_xor(v, o);
    return v;
}

DI void p0_write_tile(bf16* WT, int K, int drow0, int k0, LAS float* scr, int lane, const float* rs) {
    const int c = lane & 7;
    f32x4 s0 = {1.f, 1.f, 1.f, 1.f}, s1 = s0;
    if (rs) { s0 = *(const f32x4*)(rs + k0 + 8 * c); s1 = *(const f32x4*)(rs + k0 + 8 * c + 4); }
    LDS_WAIT(); asm volatile("" ::: "memory");
#pragma unroll
    for (int j = 0; j < 4; ++j) { const int n = (lane >> 3) + 8 * j; const LAS float* s = scr + (8 * c) * 33 + n;
        v4u o; o.x = pk2(s[0 * 33] * s0[0], s[1 * 33] * s0[1]); o.y = pk2(s[2 * 33] * s0[2], s[3 * 33] * s0[3]); o.z = pk2(s[4 * 33] * s1[0], s[5 * 33] * s1[1]); o.w = pk2(s[6 * 33] * s1[2], s[7 * 33] * s1[3]);
        *(GAS v4u*)(WT + (size_t)(drow0 + n) * K + k0 + 8 * c) = o; }
    LDS_WAIT(); asm volatile("" ::: "memory");
}
DI void p0_transpose_tile(const float* W, int SP, int scol, bf16* WT, int K, int drow0, int k0, LAS float* scr, int lane, const float* rs) {
#pragma unroll 8
    for (int i = 0; i < 32; ++i) { const int kk = 2 * i + (lane >> 5); scr[kk * 33 + (lane & 31)] = W[(size_t)(k0 + kk) * SP + scol]; }
    p0_write_tile(WT, K, drow0, k0, scr, lane, rs);
}
DI void p0_gate_tile(const float* W, const float* w2, bf16* WT, int j0, int k0, LAS float* scr, int lane, const float* rs) {
    float w2r[16];
#pragma unroll
    for (int r = 0; r < 16; ++r) w2r[r] = w2[r * 512 + j0 + (lane & 31)];
#pragma unroll 4
    for (int i = 0; i < 32; ++i) { const int kk = 2 * i + (lane >> 5); const f32x4* wr = (const f32x4*)(W + (size_t)(k0 + kk) * IN_COLS + S_LR);
        float a = 0.f;
#pragma unroll
        for (int q = 0; q < 4; ++q) { const f32x4 t = wr[q]; a = fmaf(t.x, w2r[4 * q], a); a = fmaf(t.y, w2r[4 * q + 1], a); a = fmaf(t.z, w2r[4 * q + 2], a); a = fmaf(t.w, w2r[4 * q + 3], a); }
        scr[kk * 33 + (lane & 31)] = a; }
    p0_write_tile(WT, DM, C_GATE + j0, k0, scr, lane, rs);
}
DI void sincos_red(float ang, float& s, float& c) {
    const double a = (double)ang; const double kq = __builtin_rint(a * 0.6366197723675814);
    double r = __builtin_fma(-kq, 1.5707963267948966, a); r = __builtin_fma(-kq, 6.123233995736766e-17, r);
    const float x = (float)r, x2 = x * x; const int q = (int)kq & 3;
    const float sp = x + x * x2 * (-1.6666654611e-1f + x2 * (8.3321608736e-3f + x2 * (-1.9515295891e-4f)));
    const float cp = 1.f - 0.5f * x2 + x2 * x2 * (4.166664568298827e-2f + x2 * (-1.388731625493765e-3f + x2 * 2.443315711809948e-5f));
    s = (q == 0) ? sp : (q == 1) ? cp : (q == 2) ? -sp : -cp;
    c = (q == 0) ? cp : (q == 1) ? -sp : (q == 2) ? -cp : sp;
}
DI void p0_prologue(Frame& F) {
    PH_IDS;
    LAS float* scr = (LAS float*)(F.lds + RING_OFF + wave * 16384);
    constexpr int NB_IN = NPROJ / 32, I_IN = (DM / 64) * NB_IN, I_OUT = (DM / 64) * (DM / 32), I_UP = (DM / 64) * (DFF / 32), I_DN = (DFF / 64) * (DM / 32), I_LAYER = I_IN + I_OUT + I_UP + I_DN;
    GAS unsigned char* ws = ws_opaque(F);
    bf16* WinT = (bf16*)(ws + WS_WIN); bf16* WoutT = (bf16*)(ws + WS_WOUT); bf16* WupT = (bf16*)(ws + WS_WUP); bf16* WdnT = (bf16*)(ws + WS_WDN);
    for (int it = gw; it < DEPTH * I_LAYER; it += F.NGW) {
        const int L = it / I_LAYER; int r = it - L * I_LAYER;
        if (r < I_IN) { const int kb = r / NB_IN, nb = r - kb * NB_IN, drow0 = nb * 32; const float* W = INP(float, I_WIN) + (size_t)L * DM * IN_COLS; bf16* WT = WinT + (size_t)L * NPROJ * DM;
            if (drow0 >= C_GATE && drow0 < C_DQ) p0_gate_tile(W, INP(float, I_GW2) + (size_t)L * 16 * 512, WT, drow0 - C_GATE, kb * 64, scr, lane, INP(float, I_ATTN_NW) + L * DM);
            else { const int l = lane & 31; int scol;
                if (drow0 < C_GATE) scol = drow0 + l;
                else if (drow0 >= C_DV) scol = drow0 - S_SHIFT + l;
                else { const int hb = (drow0 - C_DQ) & ~127, c0 = (drow0 - C_DQ) & 127; scol = C_DQ - S_SHIFT + hb + ((l & 1) ? 64 : 0) + (c0 >> 1) + (l >> 1); }
                p0_transpose_tile(W, IN_COLS, scol, WT, DM, drow0, kb * 64, scr, lane, INP(float, I_ATTN_NW) + L * DM); }
            continue; }
        r -= I_IN;
        if (r < I_OUT) { const int kb = r / (DM / 32), nb = r % (DM / 32); p0_transpose_tile(INP(float, I_WOUT) + (size_t)L * DM * DM, DM, nb * 32 + (lane & 31), WoutT + (size_t)L * DM * DM, DM, nb * 32, kb * 64, scr, lane, nullptr); continue; }
        r -= I_OUT;
        if (r < I_UP) { const int kb = r / (DFF / 32), nb = r % (DFF / 32); p0_transpose_tile(INP(float, I_WUP) + (size_t)L * DM * DFF, DFF, nb * 32 + (lane & 31), WupT + (size_t)L * DFF * DM, DM, nb * 32, kb * 64, scr, lane, INP(float, I_MLP_NW) + L * DM); continue; }
        r -= I_UP;
        { const int kb = r / (DM / 32), nb = r % (DM / 32); p0_transpose_tile(INP(float, I_WDN) + (size_t)L * DFF * DM, DM, nb * 32 + (lane & 31), WdnT + (size_t)L * DM * DFF, DFF, nb * 32, kb * 64, scr, lane, nullptr); }
    }
    const int gt = gw * 64 + lane, NT = F.NGW * 64;
    float* bias = (float*)(ws + WS_BIAS); const float* gate_b = INP(float, I_GB); const int* pos = INP(int, I_POS);
    for (int i = gt; i < DEPTH * NPROJ; i += NT) { const int L = i / NPROJ, c = i - L * NPROJ; bias[i] = (c >= C_GATE && c < C_DQ) ? gate_b[L * 512 + c - C_GATE] : 0.f; }
    float* ct = (float*)(ws + WS_COS); float* st = (float*)(ws + WS_SIN);
    for (int i = gt; i < M * 64; i += NT) { const int row = i >> 6, f = i & 63;
        const float inv_freq = (float)exp2(-(double)f * (13.287712379549449 / 64.0));
        const float ang = (float)pos[row] * inv_freq; float s, c; sincos_red(ang, s, c); ct[i] = c; st[i] = s; }
    const float* x = INP(float, I_X); bf16* xb = (bf16*)OUTP(); GAS f32x4* ss0 = (GAS f32x4*)(ws + WS_SS);
    for (int m = gw; m < M; m += F.NGW) {
        const GAS f32x4* xr = (const GAS f32x4*)(x + (size_t)m * DM) + lane;
        f32x4 v[8]; float s = 0.f;
#pragma unroll
        for (int j = 0; j < 8; ++j) { v[j] = xr[64 * j]; s += (v[j].x * v[j].x + v[j].y * v[j].y) + (v[j].z * v[j].z + v[j].w * v[j].w); }
        s = wave_sum(s); if (lane < 2) ss0[2 * m + lane] = (f32x4){lane == 0 ? s : 0.f, 0.f, 0.f, 0.f};
        GAS v2u* o8 = (GAS v2u*)(xb + (size_t)m * DM) + lane;
#pragma unroll
        for (int j = 0; j < 8; ++j) { v2u o; o.x = pk2(v[j].x, v[j].y); o.y = pk2(v[j].z, v[j].w); o8[64 * j] = o; }
    }
}

DI void combine_phase(Frame& F, int L) {
    PH_IDS;
    GAS unsigned char* ws = ws_opaque(F);
    const float* O = (const float*)(ws + WS_O); bf16* mix = (bf16*)(ws + WS_XN);
    const float* lq1 = INP(float, I_LQ1) + L * 128; const float* lk1 = INP(float, I_LK1) + L * 128; const float* lq2 = INP(float, I_LQ2) + L * 128; const float* lk2 = INP(float, I_LK2) + L * 128;
    const float lam_init = (L == 0) ? 0.2f : 0.35550906759096914f;
    float d1 = lq1[lane] * lk1[lane] + lq1[64 + lane] * lk1[64 + lane];
    float d2 = lq2[lane] * lk2[lane] + lq2[64 + lane] * lk2[64 + lane];
    const float lam = expf(wave_sum(d1)) - expf(wave_sum(d2)) + lam_init;
    const float osc = 1.0f - lam_init;
    const f32x4 sw = *(const f32x4*)(INP(float, I_SUBW) + L * 256 + 4 * lane);
    for (int it = gw; it < M * 4; it += F.NGW) { const int m = it >> 2, h = it & 3;
        const float* o = O + (size_t)m * 2048 + h * 512 + 4 * lane;
        const f32x4 a = *(const f32x4*)o, b = *(const f32x4*)(o + 256);
        const f32x4 d = a - b * lam;
        const float ss = wave_sum((d.x * d.x + d.y * d.y) + (d.z * d.z + d.w * d.w));
        const float r = osc / sqrtf(ss * (1.f / 256.f) + SUBLN_EPS);
        v2u w; w.x = pk2(d.x * r * sw.x, d.y * r * sw.y); w.y = pk2(d.z * r * sw.z, d.w * r * sw.w);
        *(v2u*)(mix + (size_t)m * DM + 1024 + h * 256 + 4 * lane) = w; }
}
#ifndef PROBE_DUP
#define PROBE_DUP 0
#endif

constexpr int G_QT = 0, G_QP = 272, G_KT = 17408, G_KDT = 34816, G_TP = 144, G_VT = 53248, G_AT = 90112, G_DEC = 99328, G_GT = 99840, G_END = 103936, G_OB = 0, G_OP = 1040;
static_assert(G_END <= RING_BYTES && 64 * G_OP <= G_DEC, "GLA LDS map");
DI float log_sigmoid_f(float x) { return fminf(x, 0.f) - __logf(1.f + __expf(-fabsf(x))); }
DI bf16x8 lds_frag16(LAS unsigned char* p) { return *(LAS const bf16x8*)p; }
DI bf16x8 lds_frag8x2(LAS unsigned char* p, int second_off) { const s16x4 a = *(LAS const s16x4*)p, b = *(LAS const s16x4*)(p + second_off); return __builtin_shufflevector(a, b, 0, 1, 2, 3, 4, 5, 6, 7); }
DI void gla_unit(Frame& F, int L, int unit) {
    PH_IDS;
    const int b = unit >> 2, h = unit & 3, r = lane & 31, hh = lane >> 5;
    LAS unsigned char* lds = F.lds + RING_OFF;
    GAS unsigned char* ws = ws_opaque(F);
    const bf16* pbase = (const bf16*)(ws + WS_PROJ) + (size_t)b * SEQ * NPROJ;
    bf16* mix = (bf16*)(ws + WS_XN);
    const float* nw = INP(float, I_GLA_NW) + L * 256;
    f32x16 S[4];
#pragma unroll
    for (int i = 0; i < 4; ++i)
#pragma unroll
        for (int e = 0; e < 16; ++e) S[i][e] = 0.f;
    unsigned qv[8], kv[8], gv[8], vv[16];
#define GLA_LOAD(nn) do { const bf16* pr_ = pbase + (size_t)((nn) * 64) * NPROJ; const bf16* r0_ = pr_ + (size_t)(8 * wave) * NPROJ + h * 128 + 2 * (tid & 63); \
        _Pragma("unroll") for (int i = 0; i < 8; ++i) { const bf16* rr = r0_ + (size_t)i * NPROJ; qv[i] = *(const unsigned*)(rr + C_GQ); kv[i] = *(const unsigned*)(rr + C_GK); gv[i] = *(const unsigned*)(rr + C_GATE); } \
        const bf16* v0_ = pr_ + (size_t)(16 * (tid >> 7)) * NPROJ + C_GV + h * 256 + 2 * (tid & 127); \
        _Pragma("unroll") for (int i = 0; i < 16; ++i) vv[i] = *(const unsigned*)(v0_ + (size_t)i * NPROJ); } while (0)
    GLA_LOAD(0);
#pragma unroll 1
    for (int n = 0; n < SEQ / 64; ++n) {
        const bf16* prow = pbase + (size_t)(n * 64) * NPROJ;
        {
            const int dp = tid & 63, tg = wave;
            const int vp = tid & 127, tq = tid >> 7;
            float cs0[8], cs1[8]; float a0 = 0.f, a1 = 0.f;
#pragma unroll
            for (int i = 0; i < 8; ++i) { a0 += log_sigmoid_f(bf_lo(gv[i])) * (1.f / 16.f); a1 += log_sigmoid_f(bf_hi(gv[i])) * (1.f / 16.f); cs0[i] = a0; cs1[i] = a1; }
            *(LAS f32x2v*)(lds + G_GT + (tg * 128 + 2 * dp) * 4) = (f32x2v){a0, a1};
#pragma unroll
            for (int hf = 0; hf < 2; ++hf) { v4u lo4, hi4;
#pragma unroll
                for (int j = 0; j < 4; ++j) { const unsigned x0 = vv[8 * hf + 2 * j], x1 = vv[8 * hf + 2 * j + 1]; lo4[j] = (x0 & 0xffffu) | (x1 << 16); hi4[j] = (x0 >> 16) | (x1 & 0xffff0000u); }
                *(LAS v4u*)(lds + G_VT + (2 * vp) * G_TP + (16 * tq + 8 * hf) * 2) = lo4; *(LAS v4u*)(lds + G_VT + (2 * vp + 1) * G_TP + (16 * tq + 8 * hf) * 2) = hi4; }
            __syncthreads();
            float p0 = 0.f, p1 = 0.f, t0 = 0.f, t1 = 0.f;
#pragma unroll
            for (int g = 0; g < 8; ++g) { const f32x2v x = *(LAS const f32x2v*)(lds + G_GT + (g * 128 + 2 * dp) * 4); if (g < tg) { p0 += x.x; p1 += x.y; } t0 += x.x; t1 += x.y; }
            v4u kd0, kd1; float kx0[8], kx1[8];
            const float et0 = __expf(t0), et1 = __expf(t1);
#pragma unroll
            for (int i = 0; i < 8; ++i) { const float b0 = p0 + cs0[i], b1 = p1 + cs1[i];
                const float q0 = bf_lo(qv[i]) * GLA_QSCALE * __expf(b0), q1 = bf_hi(qv[i]) * GLA_QSCALE * __expf(b1);
                const float k0 = bf_lo(kv[i]) * __expf(-b0), k1 = bf_hi(kv[i]) * __expf(-b1);
                *(LAS unsigned*)(lds + G_QT + (8 * tg + i) * G_QP + 4 * dp) = pk2(q0, q1);
                *(LAS unsigned*)(lds + G_KT + (8 * tg + i) * G_QP + 4 * dp) = pk2(k0, k1);
                kx0[i] = k0 * et0; kx1[i] = k1 * et1; }
#pragma unroll
            for (int j = 0; j < 4; ++j) { kd0[j] = pk2(kx0[2 * j], kx0[2 * j + 1]); kd1[j] = pk2(kx1[2 * j], kx1[2 * j + 1]); }
            *(LAS v4u*)(lds + G_KDT + (2 * dp) * G_TP + 16 * tg) = kd0; *(LAS v4u*)(lds + G_KDT + (2 * dp + 1) * G_TP + 16 * tg) = kd1;
            if (tg == 0) *(LAS f32x2v*)(lds + G_DEC + 8 * dp) = (f32x2v){et0, et1};
        }
        v4u gq[4];
        { const bf16* gp = prow + (size_t)(tid >> 3) * NPROJ + C_GG + h * 256 + 32 * (tid & 7);
#pragma unroll
          for (int j = 0; j < 4; ++j) gq[j] = *(const v4u*)(gp + 8 * j); }
        if (n + 1 < SEQ / 64) GLA_LOAD(n + 1);
        __syncthreads();
        if (wave < 3) {
            const int ib = wave ? 1 : 0, jb = wave == 2 ? 1 : 0;
            f32x16 acc;
#pragma unroll
            for (int e = 0; e < 16; ++e) acc[e] = 0.f;
#pragma unroll
            for (int ks = 0; ks < 8; ++ks) { const bf16x8 a = lds_frag16(lds + G_KT + (jb * 32 + r) * G_QP + ks * 32 + 16 * hh), bq = lds_frag16(lds + G_QT + (ib * 32 + r) * G_QP + ks * 32 + 16 * hh);
                acc = MFMA32(a, bq, acc); }
            const int ci = ib * 32 + r;
#pragma unroll
            for (int g = 0; g < 4; ++g) { const int cj0 = jb * 32 + 8 * g + 4 * hh; float v[4];
#pragma unroll
                for (int e = 0; e < 4; ++e) v[e] = (cj0 + e <= ci) ? acc[4 * g + e] : 0.f;
                *(LAS v2u*)(lds + G_AT + ci * G_TP + cj0 * 2) = (v2u){pk2(v[0], v[1]), pk2(v[2], v[3])}; }
        }
        __syncthreads();
        f32x16 o0, o1;
#pragma unroll
        for (int e = 0; e < 16; ++e) { o0[e] = 0.f; o1[e] = 0.f; }
#pragma unroll
        for (int i = 0; i < 4; ++i)
#pragma unroll
            for (int s = 0; s < 2; ++s) {
                v4u pw;
#pragma unroll
                for (int j = 0; j < 4; ++j) pw[j] = pk2(S[i][8 * s + 2 * j], S[i][8 * s + 2 * j + 1]);
                const bf16x8 sb = __builtin_bit_cast(bf16x8, pw);
                const int d0 = 32 * i + 16 * s + 4 * hh;
                const bf16x8 qa0 = lds_frag8x2(lds + G_QT + r * G_QP + d0 * 2, 16), qa1 = lds_frag8x2(lds + G_QT + (32 + r) * G_QP + d0 * 2, 16);
                o0 = MFMA32(qa0, sb, o0); o1 = MFMA32(qa1, sb, o1); }
        bf16x8 vf[4];
#pragma unroll
        for (int ks = 0; ks < 4; ++ks) vf[ks] = lds_frag16(lds + G_VT + (32 * wave + r) * G_TP + ks * 32 + 16 * hh);
#pragma unroll
        for (int ks = 0; ks < 2; ++ks) o0 = MFMA32(lds_frag16(lds + G_AT + r * G_TP + ks * 32 + 16 * hh), vf[ks], o0);
#pragma unroll
        for (int ks = 0; ks < 4; ++ks) o1 = MFMA32(lds_frag16(lds + G_AT + (32 + r) * G_TP + ks * 32 + 16 * hh), vf[ks], o1);
#pragma unroll
        for (int i = 0; i < 4; ++i) {
#pragma unroll
            for (int g = 0; g < 4; ++g) { const f32x4 dc = *(LAS const f32x4*)(lds + G_DEC + (32 * i + 8 * g + 4 * hh) * 4);
                S[i][4 * g] *= dc.x; S[i][4 * g + 1] *= dc.y; S[i][4 * g + 2] *= dc.z; S[i][4 * g + 3] *= dc.w; }
#pragma unroll
            for (int ks = 0; ks < 4; ++ks) S[i] = MFMA32(lds_frag16(lds + G_KDT + (32 * i + r) * G_TP + ks * 32 + 16 * hh), vf[ks], S[i]); }
        __syncthreads();
#pragma unroll
        for (int e = 0; e < 16; ++e) { const int c = (e & 3) + 8 * (e >> 2) + 4 * hh;
            *(LAS float*)(lds + G_OB + c * G_OP + (32 * wave + r) * 4) = o0[e]; *(LAS float*)(lds + G_OB + (32 + c) * G_OP + (32 * wave + r) * 4) = o1[e]; }
        __syncthreads();
        {
            const int c = tid >> 3, p = tid & 7;
            f32x4 ov[8]; float ss = 0.f;
#pragma unroll
            for (int j = 0; j < 8; ++j) { ov[j] = *(LAS const f32x4*)(lds + G_OB + c * G_OP + (32 * p + 4 * j) * 4); ss += (ov[j].x * ov[j].x + ov[j].y * ov[j].y) + (ov[j].z * ov[j].z + ov[j].w * ov[j].w); }
            ss += __shfl_xor(ss, 1); ss += __shfl_xor(ss, 2); ss += __shfl_xor(ss, 4);
            const float rstd = 1.0f / sqrtf(ss * (1.f / 256.f) + NORM_EPS);
            bf16* yp = mix + (size_t)(b * SEQ + n * 64 + c) * DM + h * 256 + 32 * p;
#pragma unroll
            for (int j = 0; j < 4; ++j) { const f32x4 w0 = *(const f32x4*)(nw + 32 * p + 8 * j), w1 = *(const f32x4*)(nw + 32 * p + 8 * j + 4); const f32x4 x0 = ov[2 * j], x1 = ov[2 * j + 1];
                float gf[8];
#pragma unroll
                for (int e = 0; e < 4; ++e) { gf[2 * e] = bf_lo(gq[j][e]); gf[2 * e + 1] = bf_hi(gq[j][e]); }
                float y[8];
#pragma unroll
                for (int e = 0; e < 4; ++e) { y[e] = x0[e] * rstd * w0[e]; y[4 + e] = x1[e] * rstd * w1[e]; }
#pragma unroll
                for (int e = 0; e < 8; ++e) y[e] = y[e] * gf[e] * __builtin_amdgcn_rcpf(1.f + __expf(-gf[e]));
                *(v4u*)(yp + 8 * j) = (v4u){pk2(y[0], y[1]), pk2(y[2], y[3]), pk2(y[4], y[5]), pk2(y[6], y[7])}; }
        }
        __syncthreads();
    }
#undef GLA_LOAD
}

typedef swa::BlockRef<swa::bf16, float> ABlk;
constexpr int N_GLA = BATCH * 4, N_ATT = BATCH * 16 * (SEQ / 256), N_ITEMS = N_GLA + N_ATT;
DI ABlk attn_ref(GAS unsigned char* ws, int a) {
    const int qb = (SEQ / 256 - 1) - (a >> 8), rest = a & 255, bb = rest >> 4, vh = rest & 15, hd = vh >> 2, c = (vh >> 1) & 1, vhalf = vh & 1;
    const swa::bf16* proj = (const swa::bf16*)(ws + WS_PROJ); float* O = (float*)(ws + WS_O);
    ABlk R;
    R.Q = proj + (size_t)(bb * SEQ + qb * 256) * NPROJ + C_DQ + (hd * 2 + c) * 128;
    R.K = proj + (size_t)(bb * SEQ) * NPROJ + C_DK + (hd * 2 + c) * 128;
    R.V = proj + (size_t)(bb * SEQ) * NPROJ + C_DV + hd * 256 + vhalf * 128;
    R.O = O + (size_t)(bb * SEQ + qb * 256) * 2048 + (hd * 2 + c) * 256 + vhalf * 128;
    R.P0 = qb * 256;
    return R;
}
DI int q_next(Frame& F, gu32* head) {
    if (threadIdx.x == 0) F.MISC[16] = __hip_atomic_fetch_add(head, 1u, RLX_AGENT);
    __syncthreads(); const int v = (int)F.MISC[16]; __syncthreads();
    return __builtin_amdgcn_readfirstlane(v);
}
DI void mixer_phase(Frame& F, int qi, int L, char* lds_generic) {
    gu32* head = F.ctl + CW_Q + 64 * qi;
    GAS unsigned char* ws = ws_opaque(F);
    int it = q_next(F, head);
    while (it < N_GLA) { _Pragma("unroll 1") for (int gr = (PROBE_DUP == 10) ? 1 : 0; gr >= 0; --gr) gla_unit(F, L, it); it = q_next(F, head); }
    if (it < N_ITEMS) {
        ABlk cur = attn_ref(ws, it - N_GLA);
        swa::Seam<swa::bf16> S;
        swa::causal_swa_prime<swa::bf16, float>(cur, SEQ, lds_generic, S);
        int nx = q_next(F, head);
        for (;;) {
            const bool last = nx >= N_ITEMS;
            const ABlk nxt = last ? cur : attn_ref(ws, nx - N_GLA);
            unsigned pend = 0u;
            if (!last && threadIdx.x == 0) pend = __hip_atomic_fetch_add(head, 1u, RLX_AGENT);
            swa::causal_swa_block<swa::bf16, float>(cur, nxt, SEQ, SEQ, lds_generic, S);
            if (last) break;
            if (threadIdx.x == 0) F.MISC[20] = pend;
            __syncthreads();
            cur = nxt; nx = __builtin_amdgcn_readfirstlane((int)F.MISC[20]);
        }
    }
}

__global__ void __launch_bounds__(NWAVES * 64, 2) fwd(Args args) {
    extern __shared__ __attribute__((aligned(16))) unsigned char lds[];
    Frame F;
    F.lds = (LAS unsigned char*)lds;
    F.MISC = (volatile LAS unsigned*)(F.lds + MISC_OFF);
    F.G = gridDim.x; F.NGW = F.G * NWAVES;
    F.ws = args.ws; F.ctl = (gu32*)(args.ws + WS_CTL);
    for (int u = threadIdx.x; u < (LDS_BYTES - LDSCTL_OFF) / 4; u += NWAVES * 64) ((LAS unsigned*)(F.lds + LDSCTL_OFF))[u] = 0u;
    __syncthreads();
    XcdBarrier bar; bar.bar = (unsigned*)(F.ctl + CW_BAR); bar.x = 0; bar.st = nullptr;
    if (!MK_SPLIT) bar = xcd_barrier_post((unsigned*)(F.ctl + CW_BAR), F.MISC + 8);
#define GRID_BAR() do { if (!MK_SPLIT) { XcdBarrier b2_ = bar; GAS unsigned* bp_ = (GAS unsigned*)bar.bar; asm volatile("" : "+s"(bp_), "+s"(b2_.x)); b2_.bar = (unsigned*)bp_; xcd_barrier(b2_); } } while (0)
    const int lo = args.ph_lo, hi = args.ph_hi;
#define IN(k) (lo <= (k) && (k) < hi)
#define BOTH(k) (IN(k) && IN((k) + 1))

#define NREP(k) ((PROBE_DUP == (k)) ? 2 : 1)
#define REPLOOP(k) _Pragma("unroll 1") for (int rep = NREP(k) - 1; rep >= 0; --rep)
#define REPBAR() do { if (rep) GRID_BAR(); } while (0)
    if (IN(0)) { REPLOOP(9) { p0_prologue(F); REPBAR(); } if (BOTH(0)) GRID_BAR(); }
#pragma unroll 1
    for (int L = 0; L < DEPTH; ++L) {
        const int pb = 1 + L * PH_PER_LAYER;
        if (IN(pb + 0)) { REPLOOP(2) {
            GAS unsigned char* ws = ws_opaque(F);
            typedef pg8::Gemm<M, NPROJ, DM> GT; typedef pg8::StaticOrder<M, NPROJ> ST; GT g{(const bf16*)OUTP(), (const bf16*)(ws + WS_WIN) + (size_t)L * NPROJ * DM}; ST S; S.init(F.G, (int)blockIdx.x);
            typedef pg8::EpiProj<NPROJ, DM, C_DQ / 256, C_DK / 256, C_DV / 256> ET; ET E{(bf16*)(ws + WS_PROJ), (const float*)(ws + WS_BIAS) + L * NPROJ, (const float*)(ws + WS_SS) + (size_t)(2 * L) * M * 8, NORM_EPS,
                INP(float, I_QNW) + L * 128, INP(float, I_KNW) + L * 128, (const float*)(ws + WS_COS), (const float*)(ws + WS_SIN), (LAS float*)(F.lds + RED_OFF)};
            pg8::gemm_phase<ET, ST, GT, true, true>(F.lds + RING_OFF, g, S, E); REPBAR(); }
            if (BOTH(pb + 0)) GRID_BAR();
        }
        if (IN(pb + 1)) {
            REPLOOP(3) { mixer_phase(F, L + 2 * rep, L, (char*)lds + RING_OFF); REPBAR(); }
            if (BOTH(pb + 1)) GRID_BAR(); }
        if (IN(pb + 2)) { REPLOOP(4) { combine_phase(F, L); REPBAR(); } if (BOTH(pb + 2)) GRID_BAR(); }
        if (IN(pb + 3)) { REPLOOP(5) {
            GAS unsigned char* ws = ws_opaque(F);
            typedef pg8::Gemm<M, DM, DM> GT; typedef pg8::StaticOrder<M, DM> ST; GT g{(const bf16*)(ws + WS_XN), (const bf16*)(ws + WS_WOUT) + (size_t)L * DM * DM}; ST S; S.init(F.G, (int)blockIdx.x);
            typedef pg8::EpiRes<DM, false> ET; ET E{(const bf16*)OUTP(), nullptr, (bf16*)(ws + (rep ? WS_HID : WS_XB2)), (float*)(ws + WS_SS) + (size_t)(rep ? 4 : 2 * L + 1) * M * 8, (LAS float*)(F.lds + RED_OFF)};
            pg8::gemm_phase<ET, ST, GT, true, true>(F.lds + RING_OFF, g, S, E); REPBAR(); }
            if (BOTH(pb + 3)) GRID_BAR();
        }
        if (IN(pb + 4)) { REPLOOP(7) {
            GAS unsigned char* ws = ws_opaque(F);
            typedef pg8::Gemm<M, DFF, DM> GT; typedef pg8::StaticOrder<M, DFF> ST; GT g{(const bf16*)(ws + WS_XB2), (const bf16*)(ws + WS_WUP) + (size_t)L * DFF * DM}; ST S; S.init(F.G, (int)blockIdx.x);
            typedef pg8::EpiBf16<2, DFF, DM> ET; ET E{(bf16*)(ws + WS_HID), nullptr, (const float*)(ws + WS_SS) + (size_t)(2 * L + 1) * M * 8, NORM_EPS};
            pg8::gemm_phase<ET, ST, GT, true, true>(F.lds + RING_OFF, g, S, E); REPBAR(); }
            if (BOTH(pb + 4)) GRID_BAR();
        }
        if (IN(pb + 5)) {
            GAS unsigned char* ws = ws_opaque(F);
            typedef pg8::Gemm<M, DM, DFF> GT; typedef pg8::StaticOrder<M, DM> ST; GT g{(const bf16*)(ws + WS_HID), (const bf16*)(ws + WS_WDN) + (size_t)L * DM * DFF}; ST S; S.init(F.G, (int)blockIdx.x);
            if (L + 1 < DEPTH) { typedef pg8::EpiRes<DM, false> ET; ET E{(const bf16*)(ws + WS_XB2), nullptr, (bf16*)OUTP(), (float*)(ws + WS_SS) + (size_t)(2 * L + 2) * M * 8, (LAS float*)(F.lds + RED_OFF)};
                pg8::gemm_phase<ET, ST, GT, true, true>(F.lds + RING_OFF, g, S, E); }
            else { typedef pg8::EpiRes<DM, true> ET; ET E{(const bf16*)(ws + WS_XB2), OUTP(), nullptr, nullptr, nullptr};
                pg8::gemm_phase<ET, ST, GT, true, true>(F.lds + RING_OFF, g, S, E); }
            if (BOTH(pb + 5)) GRID_BAR();
        }
    }
#undef IN
#undef BOTH
}

extern "C" void kernel_launch(void* const* d_in, const int* in_sizes, int n_in, void* d_out, int out_size, void* d_ws, size_t ws_size, hipStream_t stream) {
    static int grid = 0;
    if (grid == 0) {
        if (n_in != 18 || in_sizes[0] != M * DM || out_size != M * DM || ws_size < WS_END) { fprintf(stderr, "kernel_launch: built for 18 inputs, x/out of %d floats, >= %zu bytes of workspace; got n_in %d, in0 %d, out %d, ws %zu; nothing launched\n", M * DM, (size_t)WS_END, n_in, n_in > 0 ? in_sizes[0] : -1, out_size, ws_size); grid = -1; return; }
        int dev = 0, cus = 0, per_cu = 0;
        if (hipGetDevice(&dev) != hipSuccess || hipDeviceGetAttribute(&cus, hipDeviceAttributeMultiprocessorCount, dev) != hipSuccess) { fprintf(stderr, "kernel_launch: hipGetDevice / hipDeviceGetAttribute failed; nothing launched\n"); grid = -1; return; }
        if (hipFuncSetAttribute((const void*)fwd, hipFuncAttributeMaxDynamicSharedMemorySize, LDS_BYTES) != hipSuccess) { fprintf(stderr, "kernel_launch: hipFuncSetAttribute failed\n"); grid = -1; return; }
        if (hipOccupancyMaxActiveBlocksPerMultiprocessor(&per_cu, (const void*)fwd, NWAVES * 64, LDS_BYTES) != hipSuccess || per_cu < 1) fprintf(stderr, "kernel_launch: note: occupancy query reports %d workgroups per CU\n", per_cu);
        (void)hipGetLastError();
        grid = cus;
    }
    if (grid < 0) return;
    if (hipMemsetAsync((char*)d_ws + WS_CTL, 0, CTL_ZERO_BYTES, stream) != hipSuccess) { fprintf(stderr, "kernel_launch: hipMemsetAsync failed; nothing launched\n"); return; }
    Args a{};
    for (int i = 0; i < 18; ++i) a.in[i] = d_in[i];
    a.out = (float*)d_out; a.ws = (unsigned char*)d_ws;
#if MK_SPLIT
    for (int p = 0; p < N_PHASES; ++p) { a.ph_lo = p; a.ph_hi = p + 1; hipLaunchKernelGGL(fwd, dim3(grid), dim3(NWAVES * 64), LDS_BYTES, stream, a); }
#else
    a.ph_lo = 0; a.ph_hi = N_PHASES; hipLaunchKernelGGL(fwd, dim3(grid), dim3(NWAVES * 64), LDS_BYTES, stream, a);
#endif
    const hipError_t le = hipPeekAtLastError();
    if (le != hipSuccess) fprintf(stderr, "kernel_launch: launch failed: %s\n", hipGetErrorName(le));
}
```

```cpp
#include <hip/hip_runtime.h>
#include <hip/hip_bf16.h>
#include <cstdio>
#include <cstdint>
#include <cmath>
namespace pg8 {
#define PG8_LAS __attribute__((address_space(3)))
typedef unsigned short bf16_t;
typedef short bf16x8 __attribute__((ext_vector_type(8)));
typedef float f32x4 __attribute__((ext_vector_type(4)));
typedef unsigned u32x4 __attribute__((ext_vector_type(4)));
constexpr int BM = 256, BK = 64, HALF = 128, HTB = HALF * BK * 2  , STAGE_BYTES = 8 * HTB, NXCD = 8, WGM = 4;

__host__ __device__ __forceinline__ int lds_byte(int r, int c) { const int st = (r >> 4) * 2 + (c >> 5), rr = r & 15, cc = c & 31, ob = rr * 64 + cc * 2; return st * 1024 + (ob ^ (((ob >> 9) & 1) << 5)); }
__host__ __device__ __forceinline__ void stage_rc(int b, int& R, int& C) { const int st = b / 1024, sb = b % 1024, swz = sb ^ (((sb >> 9) & 1) << 5); R = (st >> 1) * 16 + swz / 64; C = (st & 1) * 32 + (swz % 64) / 2; }
__host__ __device__ __forceinline__ int perm32(int rho) { const int n = rho >> 4, i = rho & 15; return 8 * (i >> 2) + 4 * n + (i & 3); }

struct Unit { int pm, pn; };
template <int M_, int N_, int K_, bool A_TILED_ = false> struct Gemm { const bf16_t* A; const bf16_t* Bt; static constexpr int M = M_, N = N_, K = K_; static constexpr bool A_TILED = A_TILED_; };

template <int M_, int N_, int WGM_ = WGM, bool REV_ = false, int GAP_AT_ = 1 << 30, int GAP_N_ = 0> struct StaticOrder {
    static constexpr int WGM = WGM_, RT_SHIFT = (WGM_ == 2) ? 1 : (WGM_ == 4) ? 2 : (WGM_ == 8) ? 3 : 4, RT_SLOTS = (16 / WGM_) < 1 ? 1 : (16 / WGM_);
    static constexpr int nM = M_ / BM, nN = N_ / BM, nwg = nM * nN;
    int G, c;
    __host__ __device__ void init(int G_, int c_) { G = G_; c = c_; }
    __host__ __device__ bool next(int i, Unit& u) const {
        const int nr = nwg / G; const bool rev = REV_ && (nwg % G) == 0; if (rev && i >= nr) return false;
        const long L = (long)(rev ? nr - 1 - i : i) * G + c; if (L >= nwg) return false;
        int wgid = (int)L; { constexpr int q = nwg / NXCD, r = nwg % NXCD; const int xcd = wgid % NXCD, off = wgid / NXCD; wgid = (xcd < r ? xcd * (q + 1) : r * (q + 1) + (xcd - r) * q) + off; }
        constexpr int nig = WGM * nN; const int gid = wgid / nig, fm = gid * WGM, gsz = (nM - fm) < WGM ? (nM - fm) : WGM;
        u.pm = fm + ((wgid % nig) % gsz); u.pn = (wgid % nig) / gsz; if (u.pn >= GAP_AT_) u.pn += GAP_N_; return true;
    }
    __device__ __forceinline__ void a_ready(const Unit&) const {}
    __device__ __forceinline__ void done(const Unit&) const {}
};
__device__ __forceinline__ unsigned cvt_pk_bf16(float lo, float hi) { unsigned r; asm volatile("v_cvt_pk_bf16_f32 %0, %1, %2" : "=v"(r) : "v"(lo), "v"(hi)); return r; }
typedef float f32x2 __attribute__((ext_vector_type(2)));
#ifndef PG8_NT_STORE
#define PG8_NT_STORE 0
#endif
__device__ __forceinline__ float sum_fq(float s) {
    { auto r = __builtin_amdgcn_permlane16_swap(__float_as_uint(s), __float_as_uint(s), false, false); s = __uint_as_float(r[0]) + __uint_as_float(r[1]); }
    { auto r = __builtin_amdgcn_permlane32_swap(__float_as_uint(s), __float_as_uint(s), false, false); s = __uint_as_float(r[0]) + __uint_as_float(r[1]); }
    return s; }
__device__ __forceinline__ float h2f_lo(unsigned u) { return (float)__builtin_bit_cast(_Float16, (unsigned short)(u & 0xffffu)); }
__device__ __forceinline__ float h2f_hi(unsigned u) { return (float)__builtin_bit_cast(_Float16, (unsigned short)(u >> 16)); }
__device__ __forceinline__ void st16(bf16_t* p, u32x4 w) { if (PG8_NT_STORE) __builtin_nontemporal_store(w, (u32x4*)p); else *(u32x4*)p = w; }
template <int ACT, int ldc, int KN, int RT_SHIFT, int RT_SLOTS, bool OTILED = false> struct EpiBf16 {
    static constexpr bool PERM = true, AFTER_DRAIN = false;
    bf16_t* O; const float* bias; const PG8_LAS float* rt; const float* ss;
    __device__ __forceinline__ void operator()(const f32x4 (&acc)[2][2][4][2], const Unit& u, int wr, int wc, int fr, int fq) const {
        const int row0 = u.pm * BM + wr * 64 + fr; const int col0 = u.pn * BM + wc * 32 + 8 * fq;
        f32x4 bv[2][2];
#pragma unroll
        for (int bj = 0; bj < 2; ++bj)
#pragma unroll
            for (int n = 0; n < 2; ++n) bv[bj][n] = bias ? *(const f32x4*)(bias + col0 + bj * HALF + 4 * n) : (f32x4){0.f, 0.f, 0.f, 0.f};
        float rs[2][4];
#pragma unroll
        for (int ai = 0; ai < 2; ++ai)
#pragma unroll
            for (int m = 0; m < 4; ++m) rs[ai][m] = rt[((u.pm >> RT_SHIFT) & (RT_SLOTS - 1)) * BM + wr * 64 + fr + ai * HALF + m * 16];
        if (((const PG8_LAS int*)(rt + RT_SLOTS * BM))[(u.pm >> RT_SHIFT) & (RT_SLOTS - 1)] != u.pm) {
#pragma unroll
            for (int ai = 0; ai < 2; ++ai)
#pragma unroll
                for (int m = 0; m < 4; ++m) rs[ai][m] = __builtin_nanf("");
        }
#pragma unroll
        for (int ai = 0; ai < 2; ++ai)
#pragma unroll
            for (int m = 0; m < 4; ++m) { bf16_t* rowp = OTILED ? O + ((size_t)(u.pm * (ldc / 64) + u.pn * 4 + (wc >> 1)) * (BM * 64) + (wr * 64 + fr + ai * HALF + m * 16) * 64 + (wc & 1) * 32 + 8 * fq)
                                                                : O + (size_t)(row0 + ai * HALF + m * 16) * ldc + col0;
                const float rstd = rs[ai][m];
#pragma unroll
                for (int bj = 0; bj < 2; ++bj) { f32x4 v0 = acc[ai][bj][m][0] * rstd + bv[bj][0], v1 = acc[ai][bj][m][1] * rstd + bv[bj][1];
                    if (ACT == 2) {
#pragma unroll
                        for (int e = 0; e < 4; ++e) { const float a = fmaxf(v0[e], 0.f), b = fmaxf(v1[e], 0.f); v0[e] = a * a; v1[e] = b * b; } }
                    u32x4 w; w.x = cvt_pk_bf16(v0[0], v0[1]); w.y = cvt_pk_bf16(v0[2], v0[3]); w.z = cvt_pk_bf16(v1[0], v1[1]); w.w = cvt_pk_bf16(v1[2], v1[3]);
                    st16(rowp + (OTILED ? bj * 2 * (BM * 64) : bj * HALF), w); } }
    }
};
template <int ldc, int KN, int PNB, int PNQ, int PNK, int PNV, int RT_SHIFT, int RT_SLOTS> struct EpiProj {
    static constexpr bool PERM = true, AFTER_DRAIN = false;
    bf16_t* O; const float* bias; const PG8_LAS float* rt; const float* ss; const float* qw; const float* kw; const unsigned* rope; PG8_LAS float* red;
    __device__ __forceinline__ void operator()(const f32x4 (&acc)[2][2][4][2], const Unit& u, int wr, int wc, int fr, int fq) const {
        const int row0 = u.pm * BM + wr * 64 + fr; const int col0 = u.pn * BM + wc * 32 + 8 * fq;
        float rs[2][4];
#pragma unroll
        for (int ai = 0; ai < 2; ++ai)
#pragma unroll
            for (int m = 0; m < 4; ++m) rs[ai][m] = rt[((u.pm >> RT_SHIFT) & (RT_SLOTS - 1)) * BM + wr * 64 + fr + ai * HALF + m * 16];
        if (((const PG8_LAS int*)(rt + RT_SLOTS * BM))[(u.pm >> RT_SHIFT) & (RT_SLOTS - 1)] != u.pm) {
#pragma unroll
            for (int ai = 0; ai < 2; ++ai)
#pragma unroll
                for (int m = 0; m < 4; ++m) rs[ai][m] = __builtin_nanf("");
        }
        if (u.pn < PNQ || u.pn >= PNV) {
            f32x4 bv[2][2];
#pragma unroll
            for (int bj = 0; bj < 2; ++bj)
#pragma unroll
                for (int n = 0; n < 2; ++n) bv[bj][n] = (f32x4){0.f, 0.f, 0.f, 0.f};
            if (u.pn >= PNB && u.pn < PNQ) {
#pragma unroll
                for (int bj = 0; bj < 2; ++bj)
#pragma unroll
                    for (int n = 0; n < 2; ++n) bv[bj][n] = *(const f32x4*)(bias + col0 + bj * HALF + 4 * n); }
            asm volatile("" ::: "memory");
#pragma unroll
            for (int ai = 0; ai < 2; ++ai)
#pragma unroll
                for (int m = 0; m < 4; ++m) { bf16_t* rowp = O + (size_t)(row0 + ai * HALF + m * 16) * ldc + col0; const float rstd = rs[ai][m];
#pragma unroll
                    for (int bj = 0; bj < 2; ++bj) { const f32x4 v0 = acc[ai][bj][m][0] * rstd + bv[bj][0], v1 = acc[ai][bj][m][1] * rstd + bv[bj][1];
                        u32x4 w; w.x = cvt_pk_bf16(v0[0], v0[1]); w.y = cvt_pk_bf16(v0[2], v0[3]); w.z = cvt_pk_bf16(v1[0], v1[1]); w.w = cvt_pk_bf16(v1[2], v1[3]);
                        st16(rowp + bj * HALF, w); } }
        } else {
            const float* w = (u.pn < PNK) ? qw : kw; const int i0 = 16 * wc + 4 * fq;
            const f32x4 wlo = *(const f32x4*)(w + i0), whi = *(const f32x4*)(w + 64 + i0);
            u32x4 cs[2][4];
#pragma unroll
            for (int ai = 0; ai < 2; ++ai)
#pragma unroll
                for (int m = 0; m < 4; ++m)
#pragma unroll
                    for (int bj = 0; bj < 2; ++bj) { const f32x4 v0 = acc[ai][bj][m][0] * rs[ai][m], v1 = acc[ai][bj][m][1] * rs[ai][m]; const f32x4 q = v0 * v0 + v1 * v1; float s = (q[0] + q[1]) + (q[2] + q[3]);
                        s = sum_fq(s);
                        if (fq == 0) red[((wr * 64 + fr + ai * HALF + m * 16) * 2 + bj) * 4 + wc] = s; }
            asm volatile("s_waitcnt lgkmcnt(0)" ::: "memory"); __builtin_amdgcn_s_barrier(); asm volatile("" ::: "memory");
#pragma unroll
            for (int ai = 0; ai < 2; ++ai)
#pragma unroll
                for (int m = 0; m < 4; ++m) cs[ai][m] = *(const u32x4*)(rope + (size_t)(row0 + ai * HALF + m * 16) * 64 + i0);
#pragma unroll
            for (int ai = 0; ai < 2; ++ai) {
#pragma unroll
                for (int m = 0; m < 4; ++m) { bf16_t* rowp = O + (size_t)(row0 + ai * HALF + m * 16) * ldc + col0; const u32x4 t = cs[ai][m]; const f32x4 cc = {h2f_lo(t.x), h2f_lo(t.y), h2f_lo(t.z), h2f_lo(t.w)}, sn = {h2f_hi(t.x), h2f_hi(t.y), h2f_hi(t.z), h2f_hi(t.w)};
#pragma unroll
                    for (int bj = 0; bj < 2; ++bj) { const f32x4 p = *(const PG8_LAS f32x4*)(red + ((wr * 64 + fr + ai * HALF + m * 16) * 2 + bj) * 4);
                        const float rh = rs[ai][m] * __builtin_amdgcn_rsqf(((p[0] + p[1]) + (p[2] + p[3])) * (1.0f / 128.0f) + 1e-6f);
                        const f32x4 v0 = acc[ai][bj][m][0] * rh, v1 = acc[ai][bj][m][1] * rh;
                        const float a0 = v0[0] * wlo[0], b0 = v0[1] * whi[0], a1 = v0[2] * wlo[1], b1 = v0[3] * whi[1], a2 = v1[0] * wlo[2], b2 = v1[1] * whi[2], a3 = v1[2] * wlo[3], b3 = v1[3] * whi[3];
                        u32x4 o; o.x = cvt_pk_bf16(a0 * cc[0] - b0 * sn[0], a0 * sn[0] + b0 * cc[0]); o.y = cvt_pk_bf16(a1 * cc[1] - b1 * sn[1], a1 * sn[1] + b1 * cc[1]);
                        o.z = cvt_pk_bf16(a2 * cc[2] - b2 * sn[2], a2 * sn[2] + b2 * cc[2]); o.w = cvt_pk_bf16(a3 * cc[3] - b3 * sn[3], a3 * sn[3] + b3 * cc[3]);
                        st16(rowp + bj * HALF, o); } }
                asm volatile("" ::: "memory");
            }
        }
    }
};
template <int ldc, bool FINAL> struct EpiRes {
    static constexpr bool PERM = true, AFTER_DRAIN = false;
    const bf16_t* base; float* out; bf16_t* xb; float* ss; PG8_LAS float* red;
    __device__ __forceinline__ void operator()(const f32x4 (&acc)[2][2][4][2], const Unit& u, int wr, int wc, int fr, int fq) const {
        const int row0 = u.pm * BM + wr * 64 + fr; const int col0 = u.pn * BM + wc * 32 + 8 * fq;
        u32x4 bq[2][4][2];
#pragma unroll
        for (int ai = 0; ai < 2; ++ai)
#pragma unroll
            for (int m = 0; m < 4; ++m) { const size_t off = (size_t)(row0 + ai * HALF + m * 16) * ldc + col0; bq[ai][m][0] = *(const u32x4*)(base + off); bq[ai][m][1] = *(const u32x4*)(base + off + HALF); }
        asm volatile("" ::: "memory");
#pragma unroll
        for (int ai = 0; ai < 2; ++ai)
#pragma unroll
            for (int m = 0; m < 4; ++m) { const size_t off = (size_t)(row0 + ai * HALF + m * 16) * ldc + col0;
                f32x4 x[2][2];
#pragma unroll
                for (int bj = 0; bj < 2; ++bj) { const u32x4 b = bq[ai][m][bj];
                    x[bj][0] = (f32x4){__uint_as_float(b.x << 16), __uint_as_float(b.x & 0xffff0000u), __uint_as_float(b.y << 16), __uint_as_float(b.y & 0xffff0000u)} + acc[ai][bj][m][0];
                    x[bj][1] = (f32x4){__uint_as_float(b.z << 16), __uint_as_float(b.z & 0xffff0000u), __uint_as_float(b.w << 16), __uint_as_float(b.w & 0xffff0000u)} + acc[ai][bj][m][1]; }
                if constexpr (FINAL) {
                    *(f32x4*)(out + off) = x[0][0]; *(f32x4*)(out + off + 4) = x[0][1]; *(f32x4*)(out + off + HALF) = x[1][0]; *(f32x4*)(out + off + HALF + 4) = x[1][1];
                } else {
                    u32x4 w0, w1; w0.x = cvt_pk_bf16(x[0][0][0], x[0][0][1]); w0.y = cvt_pk_bf16(x[0][0][2], x[0][0][3]); w0.z = cvt_pk_bf16(x[0][1][0], x[0][1][1]); w0.w = cvt_pk_bf16(x[0][1][2], x[0][1][3]);
                    w1.x = cvt_pk_bf16(x[1][0][0], x[1][0][1]); w1.y = cvt_pk_bf16(x[1][0][2], x[1][0][3]); w1.z = cvt_pk_bf16(x[1][1][0], x[1][1][1]); w1.w = cvt_pk_bf16(x[1][1][2], x[1][1][3]);
                    *(u32x4*)(xb + off) = w0; *(u32x4*)(xb + off + HALF) = w1;
                    const f32x4 q = x[0][0] * x[0][0] + x[0][1] * x[0][1] + x[1][0] * x[1][0] + x[1][1] * x[1][1]; float s = (q[0] + q[1]) + (q[2] + q[3]);
                    s = sum_fq(s);
                    if (fq == 0) red[(wr * 64 + fr + ai * HALF + m * 16) * 4 + wc] = s; } }
        if constexpr (!FINAL) {
            asm volatile("s_waitcnt lgkmcnt(0)" ::: "memory"); __builtin_amdgcn_s_barrier(); asm volatile("" ::: "memory");
            const int t = threadIdx.x;
            if (t < BM) { const f32x4 p = *(const PG8_LAS f32x4*)(red + t * 4); ss[(size_t)(u.pm * BM + t) * 8 + u.pn] = (p[0] + p[1]) + (p[2] + p[3]); }
        }
    }
};
template <class Epi, class Sched, class GemmT, bool ALIGN_EPI = false, bool SP2 = false>
__device__ __forceinline__ void gemm_phase(PG8_LAS unsigned char* lds, const GemmT g, const Sched& S, const Epi& E) {
    int tid_ = threadIdx.x; asm volatile("" : "+v"(tid_));
    const int tid = tid_, wid = __builtin_amdgcn_readfirstlane(tid >> 6), lane = tid & 63, wr = wid >> 2, wc = wid & 3, fr = lane & 15, fq = lane >> 4;
    constexpr int K = GemmT::K, nt = K / BK;
    unsigned voffA[2], voffB[2];
#pragma unroll
    for (int i = 0; i < 2; ++i) { int R, C; stage_rc(tid * 16 + i * 8192, R, C); const int Rb = Epi::PERM ? ((R & ~31) + perm32(R & 31)) : R;
        voffA[i] = GemmT::A_TILED ? (unsigned)(R * BK + C) * 2u : (unsigned)(R * K + C) * 2u; voffB[i] = (unsigned)(Rb * K + C) * 2u; }
    constexpr size_t kstep = (size_t)(BK * 2);
    constexpr size_t hstep = (size_t)HALF * K * 2;
    constexpr size_t tstep = 2 * hstep;
    constexpr size_t kstepA = GemmT::A_TILED ? (size_t)BM * BK * 2 : kstep, hstepA = GemmT::A_TILED ? (size_t)HALF * BK * 2 : hstep, tstepA = tstep;
    const unsigned ldsw = (unsigned)wid * 1024u;
    const int aoff = lds_byte(wr * 64 + fr, fq * 8), boff = lds_byte(wc * 32 + fr, fq * 8);
#define PG8_SA(b, h) (((b) * 2 + (h)) * HTB)
#define PG8_SB(b, h) ((4 + (b) * 2 + (h)) * HTB)
#define PG8_STAGE(bufoff, gbase, voff) do { const char* gb_ = (const char*)(gbase); asm volatile("" : "+s"(gb_)); _Pragma("unroll") for (int _i = 0; _i < 2; ++_i) \
        __builtin_amdgcn_global_load_lds((const unsigned*)(gb_ + (voff)[_i]), (PG8_LAS unsigned*)(lds + (bufoff) + ldsw + _i * 8192), 16, 0, 0); } while (0)
#define PG8_VOFFS() asm volatile("" : "+v"(voffA[0]), "+v"(voffA[1]), "+v"(voffB[0]), "+v"(voffB[1]))
#define PG8_LDA(dst, b, h) do { _Pragma("unroll") for (int m = 0; m < 4; ++m) _Pragma("unroll") for (int k = 0; k < 2; ++k) dst[m][k] = *(const PG8_LAS bf16x8*)(lds + PG8_SA(b, h) + aoff + m * 2048 + k * 1024); } while (0)
#define PG8_LDB(dst, b, h) do { _Pragma("unroll") for (int n = 0; n < 2; ++n) _Pragma("unroll") for (int k = 0; k < 2; ++k) dst[n][k] = *(const PG8_LAS bf16x8*)(ldsB_ + ((b) * 2 + (h)) * HTB + n * 2048 + k * 1024); } while (0)
#define PG8_MMA(ai, bj, At, Bt) do { __builtin_amdgcn_s_setprio(1); _Pragma("unroll") for (int m = 0; m < 4; ++m) _Pragma("unroll") for (int n = 0; n < 2; ++n) _Pragma("unroll") for (int k = 0; k < 2; ++k) \
        acc[ai][bj][m][n] = __builtin_amdgcn_mfma_f32_16x16x32_bf16(Bt[n][k], At[m][k], acc[ai][bj][m][n], 0, 0, 0); __builtin_amdgcn_s_setprio(0); } while (0)
#define PG8_WAIT_V(n) asm volatile("s_waitcnt vmcnt(" #n ")" ::: "memory")
#define PG8_WAIT_L(n) asm volatile("s_waitcnt lgkmcnt(" #n ")" ::: "memory")
#define PG8_BAR __builtin_amdgcn_s_barrier()
#define PG8_SCHED __builtin_amdgcn_sched_barrier(0)
    PG8_LAS unsigned char* ldsB_ = lds + 4 * HTB + boff; asm volatile("" : "+v"(ldsB_));
    Unit cur, nxt; int ui = 0;
    if (!S.next(0, cur)) return;
    f32x4 acc[2][2][4][2];
#pragma unroll
    for (int a = 0; a < 2; ++a)
#pragma unroll
        for (int b = 0; b < 2; ++b)
#pragma unroll
            for (int m = 0; m < 4; ++m)
#pragma unroll
                for (int n = 0; n < 2; ++n) acc[a][b][m][n] = (f32x4){0.f, 0.f, 0.f, 0.f};
    bf16x8 At[4][2], B0[2][2], B1[2][2];
    const char* cA = (const char*)g.A + (size_t)cur.pm * tstepA; const char* cB = (const char*)g.Bt + (size_t)cur.pn * tstep;
    S.a_ready(cur);
    { PG8_VOFFS();
    if constexpr (SP2) {
        PG8_STAGE(PG8_SB(0, 0), cB, voffB); PG8_STAGE(PG8_SB(0, 1), cB + hstep, voffB); PG8_STAGE(PG8_SA(0, 0), cA, voffA); PG8_STAGE(PG8_SA(0, 1), cA + hstepA, voffA);
        if (wr == 1) PG8_BAR;
        PG8_WAIT_V(2); PG8_BAR;
        PG8_STAGE(PG8_SB(1, 0), cB + kstep, voffB); PG8_STAGE(PG8_SA(1, 0), cA + kstepA, voffA); PG8_STAGE(PG8_SB(1, 1), cB + hstep + kstep, voffB);
        PG8_WAIT_V(6); PG8_BAR;
    } else {
        PG8_STAGE(PG8_SB(0, 0), cB, voffB); PG8_STAGE(PG8_SA(0, 0), cA, voffA); PG8_STAGE(PG8_SB(0, 1), cB + hstep, voffB); PG8_STAGE(PG8_SA(0, 1), cA + hstepA, voffA);
        if (wr == 1) PG8_BAR;
        PG8_WAIT_V(4); PG8_BAR;
        PG8_STAGE(PG8_SB(1, 0), cB + kstep, voffB); PG8_STAGE(PG8_SA(1, 0), cA + kstepA, voffA); PG8_STAGE(PG8_SB(1, 1), cB + hstep + kstep, voffB);
        PG8_WAIT_V(6); PG8_BAR;
    }
    }
    for (;;) {
        const bool has_next = S.next(ui + 1, nxt);
        const char* nA = has_next ? (const char*)g.A + (size_t)nxt.pm * tstepA : cA; const char* nB = has_next ? (const char*)g.Bt + (size_t)nxt.pn * tstep : cB;
        for (int t = 0; t < nt; t += 2) {
            const bool last = (t == nt - 2);
            PG8_VOFFS();
            const char* a1 = cA + (size_t)(t + 1) * kstepA;
            const char* a2 = last ? nA : cA + (size_t)(t + 2) * kstepA; const char* b2 = last ? nB : cB + (size_t)(t + 2) * kstep;
            const char* a3 = a2 + kstepA; const char* b3 = b2 + kstep;
            if (last && has_next) S.a_ready(nxt);
            if constexpr (SP2) {
            PG8_LDB(B0, 0, 0); PG8_LDB(B1, 0, 1); PG8_SCHED; PG8_LDA(At, 0, 0); PG8_STAGE(PG8_SA(1, 1), a1 + hstepA, voffA);
            PG8_WAIT_V(8); PG8_WAIT_L(0); PG8_BAR; PG8_MMA(0, 0, At, B0); PG8_MMA(0, 1, At, B1); PG8_BAR; PG8_SCHED;
            PG8_LDA(At, 0, 1); PG8_STAGE(PG8_SB(0, 0), b2, voffB); PG8_STAGE(PG8_SB(0, 1), b2 + hstep, voffB); PG8_STAGE(PG8_SA(0, 0), a2, voffA);
            PG8_WAIT_V(8); PG8_WAIT_L(0); PG8_BAR; PG8_MMA(1, 0, At, B0); PG8_MMA(1, 1, At, B1); PG8_BAR; PG8_SCHED;
            PG8_LDB(B0, 1, 0); PG8_LDB(B1, 1, 1); PG8_SCHED; PG8_LDA(At, 1, 0); PG8_STAGE(PG8_SA(0, 1), a2 + hstepA, voffA);
            PG8_WAIT_V(8); PG8_WAIT_L(0); PG8_BAR; PG8_MMA(0, 0, At, B0); PG8_MMA(0, 1, At, B1); PG8_BAR; PG8_SCHED;
            PG8_LDA(At, 1, 1); PG8_STAGE(PG8_SB(1, 0), b3, voffB); PG8_STAGE(PG8_SB(1, 1), b3 + hstep, voffB); PG8_STAGE(PG8_SA(1, 0), a3, voffA);
            PG8_WAIT_V(8); PG8_WAIT_L(0); PG8_BAR; PG8_MMA(1, 0, At, B0); PG8_MMA(1, 1, At, B1); PG8_BAR; PG8_SCHED;
            } else {
            PG8_LDB(B0, 0, 0); PG8_SCHED; PG8_LDA(At, 0, 0); PG8_STAGE(PG8_SA(1, 1), a1 + hstepA, voffA);
            PG8_WAIT_L(8); PG8_BAR; PG8_WAIT_L(0); PG8_MMA(0, 0, At, B0); PG8_BAR; PG8_SCHED;
            PG8_LDB(B1, 0, 1); PG8_STAGE(PG8_SB(0, 0), b2, voffB);
            PG8_BAR; PG8_WAIT_L(0); PG8_MMA(0, 1, At, B1); PG8_BAR;
            PG8_LDA(At, 0, 1); PG8_STAGE(PG8_SA(0, 0), a2, voffA);
            PG8_BAR; PG8_WAIT_L(0); PG8_MMA(1, 0, At, B0); PG8_BAR; PG8_SCHED;
            PG8_STAGE(PG8_SB(0, 1), b2 + hstep, voffB);
            PG8_WAIT_V(6); PG8_BAR; PG8_MMA(1, 1, At, B1); PG8_BAR;
            PG8_LDB(B0, 1, 0); PG8_SCHED; PG8_LDA(At, 1, 0); PG8_STAGE(PG8_SA(0, 1), a2 + hstepA, voffA);
            PG8_WAIT_L(8); PG8_BAR; PG8_WAIT_L(0); PG8_MMA(0, 0, At, B0); PG8_BAR; PG8_SCHED;
            PG8_LDB(B1, 1, 1); PG8_STAGE(PG8_SB(1, 0), b3, voffB);
            PG8_BAR; PG8_WAIT_L(0); PG8_MMA(0, 1, At, B1); PG8_BAR;
            PG8_LDA(At, 1, 1); PG8_STAGE(PG8_SA(1, 0), a3, voffA);
            PG8_BAR; PG8_WAIT_L(0); PG8_MMA(1, 0, At, B0); PG8_BAR; PG8_SCHED;
            PG8_STAGE(PG8_SB(1, 1), b3 + hstep, voffB);
            PG8_WAIT_V(6); PG8_BAR; PG8_MMA(1, 1, At, B1); PG8_BAR;
            }
        }
        if constexpr (ALIGN_EPI) { if (wr == 0) PG8_BAR; }
        if constexpr (!Epi::AFTER_DRAIN) { E(acc, cur, wr, wc, fr, fq); S.done(cur); }
        if (!has_next) break;
#pragma unroll
        for (int a = 0; a < 2; ++a)
#pragma unroll
            for (int b = 0; b < 2; ++b)
#pragma unroll
                for (int m = 0; m < 4; ++m)
#pragma unroll
                    for (int n = 0; n < 2; ++n) acc[a][b][m][n] = (f32x4){0.f, 0.f, 0.f, 0.f};
        cur = nxt; cA = nA; cB = nB; ++ui;
        if constexpr (ALIGN_EPI) { if (wr == 1) PG8_BAR; }
    }
    PG8_WAIT_V(0);
    if constexpr (!ALIGN_EPI) { if (wr == 0) PG8_BAR; }
    PG8_BAR;
    if constexpr (Epi::AFTER_DRAIN) { E.fused(acc, cur, wr, wc, fr, fq, lds, wid, lane); S.done(cur); }
#undef PG8_SA
#undef PG8_SB
#undef PG8_STAGE
#undef PG8_VOFFS
#undef PG8_LDA
#undef PG8_LDB
#undef PG8_MMA
#undef PG8_WAIT_V
#undef PG8_WAIT_L
#undef PG8_BAR
#undef PG8_SCHED
}
}
namespace swa {
constexpr int D = 128;
constexpr int KVPITCH = 6656, QPITCH = 6656, OPITCH = 2048;
constexpr float THR = 8.f;
constexpr bool WSKIP = false;
constexpr float SCALE = 0.08838834764831845f;
constexpr int NW = 8, QBLK = 32, KVBLK = 64, QB = NW * QBLK;
constexpr int SHM_V = KVBLK * D * 2, SHM_K = KVBLK * D * 2;
constexpr int LDS_BYTES = 2 * SHM_V + 2 * SHM_K + NW * 64 * 4;
using bf16 = __hip_bfloat16;
typedef short bf16x8 __attribute__((ext_vector_type(8)));
typedef short s16x4 __attribute__((ext_vector_type(4)));
typedef float f32x16 __attribute__((ext_vector_type(16)));
typedef float f32x4 __attribute__((ext_vector_type(4)));
typedef unsigned u32x4 __attribute__((ext_vector_type(4)));
template <class A, class Bt> struct same_t { static constexpr bool v = false; };
template <class A> struct same_t<A, A> { static constexpr bool v = true; };

#define KSWZ(row, colB) ((row) * 256 + ((colB) ^ (((row) & 7) << 4)))
#define SBAR() __builtin_amdgcn_sched_barrier(0)
__device__ __forceinline__ int v_st(int k, int c) { const int kk = (k & ~0xC) | ((k & 4) << 1) | ((k & 8) >> 1); return ((kk >> 3) * 4 + (c >> 5)) * 512 + ((kk & 7) * 32 + (c & 31)) * 2; }
__device__ __forceinline__ int v_rd_base(int lane) { return ((lane & 3) << 3) | (((lane >> 2) & 3) << 6) | (((lane >> 4) & 1) << 5) | (((lane >> 5) & 1) << 8); }
constexpr int v_rd_off(int d0, int ks, int half) { return d0 * 512 + ks * 4096 + half * 2048; }
__device__ __forceinline__ int crow(int r, int hi) { return (r & 3) + 8 * (r >> 2) + 4 * hi; }
__device__ __forceinline__ unsigned cvtpk(float lo, float hi) {
    unsigned r; asm volatile("v_cvt_pk_bf16_f32 %0, %1, %2" : "=v"(r) : "v"(lo), "v"(hi)); return r;
}
__device__ __forceinline__ bf16x8 pack8(f32x4 a, f32x4 b) {
    u32x4 w = {cvtpk(a[0], a[1]), cvtpk(a[2], a[3]), cvtpk(b[0], b[1]), cvtpk(b[2], b[3])};
    return *reinterpret_cast<bf16x8*>(&w);
}
template <class T> __device__ __forceinline__ bf16x8 load8(const T* p) {
    if constexpr (same_t<T, float>::v) { return pack8(*(const f32x4*)p, *(const f32x4*)(p + 4)); }
    else { return *reinterpret_cast<const bf16x8*>(p); }
}
__device__ __forceinline__ void mask_tile(f32x16& p0, f32x16& p1, int dq, unsigned W) {
    const float NEG = -__builtin_inff();
#pragma unroll
    for (int r = 0; r < 16; ++r) {
        const int c = (r & 3) + 8 * (r >> 2);
        if ((unsigned)(dq - c) >= W) p0[r] = NEG;
        if ((unsigned)(dq - c - 32) >= W) p1[r] = NEG;
    }
}
__device__ __forceinline__ void partialSM(f32x16& p0, f32x16& p1, float& m_reg, float& mn, float& alpha) {
    float pmax = p0[0]; for (int r = 1; r < 16; ++r) pmax = fmaxf(pmax, p0[r]); for (int r = 0; r < 16; ++r) pmax = fmaxf(pmax, p1[r]);
    { auto rr = __builtin_amdgcn_permlane32_swap(__float_as_uint(pmax), __float_as_uint(pmax), false, false);
      pmax = fmaxf(__uint_as_float(rr[0]), __uint_as_float(rr[1])); }
    constexpr float C2 = 1.4426950408889634f * SCALE;
    if (__builtin_expect(__all((pmax - m_reg) * SCALE <= THR), 1)) { mn = m_reg; alpha = 1.f; }
    else { mn = fmaxf(m_reg, pmax); alpha = __builtin_amdgcn_exp2f((m_reg - mn) * C2); m_reg = mn; }
    const float mnL = -mn * C2;
    for (int r = 0; r < 16; ++r) p0[r] = fmaf(p0[r], C2, mnL); for (int r = 0; r < 16; ++r) p1[r] = fmaf(p1[r], C2, mnL);
    for (int r = 0; r < 16; ++r) p0[r] = __builtin_amdgcn_exp2f(p0[r]);
}
__device__ __forceinline__ void finishSM(f32x16& p0, f32x16& p1, float alpha, float& l_reg, bf16x8& pa0, bf16x8& pa1, bf16x8& pa2, bf16x8& pa3) {
    for (int r = 0; r < 16; ++r) p1[r] = __builtin_amdgcn_exp2f(p1[r]);
    float ps = 0; for (int r = 0; r < 16; ++r) ps += p0[r]; for (int r = 0; r < 16; ++r) ps += p1[r];
    { auto rr = __builtin_amdgcn_permlane32_swap(__float_as_uint(ps), __float_as_uint(ps), false, false);
      ps = __uint_as_float(rr[0]) + __uint_as_float(rr[1]); }
    l_reg = l_reg * alpha + ps;
#define PK4(P, B_, OUT) do { unsigned a0 = cvtpk(P[B_+0], P[B_+1]), a1 = cvtpk(P[B_+2], P[B_+3]);                          \
        unsigned b0 = cvtpk(P[B_+4], P[B_+5]), b1 = cvtpk(P[B_+6], P[B_+7]);                                             \
        auto r0 = __builtin_amdgcn_permlane32_swap(a0, b0, false, false); auto r1 = __builtin_amdgcn_permlane32_swap(a1, b1, false, false); \
        u32x4 w = {r0[0], r1[0], r0[1], r1[1]}; OUT = *reinterpret_cast<bf16x8*>(&w); } while (0)
    PK4(p0, 0, pa0); PK4(p0, 8, pa1); PK4(p1, 0, pa2); PK4(p1, 8, pa3);
#undef PK4
}
template <int KB, bool SK>
__device__ __forceinline__ void qkt(f32x16& p0, f32x16& p1, const char* K_lds, int r32, int hi, const bf16x8* qr, bool act) {
    if (SK && !act) { const float NEG = -__builtin_inff();
#pragma unroll
        for (int r = 0; r < 16; ++r) { p0[r] = NEG; p1[r] = NEG; } return; }
    p0 = f32x16{}; p1 = f32x16{};
    const char* kb[4];
#pragma unroll
    for (int dd = 0; dd < 4; ++dd) kb[dd] = K_lds + KB * SHM_K + KSWZ(r32, (dd * 16 + hi * 8) * 2);
#pragma unroll
    for (int d0 = 0; d0 < 8; ++d0) { const char* a = kb[d0 & 3] + (d0 >> 2) * 128;
        bf16x8 b0 = *reinterpret_cast<const bf16x8*>(a);
        bf16x8 b1 = *reinterpret_cast<const bf16x8*>(a + 32 * 256);
        p0 = __builtin_amdgcn_mfma_f32_32x32x16_bf16(b0, qr[d0], p0, 0, 0, 0);
        p1 = __builtin_amdgcn_mfma_f32_32x32x16_bf16(b1, qr[d0], p1, 0, 0, 0); }
}
template <int VB, bool SK>
__device__ __forceinline__ void pv_tile(f32x16* o, int vb0, bf16x8 pa0, bf16x8 pa1, bf16x8 pa2, bf16x8 pa3, bool act) {
    if (SK && !act) return;
#define TRRD(dst, off) asm volatile("ds_read_b64_tr_b16 %0, %1 offset:%2" : "=&v"(dst) : "v"(vb0), "i"(off) : "memory")
#define PV_D0(d0) do { s16x4 l0, l1, l2, l3, h0, h1, h2, h3; constexpr int b_ = VB * SHM_V + v_rd_off(d0, 0, 0);     \
        TRRD(l0, b_); TRRD(h0, b_ + 2048); TRRD(l1, b_ + 4096); TRRD(h1, b_ + 6144); TRRD(l2, b_ + 8192); TRRD(h2, b_ + 10240); TRRD(l3, b_ + 12288); TRRD(h3, b_ + 14336); \
        asm volatile("s_waitcnt lgkmcnt(0)" ::: "memory"); SBAR();                 \
        o[d0] = __builtin_amdgcn_mfma_f32_32x32x16_bf16(pa0, (bf16x8){l0[0], l0[1], l0[2], l0[3], h0[0], h0[1], h0[2], h0[3]}, o[d0], 0, 0, 0);   \
        o[d0] = __builtin_amdgcn_mfma_f32_32x32x16_bf16(pa1, (bf16x8){l1[0], l1[1], l1[2], l1[3], h1[0], h1[1], h1[2], h1[3]}, o[d0], 0, 0, 0);   \
        o[d0] = __builtin_amdgcn_mfma_f32_32x32x16_bf16(pa2, (bf16x8){l2[0], l2[1], l2[2], l2[3], h2[0], h2[1], h2[2], h2[3]}, o[d0], 0, 0, 0);   \
        o[d0] = __builtin_amdgcn_mfma_f32_32x32x16_bf16(pa3, (bf16x8){l3[0], l3[1], l3[2], l3[3], h3[0], h3[1], h3[2], h3[3]}, o[d0], 0, 0, 0); } while (0)
    PV_D0(0); PV_D0(1); PV_D0(2); PV_D0(3);
#undef PV_D0
#undef TRRD
}

template <class TIn, class TOut> struct BlockRef { const TIn* Q; const TIn* K; const TIn* V; TOut* O; int P0; };
template <class TIn> struct Seam {
    bf16x8 qr[8];
    bf16x8 st_v0, st_v1, st_k0, st_k1; f32x4 sf0, sf1, sf2, sf3;
    f32x4 tq[16];
};
__device__ __forceinline__ int swa_jlo(int P0, int W) { const int lowk = P0 - W + 1; return lowk > 0 ? lowk / KVBLK : 0; }
#define ROW(p, k0, rr) ((p) + (size_t)((k0) + (rr)) * KVPITCH + sc)
#define VMW() asm volatile("s_waitcnt vmcnt(0)" ::: "memory")
#define VMWN(n) asm volatile("s_waitcnt vmcnt(%0)" :: "i"(n) : "memory")
#define SLOAD_H(Kp, Vp, k0) do { S.st_v0 = load8<TIn>(ROW(Vp, k0, sr)); S.st_v1 = load8<TIn>(ROW(Vp, k0, 32 + sr));              \
                         S.st_k0 = load8<TIn>(ROW(Kp, k0, sr)); S.st_k1 = load8<TIn>(ROW(Kp, k0, 32 + sr)); } while (0)
#define SWRITE_HK(bf) do { *(bf16x8*)(K_lds + (bf) * SHM_K + kws) = S.st_k0; *(bf16x8*)(K_lds + (bf) * SHM_K + kws + 32 * 256) = S.st_k1; } while (0)
#define SWRITE_HV(bf) do { *(bf16x8*)(V_lds + (bf) * SHM_V + vst0) = S.st_v0; *(bf16x8*)(V_lds + (bf) * SHM_V + vst1) = S.st_v1; } while (0)
#define SWRITE_H(bf) do { SWRITE_HV(bf); SWRITE_HK(bf); } while (0)
#define SLOAD_F(p, k0) do { S.sf0 = *(const f32x4*)ROW(p, k0, sr); S.sf1 = *(const f32x4*)(ROW(p, k0, sr) + 4);                \
                            S.sf2 = *(const f32x4*)ROW(p, k0, 32 + sr); S.sf3 = *(const f32x4*)(ROW(p, k0, 32 + sr) + 4); } while (0)
#define SWRITE_KF(bf) do { *(bf16x8*)(K_lds + (bf) * SHM_K + kws) = pack8(S.sf0, S.sf1); *(bf16x8*)(K_lds + (bf) * SHM_K + kws + 32 * 256) = pack8(S.sf2, S.sf3); } while (0)
#define SWRITE_VF(bf) do { *(bf16x8*)(V_lds + (bf) * SHM_V + vst0) = pack8(S.sf0, S.sf1); *(bf16x8*)(V_lds + (bf) * SHM_V + vst1) = pack8(S.sf2, S.sf3); } while (0)
template <class TIn, class TOut>
__device__ __forceinline__ void causal_swa_prime(const BlockRef<TIn, TOut>& cur, int W, char* lds, Seam<TIn>& S) {
    constexpr bool F32 = same_t<TIn, float>::v;
    int tid_ = threadIdx.x; asm volatile("" : "+v"(tid_)); const int tid = tid_, wid = __builtin_amdgcn_readfirstlane(tid >> 6), lane = tid & 63, r32 = lane & 31, hi = lane >> 5;
    const int sr = tid >> 4, sc = (tid & 15) * 8, kws = KSWZ(sr, sc * 2); char* K_lds = lds + 2 * SHM_V;
    const int kb0 = swa_jlo(cur.P0, W) * KVBLK;
    for (int d0 = 0; d0 < 8; ++d0) S.qr[d0] = load8<TIn>(cur.Q + (size_t)(wid * QBLK + r32) * QPITCH + d0 * 16 + hi * 8);
    if constexpr (F32) { SLOAD_F((const float*)cur.K, kb0); VMW(); SWRITE_KF(0); SBAR(); SLOAD_F((const float*)cur.V, kb0); }
    else { SLOAD_H(cur.K, cur.V, kb0); VMW(); SWRITE_HK(0); }
    __syncthreads();
}
template <class TIn, class TOut>
__device__ __forceinline__ void causal_swa_block(const BlockRef<TIn, TOut>& cur, const BlockRef<TIn, TOut>& nxt, int skv, int W, char* lds, Seam<TIn>& S) {
    constexpr bool F32 = same_t<TIn, float>::v;
    int tid_ = threadIdx.x; asm volatile("" : "+v"(tid_)); const int tid = tid_, wid = __builtin_amdgcn_readfirstlane(tid >> 6), lane = tid & 63, r32 = lane & 31, hi = lane >> 5;
    const int j_lo = swa_jlo(cur.P0, W);
    int j_hi = (cur.P0 + QB - 1) / KVBLK + 1; if (j_hi > skv / KVBLK) j_hi = skv / KVBLK;
    const int NT = j_hi - j_lo;
    const int kbn = swa_jlo(nxt.P0, W) * KVBLK;
    const int qlo = cur.P0 + wid * QBLK, qm = qlo + r32 - 4 * hi;
    char* V_lds = lds; char* K_lds = lds + 2 * SHM_V;
    float* ws = (float*)(lds + 2 * SHM_V + 2 * SHM_K) + wid * 64; float* li_l = ws, * al_l = ws + 32;
    float m_reg = -1e30f, l_reg = 0; f32x16 o[4] = {};
    const int sr = tid >> 4, sc = (tid & 15) * 8, vst0 = v_st(sr, sc), vst1 = v_st(32 + sr, sc), kws = KSWZ(sr, sc * 2);
    const int vb0 = (int)(uintptr_t)V_lds + v_rd_base(lane);
    const TIn* Kh = cur.K; const TIn* Vh = cur.V;
#define RESC(a) do { if (__any((a) < 1.f)) { if (hi == 0) al_l[r32] = (a); asm volatile("s_waitcnt lgkmcnt(0)" ::: "memory");              \
                     for (int d_ = 0; d_ < 4; ++d_) for (int r = 0; r < 16; ++r) o[d_][r] *= al_l[crow(r, hi)]; } } while (0)
#define KBASE(t) ((j_lo + (t)) * KVBLK)
#define ACT(t) (KBASE(t) <= qlo + QBLK - 1 && KBASE(t) + KVBLK - 1 >= qlo - W + 1)
#define MASKT(P0_, P1_, t) do { const int kb_ = KBASE(t); if ((!SK || ACT(t)) && (kb_ + KVBLK - 1 > qlo || kb_ <= qlo + QBLK - 1 - W)) mask_tile(P0_, P1_, qm - kb_, (unsigned)W); } while (0)
    constexpr int NQL = F32 ? 16 : 8;
    constexpr bool SK = WSKIP && !F32;
#define SEAM_K0() do { VMWN(NQL); if constexpr (F32) { SWRITE_KF(0); SBAR(); SLOAD_F((const float*)nxt.V, kbn); } else { SWRITE_HK(0); } SBAR(); } while (0)
    f32x16 pA0, pA1, pB0, pB1; float mnA, mnB, alA, alB; bf16x8 pa0, pa1, pa2, pa3;
    if constexpr (F32) { VMW(); SWRITE_VF(0); SBAR(); } else { SWRITE_HV(0); SBAR(); }
    if (NT > 1) { if constexpr (F32) SLOAD_F((const float*)Kh, KBASE(1)); else SLOAD_H(Kh, Vh, KBASE(1)); }
    SBAR(); qkt<0, SK>(pA0, pA1, K_lds, r32, hi, S.qr, ACT(0));
    if constexpr (F32) { if (NT > 1) { VMW(); SWRITE_KF(1); SBAR(); SLOAD_F((const float*)Vh, KBASE(1)); } }
    MASKT(pA0, pA1, 0); partialSM(pA0, pA1, m_reg, mnA, alA);
    if (NT > 1) { VMW(); if constexpr (F32) { SWRITE_VF(1); SBAR(); if (NT > 2) SLOAD_F((const float*)Kh, KBASE(2)); } else SWRITE_H(1); }
    __syncthreads();
#define HALF_STEP(PX0, PX1, mnX, alX, PY0, PY1, alY, t, KB, VB, SB) do {                                                      \
        SBAR(); qkt<KB, SK>(PX0, PX1, K_lds, r32, hi, S.qr, ACT(t));                                             \
        finishSM(PY0, PY1, alY, l_reg, pa0, pa1, pa2, pa3); SBAR();                                                           \
        if ((t) + 1 < NT) { if constexpr (F32) { VMW(); SWRITE_KF(SB); SBAR(); SLOAD_F((const float*)Vh, KBASE((t) + 1)); }  \
                            else { SLOAD_H(Kh, Vh, KBASE((t) + 1)); } SBAR(); }                                               \
        pv_tile<VB, SK>(o, vb0, pa0, pa1, pa2, pa3, ACT((t) - 1)); MASKT(PX0, PX1, (t)); partialSM(PX0, PX1, m_reg, mnX, alX);                                        \
        __syncthreads();                                                                                                      \
        if ((t) + 1 < NT) { VMW(); if constexpr (F32) { SWRITE_VF(SB); SBAR(); if ((t) + 2 < NT) SLOAD_F((const float*)Kh, KBASE((t) + 2)); } \
                            else { SWRITE_H(SB); } }                                                                          \
        RESC(alX); __syncthreads(); } while (0)
    for (int t = 1; t + 1 < NT; t += 2) {
        HALF_STEP(pB0, pB1, mnB, alB, pA0, pA1, alA, t, 1, 0, 0);
        HALF_STEP(pA0, pA1, mnA, alA, pB0, pB1, alB, t + 1, 0, 1, 1);
    }
    const bool even = (NT & 1) == 0;
    if (even) { SBAR(); qkt<1, SK>(pB0, pB1, K_lds, r32, hi, S.qr, ACT(NT - 1)); SBAR(); }
#define QROW(e) (nxt.Q + (size_t)(wid * QBLK + r32) * QPITCH + ((e) >> 1) * 16 + hi * 8 + ((e) & 1) * 4)
    if constexpr (F32) { SLOAD_F((const float*)nxt.K, kbn); SBAR();
#pragma unroll
        for (int e = 0; e < 8; ++e) S.tq[e] = *(const f32x4*)QROW(e); }
    else { SLOAD_H(nxt.K, nxt.V, kbn); SBAR();
#pragma unroll
        for (int d0 = 0; d0 < 8; ++d0) S.qr[d0] = load8<TIn>(nxt.Q + (size_t)(wid * QBLK + r32) * QPITCH + d0 * 16 + hi * 8); }
    SBAR();
    finishSM(pA0, pA1, alA, l_reg, pa0, pa1, pa2, pa3); SBAR();
    if constexpr (F32) {
#pragma unroll
        for (int e = 8; e < 16; ++e) S.tq[e] = *(const f32x4*)QROW(e); SBAR(); }
#undef QROW
    pv_tile<0, SK>(o, vb0, pa0, pa1, pa2, pa3, ACT(even ? NT - 2 : NT - 1));
    if (even) { MASKT(pB0, pB1, NT - 1); partialSM(pB0, pB1, m_reg, mnB, alB); __syncthreads(); RESC(alB);
        finishSM(pB0, pB1, alB, l_reg, pa0, pa1, pa2, pa3); SBAR(); pv_tile<1, SK>(o, vb0, pa0, pa1, pa2, pa3, ACT(NT - 1)); }
    SBAR(); SEAM_K0();
    if (hi == 0) li_l[r32] = l_reg; asm volatile("s_waitcnt lgkmcnt(0)" ::: "memory");
    float rli[16];
#pragma unroll
    for (int r = 0; r < 16; ++r) rli[r] = __builtin_amdgcn_rcpf(li_l[crow(r, hi)]);
    TOut* Ow = cur.O + (size_t)(wid * QBLK) * OPITCH;
#pragma unroll
    for (int r = 0; r < 16; ++r) { const int orow = crow(r, hi);
        if constexpr (same_t<TOut, float>::v) {
#pragma unroll
            for (int d0 = 0; d0 < 4; ++d0) Ow[(size_t)orow * OPITCH + d0 * 32 + r32] = o[d0][r] * rli[r];
        } else {
            typedef unsigned v2u_t __attribute__((ext_vector_type(2)));
            v2u_t w; w.x = cvtpk(o[0][r] * rli[r], o[1][r] * rli[r]); w.y = cvtpk(o[2][r] * rli[r], o[3][r] * rli[r]);
            *(v2u_t*)(Ow + (size_t)orow * OPITCH + r32 * 4) = w; } }
    if constexpr (F32) {
#pragma unroll
        for (int d0 = 0; d0 < 8; ++d0) S.qr[d0] = pack8(S.tq[2 * d0], S.tq[2 * d0 + 1]); }
    __syncthreads();
#undef RESC
#undef KBASE
#undef ACT
#undef MASKT
#undef SEAM_K0
#undef HALF_STEP
}
#undef ROW
#undef VMW
#undef VMWN
#undef SLOAD_H
#undef SWRITE_HK
#undef SWRITE_HV
#undef SWRITE_H
#undef SLOAD_F
#undef SWRITE_KF
#undef SWRITE_VF

}
constexpr int NWAVES = 8;
#ifndef MK_SPLIT
#define MK_SPLIT 0
#endif
constexpr int BATCH = 16, SEQ = 2048, DM = 2048, M = BATCH * SEQ, DEPTH = 2, DFF = 8192;
constexpr int IN_COLS = 6160;
constexpr int NPROJ = 6656;
constexpr int C_GQ = 0, C_GK = 512, C_GV = 1024, C_GG = 2048, C_GATE = 3072, C_DQ = 3584, C_DK = 4608, C_DV = 5632;
constexpr int S_LR = 3072, S_SHIFT = 496;
constexpr int PH_PER_LAYER = 6, N_PHASES = 1 + DEPTH * PH_PER_LAYER;
constexpr float NORM_EPS = 1e-6f, SUBLN_EPS = 1e-5f;
constexpr float GLA_QSCALE = 0.08838834764831845f;

constexpr size_t MiB = 1u << 20;
constexpr size_t WS_CTL = 0, CTL_ZERO_BYTES = 1 * MiB;
constexpr size_t WS_BIAS = 1 * MiB;
constexpr size_t WS_WLRT = 1 * MiB + 256 * 1024;
constexpr size_t WS_W2F = 1 * MiB + 512 * 1024;
constexpr size_t WS_ROPE = 2 * MiB;
constexpr size_t WS_WIN = 18 * MiB;
constexpr size_t WS_WOUT = 70 * MiB;
constexpr size_t WS_WUP = 86 * MiB;
constexpr size_t WS_WDN = 150 * MiB;
constexpr size_t WS_XN = 214 * MiB;
constexpr size_t WS_XB2 = 342 * MiB;
constexpr size_t WS_PROJ = 342 * MiB;
constexpr size_t WS_O = 758 * MiB;
constexpr size_t WS_HID = 470 * MiB;
constexpr size_t WS_SS = 1014 * MiB;
constexpr size_t WS_END = 1019 * MiB;
static_assert(WS_WIN + (size_t)DEPTH * NPROJ * DM * 2 <= WS_WOUT && WS_WOUT + (size_t)DEPTH * DM * DM * 2 <= WS_WUP && WS_WUP + (size_t)DEPTH * DFF * DM * 2 <= WS_WDN && WS_WDN + (size_t)DEPTH * DFF * DM * 2 <= WS_XN, "ws map: weights");
static_assert(WS_XN + (size_t)M * DM * 2 <= WS_PROJ && WS_PROJ + (size_t)M * NPROJ * 2 <= WS_O && WS_O + (size_t)M * 2048 * 4 <= WS_END && WS_HID + (size_t)M * DFF * 2 <= WS_END && WS_XB2 + (size_t)M * DM * 2 <= WS_HID, "ws map: activations");
constexpr int CW_BAR = 4096;
constexpr int CW_VC = 9216;
constexpr int CW_Q = 8192;


constexpr int RING_OFF = 0, RING_BYTES = 131072;
constexpr int LDSCTL_OFF = RING_BYTES, MISC_OFF = LDSCTL_OFF + 320;
constexpr int RED_OFF = RING_BYTES + 1024;
constexpr int LDS_BYTES = 147456;
constexpr int RT_OFF = RED_OFF + 8192;
static_assert(MISC_OFF + 128 <= RED_OFF && RT_OFF + 4096 + 64 <= LDS_BYTES, "LDS map");

#define GAS __attribute__((address_space(1)))
#define LAS __attribute__((address_space(3)))
#define DI __device__ __forceinline__
typedef unsigned short bf16;
typedef unsigned v4u __attribute__((ext_vector_type(4)));
typedef unsigned v2u __attribute__((ext_vector_type(2)));
typedef float f32x4 __attribute__((ext_vector_type(4)));
typedef float f32x2v __attribute__((ext_vector_type(2)));
typedef float f32x16 __attribute__((ext_vector_type(16)));
typedef short bf16x8 __attribute__((ext_vector_type(8)));
typedef short s16x4 __attribute__((ext_vector_type(4)));
typedef __bf16 bf16x2_t __attribute__((ext_vector_type(2)));
typedef GAS unsigned gu32;
#define RLX_AGENT __ATOMIC_RELAXED, __HIP_MEMORY_SCOPE_AGENT
#define LDS_WAIT() asm volatile("s_waitcnt lgkmcnt(0)" ::: "memory")
#define VM_WAIT() asm volatile("s_waitcnt vmcnt(0)" ::: "memory")
DI unsigned pk2(float lo, float hi) { f32x2v v = {lo, hi}; bf16x2_t b = __builtin_convertvector(v, bf16x2_t); return __builtin_bit_cast(unsigned, b); }
DI float bf_lo(unsigned u) { return __uint_as_float(u << 16); }
DI float bf_hi(unsigned u) { return __uint_as_float(u & 0xffff0000u); }
DI int opaque_tid() { int t = threadIdx.x; asm volatile("" : "+v"(t)); return t; }
#define PH_IDS const int tid = opaque_tid(), lane = tid & 63, wave = __builtin_amdgcn_readfirstlane(tid >> 6), gw = (int)blockIdx.x * NWAVES + wave; (void)lane; (void)gw
#define MFMA32(a, b, c) __builtin_amdgcn_mfma_f32_32x32x16_bf16((a), (b), (c), 0, 0, 0)

#define XB_TMO      128
#define XB_XCNT(j)  (256  + 64 * (j))
#define XB_XSUB(j)  (1280 + 64 * (j))
#define XB_XGEN(j)  (2304 + 64 * (j))
#define XB_TOP      3328
#define XB_TOPGEN   3392
#define XCD_BAR_WORDS 3456
#define XB_SPIN_CAP (1u << 18)

__device__ __forceinline__ unsigned xb_ld(unsigned* p)              { return __hip_atomic_load(p, __ATOMIC_RELAXED, __HIP_MEMORY_SCOPE_AGENT); }
__device__ __forceinline__ unsigned xb_add(unsigned* p, unsigned v) { return __hip_atomic_fetch_add(p, v, __ATOMIC_RELAXED, __HIP_MEMORY_SCOPE_AGENT); }
__device__ __forceinline__ unsigned xb_xcc_id() { return (unsigned)__builtin_amdgcn_s_getreg((3 << 11) | 20) & 0xFu; }
#define XB_SPIN(cond, bar) do { unsigned _sp = 0; while (cond) { __builtin_amdgcn_s_sleep(1); \
    if ((++_sp & 255u) == 0u) { if (xb_ld(&(bar)[XB_TMO])) break; if (_sp > XB_SPIN_CAP) { atomicAdd(&(bar)[XB_TMO], 1u); break; } } } } while (0)

struct XcdBarrier {
    unsigned* bar; unsigned x;
    volatile LAS unsigned* st;
};

__device__ __forceinline__ XcdBarrier xcd_barrier_post(unsigned* bar, volatile LAS unsigned* st) {
    XcdBarrier b; b.bar = bar; b.x = xb_xcc_id(); b.st = st;
    if (threadIdx.x == 0) (void)xb_add(&bar[XB_XCNT(b.x)], 1u);
    return b;
}
__device__ __forceinline__ void xcd_barrier_complete(unsigned* bar, unsigned x, unsigned& nloc, unsigned& nx) {
    const unsigned G = gridDim.x * gridDim.y * gridDim.z;
    unsigned sum, cnt, mine, sp = 0u;
    for (;;) {
        sum = 0u; cnt = 0u; mine = 0u;
#pragma unroll
        for (unsigned j = 0; j < 16; ++j) { const unsigned c = xb_ld(&bar[XB_XCNT(j)]); sum += c; cnt += (c > 0u) ? 1u : 0u; mine = (j == x) ? c : mine; }
        if (sum == G) break;
        __builtin_amdgcn_s_sleep(1);
        if ((++sp & 255u) == 0u) { if (xb_ld(&bar[XB_TMO])) break; if (sp > XB_SPIN_CAP) { atomicAdd(&bar[XB_TMO], 1u); break; } }
    }
    nloc = mine > 0u ? mine : 1u; nx = cnt > 0u ? cnt : 1u;
}

__device__ __forceinline__ void xcd_barrier(const XcdBarrier& b) {
    asm volatile("s_waitcnt vmcnt(0)" ::: "memory");
    __syncthreads();
    if (threadIdx.x == 0) {
        unsigned* bar = b.bar;
        __builtin_amdgcn_s_waitcnt(0);
        unsigned nloc = b.st[0], nx = b.st[1];
        if (nloc == 0u) { xcd_barrier_complete(bar, b.x, nloc, nx); b.st[0] = nloc; b.st[1] = nx; }
        const unsigned old = xb_add(&bar[XB_XSUB(b.x)], 1u);
        const unsigned gen = old / nloc;
        if (old + 1u == (gen + 1u) * nloc) {
            __builtin_amdgcn_fence(__ATOMIC_RELEASE, "agent");
            asm volatile("s_waitcnt vmcnt(0)" ::: "memory");
            const unsigned og = xb_add(&bar[XB_TOP], 1u);
            const unsigned tg = og / nx;
            if (og + 1u == (tg + 1u) * nx) xb_add(&bar[XB_TOPGEN], 1u);
            else XB_SPIN(xb_ld(&bar[XB_TOPGEN]) == tg, bar);
            __builtin_amdgcn_fence(__ATOMIC_ACQUIRE, "agent");
            xb_add(&bar[XB_XGEN(b.x)], 1u);
            asm volatile("s_waitcnt vmcnt(0)" ::: "memory");
        } else {
            XB_SPIN(xb_ld(&bar[XB_XGEN(b.x)]) == gen, bar);
            __builtin_amdgcn_fence(__ATOMIC_ACQUIRE, "agent");
            asm volatile("s_waitcnt vmcnt(0)" ::: "memory");
        }
    }
    __syncthreads();
}

struct Args { const void* in[18]; float* out; unsigned char* ws; int ph_lo, ph_hi; };
struct Frame {
    LAS unsigned char* lds;
    volatile LAS unsigned* MISC;
    gu32* ctl;
    int G, NGW;
    unsigned char* ws;
};
enum { I_X = 0, I_POS, I_ATTN_NW, I_WIN, I_GW2, I_GB, I_GLA_NW, I_QNW, I_KNW, I_LQ1, I_LK1, I_LQ2, I_LK2, I_SUBW, I_WOUT, I_MLP_NW, I_WUP, I_WDN };
typedef __attribute__((address_space(4))) const Args* kargs_t;
DI kargs_t kargs() { kargs_t p = (kargs_t)__builtin_amdgcn_kernarg_segment_ptr(); asm volatile("" : "+s"(p)); return p; }
#define INP(T, k) ((const T*)(const GAS T*)kargs()->in[k])
#define OUTP() ((float*)(GAS float*)kargs()->out)
DI GAS unsigned char* ws_opaque(Frame& F) { GAS unsigned char* w = (GAS unsigned char*)F.ws; asm volatile("" : "+s"(w)); return w; }
DI float wave_sum(float v) {
#pragma unroll
    for (int o = 1; o < 64; o <<= 1) v += __shfl_xor(v, o);
    return v;
}

DI void p0_write_tile(bf16* WT, int K, int drow0, int k0, LAS float* scr, int lane, const float* rs) {
    const int c = lane & 7;
    f32x4 s0 = {1.f, 1.f, 1.f, 1.f}, s1 = s0;
    if (rs) { s0 = *(const f32x4*)(rs + k0 + 8 * c); s1 = *(const f32x4*)(rs + k0 + 8 * c + 4); }
    LDS_WAIT(); asm volatile("" ::: "memory");
#pragma unroll
    for (int j = 0; j < 4; ++j) { const int n = (lane >> 3) + 8 * j; const LAS float* s = scr + (8 * c) * 33 + n;
        v4u o; o.x = pk2(s[0 * 33] * s0[0], s[1 * 33] * s0[1]); o.y = pk2(s[2 * 33] * s0[2], s[3 * 33] * s0[3]); o.z = pk2(s[4 * 33] * s1[0], s[5 * 33] * s1[1]); o.w = pk2(s[6 * 33] * s1[2], s[7 * 33] * s1[3]);
        *(GAS v4u*)(WT + (size_t)(drow0 + n) * K + k0 + 8 * c) = o; }
    LDS_WAIT(); asm volatile("" ::: "memory");
}
DI void p0_transpose_tile(const float* W, int SP, int scol, bf16* WT, int K, int drow0, int k0, LAS float* scr, int lane, const float* rs) {
#pragma unroll 8
    for (int i = 0; i < 32; ++i) { const int kk = 2 * i + (lane >> 5); scr[kk * 33 + (lane & 31)] = W[(size_t)(k0 + kk) * SP + scol]; }
    p0_write_tile(WT, K, drow0, k0, scr, lane, rs);
}
DI void p0_gate_tile(const float* W, const float* w2, bf16* WT, int j0, int k0, LAS float* scr, int lane, const float* rs) {
    float w2r[16];
#pragma unroll
    for (int r = 0; r < 16; ++r) w2r[r] = w2[r * 512 + j0 + (lane & 31)];
#pragma unroll 4
    for (int i = 0; i < 32; ++i) { const int kk = 2 * i + (lane >> 5); const f32x4* wr = (const f32x4*)(W + (size_t)(k0 + kk) * IN_COLS + S_LR);
        float a = 0.f;
#pragma unroll
        for (int q = 0; q < 4; ++q) { const f32x4 t = wr[q]; a = fmaf(t.x, w2r[4 * q], a); a = fmaf(t.y, w2r[4 * q + 1], a); a = fmaf(t.z, w2r[4 * q + 2], a); a = fmaf(t.w, w2r[4 * q + 3], a); }
        scr[kk * 33 + (lane & 31)] = a; }
    p0_write_tile(WT, DM, C_GATE + j0, k0, scr, lane, rs);
}
#ifndef GATE_ITEMS
#define GATE_ITEMS 1
#endif
struct WTile { const float* W; bf16* WT; const float* rs; const float* w2; int SP, scol4, K, drow0, dloc_b, dstep, k0, kperm, gate_j0; };
DI void p0_t64_load(const WTile& d, int lane, f32x4 (&v)[16], f32x2v (&sc)[8]) {
    const int kq = lane >> 4;
#pragma unroll
    for (int j = 0; j < 8; ++j) sc[j] = (f32x2v){1.f, 1.f};
    if (d.gate_j0 != -1) return;
    if (d.rs) {
#pragma unroll
        for (int j = 0; j < 8; ++j) sc[j] = *(const GAS f32x2v*)(d.rs + d.k0 + 8 * j + 2 * kq); }
#pragma unroll
    for (int i = 0; i < 16; ++i) { const int k = 8 * (i >> 1) + 2 * kq + (i & 1); int kr = d.k0 + k; if (d.kperm && kr >= 1024) kr = (kr & ~127) + ((kr & 3) << 5) + ((kr & 127) >> 2);
        v[i] = *(const GAS f32x4*)(d.W + (size_t)kr * d.SP + d.scol4); }
}
DI void p0_t64_finish(const WTile& d, int lane, LAS float* scrf, const f32x4 (&v)[16], const f32x2v (&sc)[8]) {
    if (d.gate_j0 == -2) return;
    if (d.gate_j0 >= 0) { p0_gate_tile(d.W, d.w2, d.WT, d.gate_j0, d.k0, scrf, lane, d.rs); p0_gate_tile(d.W, d.w2, d.WT, d.gate_j0 + 32, d.k0, scrf, lane, d.rs); return; }
    LAS unsigned* scr = (LAS unsigned*)scrf; const int kq = lane >> 4;
#pragma unroll
    for (int j = 0; j < 8; ++j) {
        const float s0 = sc[j].x, s1 = sc[j].y;
        const int k2 = 4 * j + kq;
#pragma unroll
        for (int q = 0; q < 4; ++q) scr[(d.dloc_b + q * d.dstep) * 36 + k2] = pk2(v[2 * j][q] * s0, v[2 * j + 1][q] * s1);
    }
    LDS_WAIT(); asm volatile("" ::: "memory");
#pragma unroll
    for (int j2 = 0; j2 < 8; ++j2) { const int n = (lane >> 3) + 8 * j2, c = lane & 7;
        const v4u o = *(const LAS v4u*)(scr + n * 36 + 4 * c);
        *(GAS v4u*)(d.WT + (size_t)(d.drow0 + n) * d.K + d.k0 + 8 * c) = o; }
    LDS_WAIT(); asm volatile("" ::: "memory");
}
DI void sincos_red(float ang, float& s, float& c) {
    const double a = (double)ang; const double kq = __builtin_rint(a * 0.6366197723675814);
    double r = __builtin_fma(-kq, 1.5707963267948966, a); r = __builtin_fma(-kq, 6.123233995736766e-17, r);
    const float x = (float)r, x2 = x * x; const int q = (int)kq & 3;
    const float sp = x + x * x2 * (-1.6666654611e-1f + x2 * (8.3321608736e-3f + x2 * (-1.9515295891e-4f)));
    const float cp = 1.f - 0.5f * x2 + x2 * x2 * (4.166664568298827e-2f + x2 * (-1.388731625493765e-3f + x2 * 2.443315711809948e-5f));
    s = (q == 0) ? sp : (q == 1) ? cp : (q == 2) ? -sp : -cp;
    c = (q == 0) ? cp : (q == 1) ? -sp : (q == 2) ? -cp : sp;
}
#ifndef CONV_IN_MIXER
#define CONV_IN_MIXER 1
#endif
constexpr int P0_NB_IN = NPROJ / 64, P0_I_IN = (DM / 64) * P0_NB_IN, P0_I_OUT = (DM / 64) * (DM / 64), P0_I_UP = (DM / 64) * (DFF / 64), P0_I_DN = (DFF / 64) * (DM / 64), P0_I_LAYER = P0_I_IN + P0_I_OUT + P0_I_UP + P0_I_DN;
DI void p0_wdesc(Frame& F, GAS unsigned char* ws, int L, int r, int lane, WTile& d) {
    constexpr int NB_IN = P0_NB_IN, I_IN = P0_I_IN, I_OUT = P0_I_OUT, I_UP = P0_I_UP;
    bf16* WinT = (bf16*)(ws + WS_WIN); bf16* WoutT = (bf16*)(ws + WS_WOUT); bf16* WupT = (bf16*)(ws + WS_WUP); bf16* WdnT = (bf16*)(ws + WS_WDN);
    const int n4 = lane & 15;
    d.rs = nullptr; d.w2 = nullptr; d.kperm = 0; d.gate_j0 = -1; d.dloc_b = 4 * n4; d.dstep = 1;
    if (r < I_IN) { const int kb = r / NB_IN, nb = r - kb * NB_IN, drow0 = nb * 64;
        d.W = INP(float, I_WIN) + (size_t)L * DM * IN_COLS; d.WT = WinT + (size_t)L * NPROJ * DM; d.rs = INP(float, I_ATTN_NW) + L * DM; d.SP = IN_COLS; d.K = DM; d.drow0 = drow0; d.k0 = kb * 64;
        if (drow0 >= C_GATE && drow0 < C_DQ) { d.gate_j0 = GATE_ITEMS ? -2 : drow0 - C_GATE; d.w2 = INP(float, I_GW2) + (size_t)L * 16 * 512; d.scol4 = 0; }
        else if (drow0 >= C_DQ && drow0 < C_DV) {
            const int hb = (drow0 - C_DQ) & ~127, c0 = (drow0 - C_DQ) & 127;
            d.scol4 = C_DQ - S_SHIFT + hb + (c0 >> 1) + ((n4 >> 3) ? 64 : 0) + 4 * (n4 & 7); d.dloc_b = 8 * (n4 & 7) + (n4 >> 3); d.dstep = 2; }
        else d.scol4 = (drow0 < C_GATE ? drow0 : drow0 - S_SHIFT) + 4 * n4;
        return; }
    r -= I_IN;
    if (r < I_OUT) { const int kb = r / (DM / 64), nb = r % (DM / 64); d.W = INP(float, I_WOUT) + (size_t)L * DM * DM; d.WT = WoutT + (size_t)L * DM * DM; d.SP = DM; d.K = DM; d.scol4 = nb * 64 + 4 * n4; d.drow0 = nb * 64; d.k0 = kb * 64; d.kperm = 1; return; }
    r -= I_OUT;
    if (r < I_UP) { const int kb = r / (DFF / 64), nb = r % (DFF / 64); d.W = INP(float, I_WUP) + (size_t)L * DM * DFF; d.WT = WupT + (size_t)L * DFF * DM; d.rs = INP(float, I_MLP_NW) + L * DM; d.SP = DFF; d.K = DM; d.scol4 = nb * 64 + 4 * n4; d.drow0 = nb * 64; d.k0 = kb * 64; return; }
    r -= I_UP;
    { const int kb = r / (DM / 64), nb = r % (DM / 64); d.W = INP(float, I_WDN) + (size_t)L * DFF * DM; d.WT = WdnT + (size_t)L * DM * DFF; d.SP = DM; d.K = DFF; d.scol4 = nb * 64 + 4 * n4; d.drow0 = nb * 64; d.k0 = kb * 64; }
}
DI void p0_wtile(Frame& F, GAS unsigned char* ws, int L, int r, LAS float* scr, int lane) {
    WTile d; p0_wdesc(F, ws, L, r, lane, d);
    f32x4 v[16]; f32x2v sc[8];
    p0_t64_load(d, lane, v, sc); p0_t64_finish(d, lane, scr, v, sc);
}
constexpr int CONV_TPW = 10, CONV_TPI = 8 * CONV_TPW, CONV_L0 = P0_I_LAYER - P0_I_IN, CONV_TILES = CONV_L0 + (DEPTH - 1) * P0_I_LAYER, N_CONV = CONV_IN_MIXER ? CONV_TILES / CONV_TPI : 0;
static_assert(CONV_TILES % CONV_TPI == 0 && P0_I_IN % 8 == 0, "conversion items tile the list exactly");
DI void conv_item(Frame& F, int c) {
    PH_IDS;
    LAS float* scr = (LAS float*)(F.lds + RING_OFF + wave * 16384);
    GAS unsigned char* ws = ws_opaque(F);
    auto desc = [&](int j, WTile& d) { const int g = c * CONV_TPI + wave + 8 * j;
        if (g < CONV_L0) p0_wdesc(F, ws, 0, P0_I_IN + g, lane, d);
        else { const int g2 = g - CONV_L0, L = 1 + g2 / P0_I_LAYER; p0_wdesc(F, ws, L, g2 - (L - 1) * P0_I_LAYER, lane, d); } };
    WTile dA, dB; f32x4 vA[16], vB[16]; f32x2v sA[8], sB[8];
    desc(0, dA); p0_t64_load(dA, lane, vA, sA);
#pragma unroll 1
    for (int j = 0; j < CONV_TPW; j += 2) {
        desc(j + 1, dB); p0_t64_load(dB, lane, vB, sB);
        p0_t64_finish(dA, lane, scr, vA, sA);
        if (j + 2 < CONV_TPW) { desc(j + 2, dA); p0_t64_load(dA, lane, vA, sA); }
        p0_t64_finish(dB, lane, scr, vB, sB);
    }
}
static_assert(CONV_TPW % 2 == 0, "conv_item pairs tiles");
DI void p0_prologue(Frame& F) {
    PH_IDS;
    LAS float* scr = (LAS float*)(F.lds + RING_OFF + wave * 16384);
    constexpr int I_LAYER = P0_I_LAYER;
    GAS unsigned char* ws = ws_opaque(F);
#pragma unroll 1
    for (int it = gw; it < (CONV_IN_MIXER ? P0_I_IN : DEPTH * I_LAYER); it += F.NGW) { const int L = it / I_LAYER; p0_wtile(F, ws, L, it - L * I_LAYER, scr, lane); }
    const int gt = gw * 64 + lane, NT = F.NGW * 64;
    float* bias = (float*)(ws + WS_BIAS); const float* gate_b = INP(float, I_GB); const int* pos = INP(int, I_POS);
    for (int i = gt; i < DEPTH * NPROJ; i += NT) { const int L = i / NPROJ, c = i - L * NPROJ; bias[i] = (c >= C_GATE && c < C_DQ) ? gate_b[L * 512 + c - C_GATE] : 0.f; }
    if (GATE_ITEMS) {
        bf16* wlrt = (bf16*)(ws + WS_WLRT); bf16* w2f = (bf16*)(ws + WS_W2F);
        for (int i = gt; i < DEPTH * 16 * DM; i += NT) { const int L = i / (16 * DM), r = (i >> 11) & 15, k = i & (DM - 1);
            const float v = INP(float, I_ATTN_NW)[L * DM + k] * INP(float, I_WIN)[((size_t)L * DM + k) * IN_COLS + S_LR + r];
            wlrt[i] = (bf16)(pk2(v, 0.f) & 0xffffu); }
        for (int i = gt; i < DEPTH * 32 * 64 * 4; i += NT) { const int L = i / (32 * 64 * 4), nb = (i >> 8) & 31, ln = (i >> 2) & 63, e = i & 3;
            const float v = INP(float, I_GW2)[(size_t)L * 16 * 512 + (4 * (ln >> 4) + e) * 512 + 16 * nb + (ln & 15)];
            w2f[i] = (bf16)(pk2(v, 0.f) & 0xffffu); }
    }
    unsigned* rope = (unsigned*)(ws + WS_ROPE);
    for (int i = gt; i < M * 64; i += NT) { const int row = i >> 6, f = i & 63;
        const float inv_freq = (float)exp2(-(double)f * (13.287712379549449 / 64.0));
        const float ang = (float)pos[row] * inv_freq; float s, c; sincos_red(ang, s, c);
        rope[i] = (unsigned)__builtin_bit_cast(unsigned short, (_Float16)c) | ((unsigned)__builtin_bit_cast(unsigned short, (_Float16)s) << 16); }
    const float* x = INP(float, I_X); bf16* xb = (bf16*)OUTP(); GAS f32x4* ss0 = (GAS f32x4*)(ws + WS_SS);
    for (int m0 = 4 * gw; m0 < M; m0 += 4 * F.NGW) {
        f32x4 v[4][8]; float s[4] = {0.f, 0.f, 0.f, 0.f};
#pragma unroll
        for (int q = 0; q < 4; ++q) { const GAS f32x4* xr = (const GAS f32x4*)(x + (size_t)(m0 + q) * DM) + lane;
#pragma unroll
            for (int j = 0; j < 8; ++j) v[q][j] = xr[64 * j]; }
#pragma unroll
        for (int q = 0; q < 4; ++q) {
#pragma unroll
            for (int j = 0; j < 8; ++j) s[q] += (v[q][j].x * v[q][j].x + v[q][j].y * v[q][j].y) + (v[q][j].z * v[q][j].z + v[q][j].w * v[q][j].w);
            s[q] = wave_sum(s[q]); if (lane < 2) ss0[2 * (m0 + q) + lane] = (f32x4){lane == 0 ? s[q] : 0.f, 0.f, 0.f, 0.f};
            GAS v2u* o8 = (GAS v2u*)(xb + (size_t)(m0 + q) * DM) + lane;
#pragma unroll
            for (int j = 0; j < 8; ++j) { v2u o; o.x = pk2(v[q][j].x, v[q][j].y); o.y = pk2(v[q][j].z, v[q][j].w); o8[64 * j] = o; } }
    }
}

typedef float f32x4_t __attribute__((ext_vector_type(4)));
DI void gate_item(Frame& F, int L, int item) {
    PH_IDS;
    GAS unsigned char* ws = ws_opaque(F);
    const int t0 = item * 128 + wave * 16, li = lane & 15, lq = lane >> 4;
    const GAS bf16* xa = (const GAS bf16*)OUTP() + (size_t)(t0 + li) * DM + 8 * lq;
    constexpr int WLP = DM * 2 + 16;
    LAS unsigned char* wls = F.lds + RING_OFF;
    { const GAS v4u* src = (const GAS v4u*)(ws + WS_WLRT) + (size_t)L * (16 * DM / 8);
#pragma unroll
      for (int j = 0; j < 8; ++j) { const int q = tid + 512 * j, r = q >> 8, c = q & 255;
          *(LAS v4u*)(wls + r * WLP + c * 16) = src[q]; } }
    __syncthreads();
    const LAS unsigned char* wl = wls + li * WLP + 16 * lq;
    f32x4 acc = {0.f, 0.f, 0.f, 0.f};
#pragma unroll 16
    for (int s = 0; s < DM / 32; ++s) { const bf16x8 a = *(const LAS bf16x8*)(wl + 64 * s), b = *(const GAS bf16x8*)(xa + 32 * s);
        acc = __builtin_amdgcn_mfma_f32_16x16x32_bf16(a, b, acc, 0, 0, 0); }
    const GAS f32x4* ssp = (const GAS f32x4*)((const GAS float*)(ws + WS_SS) + ((size_t)(2 * L) * M + t0 + li) * 8); const f32x4 p0 = ssp[0], p1 = ssp[1];
    const float rstd = __builtin_amdgcn_rsqf((((p0[0] + p0[1]) + (p0[2] + p0[3])) + ((p1[0] + p1[1]) + (p1[2] + p1[3]))) * (1.0f / DM) + NORM_EPS);
    s16x4 lrb; { const unsigned u0 = pk2(acc[0] * rstd, acc[1] * rstd), u1 = pk2(acc[2] * rstd, acc[3] * rstd); lrb = (s16x4){(short)(u0 & 0xffffu), (short)(u0 >> 16), (short)(u1 & 0xffffu), (short)(u1 >> 16)}; }
    const GAS s16x4* w2f = (const GAS s16x4*)(ws + WS_W2F) + (size_t)L * 32 * 64 + lane;
    const GAS float* bias = (const GAS float*)(ws + WS_BIAS) + (size_t)L * NPROJ + C_GATE + 4 * lq;
    GAS bf16* gout = (GAS bf16*)(ws + WS_PROJ) + (size_t)(t0 + li) * NPROJ + C_GATE + 4 * lq;
#pragma unroll 8
    for (int nb = 0; nb < 32; ++nb) { const s16x4 w = w2f[nb * 64]; const f32x4 bv = *(const GAS f32x4*)(bias + 16 * nb);
        const f32x4 z = {0.f, 0.f, 0.f, 0.f};
        const f32x4 d = __builtin_amdgcn_mfma_f32_16x16x16bf16_1k(w, lrb, z, 0, 0, 0);
        v2u o; o.x = pk2(d[0] + bv[0], d[1] + bv[1]); o.y = pk2(d[2] + bv[2], d[3] + bv[3]);
        *(GAS v2u*)(gout + 16 * nb) = o; }
    __syncthreads();
}
DI void combine_phase(Frame& F, int L) {
    PH_IDS;
    GAS unsigned char* ws = ws_opaque(F);
    const bf16* O = (const bf16*)(ws + WS_O); bf16* mix = (bf16*)(ws + WS_XN);
    const float* lq1 = INP(float, I_LQ1) + L * 128; const float* lk1 = INP(float, I_LK1) + L * 128; const float* lq2 = INP(float, I_LQ2) + L * 128; const float* lk2 = INP(float, I_LK2) + L * 128;
    const float lam_init = (L == 0) ? 0.2f : 0.35550906759096914f;
    float d1 = lq1[lane] * lk1[lane] + lq1[64 + lane] * lk1[64 + lane];
    float d2 = lq2[lane] * lk2[lane] + lq2[64 + lane] * lk2[64 + lane];
    const float lam = expf(wave_sum(d1)) - expf(wave_sum(d2)) + lam_init;
    const float osc = 1.0f - lam_init;
    f32x4 sw; { const float* swp = INP(float, I_SUBW) + L * 256 + (lane >> 5) * 128 + (lane & 31); sw = (f32x4){swp[0], swp[32], swp[64], swp[96]}; }
    for (int m = gw; m < M; m += F.NGW) {
        const bf16* o = O + (size_t)m * 2048 + 4 * lane;
        v2u a[4], b[4];
#pragma unroll
        for (int h = 0; h < 4; ++h) { a[h] = *(const GAS v2u*)(o + h * 512); b[h] = *(const GAS v2u*)(o + h * 512 + 256); }
#pragma unroll
        for (int h = 0; h < 4; ++h) { const f32x4 av = {bf_lo(a[h].x), bf_hi(a[h].x), bf_lo(a[h].y), bf_hi(a[h].y)}, bv = {bf_lo(b[h].x), bf_hi(b[h].x), bf_lo(b[h].y), bf_hi(b[h].y)}; const f32x4 d = av - bv * lam;
            const float ss = wave_sum((d.x * d.x + d.y * d.y) + (d.z * d.z + d.w * d.w));
            const float r = osc * __builtin_amdgcn_rsqf(ss * (1.f / 256.f) + SUBLN_EPS);
            v2u w; w.x = pk2(d.x * r * sw.x, d.y * r * sw.y); w.y = pk2(d.z * r * sw.z, d.w * r * sw.w);
            *(v2u*)(mix + (size_t)m * DM + 1024 + h * 256 + 4 * lane) = w; } }
}
#ifndef WGM_IN
#define WGM_IN 8
#define WGM_OUT 4
#define WGM_UP 8
#define WGM_DN 4
#endif
#ifndef HID_TILED
#define HID_TILED 1
#endif
#ifndef PROBE_DUP
#define PROBE_DUP 0
#endif

constexpr int G_QT = 0, G_QP = 272, G_KT = 17408, G_KDT = 34816, G_TP = 144, G_VT = 53248, G_AT = 90112, G_DEC = 99328, G_GT = 99840, G_NW = 103936, G_END = 104960, G_OB = 0, G_OP = 1152, G_OC = 144;
static_assert(G_END <= RING_BYTES && 64 * G_OP <= G_DEC, "GLA LDS map");
DI float log_sigmoid_f(float x) { return fminf(x, 0.f) - __logf(1.f + __expf(-fabsf(x))); }
DI bf16x8 lds_frag16(LAS unsigned char* p) { return *(LAS const bf16x8*)p; }
DI bf16x8 lds_frag8x2(LAS unsigned char* p, int second_off) { const s16x4 a = *(LAS const s16x4*)p, b = *(LAS const s16x4*)(p + second_off); return __builtin_shufflevector(a, b, 0, 1, 2, 3, 4, 5, 6, 7); }
#ifndef CONV_EVERY
#define CONV_EVERY (PROBE_DUP == 12 ? 4 : 8)
#endif
#ifndef GLA_SKIP
#define GLA_SKIP 0
#endif
DI void gla_unit(Frame& F, int L, int unit, int skip) {
    PH_IDS;
    const int b = unit >> 2, h = unit & 3;
    LAS unsigned char* lds = F.lds + RING_OFF;
    GAS unsigned char* ws = ws_opaque(F);
    const bf16* pbase = (const bf16*)(ws + WS_PROJ) + (size_t)b * SEQ * NPROJ;
    bf16* mix = (bf16*)(ws + WS_XN);
    const float* nw = INP(float, I_GLA_NW) + L * 256;
    f32x16 S[4];
#pragma unroll
    for (int i = 0; i < 4; ++i)
#pragma unroll
        for (int e = 0; e < 16; ++e) S[i][e] = 0.f;
    if (tid < 256) *(LAS float*)(lds + G_NW + 4 * tid) = nw[tid];
    unsigned gv[8];
#define GLA_LOADG(dst, nn) do { const bf16* r0_ = pbase + (size_t)((nn) * 64 + 8 * wave) * NPROJ + h * 128 + 2 * (tid & 63) + C_GATE; \
        _Pragma("unroll") for (int i = 0; i < 8; ++i) dst[i] = *(const unsigned*)(r0_ + (size_t)i * NPROJ); } while (0)
    GLA_LOADG(gv, 0);
#pragma unroll 1
    for (int n = 0; n < SEQ / 64; ++n) {
        const bf16* prow = pbase + (size_t)(n * 64) * NPROJ;
        int tc = tid; asm volatile("" : "+v"(tc));
        unsigned gvn[8];
#pragma unroll
        for (int i = 0; i < 8; ++i) gvn[i] = 0u;
        {
            const int dp = tc & 63, tg = wave;
            const int vp = tc & 127, tq = tc >> 7;
            unsigned qv[8], kv[8], vv[16];
            { const bf16* r0_ = prow + (size_t)(8 * tg) * NPROJ + h * 128 + 2 * dp;
#pragma unroll
              for (int i = 0; i < 8; ++i) { qv[i] = *(const unsigned*)(r0_ + (size_t)i * NPROJ + C_GQ); kv[i] = *(const unsigned*)(r0_ + (size_t)i * NPROJ + C_GK); }
              const bf16* v0_ = prow + (size_t)(16 * tq) * NPROJ + C_GV + h * 256 + 2 * vp;
#pragma unroll
              for (int i = 0; i < 16; ++i) vv[i] = *(const unsigned*)(v0_ + (size_t)i * NPROJ); }
            if (n + 1 < SEQ / 64) GLA_LOADG(gvn, n + 1);
            float cs0[8], cs1[8]; float a0 = 0.f, a1 = 0.f;
#pragma unroll
            for (int i = 0; i < 8; ++i) { cs0[i] = 0.f; cs1[i] = 0.f; }
            if (!(skip & 16)) {
#pragma unroll
            for (int i = 0; i < 8; ++i) { a0 += log_sigmoid_f(bf_lo(gv[i])) * (1.f / 16.f); a1 += log_sigmoid_f(bf_hi(gv[i])) * (1.f / 16.f); cs0[i] = a0; cs1[i] = a1; } }
            *(LAS f32x2v*)(lds + G_GT + (tg * 128 + 2 * dp) * 4) = (f32x2v){a0, a1};
            __syncthreads();
            if (!(skip & 8)) {
            float p0 = 0.f, p1 = 0.f, t0 = 0.f, t1 = 0.f;
#pragma unroll
            for (int g = 0; g < 8; ++g) { const f32x2v x = *(LAS const f32x2v*)(lds + G_GT + (g * 128 + 2 * dp) * 4); if (g < tg) { p0 += x.x; p1 += x.y; } t0 += x.x; t1 += x.y; }
            v4u kd0, kd1; float kx0[8], kx1[8];
            const float et0 = __expf(t0), et1 = __expf(t1);
#pragma unroll
            for (int i = 0; i < 8; ++i) { const float b0 = p0 + cs0[i], b1 = p1 + cs1[i];
                const float q0 = bf_lo(qv[i]) * GLA_QSCALE * __expf(b0), q1 = bf_hi(qv[i]) * GLA_QSCALE * __expf(b1);
                const float k0 = bf_lo(kv[i]) * __expf(-b0), k1 = bf_hi(kv[i]) * __expf(-b1);
                *(LAS unsigned*)(lds + G_QT + (8 * tg + i) * G_QP + 4 * dp) = pk2(q0, q1);
                *(LAS unsigned*)(lds + G_KT + (8 * tg + i) * G_QP + 4 * dp) = pk2(k0, k1);
                kx0[i] = k0 * et0; kx1[i] = k1 * et1; }
#pragma unroll
            for (int j = 0; j < 4; ++j) { kd0[j] = pk2(kx0[2 * j], kx0[2 * j + 1]); kd1[j] = pk2(kx1[2 * j], kx1[2 * j + 1]); }
            *(LAS v4u*)(lds + G_KDT + (2 * dp) * G_TP + 16 * tg) = kd0; *(LAS v4u*)(lds + G_KDT + (2 * dp + 1) * G_TP + 16 * tg) = kd1;
            if (tg == 0) *(LAS f32x2v*)(lds + G_DEC + 8 * dp) = (f32x2v){et0, et1};
#pragma unroll
            for (int hf = 0; hf < 2; ++hf) { v4u lo4, hi4;
#pragma unroll
                for (int j = 0; j < 4; ++j) { const unsigned x0 = vv[8 * hf + 2 * j], x1 = vv[8 * hf + 2 * j + 1]; lo4[j] = (x0 & 0xffffu) | (x1 << 16); hi4[j] = (x0 >> 16) | (x1 & 0xffff0000u); }
                *(LAS v4u*)(lds + G_VT + (2 * vp) * G_TP + (16 * tq + 8 * hf) * 2) = lo4; *(LAS v4u*)(lds + G_VT + (2 * vp + 1) * G_TP + (16 * tq + 8 * hf) * 2) = hi4; }
            }
        }
        v4u gq[4];
        { const bf16* gp = prow + (size_t)(tc >> 3) * NPROJ + C_GG + h * 256 + 32 * (tc & 7);
#pragma unroll
          for (int j = 0; j < 4; ++j) gq[j] = *(const v4u*)(gp + 8 * j); }
        __syncthreads();
        int t2 = tid; asm volatile("" : "+v"(t2)); const int r = t2 & 31, hh = (t2 >> 5) & 1;
        if (wave < 3 && !(skip & 4)) {
            const int ib = wave ? 1 : 0, jb = wave == 2 ? 1 : 0;
            f32x16 acc;
#pragma unroll
            for (int e = 0; e < 16; ++e) acc[e] = 0.f;
#pragma unroll
            for (int kh = 0; kh < 2; ++kh) { bf16x8 ka[4], qb[4];
#pragma unroll
                for (int k4 = 0; k4 < 4; ++k4) { const int ks = 4 * kh + k4; ka[k4] = lds_frag16(lds + G_KT + (jb * 32 + r) * G_QP + ks * 32 + 16 * hh); qb[k4] = lds_frag16(lds + G_QT + (ib * 32 + r) * G_QP + ks * 32 + 16 * hh); }
                __builtin_amdgcn_sched_barrier(0);
#pragma unroll
                for (int k4 = 0; k4 < 4; ++k4) acc = MFMA32(ka[k4], qb[k4], acc);
                __builtin_amdgcn_sched_barrier(0); }
            const int ci = ib * 32 + r;
#pragma unroll
            for (int g = 0; g < 4; ++g) { const int cj0 = jb * 32 + 8 * g + 4 * hh; float v[4];
#pragma unroll
                for (int e = 0; e < 4; ++e) v[e] = (cj0 + e <= ci) ? acc[4 * g + e] : 0.f;
                *(LAS v2u*)(lds + G_AT + ci * G_TP + cj0 * 2) = (v2u){pk2(v[0], v[1]), pk2(v[2], v[3])}; }
        }
        __syncthreads();
        f32x16 o0, o1;
#pragma unroll
        for (int e = 0; e < 16; ++e) { o0[e] = 0.f; o1[e] = 0.f; }
        if (!(skip & 2)) {
#pragma unroll
        for (int ih = 0; ih < 2; ++ih) {
            bf16x8 qa[2][2][2];
#pragma unroll
            for (int ii = 0; ii < 2; ++ii)
#pragma unroll
                for (int s = 0; s < 2; ++s) { const int d0 = 32 * (2 * ih + ii) + 16 * s + 4 * hh;
                    qa[ii][s][0] = lds_frag8x2(lds + G_QT + r * G_QP + d0 * 2, 16); qa[ii][s][1] = lds_frag8x2(lds + G_QT + (32 + r) * G_QP + d0 * 2, 16); }
            __builtin_amdgcn_sched_barrier(0);
#pragma unroll
            for (int ii = 0; ii < 2; ++ii)
#pragma unroll
                for (int s = 0; s < 2; ++s) { const int i = 2 * ih + ii;
                    v4u pw;
#pragma unroll
                    for (int j = 0; j < 4; ++j) pw[j] = pk2(S[i][8 * s + 2 * j], S[i][8 * s + 2 * j + 1]);
                    const bf16x8 sb = __builtin_bit_cast(bf16x8, pw);
                    o0 = MFMA32(qa[ii][s][0], sb, o0); o1 = MFMA32(qa[ii][s][1], sb, o1); }
            __builtin_amdgcn_sched_barrier(0);
        }
        bf16x8 vf[4], at0[2], at1[4];
#pragma unroll
        for (int ks = 0; ks < 4; ++ks) vf[ks] = lds_frag16(lds + G_VT + (32 * wave + r) * G_TP + ks * 32 + 16 * hh);
#pragma unroll
        for (int ks = 0; ks < 2; ++ks) at0[ks] = lds_frag16(lds + G_AT + r * G_TP + ks * 32 + 16 * hh);
#pragma unroll
        for (int ks = 0; ks < 4; ++ks) at1[ks] = lds_frag16(lds + G_AT + (32 + r) * G_TP + ks * 32 + 16 * hh);
        __builtin_amdgcn_sched_barrier(0);
#pragma unroll
        for (int ks = 0; ks < 2; ++ks) o0 = MFMA32(at0[ks], vf[ks], o0);
#pragma unroll
        for (int ks = 0; ks < 4; ++ks) o1 = MFMA32(at1[ks], vf[ks], o1);
        __builtin_amdgcn_sched_barrier(0);
#pragma unroll
        for (int ih = 0; ih < 2; ++ih) {
            bf16x8 kf[2][4]; f32x4 dc[2][4];
#pragma unroll
            for (int ii = 0; ii < 2; ++ii) { const int i = 2 * ih + ii;
#pragma unroll
                for (int ks = 0; ks < 4; ++ks) kf[ii][ks] = lds_frag16(lds + G_KDT + (32 * i + r) * G_TP + ks * 32 + 16 * hh);
#pragma unroll
                for (int g = 0; g < 4; ++g) dc[ii][g] = *(LAS const f32x4*)(lds + G_DEC + (32 * i + 8 * g + 4 * hh) * 4); }
            __builtin_amdgcn_sched_barrier(0);
#pragma unroll
            for (int ii = 0; ii < 2; ++ii) { const int i = 2 * ih + ii;
#pragma unroll
                for (int g = 0; g < 4; ++g) { S[i][4 * g] *= dc[ii][g].x; S[i][4 * g + 1] *= dc[ii][g].y; S[i][4 * g + 2] *= dc[ii][g].z; S[i][4 * g + 3] *= dc[ii][g].w; }
#pragma unroll
                for (int ks = 0; ks < 4; ++ks) S[i] = MFMA32(kf[ii][ks], vf[ks], S[i]); }
            __builtin_amdgcn_sched_barrier(0);
        }
        }
        __syncthreads();
        if (!(skip & 1)) {
#pragma unroll
        for (int e = 0; e < 16; ++e) { const int c = (e & 3) + 8 * (e >> 2) + 4 * hh;
            *(LAS float*)(lds + G_OB + c * G_OP + wave * G_OC + r * 4) = o0[e]; *(LAS float*)(lds + G_OB + (32 + c) * G_OP + wave * G_OC + r * 4) = o1[e]; }
        }
        __syncthreads();
        if (!(skip & 1))
        {
            int t5 = tid; asm volatile("" : "+v"(t5)); const int c = t5 >> 3, p = t5 & 7;
            f32x4 ov[8]; float ss = 0.f;
#pragma unroll
            for (int j = 0; j < 8; ++j) { ov[j] = *(LAS const f32x4*)(lds + G_OB + c * G_OP + p * G_OC + 16 * j); ss += (ov[j].x * ov[j].x + ov[j].y * ov[j].y) + (ov[j].z * ov[j].z + ov[j].w * ov[j].w); }
            ss += __shfl_xor(ss, 1); ss += __shfl_xor(ss, 2); ss += __shfl_xor(ss, 4);
            const float rstd = 1.0f / sqrtf(ss * (1.f / 256.f) + NORM_EPS);
            bf16* yp = mix + (size_t)(b * SEQ + n * 64 + c) * DM + h * 256 + 32 * p;
#pragma unroll
            for (int j = 0; j < 4; ++j) { const f32x4 w0 = *(LAS const f32x4*)(lds + G_NW + (32 * p + 8 * j) * 4), w1 = *(LAS const f32x4*)(lds + G_NW + (32 * p + 8 * j + 4) * 4); const f32x4 x0 = ov[2 * j], x1 = ov[2 * j + 1];
                float gf[8];
#pragma unroll
                for (int e = 0; e < 4; ++e) { gf[2 * e] = bf_lo(gq[j][e]); gf[2 * e + 1] = bf_hi(gq[j][e]); }
                float y[8];
#pragma unroll
                for (int e = 0; e < 4; ++e) { y[e] = x0[e] * rstd * w0[e]; y[4 + e] = x1[e] * rstd * w1[e]; }
#pragma unroll
                for (int e = 0; e < 8; ++e) y[e] = y[e] * gf[e] * __builtin_amdgcn_rcpf(1.f + __expf(-gf[e]));
                *(v4u*)(yp + 8 * j) = (v4u){pk2(y[0], y[1]), pk2(y[2], y[3]), pk2(y[4], y[5]), pk2(y[6], y[7])}; }
        }
        __syncthreads();
#pragma unroll
        for (int i = 0; i < 8; ++i) gv[i] = gvn[i];
    }
#undef GLA_LOADG
}

typedef swa::BlockRef<swa::bf16, swa::bf16> ABlk;
constexpr int N_GLA = BATCH * 4, N_ATT = BATCH * 16 * (SEQ / 256);
DI ABlk attn_ref(GAS unsigned char* ws, int a) {
    const int qb = (SEQ / 256 - 1) - (a >> 8), rest = a & 255, bb = rest >> 4, vh = rest & 15, hd = vh >> 2, c = (vh >> 1) & 1, vhalf = vh & 1;
    const swa::bf16* proj = (const swa::bf16*)(ws + WS_PROJ); swa::bf16* O = (swa::bf16*)(ws + WS_O);
    ABlk R;
    R.Q = proj + (size_t)(bb * SEQ + qb * 256) * NPROJ + C_DQ + (hd * 2 + c) * 128;
    R.K = proj + (size_t)(bb * SEQ) * NPROJ + C_DK + (hd * 2 + c) * 128;
    R.V = proj + (size_t)(bb * SEQ) * NPROJ + C_DV + hd * 256 + vhalf * 128;
    R.O = O + (size_t)(bb * SEQ + qb * 256) * 2048 + (hd * 2 + c) * 256 + vhalf * 128;
    R.P0 = qb * 256;
    return R;
}
DI int q_next(Frame& F, gu32* head) {
    if (threadIdx.x == 0) F.MISC[16] = __hip_atomic_fetch_add(head, 1u, RLX_AGENT);
    __syncthreads(); const int v = (int)F.MISC[16]; __syncthreads();
    return __builtin_amdgcn_readfirstlane(v);
}
DI void mixer_phase(Frame& F, int qi, int L, char* lds_generic) {
    gu32* head = F.ctl + CW_Q + 64 * qi;
    GAS unsigned char* ws = ws_opaque(F);
    const int G = F.G;
    int it = (int)blockIdx.x;
    const int NCV = (L == 0 && qi == 0) ? N_CONV * (PROBE_DUP == 12 ? 2 : 1) : 0, NCVP = NCV * CONV_EVERY, N_ITEMS = N_GLA + NCV + N_ATT;
    static_assert((long)N_CONV * (PROBE_DUP == 12 ? 2 : 1) * (CONV_EVERY - 1) <= N_ATT, "the conversion items must run out before the attention blocks do");
#define Q_NEXT() (G + q_next(F, head))
#define IS_CONV(p_) ((p_) < NCVP && ((p_) % CONV_EVERY) == 0)
#define ATT_IDX(p_) ((p_) < NCVP ? (p_) - (p_) / CONV_EVERY - 1 : (p_) - NCV)
    while (it < N_GLA) { _Pragma("unroll 1") for (int gr = (PROBE_DUP == 10) ? 1 : 0; gr >= 0; --gr) gla_unit(F, L, it, gr ? GLA_SKIP : 0); it = Q_NEXT(); }
#pragma unroll 1
    while (it < N_ITEMS) {
        const int p = it - N_GLA;
        if (IS_CONV(p)) { conv_item(F, (p / CONV_EVERY) % N_CONV); it = Q_NEXT(); continue; }
        ABlk cur = attn_ref(ws, ATT_IDX(p));
        unsigned pend0 = 0u;
        if (threadIdx.x == 0) pend0 = __hip_atomic_fetch_add(head, 1u, RLX_AGENT);
        swa::Seam<swa::bf16> S;
        swa::causal_swa_prime<swa::bf16, swa::bf16>(cur, SEQ, lds_generic, S);
        if (threadIdx.x == 0) F.MISC[20] = pend0;
        __syncthreads();
        int nx = G + __builtin_amdgcn_readfirstlane((int)F.MISC[20]);
        for (;;) {
            const int pn = nx - N_GLA;
            const bool last = nx >= N_ITEMS || IS_CONV(pn);
            const ABlk nxt = last ? cur : attn_ref(ws, ATT_IDX(pn));
            unsigned pend = 0u;
            if (!last && threadIdx.x == 0) pend = __hip_atomic_fetch_add(head, 1u, RLX_AGENT);
            swa::causal_swa_block<swa::bf16, swa::bf16>(cur, nxt, SEQ, SEQ, lds_generic, S);
            if (last) break;
            if (threadIdx.x == 0) F.MISC[20] = pend;
            __syncthreads();
            cur = nxt; nx = G + __builtin_amdgcn_readfirstlane((int)F.MISC[20]);
        }
        it = nx;
    }
#undef IS_CONV
#undef ATT_IDX
#undef Q_NEXT
}


template <class Sched> DI void rstd_tables(Frame& F, const Sched& S, const float* ss, LAS float* rt) {
    constexpr int RT_SHIFT = Sched::RT_SHIFT, RT_SLOTS = Sched::RT_SLOTS;
    const int t = opaque_tid();
    pg8::Unit u; int tag[RT_SLOTS];
#pragma unroll
    for (int s = 0; s < RT_SLOTS; ++s) tag[s] = -2;
    for (int i = 0; S.next(i, u); ++i) { const int sl = (u.pm >> RT_SHIFT) & (RT_SLOTS - 1);
#pragma unroll
        for (int s = 0; s < RT_SLOTS; ++s) if (s == sl) tag[s] = (tag[s] == -2 || tag[s] == u.pm) ? u.pm : -1; }
#pragma unroll
    for (int slot = 0; slot < RT_SLOTS; ++slot) { const int pm = tag[slot];
        if (pm >= 0 && t < 256) { const f32x4* p = (const f32x4*)(ss + (size_t)(pm * 256 + t) * 8); const f32x4 a = p[0], b = p[1];
            rt[slot * 256 + t] = __builtin_amdgcn_rsqf((((a[0] + a[1]) + (a[2] + a[3])) + ((b[0] + b[1]) + (b[2] + b[3]))) * (1.0f / DM) + NORM_EPS); }
        if (t == 0) ((LAS int*)(rt + RT_SLOTS * 256))[slot] = pm; }
    __syncthreads();
}

DI int virt_c(Frame& F) {
    if (MK_SPLIT) return (int)blockIdx.x;
    bool ok = (F.G % 8) == 0;
#pragma unroll
    for (int j = 0; j < 8; ++j) ok = ok && (__hip_atomic_load(F.ctl + CW_VC + 64 * j, RLX_AGENT) == (unsigned)(F.G / 8));
    const int v = (int)(F.MISC[24] + 8u * F.MISC[25]);
    return __builtin_amdgcn_readfirstlane(ok ? v : (int)blockIdx.x);
}

__global__ void __launch_bounds__(NWAVES * 64, 2) fwd(Args args) {
    extern __shared__ __attribute__((aligned(16))) unsigned char lds[];
    Frame F;
    F.lds = (LAS unsigned char*)lds;
    F.MISC = (volatile LAS unsigned*)(F.lds + MISC_OFF);
    F.G = gridDim.x; F.NGW = F.G * NWAVES;
    F.ws = args.ws; F.ctl = (gu32*)(args.ws + WS_CTL);
    for (int u = threadIdx.x; u < (LDS_BYTES - LDSCTL_OFF) / 4; u += NWAVES * 64) ((LAS unsigned*)(F.lds + LDSCTL_OFF))[u] = 0u;
    __syncthreads();
    if (!MK_SPLIT && threadIdx.x == 0) { const unsigned x = xb_xcc_id(); F.MISC[24] = x; F.MISC[25] = __hip_atomic_fetch_add(F.ctl + CW_VC + 64 * (x & 15u), 1u, RLX_AGENT); }
    XcdBarrier bar; bar.bar = (unsigned*)(F.ctl + CW_BAR); bar.x = 0; bar.st = nullptr;
    if (!MK_SPLIT) bar = xcd_barrier_post((unsigned*)(F.ctl + CW_BAR), F.MISC + 8);
#define GRID_BAR() do { if (!MK_SPLIT) { _Pragma("unroll 1") for (int br_ = (PROBE_DUP == 11) ? 1 : 0; br_ >= 0; --br_) { XcdBarrier b2_ = bar; GAS unsigned* bp_ = (GAS unsigned*)bar.bar; asm volatile("" : "+s"(bp_), "+s"(b2_.x)); b2_.bar = (unsigned*)bp_; xcd_barrier(b2_); } } } while (0)
    const int lo = args.ph_lo, hi = args.ph_hi;
#define IN(k) (lo <= (k) && (k) < hi)
#define BOTH(k) (IN(k) && IN((k) + 1))

#ifndef REV_DN
#define REV_DN 0
#endif
#ifndef STAGGER_US
#define STAGGER_US 0
#endif
#define STAGGER() do { if (STAGGER_US && (blockIdx.x & 1)) { const unsigned long long t0_ = __builtin_amdgcn_s_memrealtime(); while (__builtin_amdgcn_s_memrealtime() - t0_ < (unsigned long long)(STAGGER_US * 100)) __builtin_amdgcn_s_sleep(8); } } while (0)
#define NREP(k) ((PROBE_DUP == (k)) ? 2 : 1)
#define REPLOOP(k) _Pragma("unroll 1") for (int rep = NREP(k) - 1; rep >= 0; --rep)
#define REPBAR() do { if (rep) GRID_BAR(); } while (0)
    if (IN(0)) { REPLOOP(9) { p0_prologue(F); REPBAR(); } if (BOTH(0)) GRID_BAR(); }
    const int vc = (!MK_SPLIT && lo == 0) ? virt_c(F) : (int)blockIdx.x;
#pragma unroll 1
    for (int L = 0; L < DEPTH; ++L) {
        const int pb = 1 + L * PH_PER_LAYER;
        if (IN(pb + 0)) { REPLOOP(2) {
            GAS unsigned char* ws = ws_opaque(F);
            typedef pg8::Gemm<M, NPROJ, DM> GT; typedef pg8::StaticOrder<M, GATE_ITEMS ? NPROJ - 512 : NPROJ, WGM_IN, false, GATE_ITEMS ? C_GATE / 256 : (1 << 30), GATE_ITEMS ? 2 : 0> ST;     GT g{(const bf16*)OUTP(), (const bf16*)(ws + WS_WIN) + (size_t)L * NPROJ * DM}; ST S; S.init(F.G, vc);
            rstd_tables(F, S, (const float*)(ws + WS_SS) + (size_t)(2 * L) * M * 8, (LAS float*)(F.lds + RT_OFF));
            typedef pg8::EpiProj<NPROJ, DM, C_GATE / 256, C_DQ / 256, C_DK / 256, C_DV / 256, ST::RT_SHIFT, ST::RT_SLOTS> ET; ET E{(bf16*)(ws + WS_PROJ), (const float*)(ws + WS_BIAS) + L * NPROJ, (const LAS float*)(F.lds + RT_OFF), (const float*)(ws + WS_SS) + (size_t)(2 * L) * M * 8,
                INP(float, I_QNW) + L * 128, INP(float, I_KNW) + L * 128, (const unsigned*)(ws + WS_ROPE), (LAS float*)(F.lds + RED_OFF)};
            STAGGER(); pg8::gemm_phase<ET, ST, GT, true, true>(F.lds + RING_OFF, g, S, E); if (GATE_ITEMS) gate_item(F, L, (vc & 7) * 32 + (vc >> 3));      REPBAR(); }
            if (BOTH(pb + 0)) GRID_BAR();
        }
        if (IN(pb + 1)) {
            REPLOOP(3) { mixer_phase(F, L + 2 * rep, L, (char*)lds + RING_OFF); REPBAR(); }
            if (BOTH(pb + 1)) GRID_BAR(); }
        if (IN(pb + 2)) { REPLOOP(4) { combine_phase(F, L); REPBAR(); } if (BOTH(pb + 2)) GRID_BAR(); }
        if (IN(pb + 3)) { REPLOOP(5) {
            GAS unsigned char* ws = ws_opaque(F);
            typedef pg8::Gemm<M, DM, DM> GT; typedef pg8::StaticOrder<M, DM, WGM_OUT> ST; GT g{(const bf16*)(ws + WS_XN), (const bf16*)(ws + WS_WOUT) + (size_t)L * DM * DM}; ST S; S.init(F.G, vc);
            typedef pg8::EpiRes<DM, false> ET; ET E{(const bf16*)OUTP(), nullptr, (bf16*)(ws + (rep ? WS_HID : WS_XB2)), (float*)(ws + WS_SS) + (size_t)(rep ? 4 : 2 * L + 1) * M * 8, (LAS float*)(F.lds + RED_OFF)};
            STAGGER(); pg8::gemm_phase<ET, ST, GT, true, true>(F.lds + RING_OFF, g, S, E); REPBAR(); }
            if (BOTH(pb + 3)) GRID_BAR();
        }
        if (IN(pb + 4)) { REPLOOP(7) {
            GAS unsigned char* ws = ws_opaque(F);
            typedef pg8::Gemm<M, DFF, DM> GT; typedef pg8::StaticOrder<M, DFF, WGM_UP> ST; GT g{(const bf16*)(ws + WS_XB2), (const bf16*)(ws + WS_WUP) + (size_t)L * DFF * DM}; ST S; S.init(F.G, vc);
            rstd_tables(F, S, (const float*)(ws + WS_SS) + (size_t)(2 * L + 1) * M * 8, (LAS float*)(F.lds + RT_OFF));
            typedef pg8::EpiBf16<2, DFF, DM, ST::RT_SHIFT, ST::RT_SLOTS, HID_TILED != 0> ET; ET E{(bf16*)(ws + WS_HID), nullptr, (const LAS float*)(F.lds + RT_OFF), (const float*)(ws + WS_SS) + (size_t)(2 * L + 1) * M * 8};
            STAGGER(); pg8::gemm_phase<ET, ST, GT, true, true>(F.lds + RING_OFF, g, S, E); REPBAR(); }
            if (BOTH(pb + 4)) GRID_BAR();
        }
        if (IN(pb + 5)) { REPLOOP(8) {
            GAS unsigned char* ws = ws_opaque(F);
            typedef pg8::Gemm<M, DM, DFF, HID_TILED != 0> GT; typedef pg8::StaticOrder<M, DM, WGM_DN, (REV_DN != 0)> ST; GT g{(const bf16*)(ws + WS_HID), (const bf16*)(ws + WS_WDN) + (size_t)L * DM * DFF}; ST S; S.init(F.G, vc);
            if (L + 1 < DEPTH) { typedef pg8::EpiRes<DM, false> ET; ET E{(const bf16*)(ws + WS_XB2), nullptr, (bf16*)OUTP(), (float*)(ws + WS_SS) + (size_t)(2 * L + 2) * M * 8, (LAS float*)(F.lds + RED_OFF)};
                STAGGER(); pg8::gemm_phase<ET, ST, GT, true, true>(F.lds + RING_OFF, g, S, E); }
            else { typedef pg8::EpiRes<DM, true> ET; ET E{(const bf16*)(ws + WS_XB2), OUTP(), nullptr, nullptr, nullptr};
                STAGGER(); pg8::gemm_phase<ET, ST, GT, true, true>(F.lds + RING_OFF, g, S, E); }
            REPBAR(); }
            if (BOTH(pb + 5)) GRID_BAR();
        }
    }
#undef IN
#undef BOTH
}

extern "C" void kernel_launch(void* const* d_in, const int* in_sizes, int n_in, void* d_out, int out_size, void* d_ws, size_t ws_size, hipStream_t stream) {
    static int grid = 0;
    if (grid == 0) {
        if (n_in != 18 || in_sizes[0] != M * DM || out_size != M * DM || ws_size < WS_END) { fprintf(stderr, "kernel_launch: built for 18 inputs, x/out of %d floats, >= %zu bytes of workspace; got n_in %d, in0 %d, out %d, ws %zu; nothing launched\n", M * DM, (size_t)WS_END, n_in, n_in > 0 ? in_sizes[0] : -1, out_size, ws_size); grid = -1; return; }
        int dev = 0, cus = 0, per_cu = 0;
        if (hipGetDevice(&dev) != hipSuccess || hipDeviceGetAttribute(&cus, hipDeviceAttributeMultiprocessorCount, dev) != hipSuccess) { fprintf(stderr, "kernel_launch: hipGetDevice / hipDeviceGetAttribute failed; nothing launched\n"); grid = -1; return; }
        if (hipFuncSetAttribute((const void*)fwd, hipFuncAttributeMaxDynamicSharedMemorySize, LDS_BYTES) != hipSuccess) { fprintf(stderr, "kernel_launch: hipFuncSetAttribute failed\n"); grid = -1; return; }
        if (hipOccupancyMaxActiveBlocksPerMultiprocessor(&per_cu, (const void*)fwd, NWAVES * 64, LDS_BYTES) != hipSuccess || per_cu < 1) fprintf(stderr, "kernel_launch: note: occupancy query reports %d workgroups per CU\n", per_cu);
        (void)hipGetLastError();
        grid = cus;
        if (cus != 256) { fprintf(stderr, "kernel_launch: built for a 256-CU device (one workgroup per CU; the per-phase row-statistics tables assume the static unit order of a 256-workgroup grid); found %d CUs; nothing launched\n", cus); grid = -1; return; }
    }
    if (grid < 0) return;
    if (hipMemsetAsync((char*)d_ws + WS_CTL, 0, CTL_ZERO_BYTES, stream) != hipSuccess) { fprintf(stderr, "kernel_launch: hipMemsetAsync failed; nothing launched\n"); return; }
    Args a{};
    for (int i = 0; i < 18; ++i) a.in[i] = d_in[i];
    a.out = (float*)d_out; a.ws = (unsigned char*)d_ws;
#if MK_SPLIT
    for (int p = 0; p < N_PHASES; ++p) { a.ph_lo = p; a.ph_hi = p + 1; hipLaunchKernelGGL(fwd, dim3(grid), dim3(NWAVES * 64), LDS_BYTES, stream, a); }
#else
    a.ph_lo = 0; a.ph_hi = N_PHASES; hipLaunchKernelGGL(fwd, dim3(grid), dim3(NWAVES * 64), LDS_BYTES, stream, a);
#endif
    const hipError_t le = hipPeekAtLastError();
    if (le != hipSuccess) fprintf(stderr, "kernel_launch: launch failed: %s\n", hipGetErrorName(le));
}
```

```cpp
#include <hip/hip_runtime.h>
#include <hip/hip_bf16.h>
#include <cstdio>
#include <cstdint>
#include <cmath>
namespace pg8 {
#define PG8_LAS __attribute__((address_space(3)))
typedef unsigned short bf16_t;
typedef short bf16x8 __attribute__((ext_vector_type(8)));
typedef float f32x4 __attribute__((ext_vector_type(4)));
typedef unsigned u32x4 __attribute__((ext_vector_type(4)));
constexpr int BM = 256, BK = 64, HALF = 128, HTB = HALF * BK * 2  , STAGE_BYTES = 8 * HTB, NXCD = 8, WGM = 4;

__host__ __device__ __forceinline__ int lds_byte(int r, int c) { const int st = (r >> 4) * 2 + (c >> 5), rr = r & 15, cc = c & 31, ob = rr * 64 + cc * 2; return st * 1024 + (ob ^ (((ob >> 9) & 1) << 5)); }
__host__ __device__ __forceinline__ void stage_rc(int b, int& R, int& C) { const int st = b / 1024, sb = b % 1024, swz = sb ^ (((sb >> 9) & 1) << 5); R = (st >> 1) * 16 + swz / 64; C = (st & 1) * 32 + (swz % 64) / 2; }
__host__ __device__ __forceinline__ int perm32(int rho) { const int n = rho >> 4, i = rho & 15; return 8 * (i >> 2) + 4 * n + (i & 3); }

struct Unit { int pm, pn; };
template <int M_, int N_, int K_, bool A_TILED_ = false> struct Gemm { const bf16_t* A; const bf16_t* Bt; static constexpr int M = M_, N = N_, K = K_; static constexpr bool A_TILED = A_TILED_; };

template <int M_, int N_, int WGM_ = WGM, bool REV_ = false, int GAP_AT_ = 1 << 30, int GAP_N_ = 0> struct StaticOrder {
    static constexpr int WGM = WGM_, RT_SHIFT = (WGM_ == 2) ? 1 : (WGM_ == 4) ? 2 : (WGM_ == 8) ? 3 : 4, RT_SLOTS = (16 / WGM_) < 1 ? 1 : (16 / WGM_);
    static constexpr int nM = M_ / BM, nN = N_ / BM, nwg = nM * nN;
    int G, c;
    __host__ __device__ void init(int G_, int c_) { G = G_; c = c_; }
    __host__ __device__ bool next(int i, Unit& u) const {
        const int nr = nwg / G; const bool rev = REV_ && (nwg % G) == 0; if (rev && i >= nr) return false;
        const long L = (long)(rev ? nr - 1 - i : i) * G + c; if (L >= nwg) return false;
        int wgid = (int)L; { constexpr int q = nwg / NXCD, r = nwg % NXCD; const int xcd = wgid % NXCD, off = wgid / NXCD; wgid = (xcd < r ? xcd * (q + 1) : r * (q + 1) + (xcd - r) * q) + off; }
        constexpr int nig = WGM * nN; const int gid = wgid / nig, fm = gid * WGM, gsz = (nM - fm) < WGM ? (nM - fm) : WGM;
        u.pm = fm + ((wgid % nig) % gsz); u.pn = (wgid % nig) / gsz; if (u.pn >= GAP_AT_) u.pn += GAP_N_; return true;
    }
    __device__ __forceinline__ void a_ready(const Unit&) const {}
    __device__ __forceinline__ void done(const Unit&) const {}
};
__device__ __forceinline__ unsigned cvt_pk_bf16(float lo, float hi) { unsigned r; asm volatile("v_cvt_pk_bf16_f32 %0, %1, %2" : "=v"(r) : "v"(lo), "v"(hi)); return r; }
typedef float f32x2 __attribute__((ext_vector_type(2)));
#ifndef PG8_NT_STORE
#define PG8_NT_STORE 0
#endif
__device__ __forceinline__ float sum_fq(float s) {
    { auto r = __builtin_amdgcn_permlane16_swap(__float_as_uint(s), __float_as_uint(s), false, false); s = __uint_as_float(r[0]) + __uint_as_float(r[1]); }
    { auto r = __builtin_amdgcn_permlane32_swap(__float_as_uint(s), __float_as_uint(s), false, false); s = __uint_as_float(r[0]) + __uint_as_float(r[1]); }
    return s; }
__device__ __forceinline__ float h2f_lo(unsigned u) { return (float)__builtin_bit_cast(_Float16, (unsigned short)(u & 0xffffu)); }
__device__ __forceinline__ float h2f_hi(unsigned u) { return (float)__builtin_bit_cast(_Float16, (unsigned short)(u >> 16)); }
__device__ __forceinline__ void st16(bf16_t* p, u32x4 w) { if (PG8_NT_STORE) __builtin_nontemporal_store(w, (u32x4*)p); else *(u32x4*)p = w; }
template <int ACT, int ldc, int KN, int RT_SHIFT, int RT_SLOTS, bool OTILED = false> struct EpiBf16 {
    static constexpr bool PERM = true, AFTER_DRAIN = false;
    bf16_t* O; const float* bias; const PG8_LAS float* rt; const float* ss;
    __device__ __forceinline__ void operator()(const f32x4 (&acc)[2][2][4][2], const Unit& u, int wr, int wc, int fr, int fq) const {
        const int row0 = u.pm * BM + wr * 64 + fr; const int col0 = u.pn * BM + wc * 32 + 8 * fq;
        f32x4 bv[2][2];
#pragma unroll
        for (int bj = 0; bj < 2; ++bj)
#pragma unroll
            for (int n = 0; n < 2; ++n) bv[bj][n] = bias ? *(const f32x4*)(bias + col0 + bj * HALF + 4 * n) : (f32x4){0.f, 0.f, 0.f, 0.f};
        float rs[2][4];
#pragma unroll
        for (int ai = 0; ai < 2; ++ai)
#pragma unroll
            for (int m = 0; m < 4; ++m) rs[ai][m] = rt[((u.pm >> RT_SHIFT) & (RT_SLOTS - 1)) * BM + wr * 64 + fr + ai * HALF + m * 16];
        if (((const PG8_LAS int*)(rt + RT_SLOTS * BM))[(u.pm >> RT_SHIFT) & (RT_SLOTS - 1)] != u.pm) {
#pragma unroll
            for (int ai = 0; ai < 2; ++ai)
#pragma unroll
                for (int m = 0; m < 4; ++m) rs[ai][m] = __builtin_nanf("");
        }
#pragma unroll
        for (int ai = 0; ai < 2; ++ai)
#pragma unroll
            for (int m = 0; m < 4; ++m) { bf16_t* rowp = OTILED ? O + ((size_t)(u.pm * (ldc / 64) + u.pn * 4 + (wc >> 1)) * (BM * 64) + (wr * 64 + fr + ai * HALF + m * 16) * 64 + (wc & 1) * 32 + 8 * fq)
                                                                : O + (size_t)(row0 + ai * HALF + m * 16) * ldc + col0;
                const float rstd = rs[ai][m];
#pragma unroll
                for (int bj = 0; bj < 2; ++bj) { f32x4 v0 = acc[ai][bj][m][0] * rstd + bv[bj][0], v1 = acc[ai][bj][m][1] * rstd + bv[bj][1];
                    if (ACT == 2) {
#pragma unroll
                        for (int e = 0; e < 4; ++e) { const float a = fmaxf(v0[e], 0.f), b = fmaxf(v1[e], 0.f); v0[e] = a * a; v1[e] = b * b; } }
                    u32x4 w; w.x = cvt_pk_bf16(v0[0], v0[1]); w.y = cvt_pk_bf16(v0[2], v0[3]); w.z = cvt_pk_bf16(v1[0], v1[1]); w.w = cvt_pk_bf16(v1[2], v1[3]);
                    st16(rowp + (OTILED ? bj * 2 * (BM * 64) : bj * HALF), w); } }
    }
};
template <int ldc, int KN, int PNB, int PNQ, int PNK, int PNV, int RT_SHIFT, int RT_SLOTS> struct EpiProj {
    static constexpr bool PERM = true, AFTER_DRAIN = false;
    bf16_t* O; const float* bias; const PG8_LAS float* rt; const float* ss; const float* qw; const float* kw; const unsigned* rope; PG8_LAS float* red;
    __device__ __forceinline__ void operator()(const f32x4 (&acc)[2][2][4][2], const Unit& u, int wr, int wc, int fr, int fq) const {
        const int row0 = u.pm * BM + wr * 64 + fr; const int col0 = u.pn * BM + wc * 32 + 8 * fq;
        float rs[2][4];
#pragma unroll
        for (int ai = 0; ai < 2; ++ai)
#pragma unroll
            for (int m = 0; m < 4; ++m) rs[ai][m] = rt[((u.pm >> RT_SHIFT) & (RT_SLOTS - 1)) * BM + wr * 64 + fr + ai * HALF + m * 16];
        if (((const PG8_LAS int*)(rt + RT_SLOTS * BM))[(u.pm >> RT_SHIFT) & (RT_SLOTS - 1)] != u.pm) {
#pragma unroll
            for (int ai = 0; ai < 2; ++ai)
#pragma unroll
                for (int m = 0; m < 4; ++m) rs[ai][m] = __builtin_nanf("");
        }
        if (u.pn < PNQ || u.pn >= PNV) {
            f32x4 bv[2][2];
#pragma unroll
            for (int bj = 0; bj < 2; ++bj)
#pragma unroll
                for (int n = 0; n < 2; ++n) bv[bj][n] = (f32x4){0.f, 0.f, 0.f, 0.f};
            if (u.pn >= PNB && u.pn < PNQ) {
#pragma unroll
                for (int bj = 0; bj < 2; ++bj)
#pragma unroll
                    for (int n = 0; n < 2; ++n) bv[bj][n] = *(const f32x4*)(bias + col0 + bj * HALF + 4 * n); }
            asm volatile("" ::: "memory");
#pragma unroll
            for (int ai = 0; ai < 2; ++ai)
#pragma unroll
                for (int m = 0; m < 4; ++m) { bf16_t* rowp = O + (size_t)(row0 + ai * HALF + m * 16) * ldc + col0; const float rstd = rs[ai][m];
#pragma unroll
                    for (int bj = 0; bj < 2; ++bj) { const f32x4 v0 = acc[ai][bj][m][0] * rstd + bv[bj][0], v1 = acc[ai][bj][m][1] * rstd + bv[bj][1];
                        u32x4 w; w.x = cvt_pk_bf16(v0[0], v0[1]); w.y = cvt_pk_bf16(v0[2], v0[3]); w.z = cvt_pk_bf16(v1[0], v1[1]); w.w = cvt_pk_bf16(v1[2], v1[3]);
                        st16(rowp + bj * HALF, w); } }
        } else {
            const float* w = (u.pn < PNK) ? qw : kw; const int i0 = 16 * wc + 4 * fq;
            const f32x4 wlo = *(const f32x4*)(w + i0), whi = *(const f32x4*)(w + 64 + i0);
            u32x4 cs[2][4];
#pragma unroll
            for (int ai = 0; ai < 2; ++ai)
#pragma unroll
                for (int m = 0; m < 4; ++m)
#pragma unroll
                    for (int bj = 0; bj < 2; ++bj) { const f32x4 v0 = acc[ai][bj][m][0] * rs[ai][m], v1 = acc[ai][bj][m][1] * rs[ai][m]; const f32x4 q = v0 * v0 + v1 * v1; float s = (q[0] + q[1]) + (q[2] + q[3]);
                        s = sum_fq(s);
                        if (fq == 0) red[((wr * 64 + fr + ai * HALF + m * 16) * 2 + bj) * 4 + wc] = s; }
            asm volatile("s_waitcnt lgkmcnt(0)" ::: "memory"); __builtin_amdgcn_s_barrier(); asm volatile("" ::: "memory");
#pragma unroll
            for (int ai = 0; ai < 2; ++ai)
#pragma unroll
                for (int m = 0; m < 4; ++m) cs[ai][m] = *(const u32x4*)(rope + (size_t)(row0 + ai * HALF + m * 16) * 64 + i0);
#pragma unroll
            for (int ai = 0; ai < 2; ++ai) {
#pragma unroll
                for (int m = 0; m < 4; ++m) { bf16_t* rowp = O + (size_t)(row0 + ai * HALF + m * 16) * ldc + col0; const u32x4 t = cs[ai][m]; const f32x4 cc = {h2f_lo(t.x), h2f_lo(t.y), h2f_lo(t.z), h2f_lo(t.w)}, sn = {h2f_hi(t.x), h2f_hi(t.y), h2f_hi(t.z), h2f_hi(t.w)};
#pragma unroll
                    for (int bj = 0; bj < 2; ++bj) { const f32x4 p = *(const PG8_LAS f32x4*)(red + ((wr * 64 + fr + ai * HALF + m * 16) * 2 + bj) * 4);
                        const float rh = rs[ai][m] * __builtin_amdgcn_rsqf(((p[0] + p[1]) + (p[2] + p[3])) * (1.0f / 128.0f) + 1e-6f);
                        const f32x4 v0 = acc[ai][bj][m][0] * rh, v1 = acc[ai][bj][m][1] * rh;
                        const float a0 = v0[0] * wlo[0], b0 = v0[1] * whi[0], a1 = v0[2] * wlo[1], b1 = v0[3] * whi[1], a2 = v1[0] * wlo[2], b2 = v1[1] * whi[2], a3 = v1[2] * wlo[3], b3 = v1[3] * whi[3];
                        u32x4 o; o.x = cvt_pk_bf16(a0 * cc[0] - b0 * sn[0], a0 * sn[0] + b0 * cc[0]); o.y = cvt_pk_bf16(a1 * cc[1] - b1 * sn[1], a1 * sn[1] + b1 * cc[1]);
                        o.z = cvt_pk_bf16(a2 * cc[2] - b2 * sn[2], a2 * sn[2] + b2 * cc[2]); o.w = cvt_pk_bf16(a3 * cc[3] - b3 * sn[3], a3 * sn[3] + b3 * cc[3]);
                        st16(rowp + bj * HALF, o); } }
                asm volatile("" ::: "memory");
            }
        }
    }
};
template <int ldc, bool FINAL> struct EpiRes {
    static constexpr bool PERM = true, AFTER_DRAIN = false;
    const bf16_t* base; float* out; bf16_t* xb; float* ss; PG8_LAS float* red;
    __device__ __forceinline__ void operator()(const f32x4 (&acc)[2][2][4][2], const Unit& u, int wr, int wc, int fr, int fq) const {
        const int row0 = u.pm * BM + wr * 64 + fr; const int col0 = u.pn * BM + wc * 32 + 8 * fq;
        u32x4 bq[2][4][2];
#pragma unroll
        for (int ai = 0; ai < 2; ++ai)
#pragma unroll
            for (int m = 0; m < 4; ++m) { const size_t off = (size_t)(row0 + ai * HALF + m * 16) * ldc + col0; bq[ai][m][0] = *(const u32x4*)(base + off); bq[ai][m][1] = *(const u32x4*)(base + off + HALF); }
        asm volatile("" ::: "memory");
#pragma unroll
        for (int ai = 0; ai < 2; ++ai)
#pragma unroll
            for (int m = 0; m < 4; ++m) { const size_t off = (size_t)(row0 + ai * HALF + m * 16) * ldc + col0;
                f32x4 x[2][2];
#pragma unroll
                for (int bj = 0; bj < 2; ++bj) { const u32x4 b = bq[ai][m][bj];
                    x[bj][0] = (f32x4){__uint_as_float(b.x << 16), __uint_as_float(b.x & 0xffff0000u), __uint_as_float(b.y << 16), __uint_as_float(b.y & 0xffff0000u)} + acc[ai][bj][m][0];
                    x[bj][1] = (f32x4){__uint_as_float(b.z << 16), __uint_as_float(b.z & 0xffff0000u), __uint_as_float(b.w << 16), __uint_as_float(b.w & 0xffff0000u)} + acc[ai][bj][m][1]; }
                if constexpr (FINAL) {
                    *(f32x4*)(out + off) = x[0][0]; *(f32x4*)(out + off + 4) = x[0][1]; *(f32x4*)(out + off + HALF) = x[1][0]; *(f32x4*)(out + off + HALF + 4) = x[1][1];
                } else {
                    u32x4 w0, w1; w0.x = cvt_pk_bf16(x[0][0][0], x[0][0][1]); w0.y = cvt_pk_bf16(x[0][0][2], x[0][0][3]); w0.z = cvt_pk_bf16(x[0][1][0], x[0][1][1]); w0.w = cvt_pk_bf16(x[0][1][2], x[0][1][3]);
                    w1.x = cvt_pk_bf16(x[1][0][0], x[1][0][1]); w1.y = cvt_pk_bf16(x[1][0][2], x[1][0][3]); w1.z = cvt_pk_bf16(x[1][1][0], x[1][1][1]); w1.w = cvt_pk_bf16(x[1][1][2], x[1][1][3]);
                    *(u32x4*)(xb + off) = w0; *(u32x4*)(xb + off + HALF) = w1;
                    const f32x4 q = x[0][0] * x[0][0] + x[0][1] * x[0][1] + x[1][0] * x[1][0] + x[1][1] * x[1][1]; float s = (q[0] + q[1]) + (q[2] + q[3]);
                    s = sum_fq(s);
                    if (fq == 0) red[(wr * 64 + fr + ai * HALF + m * 16) * 4 + wc] = s; } }
        if constexpr (!FINAL) {
            asm volatile("s_waitcnt lgkmcnt(0)" ::: "memory"); __builtin_amdgcn_s_barrier(); asm volatile("" ::: "memory");
            const int t = threadIdx.x;
            if (t < BM) { const f32x4 p = *(const PG8_LAS f32x4*)(red + t * 4); ss[(size_t)(u.pm * BM + t) * 8 + u.pn] = (p[0] + p[1]) + (p[2] + p[3]); }
        }
    }
};
template <class Epi, class Sched, class GemmT, bool ALIGN_EPI = false, bool SP2 = false>
__device__ __forceinline__ void gemm_phase(PG8_LAS unsigned char* lds, const GemmT g, const Sched& S, const Epi& E) {
    int tid_ = threadIdx.x; asm volatile("" : "+v"(tid_));
    const int tid = tid_, wid = __builtin_amdgcn_readfirstlane(tid >> 6), lane = tid & 63, wr = wid >> 2, wc = wid & 3, fr = lane & 15, fq = lane >> 4;
    constexpr int K = GemmT::K, nt = K / BK;
    unsigned voffA[2], voffB[2];
#pragma unroll
    for (int i = 0; i < 2; ++i) { int R, C; stage_rc(tid * 16 + i * 8192, R, C); const int Rb = Epi::PERM ? ((R & ~31) + perm32(R & 31)) : R;
        voffA[i] = GemmT::A_TILED ? (unsigned)(R * BK + C) * 2u : (unsigned)(R * K + C) * 2u; voffB[i] = (unsigned)(Rb * K + C) * 2u; }
    constexpr size_t kstep = (size_t)(BK * 2);
    constexpr size_t hstep = (size_t)HALF * K * 2;
    constexpr size_t tstep = 2 * hstep;
    constexpr size_t kstepA = GemmT::A_TILED ? (size_t)BM * BK * 2 : kstep, hstepA = GemmT::A_TILED ? (size_t)HALF * BK * 2 : hstep, tstepA = tstep;
    const unsigned ldsw = (unsigned)wid * 1024u;
    const int aoff = lds_byte(wr * 64 + fr, fq * 8), boff = lds_byte(wc * 32 + fr, fq * 8);
#define PG8_SA(b, h) (((b) * 2 + (h)) * HTB)
#define PG8_SB(b, h) ((4 + (b) * 2 + (h)) * HTB)
#define PG8_STAGE(bufoff, gbase, voff) do { const char* gb_ = (const char*)(gbase); asm volatile("" : "+s"(gb_)); _Pragma("unroll") for (int _i = 0; _i < 2; ++_i) \
        __builtin_amdgcn_global_load_lds((const unsigned*)(gb_ + (voff)[_i]), (PG8_LAS unsigned*)(lds + (bufoff) + ldsw + _i * 8192), 16, 0, 0); } while (0)
#define PG8_VOFFS() asm volatile("" : "+v"(voffA[0]), "+v"(voffA[1]), "+v"(voffB[0]), "+v"(voffB[1]))
#define PG8_LDA(dst, b, h) do { _Pragma("unroll") for (int m = 0; m < 4; ++m) _Pragma("unroll") for (int k = 0; k < 2; ++k) dst[m][k] = *(const PG8_LAS bf16x8*)(lds + PG8_SA(b, h) + aoff + m * 2048 + k * 1024); } while (0)
#define PG8_LDB(dst, b, h) do { _Pragma("unroll") for (int n = 0; n < 2; ++n) _Pragma("unroll") for (int k = 0; k < 2; ++k) dst[n][k] = *(const PG8_LAS bf16x8*)(ldsB_ + ((b) * 2 + (h)) * HTB + n * 2048 + k * 1024); } while (0)
#define PG8_MMA(ai, bj, At, Bt) do { __builtin_amdgcn_s_setprio(1); _Pragma("unroll") for (int m = 0; m < 4; ++m) _Pragma("unroll") for (int n = 0; n < 2; ++n) _Pragma("unroll") for (int k = 0; k < 2; ++k) \
        acc[ai][bj][m][n] = __builtin_amdgcn_mfma_f32_16x16x32_bf16(Bt[n][k], At[m][k], acc[ai][bj][m][n], 0, 0, 0); __builtin_amdgcn_s_setprio(0); } while (0)
#define PG8_WAIT_V(n) asm volatile("s_waitcnt vmcnt(" #n ")" ::: "memory")
#define PG8_WAIT_L(n) asm volatile("s_waitcnt lgkmcnt(" #n ")" ::: "memory")
#define PG8_BAR __builtin_amdgcn_s_barrier()
#define PG8_SCHED __builtin_amdgcn_sched_barrier(0)
    PG8_LAS unsigned char* ldsB_ = lds + 4 * HTB + boff; asm volatile("" : "+v"(ldsB_));
    Unit cur, nxt; int ui = 0;
    if (!S.next(0, cur)) return;
    f32x4 acc[2][2][4][2];
#pragma unroll
    for (int a = 0; a < 2; ++a)
#pragma unroll
        for (int b = 0; b < 2; ++b)
#pragma unroll
            for (int m = 0; m < 4; ++m)
#pragma unroll
                for (int n = 0; n < 2; ++n) acc[a][b][m][n] = (f32x4){0.f, 0.f, 0.f, 0.f};
    bf16x8 At[4][2], B0[2][2], B1[2][2];
    const char* cA = (const char*)g.A + (size_t)cur.pm * tstepA; const char* cB = (const char*)g.Bt + (size_t)cur.pn * tstep;
    S.a_ready(cur);
    { PG8_VOFFS();
    if constexpr (SP2) {
        PG8_STAGE(PG8_SB(0, 0), cB, voffB); PG8_STAGE(PG8_SB(0, 1), cB + hstep, voffB); PG8_STAGE(PG8_SA(0, 0), cA, voffA); PG8_STAGE(PG8_SA(0, 1), cA + hstepA, voffA);
        if (wr == 1) PG8_BAR;
        PG8_WAIT_V(2); PG8_BAR;
        PG8_STAGE(PG8_SB(1, 0), cB + kstep, voffB); PG8_STAGE(PG8_SA(1, 0), cA + kstepA, voffA); PG8_STAGE(PG8_SB(1, 1), cB + hstep + kstep, voffB);
        PG8_WAIT_V(6); PG8_BAR;
    } else {
        PG8_STAGE(PG8_SB(0, 0), cB, voffB); PG8_STAGE(PG8_SA(0, 0), cA, voffA); PG8_STAGE(PG8_SB(0, 1), cB + hstep, voffB); PG8_STAGE(PG8_SA(0, 1), cA + hstepA, voffA);
        if (wr == 1) PG8_BAR;
        PG8_WAIT_V(4); PG8_BAR;
        PG8_STAGE(PG8_SB(1, 0), cB + kstep, voffB); PG8_STAGE(PG8_SA(1, 0), cA + kstepA, voffA); PG8_STAGE(PG8_SB(1, 1), cB + hstep + kstep, voffB);
        PG8_WAIT_V(6); PG8_BAR;
    }
    }
    for (;;) {
        const bool has_next = S.next(ui + 1, nxt);
        const char* nA = has_next ? (const char*)g.A + (size_t)nxt.pm * tstepA : cA; const char* nB = has_next ? (const char*)g.Bt + (size_t)nxt.pn * tstep : cB;
        for (int t = 0; t < nt; t += 2) {
            const bool last = (t == nt - 2);
            PG8_VOFFS();
            const char* a1 = cA + (size_t)(t + 1) * kstepA;
            const char* a2 = last ? nA : cA + (size_t)(t + 2) * kstepA; const char* b2 = last ? nB : cB + (size_t)(t + 2) * kstep;
            const char* a3 = a2 + kstepA; const char* b3 = b2 + kstep;
            if (last && has_next) S.a_ready(nxt);
            if constexpr (SP2) {
            PG8_LDB(B0, 0, 0); PG8_LDB(B1, 0, 1); PG8_SCHED; PG8_LDA(At, 0, 0); PG8_STAGE(PG8_SA(1, 1), a1 + hstepA, voffA);
            PG8_WAIT_V(8); PG8_WAIT_L(0); PG8_BAR; PG8_MMA(0, 0, At, B0); PG8_MMA(0, 1, At, B1); PG8_BAR; PG8_SCHED;
            PG8_LDA(At, 0, 1); PG8_STAGE(PG8_SB(0, 0), b2, voffB); PG8_STAGE(PG8_SB(0, 1), b2 + hstep, voffB); PG8_STAGE(PG8_SA(0, 0), a2, voffA);
            PG8_WAIT_V(8); PG8_WAIT_L(0); PG8_BAR; PG8_MMA(1, 0, At, B0); PG8_MMA(1, 1, At, B1); PG8_BAR; PG8_SCHED;
            PG8_LDB(B0, 1, 0); PG8_LDB(B1, 1, 1); PG8_SCHED; PG8_LDA(At, 1, 0); PG8_STAGE(PG8_SA(0, 1), a2 + hstepA, voffA);
            PG8_WAIT_V(8); PG8_WAIT_L(0); PG8_BAR; PG8_MMA(0, 0, At, B0); PG8_MMA(0, 1, At, B1); PG8_BAR; PG8_SCHED;
            PG8_LDA(At, 1, 1); PG8_STAGE(PG8_SB(1, 0), b3, voffB); PG8_STAGE(PG8_SB(1, 1), b3 + hstep, voffB); PG8_STAGE(PG8_SA(1, 0), a3, voffA);
            PG8_WAIT_V(8); PG8_WAIT_L(0); PG8_BAR; PG8_MMA(1, 0, At, B0); PG8_MMA(1, 1, At, B1); PG8_BAR; PG8_SCHED;
            } else {
            PG8_LDB(B0, 0, 0); PG8_SCHED; PG8_LDA(At, 0, 0); PG8_STAGE(PG8_SA(1, 1), a1 + hstepA, voffA);
            PG8_WAIT_L(8); PG8_BAR; PG8_WAIT_L(0); PG8_MMA(0, 0, At, B0); PG8_BAR; PG8_SCHED;
            PG8_LDB(B1, 0, 1); PG8_STAGE(PG8_SB(0, 0), b2, voffB);
            PG8_BAR; PG8_WAIT_L(0); PG8_MMA(0, 1, At, B1); PG8_BAR;
            PG8_LDA(At, 0, 1); PG8_STAGE(PG8_SA(0, 0), a2, voffA);
            PG8_BAR; PG8_WAIT_L(0); PG8_MMA(1, 0, At, B0); PG8_BAR; PG8_SCHED;
            PG8_STAGE(PG8_SB(0, 1), b2 + hstep, voffB);
            PG8_WAIT_V(6); PG8_BAR; PG8_MMA(1, 1, At, B1); PG8_BAR;
            PG8_LDB(B0, 1, 0); PG8_SCHED; PG8_LDA(At, 1, 0); PG8_STAGE(PG8_SA(0, 1), a2 + hstepA, voffA);
            PG8_WAIT_L(8); PG8_BAR; PG8_WAIT_L(0); PG8_MMA(0, 0, At, B0); PG8_BAR; PG8_SCHED;
            PG8_LDB(B1, 1, 1); PG8_STAGE(PG8_SB(1, 0), b3, voffB);
            PG8_BAR; PG8_WAIT_L(0); PG8_MMA(0, 1, At, B1); PG8_BAR;
            PG8_LDA(At, 1, 1); PG8_STAGE(PG8_SA(1, 0), a3, voffA);
            PG8_BAR; PG8_WAIT_L(0); PG8_MMA(1, 0, At, B0); PG8_BAR; PG8_SCHED;
            PG8_STAGE(PG8_SB(1, 1), b3 + hstep, voffB);
            PG8_WAIT_V(6); PG8_BAR; PG8_MMA(1, 1, At, B1); PG8_BAR;
            }
        }
        if constexpr (ALIGN_EPI) { if (wr == 0) PG8_BAR; }
        if constexpr (!Epi::AFTER_DRAIN) { E(acc, cur, wr, wc, fr, fq); S.done(cur); }
        if (!has_next) break;
#pragma unroll
        for (int a = 0; a < 2; ++a)
#pragma unroll
            for (int b = 0; b < 2; ++b)
#pragma unroll
                for (int m = 0; m < 4; ++m)
#pragma unroll
                    for (int n = 0; n < 2; ++n) acc[a][b][m][n] = (f32x4){0.f, 0.f, 0.f, 0.f};
        cur = nxt; cA = nA; cB = nB; ++ui;
        if constexpr (ALIGN_EPI) { if (wr == 1) PG8_BAR; }
    }
    PG8_WAIT_V(0);
    if constexpr (!ALIGN_EPI) { if (wr == 0) PG8_BAR; }
    PG8_BAR;
    if constexpr (Epi::AFTER_DRAIN) { E.fused(acc, cur, wr, wc, fr, fq, lds, wid, lane); S.done(cur); }
#undef PG8_SA
#undef PG8_SB
#undef PG8_STAGE
#undef PG8_VOFFS
#undef PG8_LDA
#undef PG8_LDB
#undef PG8_MMA
#undef PG8_WAIT_V
#undef PG8_WAIT_L
#undef PG8_BAR
#undef PG8_SCHED
}
}
namespace swa {
constexpr int D = 128;
constexpr int KVPITCH = 6656, QPITCH = 6656, OPITCH = 2048;
constexpr float THR = 8.f;
constexpr bool WSKIP = false;
constexpr float SCALE = 0.08838834764831845f;
constexpr int NW = 8, QBLK = 32, KVBLK = 64, QB = NW * QBLK;
constexpr int SHM_V = KVBLK * D * 2, SHM_K = KVBLK * D * 2;
constexpr int LDS_BYTES = 2 * SHM_V + 2 * SHM_K + NW * 64 * 4;
using bf16 = __hip_bfloat16;
typedef short bf16x8 __attribute__((ext_vector_type(8)));
typedef short s16x4 __attribute__((ext_vector_type(4)));
typedef float f32x16 __attribute__((ext_vector_type(16)));
typedef float f32x4 __attribute__((ext_vector_type(4)));
typedef unsigned u32x4 __attribute__((ext_vector_type(4)));
template <class A, class Bt> struct same_t { static constexpr bool v = false; };
template <class A> struct same_t<A, A> { static constexpr bool v = true; };

#define KSWZ(row, colB) ((row) * 256 + ((colB) ^ (((row) & 7) << 4)))
#define SBAR() __builtin_amdgcn_sched_barrier(0)
__device__ __forceinline__ int v_st(int k, int c) { const int kk = (k & ~0xC) | ((k & 4) << 1) | ((k & 8) >> 1); return ((kk >> 3) * 4 + (c >> 5)) * 512 + ((kk & 7) * 32 + (c & 31)) * 2; }
__device__ __forceinline__ int v_rd_base(int lane) { return ((lane & 3) << 3) | (((lane >> 2) & 3) << 6) | (((lane >> 4) & 1) << 5) | (((lane >> 5) & 1) << 8); }
constexpr int v_rd_off(int d0, int ks, int half) { return d0 * 512 + ks * 4096 + half * 2048; }
__device__ __forceinline__ int crow(int r, int hi) { return (r & 3) + 8 * (r >> 2) + 4 * hi; }
__device__ __forceinline__ unsigned cvtpk(float lo, float hi) {
    unsigned r; asm volatile("v_cvt_pk_bf16_f32 %0, %1, %2" : "=v"(r) : "v"(lo), "v"(hi)); return r;
}
__device__ __forceinline__ bf16x8 pack8(f32x4 a, f32x4 b) {
    u32x4 w = {cvtpk(a[0], a[1]), cvtpk(a[2], a[3]), cvtpk(b[0], b[1]), cvtpk(b[2], b[3])};
    return *reinterpret_cast<bf16x8*>(&w);
}
template <class T> __device__ __forceinline__ bf16x8 load8(const T* p) {
    if constexpr (same_t<T, float>::v) { return pack8(*(const f32x4*)p, *(const f32x4*)(p + 4)); }
    else { return *reinterpret_cast<const bf16x8*>(p); }
}
__device__ __forceinline__ void mask_tile(f32x16& p0, f32x16& p1, int dq, unsigned W) {
    const float NEG = -__builtin_inff();
#pragma unroll
    for (int r = 0; r < 16; ++r) {
        const int c = (r & 3) + 8 * (r >> 2);
        if ((unsigned)(dq - c) >= W) p0[r] = NEG;
        if ((unsigned)(dq - c - 32) >= W) p1[r] = NEG;
    }
}
__device__ __forceinline__ void partialSM(f32x16& p0, f32x16& p1, float& m_reg, float& mn, float& alpha) {
    float pmax = p0[0]; for (int r = 1; r < 16; ++r) pmax = fmaxf(pmax, p0[r]); for (int r = 0; r < 16; ++r) pmax = fmaxf(pmax, p1[r]);
    { auto rr = __builtin_amdgcn_permlane32_swap(__float_as_uint(pmax), __float_as_uint(pmax), false, false);
      pmax = fmaxf(__uint_as_float(rr[0]), __uint_as_float(rr[1])); }
    constexpr float C2 = 1.4426950408889634f * SCALE;
    if (__builtin_expect(__all((pmax - m_reg) * SCALE <= THR), 1)) { mn = m_reg; alpha = 1.f; }
    else { mn = fmaxf(m_reg, pmax); alpha = __builtin_amdgcn_exp2f((m_reg - mn) * C2); m_reg = mn; }
    const float mnL = -mn * C2;
    for (int r = 0; r < 16; ++r) p0[r] = fmaf(p0[r], C2, mnL); for (int r = 0; r < 16; ++r) p1[r] = fmaf(p1[r], C2, mnL);
    for (int r = 0; r < 16; ++r) p0[r] = __builtin_amdgcn_exp2f(p0[r]);
}
__device__ __forceinline__ void finishSM(f32x16& p0, f32x16& p1, float alpha, float& l_reg, bf16x8& pa0, bf16x8& pa1, bf16x8& pa2, bf16x8& pa3) {
    for (int r = 0; r < 16; ++r) p1[r] = __builtin_amdgcn_exp2f(p1[r]);
    float ps = 0; for (int r = 0; r < 16; ++r) ps += p0[r]; for (int r = 0; r < 16; ++r) ps += p1[r];
    { auto rr = __builtin_amdgcn_permlane32_swap(__float_as_uint(ps), __float_as_uint(ps), false, false);
      ps = __uint_as_float(rr[0]) + __uint_as_float(rr[1]); }
    l_reg = l_reg * alpha + ps;
#define PK4(P, B_, OUT) do { unsigned a0 = cvtpk(P[B_+0], P[B_+1]), a1 = cvtpk(P[B_+2], P[B_+3]);                          \
        unsigned b0 = cvtpk(P[B_+4], P[B_+5]), b1 = cvtpk(P[B_+6], P[B_+7]);                                             \
        auto r0 = __builtin_amdgcn_permlane32_swap(a0, b0, false, false); auto r1 = __builtin_amdgcn_permlane32_swap(a1, b1, false, false); \
        u32x4 w = {r0[0], r1[0], r0[1], r1[1]}; OUT = *reinterpret_cast<bf16x8*>(&w); } while (0)
    PK4(p0, 0, pa0); PK4(p0, 8, pa1); PK4(p1, 0, pa2); PK4(p1, 8, pa3);
#undef PK4
}
template <int KB, bool SK>
__device__ __forceinline__ void qkt(f32x16& p0, f32x16& p1, const char* K_lds, int r32, int hi, const bf16x8* qr, bool act) {
    if (SK && !act) { const float NEG = -__builtin_inff();
#pragma unroll
        for (int r = 0; r < 16; ++r) { p0[r] = NEG; p1[r] = NEG; } return; }
    p0 = f32x16{}; p1 = f32x16{};
    const char* kb[4];
#pragma unroll
    for (int dd = 0; dd < 4; ++dd) kb[dd] = K_lds + KB * SHM_K + KSWZ(r32, (dd * 16 + hi * 8) * 2);
#pragma unroll
    for (int d0 = 0; d0 < 8; ++d0) { const char* a = kb[d0 & 3] + (d0 >> 2) * 128;
        bf16x8 b0 = *reinterpret_cast<const bf16x8*>(a);
        bf16x8 b1 = *reinterpret_cast<const bf16x8*>(a + 32 * 256);
        p0 = __builtin_amdgcn_mfma_f32_32x32x16_bf16(b0, qr[d0], p0, 0, 0, 0);
        p1 = __builtin_amdgcn_mfma_f32_32x32x16_bf16(b1, qr[d0], p1, 0, 0, 0); }
}
template <int VB, bool SK>
__device__ __forceinline__ void pv_tile(f32x16* o, int vb0, bf16x8 pa0, bf16x8 pa1, bf16x8 pa2, bf16x8 pa3, bool act) {
    if (SK && !act) return;
#define TRRD(dst, off) asm volatile("ds_read_b64_tr_b16 %0, %1 offset:%2" : "=&v"(dst) : "v"(vb0), "i"(off) : "memory")
#define PV_D0(d0) do { s16x4 l0, l1, l2, l3, h0, h1, h2, h3; constexpr int b_ = VB * SHM_V + v_rd_off(d0, 0, 0);     \
        TRRD(l0, b_); TRRD(h0, b_ + 2048); TRRD(l1, b_ + 4096); TRRD(h1, b_ + 6144); TRRD(l2, b_ + 8192); TRRD(h2, b_ + 10240); TRRD(l3, b_ + 12288); TRRD(h3, b_ + 14336); \
        asm volatile("s_waitcnt lgkmcnt(0)" ::: "memory"); SBAR();                 \
        o[d0] = __builtin_amdgcn_mfma_f32_32x32x16_bf16(pa0, (bf16x8){l0[0], l0[1], l0[2], l0[3], h0[0], h0[1], h0[2], h0[3]}, o[d0], 0, 0, 0);   \
        o[d0] = __builtin_amdgcn_mfma_f32_32x32x16_bf16(pa1, (bf16x8){l1[0], l1[1], l1[2], l1[3], h1[0], h1[1], h1[2], h1[3]}, o[d0], 0, 0, 0);   \
        o[d0] = __builtin_amdgcn_mfma_f32_32x32x16_bf16(pa2, (bf16x8){l2[0], l2[1], l2[2], l2[3], h2[0], h2[1], h2[2], h2[3]}, o[d0], 0, 0, 0);   \
        o[d0] = __builtin_amdgcn_mfma_f32_32x32x16_bf16(pa3, (bf16x8){l3[0], l3[1], l3[2], l3[3], h3[0], h3[1], h3[2], h3[3]}, o[d0], 0, 0, 0); } while (0)
    PV_D0(0); PV_D0(1); PV_D0(2); PV_D0(3);
#undef PV_D0
#undef TRRD
}

template <class TIn, class TOut> struct BlockRef { const TIn* Q; const TIn* K; const TIn* V; TOut* O; int P0; };
template <class TIn> struct Seam {
    bf16x8 qr[8];
    bf16x8 st_v0, st_v1, st_k0, st_k1; f32x4 sf0, sf1, sf2, sf3;
    f32x4 tq[16];
};
__device__ __forceinline__ int swa_jlo(int P0, int W) { const int lowk = P0 - W + 1; return lowk > 0 ? lowk / KVBLK : 0; }
#define ROW(p, k0, rr) ((p) + (size_t)((k0) + (rr)) * KVPITCH + sc)
#define VMW() asm volatile("s_waitcnt vmcnt(0)" ::: "memory")
#define VMWN(n) asm volatile("s_waitcnt vmcnt(%0)" :: "i"(n) : "memory")
#define SLOAD_H(Kp, Vp, k0) do { S.st_v0 = load8<TIn>(ROW(Vp, k0, sr)); S.st_v1 = load8<TIn>(ROW(Vp, k0, 32 + sr));              \
                         S.st_k0 = load8<TIn>(ROW(Kp, k0, sr)); S.st_k1 = load8<TIn>(ROW(Kp, k0, 32 + sr)); } while (0)
#define SWRITE_HK(bf) do { *(bf16x8*)(K_lds + (bf) * SHM_K + kws) = S.st_k0; *(bf16x8*)(K_lds + (bf) * SHM_K + kws + 32 * 256) = S.st_k1; } while (0)
#define SWRITE_HV(bf) do { *(bf16x8*)(V_lds + (bf) * SHM_V + vst0) = S.st_v0; *(bf16x8*)(V_lds + (bf) * SHM_V + vst1) = S.st_v1; } while (0)
#define SWRITE_H(bf) do { SWRITE_HV(bf); SWRITE_HK(bf); } while (0)
#define SLOAD_F(p, k0) do { S.sf0 = *(const f32x4*)ROW(p, k0, sr); S.sf1 = *(const f32x4*)(ROW(p, k0, sr) + 4);                \
                            S.sf2 = *(const f32x4*)ROW(p, k0, 32 + sr); S.sf3 = *(const f32x4*)(ROW(p, k0, 32 + sr) + 4); } while (0)
#define SWRITE_KF(bf) do { *(bf16x8*)(K_lds + (bf) * SHM_K + kws) = pack8(S.sf0, S.sf1); *(bf16x8*)(K_lds + (bf) * SHM_K + kws + 32 * 256) = pack8(S.sf2, S.sf3); } while (0)
#define SWRITE_VF(bf) do { *(bf16x8*)(V_lds + (bf) * SHM_V + vst0) = pack8(S.sf0, S.sf1); *(bf16x8*)(V_lds + (bf) * SHM_V + vst1) = pack8(S.sf2, S.sf3); } while (0)
template <class TIn, class TOut>
__device__ __forceinline__ void causal_swa_prime(const BlockRef<TIn, TOut>& cur, int W, char* lds, Seam<TIn>& S) {
    constexpr bool F32 = same_t<TIn, float>::v;
    int tid_ = threadIdx.x; asm volatile("" : "+v"(tid_)); const int tid = tid_, wid = __builtin_amdgcn_readfirstlane(tid >> 6), lane = tid & 63, r32 = lane & 31, hi = lane >> 5;
    const int sr = tid >> 4, sc = (tid & 15) * 8, kws = KSWZ(sr, sc * 2); char* K_lds = lds + 2 * SHM_V;
    const int kb0 = swa_jlo(cur.P0, W) * KVBLK;
    for (int d0 = 0; d0 < 8; ++d0) S.qr[d0] = load8<TIn>(cur.Q + (size_t)(wid * QBLK + r32) * QPITCH + d0 * 16 + hi * 8);
    if constexpr (F32) { SLOAD_F((const float*)cur.K, kb0); VMW(); SWRITE_KF(0); SBAR(); SLOAD_F((const float*)cur.V, kb0); }
    else { SLOAD_H(cur.K, cur.V, kb0); VMW(); SWRITE_HK(0); }
    __syncthreads();
}
template <class TIn, class TOut>
__device__ __forceinline__ void causal_swa_block(const BlockRef<TIn, TOut>& cur, const BlockRef<TIn, TOut>& nxt, int skv, int W, char* lds, Seam<TIn>& S) {
    constexpr bool F32 = same_t<TIn, float>::v;
    int tid_ = threadIdx.x; asm volatile("" : "+v"(tid_)); const int tid = tid_, wid = __builtin_amdgcn_readfirstlane(tid >> 6), lane = tid & 63, r32 = lane & 31, hi = lane >> 5;
    const int j_lo = swa_jlo(cur.P0, W);
    int j_hi = (cur.P0 + QB - 1) / KVBLK + 1; if (j_hi > skv / KVBLK) j_hi = skv / KVBLK;
    const int NT = j_hi - j_lo;
    const int kbn = swa_jlo(nxt.P0, W) * KVBLK;
    const int qlo = cur.P0 + wid * QBLK, qm = qlo + r32 - 4 * hi;
    char* V_lds = lds; char* K_lds = lds + 2 * SHM_V;
    float* ws = (float*)(lds + 2 * SHM_V + 2 * SHM_K) + wid * 64; float* li_l = ws, * al_l = ws + 32;
    float m_reg = -1e30f, l_reg = 0; f32x16 o[4] = {};
    const int sr = tid >> 4, sc = (tid & 15) * 8, vst0 = v_st(sr, sc), vst1 = v_st(32 + sr, sc), kws = KSWZ(sr, sc * 2);
    const int vb0 = (int)(uintptr_t)V_lds + v_rd_base(lane);
    const TIn* Kh = cur.K; const TIn* Vh = cur.V;
#define RESC(a) do { if (__any((a) < 1.f)) { if (hi == 0) al_l[r32] = (a); asm volatile("s_waitcnt lgkmcnt(0)" ::: "memory");              \
                     for (int d_ = 0; d_ < 4; ++d_) for (int r = 0; r < 16; ++r) o[d_][r] *= al_l[crow(r, hi)]; } } while (0)
#define KBASE(t) ((j_lo + (t)) * KVBLK)
#define ACT(t) (KBASE(t) <= qlo + QBLK - 1 && KBASE(t) + KVBLK - 1 >= qlo - W + 1)
#define MASKT(P0_, P1_, t) do { const int kb_ = KBASE(t); if ((!SK || ACT(t)) && (kb_ + KVBLK - 1 > qlo || kb_ <= qlo + QBLK - 1 - W)) mask_tile(P0_, P1_, qm - kb_, (unsigned)W); } while (0)
    constexpr int NQL = F32 ? 16 : 8;
    constexpr bool SK = WSKIP && !F32;
#define SEAM_K0() do { VMWN(NQL); if constexpr (F32) { SWRITE_KF(0); SBAR(); SLOAD_F((const float*)nxt.V, kbn); } else { SWRITE_HK(0); } SBAR(); } while (0)
    f32x16 pA0, pA1, pB0, pB1; float mnA, mnB, alA, alB; bf16x8 pa0, pa1, pa2, pa3;
    if constexpr (F32) { VMW(); SWRITE_VF(0); SBAR(); } else { SWRITE_HV(0); SBAR(); }
    if (NT > 1) { if constexpr (F32) SLOAD_F((const float*)Kh, KBASE(1)); else SLOAD_H(Kh, Vh, KBASE(1)); }
    SBAR(); qkt<0, SK>(pA0, pA1, K_lds, r32, hi, S.qr, ACT(0));
    if constexpr (F32) { if (NT > 1) { VMW(); SWRITE_KF(1); SBAR(); SLOAD_F((const float*)Vh, KBASE(1)); } }
    MASKT(pA0, pA1, 0); partialSM(pA0, pA1, m_reg, mnA, alA);
    if (NT > 1) { VMW(); if constexpr (F32) { SWRITE_VF(1); SBAR(); if (NT > 2) SLOAD_F((const float*)Kh, KBASE(2)); } else SWRITE_H(1); }
    __syncthreads();
#define HALF_STEP(PX0, PX1, mnX, alX, PY0, PY1, alY, t, KB, VB, SB) do {                                                      \
        SBAR(); qkt<KB, SK>(PX0, PX1, K_lds, r32, hi, S.qr, ACT(t));                                             \
        finishSM(PY0, PY1, alY, l_reg, pa0, pa1, pa2, pa3); SBAR();                                                           \
        if ((t) + 1 < NT) { if constexpr (F32) { VMW(); SWRITE_KF(SB); SBAR(); SLOAD_F((const float*)Vh, KBASE((t) + 1)); }  \
                            else { SLOAD_H(Kh, Vh, KBASE((t) + 1)); } SBAR(); }                                               \
        pv_tile<VB, SK>(o, vb0, pa0, pa1, pa2, pa3, ACT((t) - 1)); MASKT(PX0, PX1, (t)); partialSM(PX0, PX1, m_reg, mnX, alX);                                        \
        __syncthreads();                                                                                                      \
        if ((t) + 1 < NT) { VMW(); if constexpr (F32) { SWRITE_VF(SB); SBAR(); if ((t) + 2 < NT) SLOAD_F((const float*)Kh, KBASE((t) + 2)); } \
                            else { SWRITE_H(SB); } }                                                                          \
        RESC(alX); __syncthreads(); } while (0)
    for (int t = 1; t + 1 < NT; t += 2) {
        HALF_STEP(pB0, pB1, mnB, alB, pA0, pA1, alA, t, 1, 0, 0);
        HALF_STEP(pA0, pA1, mnA, alA, pB0, pB1, alB, t + 1, 0, 1, 1);
    }
    const bool even = (NT & 1) == 0;
    if (even) { SBAR(); qkt<1, SK>(pB0, pB1, K_lds, r32, hi, S.qr, ACT(NT - 1)); SBAR(); }
#define QROW(e) (nxt.Q + (size_t)(wid * QBLK + r32) * QPITCH + ((e) >> 1) * 16 + hi * 8 + ((e) & 1) * 4)
    if constexpr (F32) { SLOAD_F((const float*)nxt.K, kbn); SBAR();
#pragma unroll
        for (int e = 0; e < 8; ++e) S.tq[e] = *(const f32x4*)QROW(e); }
    else { SLOAD_H(nxt.K, nxt.V, kbn); SBAR();
#pragma unroll
        for (int d0 = 0; d0 < 8; ++d0) S.qr[d0] = load8<TIn>(nxt.Q + (size_t)(wid * QBLK + r32) * QPITCH + d0 * 16 + hi * 8); }
    SBAR();
    finishSM(pA0, pA1, alA, l_reg, pa0, pa1, pa2, pa3); SBAR();
    if constexpr (F32) {
#pragma unroll
        for (int e = 8; e < 16; ++e) S.tq[e] = *(const f32x4*)QROW(e); SBAR(); }
#undef QROW
    pv_tile<0, SK>(o, vb0, pa0, pa1, pa2, pa3, ACT(even ? NT - 2 : NT - 1));
    if (even) { MASKT(pB0, pB1, NT - 1); partialSM(pB0, pB1, m_reg, mnB, alB); __syncthreads(); RESC(alB);
        finishSM(pB0, pB1, alB, l_reg, pa0, pa1, pa2, pa3); SBAR(); pv_tile<1, SK>(o, vb0, pa0, pa1, pa2, pa3, ACT(NT - 1)); }
    SBAR(); SEAM_K0();
    if (hi == 0) li_l[r32] = l_reg; asm volatile("s_waitcnt lgkmcnt(0)" ::: "memory");
    float rli[16];
#pragma unroll
    for (int r = 0; r < 16; ++r) rli[r] = __builtin_amdgcn_rcpf(li_l[crow(r, hi)]);
    TOut* Ow = cur.O + (size_t)(wid * QBLK) * OPITCH;
#pragma unroll
    for (int r = 0; r < 16; ++r) { const int orow = crow(r, hi);
        if constexpr (same_t<TOut, float>::v) {
#pragma unroll
            for (int d0 = 0; d0 < 4; ++d0) Ow[(size_t)orow * OPITCH + d0 * 32 + r32] = o[d0][r] * rli[r];
        } else {
            typedef unsigned v2u_t __attribute__((ext_vector_type(2)));
            v2u_t w; w.x = cvtpk(o[0][r] * rli[r], o[1][r] * rli[r]); w.y = cvtpk(o[2][r] * rli[r], o[3][r] * rli[r]);
            *(v2u_t*)(Ow + (size_t)orow * OPITCH + r32 * 4) = w; } }
    if constexpr (F32) {
#pragma unroll
        for (int d0 = 0; d0 < 8; ++d0) S.qr[d0] = pack8(S.tq[2 * d0], S.tq[2 * d0 + 1]); }
    __syncthreads();
#undef RESC
#undef KBASE
#undef ACT
#undef MASKT
#undef SEAM_K0
#undef HALF_STEP
}
#undef ROW
#undef VMW
#undef VMWN
#undef SLOAD_H
#undef SWRITE_HK
#undef SWRITE_HV
#undef SWRITE_H
#undef SLOAD_F
#undef SWRITE_KF
#undef SWRITE_VF

}
constexpr int NWAVES = 8;
#ifndef MK_SPLIT
#define MK_SPLIT 0
#endif
constexpr int BATCH = 16, SEQ = 2048, DM = 2048, M = BATCH * SEQ, DEPTH = 2, DFF = 8192;
constexpr int IN_COLS = 6160;
constexpr int NPROJ = 6656;
constexpr int C_GQ = 0, C_GK = 512, C_GV = 1024, C_GG = 2048, C_GATE = 3072, C_DQ = 3584, C_DK = 4608, C_DV = 5632;
constexpr int S_LR = 3072, S_SHIFT = 496;
constexpr int PH_PER_LAYER = 6, N_PHASES = 1 + DEPTH * PH_PER_LAYER;
constexpr float NORM_EPS = 1e-6f, SUBLN_EPS = 1e-5f;
constexpr float GLA_QSCALE = 0.08838834764831845f;

constexpr size_t MiB = 1u << 20;
constexpr size_t WS_CTL = 0, CTL_ZERO_BYTES = 1 * MiB;
constexpr size_t WS_BIAS = 1 * MiB;
constexpr size_t WS_WLRT = 1 * MiB + 256 * 1024;
constexpr size_t WS_W2F = 1 * MiB + 512 * 1024;
constexpr size_t WS_ROPE = 2 * MiB;
constexpr size_t WS_WIN = 18 * MiB;
constexpr size_t WS_WOUT = 70 * MiB;
constexpr size_t WS_WUP = 86 * MiB;
constexpr size_t WS_WDN = 150 * MiB;
constexpr size_t WS_XN = 214 * MiB;
constexpr size_t WS_XB2 = 342 * MiB;
constexpr size_t WS_PROJ = 342 * MiB;
constexpr size_t WS_O = 758 * MiB;
constexpr size_t WS_HID = 470 * MiB;
constexpr size_t WS_SS = 1014 * MiB;
constexpr size_t WS_END = 1019 * MiB;
static_assert(WS_WIN + (size_t)DEPTH * NPROJ * DM * 2 <= WS_WOUT && WS_WOUT + (size_t)DEPTH * DM * DM * 2 <= WS_WUP && WS_WUP + (size_t)DEPTH * DFF * DM * 2 <= WS_WDN && WS_WDN + (size_t)DEPTH * DFF * DM * 2 <= WS_XN, "ws map: weights");
static_assert(WS_XN + (size_t)M * DM * 2 <= WS_PROJ && WS_PROJ + (size_t)M * NPROJ * 2 <= WS_O && WS_O + (size_t)M * 2048 * 4 <= WS_END && WS_HID + (size_t)M * DFF * 2 <= WS_END && WS_XB2 + (size_t)M * DM * 2 <= WS_HID, "ws map: activations");
constexpr int CW_BAR = 4096;
constexpr int CW_VC = 9216;
constexpr int CW_Q = 8192;


constexpr int RING_OFF = 0, RING_BYTES = 131072;
constexpr int LDSCTL_OFF = RING_BYTES, MISC_OFF = LDSCTL_OFF + 320;
constexpr int RED_OFF = RING_BYTES + 1024;
constexpr int LDS_BYTES = 147456;
constexpr int RT_OFF = RED_OFF + 8192;
static_assert(MISC_OFF + 128 <= RED_OFF && RT_OFF + 4096 + 64 <= LDS_BYTES, "LDS map");

#define GAS __attribute__((address_space(1)))
#define LAS __attribute__((address_space(3)))
#define DI __device__ __forceinline__
typedef unsigned short bf16;
typedef unsigned v4u __attribute__((ext_vector_type(4)));
typedef unsigned v2u __attribute__((ext_vector_type(2)));
typedef float f32x4 __attribute__((ext_vector_type(4)));
typedef float f32x2v __attribute__((ext_vector_type(2)));
typedef float f32x16 __attribute__((ext_vector_type(16)));
typedef short bf16x8 __attribute__((ext_vector_type(8)));
typedef short s16x4 __attribute__((ext_vector_type(4)));
typedef __bf16 bf16x2_t __attribute__((ext_vector_type(2)));
typedef GAS unsigned gu32;
#define RLX_AGENT __ATOMIC_RELAXED, __HIP_MEMORY_SCOPE_AGENT
#define LDS_WAIT() asm volatile("s_waitcnt lgkmcnt(0)" ::: "memory")
#define VM_WAIT() asm volatile("s_waitcnt vmcnt(0)" ::: "memory")
DI unsigned pk2(float lo, float hi) { f32x2v v = {lo, hi}; bf16x2_t b = __builtin_convertvector(v, bf16x2_t); return __builtin_bit_cast(unsigned, b); }
DI float bf_lo(unsigned u) { return __uint_as_float(u << 16); }
DI float bf_hi(unsigned u) { return __uint_as_float(u & 0xffff0000u); }
DI int opaque_tid() { int t = threadIdx.x; asm volatile("" : "+v"(t)); return t; }
#define PH_IDS const int tid = opaque_tid(), lane = tid & 63, wave = __builtin_amdgcn_readfirstlane(tid >> 6), gw = (int)blockIdx.x * NWAVES + wave; (void)lane; (void)gw
#define MFMA32(a, b, c) __builtin_amdgcn_mfma_f32_32x32x16_bf16((a), (b), (c), 0, 0, 0)

#define XB_TMO      128
#define XB_XCNT(j)  (256  + 64 * (j))
#define XB_XSUB(j)  (1280 + 64 * (j))
#define XB_XGEN(j)  (2304 + 64 * (j))
#define XB_TOP      3328
#define XB_TOPGEN   3392
#define XCD_BAR_WORDS 3456
#define XB_SPIN_CAP (1u << 18)

__device__ __forceinline__ unsigned xb_ld(unsigned* p)              { return __hip_atomic_load(p, __ATOMIC_RELAXED, __HIP_MEMORY_SCOPE_AGENT); }
__device__ __forceinline__ unsigned xb_add(unsigned* p, unsigned v) { return __hip_atomic_fetch_add(p, v, __ATOMIC_RELAXED, __HIP_MEMORY_SCOPE_AGENT); }
__device__ __forceinline__ unsigned xb_xcc_id() { return (unsigned)__builtin_amdgcn_s_getreg((3 << 11) | 20) & 0xFu; }
#define XB_SPIN(cond, bar) do { unsigned _sp = 0; while (cond) { __builtin_amdgcn_s_sleep(1); \
    if ((++_sp & 255u) == 0u) { if (xb_ld(&(bar)[XB_TMO])) break; if (_sp > XB_SPIN_CAP) { atomicAdd(&(bar)[XB_TMO], 1u); break; } } } } while (0)

struct XcdBarrier {
    unsigned* bar; unsigned x;
    volatile LAS unsigned* st;
};

__device__ __forceinline__ XcdBarrier xcd_barrier_post(unsigned* bar, volatile LAS unsigned* st) {
    XcdBarrier b; b.bar = bar; b.x = xb_xcc_id(); b.st = st;
    if (threadIdx.x == 0) (void)xb_add(&bar[XB_XCNT(b.x)], 1u);
    return b;
}
__device__ __forceinline__ void xcd_barrier_complete(unsigned* bar, unsigned x, unsigned& nloc, unsigned& nx) {
    const unsigned G = gridDim.x * gridDim.y * gridDim.z;
    unsigned sum, cnt, mine, sp = 0u;
    for (;;) {
        sum = 0u; cnt = 0u; mine = 0u;
#pragma unroll
        for (unsigned j = 0; j < 16; ++j) { const unsigned c = xb_ld(&bar[XB_XCNT(j)]); sum += c; cnt += (c > 0u) ? 1u : 0u; mine = (j == x) ? c : mine; }
        if (sum == G) break;
        __builtin_amdgcn_s_sleep(1);
        if ((++sp & 255u) == 0u) { if (xb_ld(&bar[XB_TMO])) break; if (sp > XB_SPIN_CAP) { atomicAdd(&bar[XB_TMO], 1u); break; } }
    }
    nloc = mine > 0u ? mine : 1u; nx = cnt > 0u ? cnt : 1u;
}

__device__ __forceinline__ void xcd_barrier(const XcdBarrier& b) {
    asm volatile("s_waitcnt vmcnt(0)" ::: "memory");
    __syncthreads();
    if (threadIdx.x == 0) {
        unsigned* bar = b.bar;
        __builtin_amdgcn_s_waitcnt(0);
        unsigned nloc = b.st[0], nx = b.st[1];
        if (nloc == 0u) { xcd_barrier_complete(bar, b.x, nloc, nx); b.st[0] = nloc; b.st[1] = nx; }
        const unsigned old = xb_add(&bar[XB_XSUB(b.x)], 1u);
        const unsigned gen = old / nloc;
        if (old + 1u == (gen + 1u) * nloc) {
            __builtin_amdgcn_fence(__ATOMIC_RELEASE, "agent");
            asm volatile("s_waitcnt vmcnt(0)" ::: "memory");
            const unsigned og = xb_add(&bar[XB_TOP], 1u);
            const unsigned tg = og / nx;
            if (og + 1u == (tg + 1u) * nx) xb_add(&bar[XB_TOPGEN], 1u);
            else XB_SPIN(xb_ld(&bar[XB_TOPGEN]) == tg, bar);
            __builtin_amdgcn_fence(__ATOMIC_ACQUIRE, "agent");
            xb_add(&bar[XB_XGEN(b.x)], 1u);
            asm volatile("s_waitcnt vmcnt(0)" ::: "memory");
        } else {
            XB_SPIN(xb_ld(&bar[XB_XGEN(b.x)]) == gen, bar);
            __builtin_amdgcn_fence(__ATOMIC_ACQUIRE, "agent");
            asm volatile("s_waitcnt vmcnt(0)" ::: "memory");
        }
    }
    __syncthreads();
}

struct Args { const void* in[18]; float* out; unsigned char* ws; int ph_lo, ph_hi; };
struct Frame {
    LAS unsigned char* lds;
    volatile LAS unsigned* MISC;
    gu32* ctl;
    int G, NGW;
    unsigned char* ws;
};
enum { I_X = 0, I_POS, I_ATTN_NW, I_WIN, I_GW2, I_GB, I_GLA_NW, I_QNW, I_KNW, I_LQ1, I_LK1, I_LQ2, I_LK2, I_SUBW, I_WOUT, I_MLP_NW, I_WUP, I_WDN };
typedef __attribute__((address_space(4))) const Args* kargs_t;
DI kargs_t kargs() { kargs_t p = (kargs_t)__builtin_amdgcn_kernarg_segment_ptr(); asm volatile("" : "+s"(p)); return p; }
#define INP(T, k) ((const T*)(const GAS T*)kargs()->in[k])
#define OUTP() ((float*)(GAS float*)kargs()->out)
DI GAS unsigned char* ws_opaque(Frame& F) { GAS unsigned char* w = (GAS unsigned char*)F.ws; asm volatile("" : "+s"(w)); return w; }
DI float wave_sum(float v) {
#pragma unroll
    for (int o = 1; o < 64; o <<= 1) v += __shfl_xor(v, o);
    return v;
}

DI void p0_write_tile(bf16* WT, int K, int drow0, int k0, LAS float* scr, int lane, const float* rs) {
    const int c = lane & 7;
    f32x4 s0 = {1.f, 1.f, 1.f, 1.f}, s1 = s0;
    if (rs) { s0 = *(const f32x4*)(rs + k0 + 8 * c); s1 = *(const f32x4*)(rs + k0 + 8 * c + 4); }
    LDS_WAIT(); asm volatile("" ::: "memory");
#pragma unroll
    for (int j = 0; j < 4; ++j) { const int n = (lane >> 3) + 8 * j; const LAS float* s = scr + (8 * c) * 33 + n;
        v4u o; o.x = pk2(s[0 * 33] * s0[0], s[1 * 33] * s0[1]); o.y = pk2(s[2 * 33] * s0[2], s[3 * 33] * s0[3]); o.z = pk2(s[4 * 33] * s1[0], s[5 * 33] * s1[1]); o.w = pk2(s[6 * 33] * s1[2], s[7 * 33] * s1[3]);
        *(GAS v4u*)(WT + (size_t)(drow0 + n) * K + k0 + 8 * c) = o; }
    LDS_WAIT(); asm volatile("" ::: "memory");
}
DI void p0_transpose_tile(const float* W, int SP, int scol, bf16* WT, int K, int drow0, int k0, LAS float* scr, int lane, const float* rs) {
#pragma unroll 8
    for (int i = 0; i < 32; ++i) { const int kk = 2 * i + (lane >> 5); scr[kk * 33 + (lane & 31)] = W[(size_t)(k0 + kk) * SP + scol]; }
    p0_write_tile(WT, K, drow0, k0, scr, lane, rs);
}
DI void p0_gate_tile(const float* W, const float* w2, bf16* WT, int j0, int k0, LAS float* scr, int lane, const float* rs) {
    float w2r[16];
#pragma unroll
    for (int r = 0; r < 16; ++r) w2r[r] = w2[r * 512 + j0 + (lane & 31)];
#pragma unroll 4
    for (int i = 0; i < 32; ++i) { const int kk = 2 * i + (lane >> 5); const f32x4* wr = (const f32x4*)(W + (size_t)(k0 + kk) * IN_COLS + S_LR);
        float a = 0.f;
#pragma unroll
        for (int q = 0; q < 4; ++q) { const f32x4 t = wr[q]; a = fmaf(t.x, w2r[4 * q], a); a = fmaf(t.y, w2r[4 * q + 1], a); a = fmaf(t.z, w2r[4 * q + 2], a); a = fmaf(t.w, w2r[4 * q + 3], a); }
        scr[kk * 33 + (lane & 31)] = a; }
    p0_write_tile(WT, DM, C_GATE + j0, k0, scr, lane, rs);
}
#ifndef GATE_ITEMS
#define GATE_ITEMS 1
#endif
struct WTile { const float* W; bf16* WT; const float* rs; const float* w2; int SP, scol4, K, drow0, dloc_b, dstep, k0, kperm, gate_j0; };
DI void p0_t64_load(const WTile& d, int lane, f32x4 (&v)[16], f32x2v (&sc)[8]) {
    const int kq = lane >> 4;
#pragma unroll
    for (int j = 0; j < 8; ++j) sc[j] = (f32x2v){1.f, 1.f};
    if (d.gate_j0 != -1) return;
    if (d.rs) {
#pragma unroll
        for (int j = 0; j < 8; ++j) sc[j] = *(const GAS f32x2v*)(d.rs + d.k0 + 8 * j + 2 * kq); }
#pragma unroll
    for (int i = 0; i < 16; ++i) { const int k = 8 * (i >> 1) + 2 * kq + (i & 1); int kr = d.k0 + k; if (d.kperm && kr >= 1024) kr = (kr & ~127) + ((kr & 3) << 5) + ((kr & 127) >> 2);
        v[i] = *(const GAS f32x4*)(d.W + (size_t)kr * d.SP + d.scol4); }
}
DI void p0_t64_finish(const WTile& d, int lane, LAS float* scrf, const f32x4 (&v)[16], const f32x2v (&sc)[8]) {
    if (d.gate_j0 == -2) return;
    if (d.gate_j0 >= 0) { p0_gate_tile(d.W, d.w2, d.WT, d.gate_j0, d.k0, scrf, lane, d.rs); p0_gate_tile(d.W, d.w2, d.WT, d.gate_j0 + 32, d.k0, scrf, lane, d.rs); return; }
    LAS unsigned* scr = (LAS unsigned*)scrf; const int kq = lane >> 4;
#pragma unroll
    for (int j = 0; j < 8; ++j) {
        const float s0 = sc[j].x, s1 = sc[j].y;
        const int k2 = 4 * j + kq;
#pragma unroll
        for (int q = 0; q < 4; ++q) scr[(d.dloc_b + q * d.dstep) * 36 + k2] = pk2(v[2 * j][q] * s0, v[2 * j + 1][q] * s1);
    }
    LDS_WAIT(); asm volatile("" ::: "memory");
#pragma unroll
    for (int j2 = 0; j2 < 8; ++j2) { const int n = (lane >> 3) + 8 * j2, c = lane & 7;
        const v4u o = *(const LAS v4u*)(scr + n * 36 + 4 * c);
        *(GAS v4u*)(d.WT + (size_t)(d.drow0 + n) * d.K + d.k0 + 8 * c) = o; }
    LDS_WAIT(); asm volatile("" ::: "memory");
}
DI void sincos_red(float ang, float& s, float& c) {
    const double a = (double)ang; const double kq = __builtin_rint(a * 0.6366197723675814);
    double r = __builtin_fma(-kq, 1.5707963267948966, a); r = __builtin_fma(-kq, 6.123233995736766e-17, r);
    const float x = (float)r, x2 = x * x; const int q = (int)kq & 3;
    const float sp = x + x * x2 * (-1.6666654611e-1f + x2 * (8.3321608736e-3f + x2 * (-1.9515295891e-4f)));
    const float cp = 1.f - 0.5f * x2 + x2 * x2 * (4.166664568298827e-2f + x2 * (-1.388731625493765e-3f + x2 * 2.443315711809948e-5f));
    s = (q == 0) ? sp : (q == 1) ? cp : (q == 2) ? -sp : -cp;
    c = (q == 0) ? cp : (q == 1) ? -sp : (q == 2) ? -cp : sp;
}
#ifndef CONV_IN_MIXER
#define CONV_IN_MIXER 1
#endif
constexpr int P0_NB_IN = NPROJ / 64, P0_I_IN = (DM / 64) * P0_NB_IN, P0_I_OUT = (DM / 64) * (DM / 64), P0_I_UP = (DM / 64) * (DFF / 64), P0_I_DN = (DFF / 64) * (DM / 64), P0_I_LAYER = P0_I_IN + P0_I_OUT + P0_I_UP + P0_I_DN;
DI void p0_wdesc(Frame& F, GAS unsigned char* ws, int L, int r, int lane, WTile& d) {
    constexpr int NB_IN = P0_NB_IN, I_IN = P0_I_IN, I_OUT = P0_I_OUT, I_UP = P0_I_UP;
    bf16* WinT = (bf16*)(ws + WS_WIN); bf16* WoutT = (bf16*)(ws + WS_WOUT); bf16* WupT = (bf16*)(ws + WS_WUP); bf16* WdnT = (bf16*)(ws + WS_WDN);
    const int n4 = lane & 15;
    d.rs = nullptr; d.w2 = nullptr; d.kperm = 0; d.gate_j0 = -1; d.dloc_b = 4 * n4; d.dstep = 1;
    if (r < I_IN) { const int kb = r / NB_IN, nb = r - kb * NB_IN, drow0 = nb * 64;
        d.W = INP(float, I_WIN) + (size_t)L * DM * IN_COLS; d.WT = WinT + (size_t)L * NPROJ * DM; d.rs = INP(float, I_ATTN_NW) + L * DM; d.SP = IN_COLS; d.K = DM; d.drow0 = drow0; d.k0 = kb * 64;
        if (drow0 >= C_GATE && drow0 < C_DQ) { d.gate_j0 = GATE_ITEMS ? -2 : drow0 - C_GATE; d.w2 = INP(float, I_GW2) + (size_t)L * 16 * 512; d.scol4 = 0; }
        else if (drow0 >= C_DQ && drow0 < C_DV) {
            const int hb = (drow0 - C_DQ) & ~127, c0 = (drow0 - C_DQ) & 127;
            d.scol4 = C_DQ - S_SHIFT + hb + (c0 >> 1) + ((n4 >> 3) ? 64 : 0) + 4 * (n4 & 7); d.dloc_b = 8 * (n4 & 7) + (n4 >> 3); d.dstep = 2; }
        else d.scol4 = (drow0 < C_GATE ? drow0 : drow0 - S_SHIFT) + 4 * n4;
        return; }
    r -= I_IN;
    if (r < I_OUT) { const int kb = r / (DM / 64), nb = r % (DM / 64); d.W = INP(float, I_WOUT) + (size_t)L * DM * DM; d.WT = WoutT + (size_t)L * DM * DM; d.SP = DM; d.K = DM; d.scol4 = nb * 64 + 4 * n4; d.drow0 = nb * 64; d.k0 = kb * 64; d.kperm = 1; return; }
    r -= I_OUT;
    if (r < I_UP) { const int kb = r / (DFF / 64), nb = r % (DFF / 64); d.W = INP(float, I_WUP) + (size_t)L * DM * DFF; d.WT = WupT + (size_t)L * DFF * DM; d.rs = INP(float, I_MLP_NW) + L * DM; d.SP = DFF; d.K = DM; d.scol4 = nb * 64 + 4 * n4; d.drow0 = nb * 64; d.k0 = kb * 64; return; }
    r -= I_UP;
    { const int kb = r / (DM / 64), nb = r % (DM / 64); d.W = INP(float, I_WDN) + (size_t)L * DFF * DM; d.WT = WdnT + (size_t)L * DM * DFF; d.SP = DM; d.K = DFF; d.scol4 = nb * 64 + 4 * n4; d.drow0 = nb * 64; d.k0 = kb * 64; }
}
DI void p0_wtile(Frame& F, GAS unsigned char* ws, int L, int r, LAS float* scr, int lane) {
    WTile d; p0_wdesc(F, ws, L, r, lane, d);
    f32x4 v[16]; f32x2v sc[8];
    p0_t64_load(d, lane, v, sc); p0_t64_finish(d, lane, scr, v, sc);
}
constexpr int CONV_TPW = 10, CONV_TPI = 8 * CONV_TPW, CONV_L0 = P0_I_LAYER - P0_I_IN, CONV_TILES = CONV_L0 + (DEPTH - 1) * P0_I_LAYER, N_CONV = CONV_IN_MIXER ? CONV_TILES / CONV_TPI : 0;
static_assert(CONV_TILES % CONV_TPI == 0 && P0_I_IN % 8 == 0, "conversion items tile the list exactly");
DI void conv_item(Frame& F, int c) {
    PH_IDS;
    LAS float* scr = (LAS float*)(F.lds + RING_OFF + wave * 16384);
    GAS unsigned char* ws = ws_opaque(F);
    auto desc = [&](int j, WTile& d) { const int g = c * CONV_TPI + wave + 8 * j;
        if (g < CONV_L0) p0_wdesc(F, ws, 0, P0_I_IN + g, lane, d);
        else { const int g2 = g - CONV_L0, L = 1 + g2 / P0_I_LAYER; p0_wdesc(F, ws, L, g2 - (L - 1) * P0_I_LAYER, lane, d); } };
    WTile dA, dB; f32x4 vA[16], vB[16]; f32x2v sA[8], sB[8];
    desc(0, dA); p0_t64_load(dA, lane, vA, sA);
#pragma unroll 1
    for (int j = 0; j < CONV_TPW; j += 2) {
        desc(j + 1, dB); p0_t64_load(dB, lane, vB, sB);
        p0_t64_finish(dA, lane, scr, vA, sA);
        if (j + 2 < CONV_TPW) { desc(j + 2, dA); p0_t64_load(dA, lane, vA, sA); }
        p0_t64_finish(dB, lane, scr, vB, sB);
    }
}
static_assert(CONV_TPW % 2 == 0, "conv_item pairs tiles");
DI void p0_prologue(Frame& F) {
    PH_IDS;
    LAS float* scr = (LAS float*)(F.lds + RING_OFF + wave * 16384);
    constexpr int I_LAYER = P0_I_LAYER;
    GAS unsigned char* ws = ws_opaque(F);
#pragma unroll 1
    for (int it = gw; it < (CONV_IN_MIXER ? P0_I_IN : DEPTH * I_LAYER); it += F.NGW) { const int L = it / I_LAYER; p0_wtile(F, ws, L, it - L * I_LAYER, scr, lane); }
    const int gt = gw * 64 + lane, NT = F.NGW * 64;
    float* bias = (float*)(ws + WS_BIAS); const float* gate_b = INP(float, I_GB); const int* pos = INP(int, I_POS);
    for (int i = gt; i < DEPTH * NPROJ; i += NT) { const int L = i / NPROJ, c = i - L * NPROJ; bias[i] = (c >= C_GATE && c < C_DQ) ? gate_b[L * 512 + c - C_GATE] : 0.f; }
    if (GATE_ITEMS) {
        bf16* wlrt = (bf16*)(ws + WS_WLRT); bf16* w2f = (bf16*)(ws + WS_W2F);
        for (int i = gt; i < DEPTH * 16 * DM; i += NT) { const int L = i / (16 * DM), r = (i >> 11) & 15, k = i & (DM - 1);
            const float v = INP(float, I_ATTN_NW)[L * DM + k] * INP(float, I_WIN)[((size_t)L * DM + k) * IN_COLS + S_LR + r];
            wlrt[i] = (bf16)(pk2(v, 0.f) & 0xffffu); }
        for (int i = gt; i < DEPTH * 32 * 64 * 4; i += NT) { const int L = i / (32 * 64 * 4), nb = (i >> 8) & 31, ln = (i >> 2) & 63, e = i & 3;
            const float v = INP(float, I_GW2)[(size_t)L * 16 * 512 + (4 * (ln >> 4) + e) * 512 + 16 * nb + (ln & 15)];
            w2f[i] = (bf16)(pk2(v, 0.f) & 0xffffu); }
    }
    unsigned* rope = (unsigned*)(ws + WS_ROPE);
    for (int i = gt; i < M * 64; i += NT) { const int row = i >> 6, f = i & 63;
        const float inv_freq = (float)exp2(-(double)f * (13.287712379549449 / 64.0));
        const float ang = (float)pos[row] * inv_freq; float s, c; sincos_red(ang, s, c);
        rope[i] = (unsigned)__builtin_bit_cast(unsigned short, (_Float16)c) | ((unsigned)__builtin_bit_cast(unsigned short, (_Float16)s) << 16); }
    const float* x = INP(float, I_X); bf16* xb = (bf16*)OUTP(); GAS f32x4* ss0 = (GAS f32x4*)(ws + WS_SS);
    for (int m0 = 4 * gw; m0 < M; m0 += 4 * F.NGW) {
        f32x4 v[4][8]; float s[4] = {0.f, 0.f, 0.f, 0.f};
#pragma unroll
        for (int q = 0; q < 4; ++q) { const GAS f32x4* xr = (const GAS f32x4*)(x + (size_t)(m0 + q) * DM) + lane;
#pragma unroll
            for (int j = 0; j < 8; ++j) v[q][j] = xr[64 * j]; }
#pragma unroll
        for (int q = 0; q < 4; ++q) {
#pragma unroll
            for (int j = 0; j < 8; ++j) s[q] += (v[q][j].x * v[q][j].x + v[q][j].y * v[q][j].y) + (v[q][j].z * v[q][j].z + v[q][j].w * v[q][j].w);
            s[q] = wave_sum(s[q]); if (lane < 2) ss0[2 * (m0 + q) + lane] = (f32x4){lane == 0 ? s[q] : 0.f, 0.f, 0.f, 0.f};
            GAS v2u* o8 = (GAS v2u*)(xb + (size_t)(m0 + q) * DM) + lane;
#pragma unroll
            for (int j = 0; j < 8; ++j) { v2u o; o.x = pk2(v[q][j].x, v[q][j].y); o.y = pk2(v[q][j].z, v[q][j].w); o8[64 * j] = o; } }
    }
}

typedef float f32x4_t __attribute__((ext_vector_type(4)));
DI void gate_item(Frame& F, int L, int item) {
    PH_IDS;
    GAS unsigned char* ws = ws_opaque(F);
    const int t0 = item * 128 + wave * 16, li = lane & 15, lq = lane >> 4;
    const GAS bf16* xa = (const GAS bf16*)OUTP() + (size_t)(t0 + li) * DM + 8 * lq;
    const GAS bf16* wl = (const GAS bf16*)(ws + WS_WLRT) + ((size_t)L * 16 + li) * DM + 8 * lq;
    f32x4 acc = {0.f, 0.f, 0.f, 0.f};
#pragma unroll 1
    for (int s0 = 0; s0 < DM / 32; s0 += 16) {
        bf16x8 a[16], b[16];
#pragma unroll
        for (int j = 0; j < 16; ++j) { a[j] = *(const GAS bf16x8*)(wl + 32 * (s0 + j)); b[j] = *(const GAS bf16x8*)(xa + 32 * (s0 + j)); }
        __builtin_amdgcn_sched_barrier(0);
#pragma unroll
        for (int j = 0; j < 16; ++j) acc = __builtin_amdgcn_mfma_f32_16x16x32_bf16(a[j], b[j], acc, 0, 0, 0);
        __builtin_amdgcn_sched_barrier(0);
    }
    const GAS f32x4* ssp = (const GAS f32x4*)((const GAS float*)(ws + WS_SS) + ((size_t)(2 * L) * M + t0 + li) * 8); const f32x4 p0 = ssp[0], p1 = ssp[1];
    const float rstd = __builtin_amdgcn_rsqf((((p0[0] + p0[1]) + (p0[2] + p0[3])) + ((p1[0] + p1[1]) + (p1[2] + p1[3]))) * (1.0f / DM) + NORM_EPS);
    s16x4 lrb; { const unsigned u0 = pk2(acc[0] * rstd, acc[1] * rstd), u1 = pk2(acc[2] * rstd, acc[3] * rstd); lrb = (s16x4){(short)(u0 & 0xffffu), (short)(u0 >> 16), (short)(u1 & 0xffffu), (short)(u1 >> 16)}; }
    const GAS s16x4* w2f = (const GAS s16x4*)(ws + WS_W2F) + (size_t)L * 32 * 64 + lane;
    const GAS float* bias = (const GAS float*)(ws + WS_BIAS) + (size_t)L * NPROJ + C_GATE + 4 * lq;
    GAS bf16* gout = (GAS bf16*)(ws + WS_PROJ) + (size_t)(t0 + li) * NPROJ + C_GATE + 4 * lq;
#pragma unroll 1
    for (int n0 = 0; n0 < 32; n0 += 16) {
        s16x4 w[16]; f32x4 bv[16];
#pragma unroll
        for (int j = 0; j < 16; ++j) { w[j] = w2f[(n0 + j) * 64]; bv[j] = *(const GAS f32x4*)(bias + 16 * (n0 + j)); }
        __builtin_amdgcn_sched_barrier(0);
#pragma unroll
        for (int j = 0; j < 16; ++j) { const f32x4 z = {0.f, 0.f, 0.f, 0.f};
            const f32x4 d = __builtin_amdgcn_mfma_f32_16x16x16bf16_1k(w[j], lrb, z, 0, 0, 0);
            v2u o; o.x = pk2(d[0] + bv[j][0], d[1] + bv[j][1]); o.y = pk2(d[2] + bv[j][2], d[3] + bv[j][3]);
            *(GAS v2u*)(gout + 16 * (n0 + j)) = o; }
    }
}
DI void combine_phase(Frame& F, int L) {
    PH_IDS;
    GAS unsigned char* ws = ws_opaque(F);
    const bf16* O = (const bf16*)(ws + WS_O); bf16* mix = (bf16*)(ws + WS_XN);
    const float* lq1 = INP(float, I_LQ1) + L * 128; const float* lk1 = INP(float, I_LK1) + L * 128; const float* lq2 = INP(float, I_LQ2) + L * 128; const float* lk2 = INP(float, I_LK2) + L * 128;
    const float lam_init = (L == 0) ? 0.2f : 0.35550906759096914f;
    float d1 = lq1[lane] * lk1[lane] + lq1[64 + lane] * lk1[64 + lane];
    float d2 = lq2[lane] * lk2[lane] + lq2[64 + lane] * lk2[64 + lane];
    const float lam = expf(wave_sum(d1)) - expf(wave_sum(d2)) + lam_init;
    const float osc = 1.0f - lam_init;
    f32x4 sw; { const float* swp = INP(float, I_SUBW) + L * 256 + (lane >> 5) * 128 + (lane & 31); sw = (f32x4){swp[0], swp[32], swp[64], swp[96]}; }
    for (int m = gw; m < M; m += F.NGW) {
        const bf16* o = O + (size_t)m * 2048 + 4 * lane;
        v2u a[4], b[4];
#pragma unroll
        for (int h = 0; h < 4; ++h) { a[h] = *(const GAS v2u*)(o + h * 512); b[h] = *(const GAS v2u*)(o + h * 512 + 256); }
#pragma unroll
        for (int h = 0; h < 4; ++h) { const f32x4 av = {bf_lo(a[h].x), bf_hi(a[h].x), bf_lo(a[h].y), bf_hi(a[h].y)}, bv = {bf_lo(b[h].x), bf_hi(b[h].x), bf_lo(b[h].y), bf_hi(b[h].y)}; const f32x4 d = av - bv * lam;
            const float ss = wave_sum((d.x * d.x + d.y * d.y) + (d.z * d.z + d.w * d.w));
            const float r = osc * __builtin_amdgcn_rsqf(ss * (1.f / 256.f) + SUBLN_EPS);
            v2u w; w.x = pk2(d.x * r * sw.x, d.y * r * sw.y); w.y = pk2(d.z * r * sw.z, d.w * r * sw.w);
            *(v2u*)(mix + (size_t)m * DM + 1024 + h * 256 + 4 * lane) = w; } }
}
#ifndef WGM_IN
#define WGM_IN 8
#define WGM_OUT 4
#define WGM_UP 8
#define WGM_DN 4
#endif
#ifndef HID_TILED
#define HID_TILED 1
#endif
#ifndef PROBE_DUP
#define PROBE_DUP 0
#endif

constexpr int G_QT = 0, G_QP = 272, G_KT = 17408, G_KDT = 34816, G_TP = 144, G_VT = 53248, G_AT = 90112, G_DEC = 99328, G_GT = 99840, G_NW = 103936, G_END = 104960, G_OB = 0, G_OP = 1152, G_OC = 144;
static_assert(G_END <= RING_BYTES && 64 * G_OP <= G_DEC, "GLA LDS map");
DI float log_sigmoid_f(float x) { return fminf(x, 0.f) - __logf(1.f + __expf(-fabsf(x))); }
DI bf16x8 lds_frag16(LAS unsigned char* p) { return *(LAS const bf16x8*)p; }
DI bf16x8 lds_frag8x2(LAS unsigned char* p, int second_off) { const s16x4 a = *(LAS const s16x4*)p, b = *(LAS const s16x4*)(p + second_off); return __builtin_shufflevector(a, b, 0, 1, 2, 3, 4, 5, 6, 7); }
#ifndef CONV_EVERY
#define CONV_EVERY (PROBE_DUP == 12 ? 4 : 8)
#endif
#ifndef GLA_SKIP
#define GLA_SKIP 0
#endif
DI void gla_unit(Frame& F, int L, int unit, int skip) {
    PH_IDS;
    const int b = unit >> 2, h = unit & 3;
    LAS unsigned char* lds = F.lds + RING_OFF;
    GAS unsigned char* ws = ws_opaque(F);
    const bf16* pbase = (const bf16*)(ws + WS_PROJ) + (size_t)b * SEQ * NPROJ;
    bf16* mix = (bf16*)(ws + WS_XN);
    const float* nw = INP(float, I_GLA_NW) + L * 256;
    f32x16 S[4];
#pragma unroll
    for (int i = 0; i < 4; ++i)
#pragma unroll
        for (int e = 0; e < 16; ++e) S[i][e] = 0.f;
    if (tid < 256) *(LAS float*)(lds + G_NW + 4 * tid) = nw[tid];
    unsigned gv[8];
#define GLA_LOADG(dst, nn) do { const bf16* r0_ = pbase + (size_t)((nn) * 64 + 8 * wave) * NPROJ + h * 128 + 2 * (tid & 63) + C_GATE; \
        _Pragma("unroll") for (int i = 0; i < 8; ++i) dst[i] = *(const unsigned*)(r0_ + (size_t)i * NPROJ); } while (0)
    GLA_LOADG(gv, 0);
#pragma unroll 1
    for (int n = 0; n < SEQ / 64; ++n) {
        const bf16* prow = pbase + (size_t)(n * 64) * NPROJ;
        int tc = tid; asm volatile("" : "+v"(tc));
        unsigned gvn[8];
#pragma unroll
        for (int i = 0; i < 8; ++i) gvn[i] = 0u;
        {
            const int dp = tc & 63, tg = wave;
            const int vp = tc & 127, tq = tc >> 7;
            unsigned qv[8], kv[8], vv[16];
            { const bf16* r0_ = prow + (size_t)(8 * tg) * NPROJ + h * 128 + 2 * dp;
#pragma unroll
              for (int i = 0; i < 8; ++i) { qv[i] = *(const unsigned*)(r0_ + (size_t)i * NPROJ + C_GQ); kv[i] = *(const unsigned*)(r0_ + (size_t)i * NPROJ + C_GK); }
              const bf16* v0_ = prow + (size_t)(16 * tq) * NPROJ + C_GV + h * 256 + 2 * vp;
#pragma unroll
              for (int i = 0; i < 16; ++i) vv[i] = *(const unsigned*)(v0_ + (size_t)i * NPROJ); }
            if (n + 1 < SEQ / 64) GLA_LOADG(gvn, n + 1);
            float cs0[8], cs1[8]; float a0 = 0.f, a1 = 0.f;
#pragma unroll
            for (int i = 0; i < 8; ++i) { cs0[i] = 0.f; cs1[i] = 0.f; }
            if (!(skip & 16)) {
#pragma unroll
            for (int i = 0; i < 8; ++i) { a0 += log_sigmoid_f(bf_lo(gv[i])) * (1.f / 16.f); a1 += log_sigmoid_f(bf_hi(gv[i])) * (1.f / 16.f); cs0[i] = a0; cs1[i] = a1; } }
            *(LAS f32x2v*)(lds + G_GT + (tg * 128 + 2 * dp) * 4) = (f32x2v){a0, a1};
            __syncthreads();
            if (!(skip & 8)) {
            float p0 = 0.f, p1 = 0.f, t0 = 0.f, t1 = 0.f;
#pragma unroll
            for (int g = 0; g < 8; ++g) { const f32x2v x = *(LAS const f32x2v*)(lds + G_GT + (g * 128 + 2 * dp) * 4); if (g < tg) { p0 += x.x; p1 += x.y; } t0 += x.x; t1 += x.y; }
            v4u kd0, kd1; float kx0[8], kx1[8];
            const float et0 = __expf(t0), et1 = __expf(t1);
#pragma unroll
            for (int i = 0; i < 8; ++i) { const float b0 = p0 + cs0[i], b1 = p1 + cs1[i];
                const float q0 = bf_lo(qv[i]) * GLA_QSCALE * __expf(b0), q1 = bf_hi(qv[i]) * GLA_QSCALE * __expf(b1);
                const float k0 = bf_lo(kv[i]) * __expf(-b0), k1 = bf_hi(kv[i]) * __expf(-b1);
                *(LAS unsigned*)(lds + G_QT + (8 * tg + i) * G_QP + 4 * dp) = pk2(q0, q1);
                *(LAS unsigned*)(lds + G_KT + (8 * tg + i) * G_QP + 4 * dp) = pk2(k0, k1);
                kx0[i] = k0 * et0; kx1[i] = k1 * et1; }
#pragma unroll
            for (int j = 0; j < 4; ++j) { kd0[j] = pk2(kx0[2 * j], kx0[2 * j + 1]); kd1[j] = pk2(kx1[2 * j], kx1[2 * j + 1]); }
            *(LAS v4u*)(lds + G_KDT + (2 * dp) * G_TP + 16 * tg) = kd0; *(LAS v4u*)(lds + G_KDT + (2 * dp + 1) * G_TP + 16 * tg) = kd1;
            if (tg == 0) *(LAS f32x2v*)(lds + G_DEC + 8 * dp) = (f32x2v){et0, et1};
#pragma unroll
            for (int hf = 0; hf < 2; ++hf) { v4u lo4, hi4;
#pragma unroll
                for (int j = 0; j < 4; ++j) { const unsigned x0 = vv[8 * hf + 2 * j], x1 = vv[8 * hf + 2 * j + 1]; lo4[j] = (x0 & 0xffffu) | (x1 << 16); hi4[j] = (x0 >> 16) | (x1 & 0xffff0000u); }
                *(LAS v4u*)(lds + G_VT + (2 * vp) * G_TP + (16 * tq + 8 * hf) * 2) = lo4; *(LAS v4u*)(lds + G_VT + (2 * vp + 1) * G_TP + (16 * tq + 8 * hf) * 2) = hi4; }
            }
        }
        v4u gq[4];
        { const bf16* gp = prow + (size_t)(tc >> 3) * NPROJ + C_GG + h * 256 + 32 * (tc & 7);
#pragma unroll
          for (int j = 0; j < 4; ++j) gq[j] = *(const v4u*)(gp + 8 * j); }
        __syncthreads();
        int t2 = tid; asm volatile("" : "+v"(t2)); const int r = t2 & 31, hh = (t2 >> 5) & 1;
        if (wave < 3 && !(skip & 4)) {
            const int ib = wave ? 1 : 0, jb = wave == 2 ? 1 : 0;
            f32x16 acc;
#pragma unroll
            for (int e = 0; e < 16; ++e) acc[e] = 0.f;
#pragma unroll
            for (int kh = 0; kh < 2; ++kh) { bf16x8 ka[4], qb[4];
#pragma unroll
                for (int k4 = 0; k4 < 4; ++k4) { const int ks = 4 * kh + k4; ka[k4] = lds_frag16(lds + G_KT + (jb * 32 + r) * G_QP + ks * 32 + 16 * hh); qb[k4] = lds_frag16(lds + G_QT + (ib * 32 + r) * G_QP + ks * 32 + 16 * hh); }
                __builtin_amdgcn_sched_barrier(0);
#pragma unroll
                for (int k4 = 0; k4 < 4; ++k4) acc = MFMA32(ka[k4], qb[k4], acc);
                __builtin_amdgcn_sched_barrier(0); }
            const int ci = ib * 32 + r;
#pragma unroll
            for (int g = 0; g < 4; ++g) { const int cj0 = jb * 32 + 8 * g + 4 * hh; float v[4];
#pragma unroll
                for (int e = 0; e < 4; ++e) v[e] = (cj0 + e <= ci) ? acc[4 * g + e] : 0.f;
                *(LAS v2u*)(lds + G_AT + ci * G_TP + cj0 * 2) = (v2u){pk2(v[0], v[1]), pk2(v[2], v[3])}; }
        }
        __syncthreads();
        f32x16 o0, o1;
#pragma unroll
        for (int e = 0; e < 16; ++e) { o0[e] = 0.f; o1[e] = 0.f; }
        if (!(skip & 2)) {
#pragma unroll
        for (int ih = 0; ih < 2; ++ih) {
            bf16x8 qa[2][2][2];
#pragma unroll
            for (int ii = 0; ii < 2; ++ii)
#pragma unroll
                for (int s = 0; s < 2; ++s) { const int d0 = 32 * (2 * ih + ii) + 16 * s + 4 * hh;
                    qa[ii][s][0] = lds_frag8x2(lds + G_QT + r * G_QP + d0 * 2, 16); qa[ii][s][1] = lds_frag8x2(lds + G_QT + (32 + r) * G_QP + d0 * 2, 16); }
            __builtin_amdgcn_sched_barrier(0);
#pragma unroll
            for (int ii = 0; ii < 2; ++ii)
#pragma unroll
                for (int s = 0; s < 2; ++s) { const int i = 2 * ih + ii;
                    v4u pw;
#pragma unroll
                    for (int j = 0; j < 4; ++j) pw[j] = pk2(S[i][8 * s + 2 * j], S[i][8 * s + 2 * j + 1]);
                    const bf16x8 sb = __builtin_bit_cast(bf16x8, pw);
                    o0 = MFMA32(qa[ii][s][0], sb, o0); o1 = MFMA32(qa[ii][s][1], sb, o1); }
            __builtin_amdgcn_sched_barrier(0);
        }
        bf16x8 vf[4], at0[2], at1[4];
#pragma unroll
        for (int ks = 0; ks < 4; ++ks) vf[ks] = lds_frag16(lds + G_VT + (32 * wave + r) * G_TP + ks * 32 + 16 * hh);
#pragma unroll
        for (int ks = 0; ks < 2; ++ks) at0[ks] = lds_frag16(lds + G_AT + r * G_TP + ks * 32 + 16 * hh);
#pragma unroll
        for (int ks = 0; ks < 4; ++ks) at1[ks] = lds_frag16(lds + G_AT + (32 + r) * G_TP + ks * 32 + 16 * hh);
        __builtin_amdgcn_sched_barrier(0);
#pragma unroll
        for (int ks = 0; ks < 2; ++ks) o0 = MFMA32(at0[ks], vf[ks], o0);
#pragma unroll
        for (int ks = 0; ks < 4; ++ks) o1 = MFMA32(at1[ks], vf[ks], o1);
        __builtin_amdgcn_sched_barrier(0);
#pragma unroll
        for (int ih = 0; ih < 2; ++ih) {
            bf16x8 kf[2][4]; f32x4 dc[2][4];
#pragma unroll
            for (int ii = 0; ii < 2; ++ii) { const int i = 2 * ih + ii;
#pragma unroll
                for (int ks = 0; ks < 4; ++ks) kf[ii][ks] = lds_frag16(lds + G_KDT + (32 * i + r) * G_TP + ks * 32 + 16 * hh);
#pragma unroll
                for (int g = 0; g < 4; ++g) dc[ii][g] = *(LAS const f32x4*)(lds + G_DEC + (32 * i + 8 * g + 4 * hh) * 4); }
            __builtin_amdgcn_sched_barrier(0);
#pragma unroll
            for (int ii = 0; ii < 2; ++ii) { const int i = 2 * ih + ii;
#pragma unroll
                for (int g = 0; g < 4; ++g) { S[i][4 * g] *= dc[ii][g].x; S[i][4 * g + 1] *= dc[ii][g].y; S[i][4 * g + 2] *= dc[ii][g].z; S[i][4 * g + 3] *= dc[ii][g].w; }
#pragma unroll
                for (int ks = 0; ks < 4; ++ks) S[i] = MFMA32(kf[ii][ks], vf[ks], S[i]); }
            __builtin_amdgcn_sched_barrier(0);
        }
        }
        __syncthreads();
        if (!(skip & 1)) {
#pragma unroll
        for (int e = 0; e < 16; ++e) { const int c = (e & 3) + 8 * (e >> 2) + 4 * hh;
            *(LAS float*)(lds + G_OB + c * G_OP + wave * G_OC + r * 4) = o0[e]; *(LAS float*)(lds + G_OB + (32 + c) * G_OP + wave * G_OC + r * 4) = o1[e]; }
        }
        __syncthreads();
        if (!(skip & 1))
        {
            int t5 = tid; asm volatile("" : "+v"(t5)); const int c = t5 >> 3, p = t5 & 7;
            f32x4 ov[8]; float ss = 0.f;
#pragma unroll
            for (int j = 0; j < 8; ++j) { ov[j] = *(LAS const f32x4*)(lds + G_OB + c * G_OP + p * G_OC + 16 * j); ss += (ov[j].x * ov[j].x + ov[j].y * ov[j].y) + (ov[j].z * ov[j].z + ov[j].w * ov[j].w); }
            ss += __shfl_xor(ss, 1); ss += __shfl_xor(ss, 2); ss += __shfl_xor(ss, 4);
            const float rstd = 1.0f / sqrtf(ss * (1.f / 256.f) + NORM_EPS);
            bf16* yp = mix + (size_t)(b * SEQ + n * 64 + c) * DM + h * 256 + 32 * p;
#pragma unroll
            for (int j = 0; j < 4; ++j) { const f32x4 w0 = *(LAS const f32x4*)(lds + G_NW + (32 * p + 8 * j) * 4), w1 = *(LAS const f32x4*)(lds + G_NW + (32 * p + 8 * j + 4) * 4); const f32x4 x0 = ov[2 * j], x1 = ov[2 * j + 1];
                float gf[8];
#pragma unroll
                for (int e = 0; e < 4; ++e) { gf[2 * e] = bf_lo(gq[j][e]); gf[2 * e + 1] = bf_hi(gq[j][e]); }
                float y[8];
#pragma unroll
                for (int e = 0; e < 4; ++e) { y[e] = x0[e] * rstd * w0[e]; y[4 + e] = x1[e] * rstd * w1[e]; }
#pragma unroll
                for (int e = 0; e < 8; ++e) y[e] = y[e] * gf[e] * __builtin_amdgcn_rcpf(1.f + __expf(-gf[e]));
                *(v4u*)(yp + 8 * j) = (v4u){pk2(y[0], y[1]), pk2(y[2], y[3]), pk2(y[4], y[5]), pk2(y[6], y[7])}; }
        }
        __syncthreads();
#pragma unroll
        for (int i = 0; i < 8; ++i) gv[i] = gvn[i];
    }
#undef GLA_LOADG
}

typedef swa::BlockRef<swa::bf16, swa::bf16> ABlk;
constexpr int N_GLA = BATCH * 4, N_ATT = BATCH * 16 * (SEQ / 256);
DI ABlk attn_ref(GAS unsigned char* ws, int a) {
    const int qb = (SEQ / 256 - 1) - (a >> 8), rest = a & 255, bb = rest >> 4, vh = rest & 15, hd = vh >> 2, c = (vh >> 1) & 1, vhalf = vh & 1;
    const swa::bf16* proj = (const swa::bf16*)(ws + WS_PROJ); swa::bf16* O = (swa::bf16*)(ws + WS_O);
    ABlk R;
    R.Q = proj + (size_t)(bb * SEQ + qb * 256) * NPROJ + C_DQ + (hd * 2 + c) * 128;
    R.K = proj + (size_t)(bb * SEQ) * NPROJ + C_DK + (hd * 2 + c) * 128;
    R.V = proj + (size_t)(bb * SEQ) * NPROJ + C_DV + hd * 256 + vhalf * 128;
    R.O = O + (size_t)(bb * SEQ + qb * 256) * 2048 + (hd * 2 + c) * 256 + vhalf * 128;
    R.P0 = qb * 256;
    return R;
}
DI int q_next(Frame& F, gu32* head) {
    if (threadIdx.x == 0) F.MISC[16] = __hip_atomic_fetch_add(head, 1u, RLX_AGENT);
    __syncthreads(); const int v = (int)F.MISC[16]; __syncthreads();
    return __builtin_amdgcn_readfirstlane(v);
}
DI void mixer_phase(Frame& F, int qi, int L, char* lds_generic) {
    gu32* head = F.ctl + CW_Q + 64 * qi;
    GAS unsigned char* ws = ws_opaque(F);
    const int G = F.G;
    int it = (int)blockIdx.x;
    const int NCV = (L == 0 && qi == 0) ? N_CONV * (PROBE_DUP == 12 ? 2 : 1) : 0, NCVP = NCV * CONV_EVERY, N_ITEMS = N_GLA + NCV + N_ATT;
    static_assert((long)N_CONV * (PROBE_DUP == 12 ? 2 : 1) * (CONV_EVERY - 1) <= N_ATT, "the conversion items must run out before the attention blocks do");
#define Q_NEXT() (G + q_next(F, head))
#define IS_CONV(p_) ((p_) < NCVP && ((p_) % CONV_EVERY) == 0)
#define ATT_IDX(p_) ((p_) < NCVP ? (p_) - (p_) / CONV_EVERY - 1 : (p_) - NCV)
    while (it < N_GLA) { _Pragma("unroll 1") for (int gr = (PROBE_DUP == 10) ? 1 : 0; gr >= 0; --gr) gla_unit(F, L, it, gr ? GLA_SKIP : 0); it = Q_NEXT(); }
#pragma unroll 1
    while (it < N_ITEMS) {
        const int p = it - N_GLA;
        if (IS_CONV(p)) { conv_item(F, (p / CONV_EVERY) % N_CONV); it = Q_NEXT(); continue; }
        ABlk cur = attn_ref(ws, ATT_IDX(p));
        unsigned pend0 = 0u;
        if (threadIdx.x == 0) pend0 = __hip_atomic_fetch_add(head, 1u, RLX_AGENT);
        swa::Seam<swa::bf16> S;
        swa::causal_swa_prime<swa::bf16, swa::bf16>(cur, SEQ, lds_generic, S);
        if (threadIdx.x == 0) F.MISC[20] = pend0;
        __syncthreads();
        int nx = G + __builtin_amdgcn_readfirstlane((int)F.MISC[20]);
        for (;;) {
            const int pn = nx - N_GLA;
            const bool last = nx >= N_ITEMS || IS_CONV(pn);
            const ABlk nxt = last ? cur : attn_ref(ws, ATT_IDX(pn));
            unsigned pend = 0u;
            if (!last && threadIdx.x == 0) pend = __hip_atomic_fetch_add(head, 1u, RLX_AGENT);
            swa::causal_swa_block<swa::bf16, swa::bf16>(cur, nxt, SEQ, SEQ, lds_generic, S);
            if (last) break;
            if (threadIdx.x == 0) F.MISC[20] = pend;
            __syncthreads();
            cur = nxt; nx = G + __builtin_amdgcn_readfirstlane((int)F.MISC[20]);
        }
        it = nx;
    }
#undef IS_CONV
#undef ATT_IDX
#undef Q_NEXT
}


template <class Sched> DI void rstd_tables(Frame& F, const Sched& S, const float* ss, LAS float* rt) {
    constexpr int RT_SHIFT = Sched::RT_SHIFT, RT_SLOTS = Sched::RT_SLOTS;
    const int t = opaque_tid();
    pg8::Unit u; int tag[RT_SLOTS];
#pragma unroll
    for (int s = 0; s < RT_SLOTS; ++s) tag[s] = -2;
    for (int i = 0; S.next(i, u); ++i) { const int sl = (u.pm >> RT_SHIFT) & (RT_SLOTS - 1);
#pragma unroll
        for (int s = 0; s < RT_SLOTS; ++s) if (s == sl) tag[s] = (tag[s] == -2 || tag[s] == u.pm) ? u.pm : -1; }
#pragma unroll
    for (int slot = 0; slot < RT_SLOTS; ++slot) { const int pm = tag[slot];
        if (pm >= 0 && t < 256) { const f32x4* p = (const f32x4*)(ss + (size_t)(pm * 256 + t) * 8); const f32x4 a = p[0], b = p[1];
            rt[slot * 256 + t] = __builtin_amdgcn_rsqf((((a[0] + a[1]) + (a[2] + a[3])) + ((b[0] + b[1]) + (b[2] + b[3]))) * (1.0f / DM) + NORM_EPS); }
        if (t == 0) ((LAS int*)(rt + RT_SLOTS * 256))[slot] = pm; }
    __syncthreads();
}

DI int virt_c(Frame& F) {
    if (MK_SPLIT) return (int)blockIdx.x;
    bool ok = (F.G % 8) == 0;
#pragma unroll
    for (int j = 0; j < 8; ++j) ok = ok && (__hip_atomic_load(F.ctl + CW_VC + 64 * j, RLX_AGENT) == (unsigned)(F.G / 8));
    const int v = (int)(F.MISC[24] + 8u * F.MISC[25]);
    return __builtin_amdgcn_readfirstlane(ok ? v : (int)blockIdx.x);
}

__global__ void __launch_bounds__(NWAVES * 64, 2) fwd(Args args) {
    extern __shared__ __attribute__((aligned(16))) unsigned char lds[];
    Frame F;
    F.lds = (LAS unsigned char*)lds;
    F.MISC = (volatile LAS unsigned*)(F.lds + MISC_OFF);
    F.G = gridDim.x; F.NGW = F.G * NWAVES;
    F.ws = args.ws; F.ctl = (gu32*)(args.ws + WS_CTL);
    for (int u = threadIdx.x; u < (LDS_BYTES - LDSCTL_OFF) / 4; u += NWAVES * 64) ((LAS unsigned*)(F.lds + LDSCTL_OFF))[u] = 0u;
    __syncthreads();
    if (!MK_SPLIT && threadIdx.x == 0) { const unsigned x = xb_xcc_id(); F.MISC[24] = x; F.MISC[25] = __hip_atomic_fetch_add(F.ctl + CW_VC + 64 * (x & 15u), 1u, RLX_AGENT); }
    XcdBarrier bar; bar.bar = (unsigned*)(F.ctl + CW_BAR); bar.x = 0; bar.st = nullptr;
    if (!MK_SPLIT) bar = xcd_barrier_post((unsigned*)(F.ctl + CW_BAR), F.MISC + 8);
#define GRID_BAR() do { if (!MK_SPLIT) { _Pragma("unroll 1") for (int br_ = (PROBE_DUP == 11) ? 1 : 0; br_ >= 0; --br_) { XcdBarrier b2_ = bar; GAS unsigned* bp_ = (GAS unsigned*)bar.bar; asm volatile("" : "+s"(bp_), "+s"(b2_.x)); b2_.bar = (unsigned*)bp_; xcd_barrier(b2_); } } } while (0)
    const int lo = args.ph_lo, hi = args.ph_hi;
#define IN(k) (lo <= (k) && (k) < hi)
#define BOTH(k) (IN(k) && IN((k) + 1))

#ifndef REV_DN
#define REV_DN 0
#endif
#ifndef STAGGER_US
#define STAGGER_US 0
#endif
#define STAGGER() do { if (STAGGER_US && (blockIdx.x & 1)) { const unsigned long long t0_ = __builtin_amdgcn_s_memrealtime(); while (__builtin_amdgcn_s_memrealtime() - t0_ < (unsigned long long)(STAGGER_US * 100)) __builtin_amdgcn_s_sleep(8); } } while (0)
#define NREP(k) ((PROBE_DUP == (k)) ? 2 : 1)
#define REPLOOP(k) _Pragma("unroll 1") for (int rep = NREP(k) - 1; rep >= 0; --rep)
#define REPBAR() do { if (rep) GRID_BAR(); } while (0)
    if (IN(0)) { REPLOOP(9) { p0_prologue(F); REPBAR(); } if (BOTH(0)) GRID_BAR(); }
    const int vc = (!MK_SPLIT && lo == 0) ? virt_c(F) : (int)blockIdx.x;
#pragma unroll 1
    for (int L = 0; L < DEPTH; ++L) {
        const int pb = 1 + L * PH_PER_LAYER;
        if (IN(pb + 0)) { REPLOOP(2) {
            GAS unsigned char* ws = ws_opaque(F);
            typedef pg8::Gemm<M, NPROJ, DM> GT; typedef pg8::StaticOrder<M, GATE_ITEMS ? NPROJ - 512 : NPROJ, WGM_IN, false, GATE_ITEMS ? C_GATE / 256 : (1 << 30), GATE_ITEMS ? 2 : 0> ST;     GT g{(const bf16*)OUTP(), (const bf16*)(ws + WS_WIN) + (size_t)L * NPROJ * DM}; ST S; S.init(F.G, vc);
            rstd_tables(F, S, (const float*)(ws + WS_SS) + (size_t)(2 * L) * M * 8, (LAS float*)(F.lds + RT_OFF));
            typedef pg8::EpiProj<NPROJ, DM, C_GATE / 256, C_DQ / 256, C_DK / 256, C_DV / 256, ST::RT_SHIFT, ST::RT_SLOTS> ET; ET E{(bf16*)(ws + WS_PROJ), (const float*)(ws + WS_BIAS) + L * NPROJ, (const LAS float*)(F.lds + RT_OFF), (const float*)(ws + WS_SS) + (size_t)(2 * L) * M * 8,
                INP(float, I_QNW) + L * 128, INP(float, I_KNW) + L * 128, (const unsigned*)(ws + WS_ROPE), (LAS float*)(F.lds + RED_OFF)};
            STAGGER(); pg8::gemm_phase<ET, ST, GT, true, true>(F.lds + RING_OFF, g, S, E); if (GATE_ITEMS) { _Pragma("unroll 1") for (int gr_ = NREP(13); gr_ > 0; --gr_) gate_item(F, L, (vc & 7) * 32 + (vc >> 3)); }      REPBAR(); }
            if (BOTH(pb + 0)) GRID_BAR();
        }
        if (IN(pb + 1)) {
            REPLOOP(3) { mixer_phase(F, L + 2 * rep, L, (char*)lds + RING_OFF); REPBAR(); }
            if (BOTH(pb + 1)) GRID_BAR(); }
        if (IN(pb + 2)) { REPLOOP(4) { combine_phase(F, L); REPBAR(); } if (BOTH(pb + 2)) GRID_BAR(); }
        if (IN(pb + 3)) { REPLOOP(5) {
            GAS unsigned char* ws = ws_opaque(F);
            typedef pg8::Gemm<M, DM, DM> GT; typedef pg8::StaticOrder<M, DM, WGM_OUT> ST; GT g{(const bf16*)(ws + WS_XN), (const bf16*)(ws + WS_WOUT) + (size_t)L * DM * DM}; ST S; S.init(F.G, vc);
            typedef pg8::EpiRes<DM, false> ET; ET E{(const bf16*)OUTP(), nullptr, (bf16*)(ws + (rep ? WS_HID : WS_XB2)), (float*)(ws + WS_SS) + (size_t)(rep ? 4 : 2 * L + 1) * M * 8, (LAS float*)(F.lds + RED_OFF)};
            STAGGER(); pg8::gemm_phase<ET, ST, GT, true, true>(F.lds + RING_OFF, g, S, E); REPBAR(); }
            if (BOTH(pb + 3)) GRID_BAR();
        }
        if (IN(pb + 4)) { REPLOOP(7) {
            GAS unsigned char* ws = ws_opaque(F);
            typedef pg8::Gemm<M, DFF, DM> GT; typedef pg8::StaticOrder<M, DFF, WGM_UP> ST; GT g{(const bf16*)(ws + WS_XB2), (const bf16*)(ws + WS_WUP) + (size_t)L * DFF * DM}; ST S; S.init(F.G, vc);
            rstd_tables(F, S, (const float*)(ws + WS_SS) + (size_t)(2 * L + 1) * M * 8, (LAS float*)(F.lds + RT_OFF));
            typedef pg8::EpiBf16<2, DFF, DM, ST::RT_SHIFT, ST::RT_SLOTS, HID_TILED != 0> ET; ET E{(bf16*)(ws + WS_HID), nullptr, (const LAS float*)(F.lds + RT_OFF), (const float*)(ws + WS_SS) + (size_t)(2 * L + 1) * M * 8};
            STAGGER(); pg8::gemm_phase<ET, ST, GT, true, true>(F.lds + RING_OFF, g, S, E); REPBAR(); }
            if (BOTH(pb + 4)) GRID_BAR();
        }
        if (IN(pb + 5)) { REPLOOP(8) {
            GAS unsigned char* ws = ws_opaque(F);
            typedef pg8::Gemm<M, DM, DFF, HID_TILED != 0> GT; typedef pg8::StaticOrder<M, DM, WGM_DN, (REV_DN != 0)> ST; GT g{(const bf16*)(ws + WS_HID), (const bf16*)(ws + WS_WDN) + (size_t)L * DM * DFF}; ST S; S.init(F.G, vc);
            if (L + 1 < DEPTH) { typedef pg8::EpiRes<DM, false> ET; ET E{(const bf16*)(ws + WS_XB2), nullptr, (bf16*)OUTP(), (float*)(ws + WS_SS) + (size_t)(2 * L + 2) * M * 8, (LAS float*)(F.lds + RED_OFF)};
                STAGGER(); pg8::gemm_phase<ET, ST, GT, true, true>(F.lds + RING_OFF, g, S, E); }
            else { typedef pg8::EpiRes<DM, true> ET; ET E{(const bf16*)(ws + WS_XB2), OUTP(), nullptr, nullptr, nullptr};
                STAGGER(); pg8::gemm_phase<ET, ST, GT, true, true>(F.lds + RING_OFF, g, S, E); }
            REPBAR(); }
            if (BOTH(pb + 5)) GRID_BAR();
        }
    }
#undef IN
#undef BOTH
}

extern "C" void kernel_launch(void* const* d_in, const int* in_sizes, int n_in, void* d_out, int out_size, void* d_ws, size_t ws_size, hipStream_t stream) {
    static int grid = 0;
    if (grid == 0) {
        if (n_in != 18 || in_sizes[0] != M * DM || out_size != M * DM || ws_size < WS_END) { fprintf(stderr, "kernel_launch: built for 18 inputs, x/out of %d floats, >= %zu bytes of workspace; got n_in %d, in0 %d, out %d, ws %zu; nothing launched\n", M * DM, (size_t)WS_END, n_in, n_in > 0 ? in_sizes[0] : -1, out_size, ws_size); grid = -1; return; }
        int dev = 0, cus = 0, per_cu = 0;
        if (hipGetDevice(&dev) != hipSuccess || hipDeviceGetAttribute(&cus, hipDeviceAttributeMultiprocessorCount, dev) != hipSuccess) { fprintf(stderr, "kernel_launch: hipGetDevice / hipDeviceGetAttribute failed; nothing launched\n"); grid = -1; return; }
        if (hipFuncSetAttribute((const void*)fwd, hipFuncAttributeMaxDynamicSharedMemorySize, LDS_BYTES) != hipSuccess) { fprintf(stderr, "kernel_launch: hipFuncSetAttribute failed\n"); grid = -1; return; }
        if (hipOccupancyMaxActiveBlocksPerMultiprocessor(&per_cu, (const void*)fwd, NWAVES * 64, LDS_BYTES) != hipSuccess || per_cu < 1) fprintf(stderr, "kernel_launch: note: occupancy query reports %d workgroups per CU\n", per_cu);
        (void)hipGetLastError();
        grid = cus;
        if (cus != 256) { fprintf(stderr, "kernel_launch: built for a 256-CU device (one workgroup per CU; the per-phase row-statistics tables assume the static unit order of a 256-workgroup grid); found %d CUs; nothing launched\n", cus); grid = -1; return; }
    }
    if (grid < 0) return;
    if (hipMemsetAsync((char*)d_ws + WS_CTL, 0, CTL_ZERO_BYTES, stream) != hipSuccess) { fprintf(stderr, "kernel_launch: hipMemsetAsync failed; nothing launched\n"); return; }
    Args a{};
    for (int i = 0; i < 18; ++i) a.in[i] = d_in[i];
    a.out = (float*)d_out; a.ws = (unsigned char*)d_ws;
#if MK_SPLIT
    for (int p = 0; p < N_PHASES; ++p) { a.ph_lo = p; a.ph_hi = p + 1; hipLaunchKernelGGL(fwd, dim3(grid), dim3(NWAVES * 64), LDS_BYTES, stream, a); }
#else
    a.ph_lo = 0; a.ph_hi = N_PHASES; hipLaunchKernelGGL(fwd, dim3(grid), dim3(NWAVES * 64), LDS_BYTES, stream, a);
#endif
    const hipError_t le = hipPeekAtLastError();
    if (le != hipSuccess) fprintf(stderr, "kernel_launch: launch failed: %s\n", hipGetErrorName(le));
}
```

```cpp
#include <hip/hip_runtime.h>
#include <hip/hip_bf16.h>
#include <cstdio>
#include <cstdint>
#include <cmath>
namespace pg8 {
#define PG8_LAS __attribute__((address_space(3)))
typedef unsigned short bf16_t;
typedef short bf16x8 __attribute__((ext_vector_type(8)));
typedef float f32x4 __attribute__((ext_vector_type(4)));
typedef unsigned u32x4 __attribute__((ext_vector_type(4)));
constexpr int BM = 256, BK = 64, HALF = 128, HTB = HALF * BK * 2  , STAGE_BYTES = 8 * HTB, NXCD = 8, WGM = 4;

__host__ __device__ __forceinline__ int lds_byte(int r, int c) { const int st = (r >> 4) * 2 + (c >> 5), rr = r & 15, cc = c & 31, ob = rr * 64 + cc * 2; return st * 1024 + (ob ^ (((ob >> 9) & 1) << 5)); }
__host__ __device__ __forceinline__ void stage_rc(int b, int& R, int& C) { const int st = b / 1024, sb = b % 1024, swz = sb ^ (((sb >> 9) & 1) << 5); R = (st >> 1) * 16 + swz / 64; C = (st & 1) * 32 + (swz % 64) / 2; }
__host__ __device__ __forceinline__ int perm32(int rho) { const int n = rho >> 4, i = rho & 15; return 8 * (i >> 2) + 4 * n + (i & 3); }

struct Unit { int pm, pn; };
template <int M_, int N_, int K_, bool A_TILED_ = false> struct Gemm { const bf16_t* A; const bf16_t* Bt; static constexpr int M = M_, N = N_, K = K_; static constexpr bool A_TILED = A_TILED_; };

template <int M_, int N_, int WGM_ = WGM, bool REV_ = false, int GAP_AT_ = 1 << 30, int GAP_N_ = 0> struct StaticOrder {
    static constexpr int WGM = WGM_, RT_SHIFT = (WGM_ == 2) ? 1 : (WGM_ == 4) ? 2 : (WGM_ == 8) ? 3 : 4, RT_SLOTS = (16 / WGM_) < 1 ? 1 : (16 / WGM_);
    static constexpr int nM = M_ / BM, nN = N_ / BM, nwg = nM * nN;
    int G, c;
    __host__ __device__ void init(int G_, int c_) { G = G_; c = c_; }
    __host__ __device__ bool next(int i, Unit& u) const {
        const int nr = nwg / G; const bool rev = REV_ && (nwg % G) == 0; if (rev && i >= nr) return false;
        const long L = (long)(rev ? nr - 1 - i : i) * G + c; if (L >= nwg) return false;
        int wgid = (int)L; { constexpr int q = nwg / NXCD, r = nwg % NXCD; const int xcd = wgid % NXCD, off = wgid / NXCD; wgid = (xcd < r ? xcd * (q + 1) : r * (q + 1) + (xcd - r) * q) + off; }
        constexpr int nig = WGM * nN; const int gid = wgid / nig, fm = gid * WGM, gsz = (nM - fm) < WGM ? (nM - fm) : WGM;
        u.pm = fm + ((wgid % nig) % gsz); u.pn = (wgid % nig) / gsz; if (u.pn >= GAP_AT_) u.pn += GAP_N_; return true;
    }
    __device__ __forceinline__ void a_ready(const Unit&) const {}
    __device__ __forceinline__ void done(const Unit&) const {}
};
__device__ __forceinline__ unsigned cvt_pk_bf16(float lo, float hi) { unsigned r; asm volatile("v_cvt_pk_bf16_f32 %0, %1, %2" : "=v"(r) : "v"(lo), "v"(hi)); return r; }
typedef float f32x2 __attribute__((ext_vector_type(2)));
#ifndef PG8_NT_STORE
#define PG8_NT_STORE 0
#endif
__device__ __forceinline__ float sum_fq(float s) {
    { auto r = __builtin_amdgcn_permlane16_swap(__float_as_uint(s), __float_as_uint(s), false, false); s = __uint_as_float(r[0]) + __uint_as_float(r[1]); }
    { auto r = __builtin_amdgcn_permlane32_swap(__float_as_uint(s), __float_as_uint(s), false, false); s = __uint_as_float(r[0]) + __uint_as_float(r[1]); }
    return s; }
__device__ __forceinline__ float h2f_lo(unsigned u) { return (float)__builtin_bit_cast(_Float16, (unsigned short)(u & 0xffffu)); }
__device__ __forceinline__ float h2f_hi(unsigned u) { return (float)__builtin_bit_cast(_Float16, (unsigned short)(u >> 16)); }
__device__ __forceinline__ void st16(bf16_t* p, u32x4 w) { if (PG8_NT_STORE) __builtin_nontemporal_store(w, (u32x4*)p); else *(u32x4*)p = w; }
template <int ACT, int ldc, int KN, int RT_SHIFT, int RT_SLOTS, bool OTILED = false> struct EpiBf16 {
    static constexpr bool PERM = true, AFTER_DRAIN = false;
    bf16_t* O; const float* bias; const PG8_LAS float* rt; const float* ss;
    __device__ __forceinline__ void operator()(const f32x4 (&acc)[2][2][4][2], const Unit& u, int wr, int wc, int fr, int fq) const {
        const int row0 = u.pm * BM + wr * 64 + fr; const int col0 = u.pn * BM + wc * 32 + 8 * fq;
        f32x4 bv[2][2];
#pragma unroll
        for (int bj = 0; bj < 2; ++bj)
#pragma unroll
            for (int n = 0; n < 2; ++n) bv[bj][n] = bias ? *(const f32x4*)(bias + col0 + bj * HALF + 4 * n) : (f32x4){0.f, 0.f, 0.f, 0.f};
        float rs[2][4];
#pragma unroll
        for (int ai = 0; ai < 2; ++ai)
#pragma unroll
            for (int m = 0; m < 4; ++m) rs[ai][m] = rt[((u.pm >> RT_SHIFT) & (RT_SLOTS - 1)) * BM + wr * 64 + fr + ai * HALF + m * 16];
        if (((const PG8_LAS int*)(rt + RT_SLOTS * BM))[(u.pm >> RT_SHIFT) & (RT_SLOTS - 1)] != u.pm) {
#pragma unroll
            for (int ai = 0; ai < 2; ++ai)
#pragma unroll
                for (int m = 0; m < 4; ++m) rs[ai][m] = __builtin_nanf("");
        }
#pragma unroll
        for (int ai = 0; ai < 2; ++ai)
#pragma unroll
            for (int m = 0; m < 4; ++m) { bf16_t* rowp = OTILED ? O + ((size_t)(u.pm * (ldc / 64) + u.pn * 4 + (wc >> 1)) * (BM * 64) + (wr * 64 + fr + ai * HALF + m * 16) * 64 + (wc & 1) * 32 + 8 * fq)
                                                                : O + (size_t)(row0 + ai * HALF + m * 16) * ldc + col0;
                const float rstd = rs[ai][m];
#pragma unroll
                for (int bj = 0; bj < 2; ++bj) { f32x4 v0 = acc[ai][bj][m][0] * rstd + bv[bj][0], v1 = acc[ai][bj][m][1] * rstd + bv[bj][1];
                    if (ACT == 2) {
#pragma unroll
                        for (int e = 0; e < 4; ++e) { const float a = fmaxf(v0[e], 0.f), b = fmaxf(v1[e], 0.f); v0[e] = a * a; v1[e] = b * b; } }
                    u32x4 w; w.x = cvt_pk_bf16(v0[0], v0[1]); w.y = cvt_pk_bf16(v0[2], v0[3]); w.z = cvt_pk_bf16(v1[0], v1[1]); w.w = cvt_pk_bf16(v1[2], v1[3]);
                    st16(rowp + (OTILED ? bj * 2 * (BM * 64) : bj * HALF), w); } }
    }
};
template <int ldc, int KN, int PNB, int PNQ, int PNK, int PNV, int RT_SHIFT, int RT_SLOTS> struct EpiProj {
    static constexpr bool PERM = true, AFTER_DRAIN = false;
    bf16_t* O; const float* bias; const PG8_LAS float* rt; const float* ss; const float* qw; const float* kw; const unsigned* rope; PG8_LAS float* red;
    __device__ __forceinline__ void operator()(const f32x4 (&acc)[2][2][4][2], const Unit& u, int wr, int wc, int fr, int fq) const {
        const int row0 = u.pm * BM + wr * 64 + fr; const int col0 = u.pn * BM + wc * 32 + 8 * fq;
        float rs[2][4];
#pragma unroll
        for (int ai = 0; ai < 2; ++ai)
#pragma unroll
            for (int m = 0; m < 4; ++m) rs[ai][m] = rt[((u.pm >> RT_SHIFT) & (RT_SLOTS - 1)) * BM + wr * 64 + fr + ai * HALF + m * 16];
        if (((const PG8_LAS int*)(rt + RT_SLOTS * BM))[(u.pm >> RT_SHIFT) & (RT_SLOTS - 1)] != u.pm) {
#pragma unroll
            for (int ai = 0; ai < 2; ++ai)
#pragma unroll
                for (int m = 0; m < 4; ++m) rs[ai][m] = __builtin_nanf("");
        }
        if (u.pn < PNQ || u.pn >= PNV) {
            f32x4 bv[2][2];
#pragma unroll
            for (int bj = 0; bj < 2; ++bj)
#pragma unroll
                for (int n = 0; n < 2; ++n) bv[bj][n] = (f32x4){0.f, 0.f, 0.f, 0.f};
            if (u.pn >= PNB && u.pn < PNQ) {
#pragma unroll
                for (int bj = 0; bj < 2; ++bj)
#pragma unroll
                    for (int n = 0; n < 2; ++n) bv[bj][n] = *(const f32x4*)(bias + col0 + bj * HALF + 4 * n); }
            asm volatile("" ::: "memory");
#pragma unroll
            for (int ai = 0; ai < 2; ++ai)
#pragma unroll
                for (int m = 0; m < 4; ++m) { bf16_t* rowp = O + (size_t)(row0 + ai * HALF + m * 16) * ldc + col0; const float rstd = rs[ai][m];
#pragma unroll
                    for (int bj = 0; bj < 2; ++bj) { const f32x4 v0 = acc[ai][bj][m][0] * rstd + bv[bj][0], v1 = acc[ai][bj][m][1] * rstd + bv[bj][1];
                        u32x4 w; w.x = cvt_pk_bf16(v0[0], v0[1]); w.y = cvt_pk_bf16(v0[2], v0[3]); w.z = cvt_pk_bf16(v1[0], v1[1]); w.w = cvt_pk_bf16(v1[2], v1[3]);
                        st16(rowp + bj * HALF, w); } }
        } else {
            const float* w = (u.pn < PNK) ? qw : kw; const int i0 = 16 * wc + 4 * fq;
            const f32x4 wlo = *(const f32x4*)(w + i0), whi = *(const f32x4*)(w + 64 + i0);
            u32x4 cs[2][4];
#pragma unroll
            for (int ai = 0; ai < 2; ++ai)
#pragma unroll
                for (int m = 0; m < 4; ++m)
#pragma unroll
                    for (int bj = 0; bj < 2; ++bj) { const f32x4 v0 = acc[ai][bj][m][0] * rs[ai][m], v1 = acc[ai][bj][m][1] * rs[ai][m]; const f32x4 q = v0 * v0 + v1 * v1; float s = (q[0] + q[1]) + (q[2] + q[3]);
                        s = sum_fq(s);
                        if (fq == 0) red[((wr * 64 + fr + ai * HALF + m * 16) * 2 + bj) * 4 + wc] = s; }
            asm volatile("s_waitcnt lgkmcnt(0)" ::: "memory"); __builtin_amdgcn_s_barrier(); asm volatile("" ::: "memory");
#pragma unroll
            for (int ai = 0; ai < 2; ++ai)
#pragma unroll
                for (int m = 0; m < 4; ++m) cs[ai][m] = *(const u32x4*)(rope + (size_t)(row0 + ai * HALF + m * 16) * 64 + i0);
#pragma unroll
            for (int ai = 0; ai < 2; ++ai) {
#pragma unroll
                for (int m = 0; m < 4; ++m) { bf16_t* rowp = O + (size_t)(row0 + ai * HALF + m * 16) * ldc + col0; const u32x4 t = cs[ai][m]; const f32x4 cc = {h2f_lo(t.x), h2f_lo(t.y), h2f_lo(t.z), h2f_lo(t.w)}, sn = {h2f_hi(t.x), h2f_hi(t.y), h2f_hi(t.z), h2f_hi(t.w)};
#pragma unroll
                    for (int bj = 0; bj < 2; ++bj) { const f32x4 p = *(const PG8_LAS f32x4*)(red + ((wr * 64 + fr + ai * HALF + m * 16) * 2 + bj) * 4);
                        const float rh = rs[ai][m] * __builtin_amdgcn_rsqf(((p[0] + p[1]) + (p[2] + p[3])) * (1.0f / 128.0f) + 1e-6f);
                        const f32x4 v0 = acc[ai][bj][m][0] * rh, v1 = acc[ai][bj][m][1] * rh;
                        const float a0 = v0[0] * wlo[0], b0 = v0[1] * whi[0], a1 = v0[2] * wlo[1], b1 = v0[3] * whi[1], a2 = v1[0] * wlo[2], b2 = v1[1] * whi[2], a3 = v1[2] * wlo[3], b3 = v1[3] * whi[3];
                        u32x4 o; o.x = cvt_pk_bf16(a0 * cc[0] - b0 * sn[0], a0 * sn[0] + b0 * cc[0]); o.y = cvt_pk_bf16(a1 * cc[1] - b1 * sn[1], a1 * sn[1] + b1 * cc[1]);
                        o.z = cvt_pk_bf16(a2 * cc[2] - b2 * sn[2], a2 * sn[2] + b2 * cc[2]); o.w = cvt_pk_bf16(a3 * cc[3] - b3 * sn[3], a3 * sn[3] + b3 * cc[3]);
                        st16(rowp + bj * HALF, o); } }
                asm volatile("" ::: "memory");
            }
        }
    }
};
template <int ldc, bool FINAL> struct EpiRes {
    static constexpr bool PERM = true, AFTER_DRAIN = false;
    const bf16_t* base; float* out; bf16_t* xb; float* ss; PG8_LAS float* red;
    __device__ __forceinline__ void operator()(const f32x4 (&acc)[2][2][4][2], const Unit& u, int wr, int wc, int fr, int fq) const {
        const int row0 = u.pm * BM + wr * 64 + fr; const int col0 = u.pn * BM + wc * 32 + 8 * fq;
        u32x4 bq[2][4][2];
#pragma unroll
        for (int ai = 0; ai < 2; ++ai)
#pragma unroll
            for (int m = 0; m < 4; ++m) { const size_t off = (size_t)(row0 + ai * HALF + m * 16) * ldc + col0; bq[ai][m][0] = *(const u32x4*)(base + off); bq[ai][m][1] = *(const u32x4*)(base + off + HALF); }
        asm volatile("" ::: "memory");
#pragma unroll
        for (int ai = 0; ai < 2; ++ai)
#pragma unroll
            for (int m = 0; m < 4; ++m) { const size_t off = (size_t)(row0 + ai * HALF + m * 16) * ldc + col0;
                f32x4 x[2][2];
#pragma unroll
                for (int bj = 0; bj < 2; ++bj) { const u32x4 b = bq[ai][m][bj];
                    x[bj][0] = (f32x4){__uint_as_float(b.x << 16), __uint_as_float(b.x & 0xffff0000u), __uint_as_float(b.y << 16), __uint_as_float(b.y & 0xffff0000u)} + acc[ai][bj][m][0];
                    x[bj][1] = (f32x4){__uint_as_float(b.z << 16), __uint_as_float(b.z & 0xffff0000u), __uint_as_float(b.w << 16), __uint_as_float(b.w & 0xffff0000u)} + acc[ai][bj][m][1]; }
                if constexpr (FINAL) {
                    *(f32x4*)(out + off) = x[0][0]; *(f32x4*)(out + off + 4) = x[0][1]; *(f32x4*)(out + off + HALF) = x[1][0]; *(f32x4*)(out + off + HALF + 4) = x[1][1];
                } else {
                    u32x4 w0, w1; w0.x = cvt_pk_bf16(x[0][0][0], x[0][0][1]); w0.y = cvt_pk_bf16(x[0][0][2], x[0][0][3]); w0.z = cvt_pk_bf16(x[0][1][0], x[0][1][1]); w0.w = cvt_pk_bf16(x[0][1][2], x[0][1][3]);
                    w1.x = cvt_pk_bf16(x[1][0][0], x[1][0][1]); w1.y = cvt_pk_bf16(x[1][0][2], x[1][0][3]); w1.z = cvt_pk_bf16(x[1][1][0], x[1][1][1]); w1.w = cvt_pk_bf16(x[1][1][2], x[1][1][3]);
                    *(u32x4*)(xb + off) = w0; *(u32x4*)(xb + off + HALF) = w1;
                    const f32x4 q = x[0][0] * x[0][0] + x[0][1] * x[0][1] + x[1][0] * x[1][0] + x[1][1] * x[1][1]; float s = (q[0] + q[1]) + (q[2] + q[3]);
                    s = sum_fq(s);
                    if (fq == 0) red[(wr * 64 + fr + ai * HALF + m * 16) * 4 + wc] = s; } }
        if constexpr (!FINAL) {
            asm volatile("s_waitcnt lgkmcnt(0)" ::: "memory"); __builtin_amdgcn_s_barrier(); asm volatile("" ::: "memory");
            const int t = threadIdx.x;
            if (t < BM) { const f32x4 p = *(const PG8_LAS f32x4*)(red + t * 4); ss[(size_t)(u.pm * BM + t) * 8 + u.pn] = (p[0] + p[1]) + (p[2] + p[3]); }
        }
    }
};
template <class Epi, class Sched, class GemmT, bool ALIGN_EPI = false, bool SP2 = false>
__device__ __forceinline__ void gemm_phase(PG8_LAS unsigned char* lds, const GemmT g, const Sched& S, const Epi& E) {
    int tid_ = threadIdx.x; asm volatile("" : "+v"(tid_));
    const int tid = tid_, wid = __builtin_amdgcn_readfirstlane(tid >> 6), lane = tid & 63, wr = wid >> 2, wc = wid & 3, fr = lane & 15, fq = lane >> 4;
    constexpr int K = GemmT::K, nt = K / BK;
    unsigned voffA[2], voffB[2];
#pragma unroll
    for (int i = 0; i < 2; ++i) { int R, C; stage_rc(tid * 16 + i * 8192, R, C); const int Rb = Epi::PERM ? ((R & ~31) + perm32(R & 31)) : R;
        voffA[i] = GemmT::A_TILED ? (unsigned)(R * BK + C) * 2u : (unsigned)(R * K + C) * 2u; voffB[i] = (unsigned)(Rb * K + C) * 2u; }
    constexpr size_t kstep = (size_t)(BK * 2);
    constexpr size_t hstep = (size_t)HALF * K * 2;
    constexpr size_t tstep = 2 * hstep;
    constexpr size_t kstepA = GemmT::A_TILED ? (size_t)BM * BK * 2 : kstep, hstepA = GemmT::A_TILED ? (size_t)HALF * BK * 2 : hstep, tstepA = tstep;
    const unsigned ldsw = (unsigned)wid * 1024u;
    const int aoff = lds_byte(wr * 64 + fr, fq * 8), boff = lds_byte(wc * 32 + fr, fq * 8);
#define PG8_SA(b, h) (((b) * 2 + (h)) * HTB)
#define PG8_SB(b, h) ((4 + (b) * 2 + (h)) * HTB)
#define PG8_STAGE(bufoff, gbase, voff) do { const char* gb_ = (const char*)(gbase); asm volatile("" : "+s"(gb_)); _Pragma("unroll") for (int _i = 0; _i < 2; ++_i) \
        __builtin_amdgcn_global_load_lds((const unsigned*)(gb_ + (voff)[_i]), (PG8_LAS unsigned*)(lds + (bufoff) + ldsw + _i * 8192), 16, 0, 0); } while (0)
#define PG8_VOFFS() asm volatile("" : "+v"(voffA[0]), "+v"(voffA[1]), "+v"(voffB[0]), "+v"(voffB[1]))
#define PG8_LDA(dst, b, h) do { _Pragma("unroll") for (int m = 0; m < 4; ++m) _Pragma("unroll") for (int k = 0; k < 2; ++k) dst[m][k] = *(const PG8_LAS bf16x8*)(lds + PG8_SA(b, h) + aoff + m * 2048 + k * 1024); } while (0)
#define PG8_LDB(dst, b, h) do { _Pragma("unroll") for (int n = 0; n < 2; ++n) _Pragma("unroll") for (int k = 0; k < 2; ++k) dst[n][k] = *(const PG8_LAS bf16x8*)(ldsB_ + ((b) * 2 + (h)) * HTB + n * 2048 + k * 1024); } while (0)
#define PG8_MMA(ai, bj, At, Bt) do { __builtin_amdgcn_s_setprio(1); _Pragma("unroll") for (int m = 0; m < 4; ++m) _Pragma("unroll") for (int n = 0; n < 2; ++n) _Pragma("unroll") for (int k = 0; k < 2; ++k) \
        acc[ai][bj][m][n] = __builtin_amdgcn_mfma_f32_16x16x32_bf16(Bt[n][k], At[m][k], acc[ai][bj][m][n], 0, 0, 0); __builtin_amdgcn_s_setprio(0); } while (0)
#define PG8_WAIT_V(n) asm volatile("s_waitcnt vmcnt(" #n ")" ::: "memory")
#define PG8_WAIT_L(n) asm volatile("s_waitcnt lgkmcnt(" #n ")" ::: "memory")
#define PG8_BAR __builtin_amdgcn_s_barrier()
#define PG8_SCHED __builtin_amdgcn_sched_barrier(0)
    PG8_LAS unsigned char* ldsB_ = lds + 4 * HTB + boff; asm volatile("" : "+v"(ldsB_));
    Unit cur, nxt; int ui = 0;
    if (!S.next(0, cur)) return;
    f32x4 acc[2][2][4][2];
#pragma unroll
    for (int a = 0; a < 2; ++a)
#pragma unroll
        for (int b = 0; b < 2; ++b)
#pragma unroll
            for (int m = 0; m < 4; ++m)
#pragma unroll
                for (int n = 0; n < 2; ++n) acc[a][b][m][n] = (f32x4){0.f, 0.f, 0.f, 0.f};
    bf16x8 At[4][2], B0[2][2], B1[2][2];
    const char* cA = (const char*)g.A + (size_t)cur.pm * tstepA; const char* cB = (const char*)g.Bt + (size_t)cur.pn * tstep;
    S.a_ready(cur);
    { PG8_VOFFS();
    if constexpr (SP2) {
        PG8_STAGE(PG8_SB(0, 0), cB, voffB); PG8_STAGE(PG8_SB(0, 1), cB + hstep, voffB); PG8_STAGE(PG8_SA(0, 0), cA, voffA); PG8_STAGE(PG8_SA(0, 1), cA + hstepA, voffA);
        if (wr == 1) PG8_BAR;
        PG8_WAIT_V(2); PG8_BAR;
        PG8_STAGE(PG8_SB(1, 0), cB + kstep, voffB); PG8_STAGE(PG8_SA(1, 0), cA + kstepA, voffA); PG8_STAGE(PG8_SB(1, 1), cB + hstep + kstep, voffB);
        PG8_WAIT_V(6); PG8_BAR;
    } else {
        PG8_STAGE(PG8_SB(0, 0), cB, voffB); PG8_STAGE(PG8_SA(0, 0), cA, voffA); PG8_STAGE(PG8_SB(0, 1), cB + hstep, voffB); PG8_STAGE(PG8_SA(0, 1), cA + hstepA, voffA);
        if (wr == 1) PG8_BAR;
        PG8_WAIT_V(4); PG8_BAR;
        PG8_STAGE(PG8_SB(1, 0), cB + kstep, voffB); PG8_STAGE(PG8_SA(1, 0), cA + kstepA, voffA); PG8_STAGE(PG8_SB(1, 1), cB + hstep + kstep, voffB);
        PG8_WAIT_V(6); PG8_BAR;
    }
    }
    for (;;) {
        const bool has_next = S.next(ui + 1, nxt);
        const char* nA = has_next ? (const char*)g.A + (size_t)nxt.pm * tstepA : cA; const char* nB = has_next ? (const char*)g.Bt + (size_t)nxt.pn * tstep : cB;
        for (int t = 0; t < nt; t += 2) {
            const bool last = (t == nt - 2);
            PG8_VOFFS();
            const char* a1 = cA + (size_t)(t + 1) * kstepA;
            const char* a2 = last ? nA : cA + (size_t)(t + 2) * kstepA; const char* b2 = last ? nB : cB + (size_t)(t + 2) * kstep;
            const char* a3 = a2 + kstepA; const char* b3 = b2 + kstep;
            if (last && has_next) S.a_ready(nxt);
            if constexpr (SP2) {
            PG8_LDB(B0, 0, 0); PG8_LDB(B1, 0, 1); PG8_SCHED; PG8_LDA(At, 0, 0); PG8_STAGE(PG8_SA(1, 1), a1 + hstepA, voffA);
            PG8_WAIT_V(8); PG8_WAIT_L(0); PG8_BAR; PG8_MMA(0, 0, At, B0); PG8_MMA(0, 1, At, B1); PG8_BAR; PG8_SCHED;
            PG8_LDA(At, 0, 1); PG8_STAGE(PG8_SB(0, 0), b2, voffB); PG8_STAGE(PG8_SB(0, 1), b2 + hstep, voffB); PG8_STAGE(PG8_SA(0, 0), a2, voffA);
            PG8_WAIT_V(8); PG8_WAIT_L(0); PG8_BAR; PG8_MMA(1, 0, At, B0); PG8_MMA(1, 1, At, B1); PG8_BAR; PG8_SCHED;
            PG8_LDB(B0, 1, 0); PG8_LDB(B1, 1, 1); PG8_SCHED; PG8_LDA(At, 1, 0); PG8_STAGE(PG8_SA(0, 1), a2 + hstepA, voffA);
            PG8_WAIT_V(8); PG8_WAIT_L(0); PG8_BAR; PG8_MMA(0, 0, At, B0); PG8_MMA(0, 1, At, B1); PG8_BAR; PG8_SCHED;
            PG8_LDA(At, 1, 1); PG8_STAGE(PG8_SB(1, 0), b3, voffB); PG8_STAGE(PG8_SB(1, 1), b3 + hstep, voffB); PG8_STAGE(PG8_SA(1, 0), a3, voffA);
            PG8_WAIT_V(8); PG8_WAIT_L(0); PG8_BAR; PG8_MMA(1, 0, At, B0); PG8_MMA(1, 1, At, B1); PG8_BAR; PG8_SCHED;
            } else {
            PG8_LDB(B0, 0, 0); PG8_SCHED; PG8_LDA(At, 0, 0); PG8_STAGE(PG8_SA(1, 1), a1 + hstepA, voffA);
            PG8_WAIT_L(8); PG8_BAR; PG8_WAIT_L(0); PG8_MMA(0, 0, At, B0); PG8_BAR; PG8_SCHED;
            PG8_LDB(B1, 0, 1); PG8_STAGE(PG8_SB(0, 0), b2, voffB);
            PG8_BAR; PG8_WAIT_L(0); PG8_MMA(0, 1, At, B1); PG8_BAR;
            PG8_LDA(At, 0, 1); PG8_STAGE(PG8_SA(0, 0), a2, voffA);
            PG8_BAR; PG8_WAIT_L(0); PG8_MMA(1, 0, At, B0); PG8_BAR; PG8_SCHED;
            PG8_STAGE(PG8_SB(0, 1), b2 + hstep, voffB);
            PG8_WAIT_V(6); PG8_BAR; PG8_MMA(1, 1, At, B1); PG8_BAR;
            PG8_LDB(B0, 1, 0); PG8_SCHED; PG8_LDA(At, 1, 0); PG8_STAGE(PG8_SA(0, 1), a2 + hstepA, voffA);
            PG8_WAIT_L(8); PG8_BAR; PG8_WAIT_L(0); PG8_MMA(0, 0, At, B0); PG8_BAR; PG8_SCHED;
            PG8_LDB(B1, 1, 1); PG8_STAGE(PG8_SB(1, 0), b3, voffB);
            PG8_BAR; PG8_WAIT_L(0); PG8_MMA(0, 1, At, B1); PG8_BAR;
            PG8_LDA(At, 1, 1); PG8_STAGE(PG8_SA(1, 0), a3, voffA);
            PG8_BAR; PG8_WAIT_L(0); PG8_MMA(1, 0, At, B0); PG8_BAR; PG8_SCHED;
            PG8_STAGE(PG8_SB(1, 1), b3 + hstep, voffB);
            PG8_WAIT_V(6); PG8_BAR; PG8_MMA(1, 1, At, B1); PG8_BAR;
            }
        }
        if constexpr (ALIGN_EPI) { if (wr == 0) PG8_BAR; }
        if constexpr (!Epi::AFTER_DRAIN) { E(acc, cur, wr, wc, fr, fq); S.done(cur); }
        if (!has_next) break;
#pragma unroll
        for (int a = 0; a < 2; ++a)
#pragma unroll
            for (int b = 0; b < 2; ++b)
#pragma unroll
                for (int m = 0; m < 4; ++m)
#pragma unroll
                    for (int n = 0; n < 2; ++n) acc[a][b][m][n] = (f32x4){0.f, 0.f, 0.f, 0.f};
        cur = nxt; cA = nA; cB = nB; ++ui;
        if constexpr (ALIGN_EPI) { if (wr == 1) PG8_BAR; }
    }
    PG8_WAIT_V(0);
    if constexpr (!ALIGN_EPI) { if (wr == 0) PG8_BAR; }
    PG8_BAR;
    if constexpr (Epi::AFTER_DRAIN) { E.fused(acc, cur, wr, wc, fr, fq, lds, wid, lane); S.done(cur); }
#undef PG8_SA
#undef PG8_SB
#undef PG8_STAGE
#undef PG8_VOFFS
#undef PG8_LDA
#undef PG8_LDB
#undef PG8_MMA
#undef PG8_WAIT_V
#undef PG8_WAIT_L
#undef PG8_BAR
#undef PG8_SCHED
}
}
namespace swa {
constexpr int D = 128;
constexpr int KVPITCH = 6656, QPITCH = 6656, OPITCH = 2048;
constexpr float THR = 8.f;
constexpr bool WSKIP = false;
constexpr float SCALE = 0.08838834764831845f;
constexpr int NW = 8, QBLK = 32, KVBLK = 64, QB = NW * QBLK;
constexpr int SHM_V = KVBLK * D * 2, SHM_K = KVBLK * D * 2;
constexpr int LDS_BYTES = 2 * SHM_V + 2 * SHM_K + NW * 64 * 4;
using bf16 = __hip_bfloat16;
typedef short bf16x8 __attribute__((ext_vector_type(8)));
typedef short s16x4 __attribute__((ext_vector_type(4)));
typedef float f32x16 __attribute__((ext_vector_type(16)));
typedef float f32x4 __attribute__((ext_vector_type(4)));
typedef unsigned u32x4 __attribute__((ext_vector_type(4)));
template <class A, class Bt> struct same_t { static constexpr bool v = false; };
template <class A> struct same_t<A, A> { static constexpr bool v = true; };

#define KSWZ(row, colB) ((row) * 256 + ((colB) ^ (((row) & 7) << 4)))
#define SBAR() __builtin_amdgcn_sched_barrier(0)
__device__ __forceinline__ int v_st(int k, int c) { const int kk = (k & ~0xC) | ((k & 4) << 1) | ((k & 8) >> 1); return ((kk >> 3) * 4 + (c >> 5)) * 512 + ((kk & 7) * 32 + (c & 31)) * 2; }
__device__ __forceinline__ int v_rd_base(int lane) { return ((lane & 3) << 3) | (((lane >> 2) & 3) << 6) | (((lane >> 4) & 1) << 5) | (((lane >> 5) & 1) << 8); }
constexpr int v_rd_off(int d0, int ks, int half) { return d0 * 512 + ks * 4096 + half * 2048; }
__device__ __forceinline__ int crow(int r, int hi) { return (r & 3) + 8 * (r >> 2) + 4 * hi; }
__device__ __forceinline__ unsigned cvtpk(float lo, float hi) {
    unsigned r; asm volatile("v_cvt_pk_bf16_f32 %0, %1, %2" : "=v"(r) : "v"(lo), "v"(hi)); return r;
}
__device__ __forceinline__ bf16x8 pack8(f32x4 a, f32x4 b) {
    u32x4 w = {cvtpk(a[0], a[1]), cvtpk(a[2], a[3]), cvtpk(b[0], b[1]), cvtpk(b[2], b[3])};
    return *reinterpret_cast<bf16x8*>(&w);
}
template <class T> __device__ __forceinline__ bf16x8 load8(const T* p) {
    if constexpr (same_t<T, float>::v) { return pack8(*(const f32x4*)p, *(const f32x4*)(p + 4)); }
    else { return *reinterpret_cast<const bf16x8*>(p); }
}
__device__ __forceinline__ void mask_tile(f32x16& p0, f32x16& p1, int dq, unsigned W) {
    const float NEG = -__builtin_inff();
#pragma unroll
    for (int r = 0; r < 16; ++r) {
        const int c = (r & 3) + 8 * (r >> 2);
        if ((unsigned)(dq - c) >= W) p0[r] = NEG;
        if ((unsigned)(dq - c - 32) >= W) p1[r] = NEG;
    }
}
__device__ __forceinline__ void partialSM(f32x16& p0, f32x16& p1, float& m_reg, float& mn, float& alpha) {
    float pmax = p0[0]; for (int r = 1; r < 16; ++r) pmax = fmaxf(pmax, p0[r]); for (int r = 0; r < 16; ++r) pmax = fmaxf(pmax, p1[r]);
    { auto rr = __builtin_amdgcn_permlane32_swap(__float_as_uint(pmax), __float_as_uint(pmax), false, false);
      pmax = fmaxf(__uint_as_float(rr[0]), __uint_as_float(rr[1])); }
    constexpr float C2 = 1.4426950408889634f * SCALE;
    if (__builtin_expect(__all((pmax - m_reg) * SCALE <= THR), 1)) { mn = m_reg; alpha = 1.f; }
    else { mn = fmaxf(m_reg, pmax); alpha = __builtin_amdgcn_exp2f((m_reg - mn) * C2); m_reg = mn; }
    const float mnL = -mn * C2;
    for (int r = 0; r < 16; ++r) p0[r] = fmaf(p0[r], C2, mnL); for (int r = 0; r < 16; ++r) p1[r] = fmaf(p1[r], C2, mnL);
    for (int r = 0; r < 16; ++r) p0[r] = __builtin_amdgcn_exp2f(p0[r]);
}
__device__ __forceinline__ void finishSM(f32x16& p0, f32x16& p1, float alpha, float& l_reg, bf16x8& pa0, bf16x8& pa1, bf16x8& pa2, bf16x8& pa3) {
    for (int r = 0; r < 16; ++r) p1[r] = __builtin_amdgcn_exp2f(p1[r]);
    float ps = 0; for (int r = 0; r < 16; ++r) ps += p0[r]; for (int r = 0; r < 16; ++r) ps += p1[r];
    { auto rr = __builtin_amdgcn_permlane32_swap(__float_as_uint(ps), __float_as_uint(ps), false, false);
      ps = __uint_as_float(rr[0]) + __uint_as_float(rr[1]); }
    l_reg = l_reg * alpha + ps;
#define PK4(P, B_, OUT) do { unsigned a0 = cvtpk(P[B_+0], P[B_+1]), a1 = cvtpk(P[B_+2], P[B_+3]);                          \
        unsigned b0 = cvtpk(P[B_+4], P[B_+5]), b1 = cvtpk(P[B_+6], P[B_+7]);                                             \
        auto r0 = __builtin_amdgcn_permlane32_swap(a0, b0, false, false); auto r1 = __builtin_amdgcn_permlane32_swap(a1, b1, false, false); \
        u32x4 w = {r0[0], r1[0], r0[1], r1[1]}; OUT = *reinterpret_cast<bf16x8*>(&w); } while (0)
    PK4(p0, 0, pa0); PK4(p0, 8, pa1); PK4(p1, 0, pa2); PK4(p1, 8, pa3);
#undef PK4
}
template <int KB, bool SK>
__device__ __forceinline__ void qkt(f32x16& p0, f32x16& p1, const char* K_lds, int r32, int hi, const bf16x8* qr, bool act) {
    if (SK && !act) { const float NEG = -__builtin_inff();
#pragma unroll
        for (int r = 0; r < 16; ++r) { p0[r] = NEG; p1[r] = NEG; } return; }
    p0 = f32x16{}; p1 = f32x16{};
    const char* kb[4];
#pragma unroll
    for (int dd = 0; dd < 4; ++dd) kb[dd] = K_lds + KB * SHM_K + KSWZ(r32, (dd * 16 + hi * 8) * 2);
#pragma unroll
    for (int d0 = 0; d0 < 8; ++d0) { const char* a = kb[d0 & 3] + (d0 >> 2) * 128;
        bf16x8 b0 = *reinterpret_cast<const bf16x8*>(a);
        bf16x8 b1 = *reinterpret_cast<const bf16x8*>(a + 32 * 256);
        p0 = __builtin_amdgcn_mfma_f32_32x32x16_bf16(b0, qr[d0], p0, 0, 0, 0);
        p1 = __builtin_amdgcn_mfma_f32_32x32x16_bf16(b1, qr[d0], p1, 0, 0, 0); }
}
template <int VB, bool SK>
__device__ __forceinline__ void pv_tile(f32x16* o, int vb0, bf16x8 pa0, bf16x8 pa1, bf16x8 pa2, bf16x8 pa3, bool act) {
    if (SK && !act) return;
#define TRRD(dst, off) asm volatile("ds_read_b64_tr_b16 %0, %1 offset:%2" : "=&v"(dst) : "v"(vb0), "i"(off) : "memory")
#define PV_D0(d0) do { s16x4 l0, l1, l2, l3, h0, h1, h2, h3; constexpr int b_ = VB * SHM_V + v_rd_off(d0, 0, 0);     \
        TRRD(l0, b_); TRRD(h0, b_ + 2048); TRRD(l1, b_ + 4096); TRRD(h1, b_ + 6144); TRRD(l2, b_ + 8192); TRRD(h2, b_ + 10240); TRRD(l3, b_ + 12288); TRRD(h3, b_ + 14336); \
        asm volatile("s_waitcnt lgkmcnt(0)" ::: "memory"); SBAR();                 \
        o[d0] = __builtin_amdgcn_mfma_f32_32x32x16_bf16(pa0, (bf16x8){l0[0], l0[1], l0[2], l0[3], h0[0], h0[1], h0[2], h0[3]}, o[d0], 0, 0, 0);   \
        o[d0] = __builtin_amdgcn_mfma_f32_32x32x16_bf16(pa1, (bf16x8){l1[0], l1[1], l1[2], l1[3], h1[0], h1[1], h1[2], h1[3]}, o[d0], 0, 0, 0);   \
        o[d0] = __builtin_amdgcn_mfma_f32_32x32x16_bf16(pa2, (bf16x8){l2[0], l2[1], l2[2], l2[3], h2[0], h2[1], h2[2], h2[3]}, o[d0], 0, 0, 0);   \
        o[d0] = __builtin_amdgcn_mfma_f32_32x32x16_bf16(pa3, (bf16x8){l3[0], l3[1], l3[2], l3[3], h3[0], h3[1], h3[2], h3[3]}, o[d0], 0, 0, 0); } while (0)
    PV_D0(0); PV_D0(1); PV_D0(2); PV_D0(3);
#undef PV_D0
#undef TRRD
}

template <class TIn, class TOut> struct BlockRef { const TIn* Q; const TIn* K; const TIn* V; TOut* O; int P0; };
template <class TIn> struct Seam {
    bf16x8 qr[8];
    bf16x8 st_v0, st_v1, st_k0, st_k1; f32x4 sf0, sf1, sf2, sf3;
    f32x4 tq[16];
};
__device__ __forceinline__ int swa_jlo(int P0, int W) { const int lowk = P0 - W + 1; return lowk > 0 ? lowk / KVBLK : 0; }
#define ROW(p, k0, rr) ((p) + (size_t)((k0) + (rr)) * KVPITCH + sc)
#define VMW() asm volatile("s_waitcnt vmcnt(0)" ::: "memory")
#define VMWN(n) asm volatile("s_waitcnt vmcnt(%0)" :: "i"(n) : "memory")
#define SLOAD_H(Kp, Vp, k0) do { S.st_v0 = load8<TIn>(ROW(Vp, k0, sr)); S.st_v1 = load8<TIn>(ROW(Vp, k0, 32 + sr));              \
                         S.st_k0 = load8<TIn>(ROW(Kp, k0, sr)); S.st_k1 = load8<TIn>(ROW(Kp, k0, 32 + sr)); } while (0)
#define SWRITE_HK(bf) do { *(bf16x8*)(K_lds + (bf) * SHM_K + kws) = S.st_k0; *(bf16x8*)(K_lds + (bf) * SHM_K + kws + 32 * 256) = S.st_k1; } while (0)
#define SWRITE_HV(bf) do { *(bf16x8*)(V_lds + (bf) * SHM_V + vst0) = S.st_v0; *(bf16x8*)(V_lds + (bf) * SHM_V + vst1) = S.st_v1; } while (0)
#define SWRITE_H(bf) do { SWRITE_HV(bf); SWRITE_HK(bf); } while (0)
#define SLOAD_F(p, k0) do { S.sf0 = *(const f32x4*)ROW(p, k0, sr); S.sf1 = *(const f32x4*)(ROW(p, k0, sr) + 4);                \
                            S.sf2 = *(const f32x4*)ROW(p, k0, 32 + sr); S.sf3 = *(const f32x4*)(ROW(p, k0, 32 + sr) + 4); } while (0)
#define SWRITE_KF(bf) do { *(bf16x8*)(K_lds + (bf) * SHM_K + kws) = pack8(S.sf0, S.sf1); *(bf16x8*)(K_lds + (bf) * SHM_K + kws + 32 * 256) = pack8(S.sf2, S.sf3); } while (0)
#define SWRITE_VF(bf) do { *(bf16x8*)(V_lds + (bf) * SHM_V + vst0) = pack8(S.sf0, S.sf1); *(bf16x8*)(V_lds + (bf) * SHM_V + vst1) = pack8(S.sf2, S.sf3); } while (0)
template <class TIn, class TOut>
__device__ __forceinline__ void causal_swa_prime(const BlockRef<TIn, TOut>& cur, int W, char* lds, Seam<TIn>& S) {
    constexpr bool F32 = same_t<TIn, float>::v;
    int tid_ = threadIdx.x; asm volatile("" : "+v"(tid_)); const int tid = tid_, wid = __builtin_amdgcn_readfirstlane(tid >> 6), lane = tid & 63, r32 = lane & 31, hi = lane >> 5;
    const int sr = tid >> 4, sc = (tid & 15) * 8, kws = KSWZ(sr, sc * 2); char* K_lds = lds + 2 * SHM_V;
    const int kb0 = swa_jlo(cur.P0, W) * KVBLK;
    for (int d0 = 0; d0 < 8; ++d0) S.qr[d0] = load8<TIn>(cur.Q + (size_t)(wid * QBLK + r32) * QPITCH + d0 * 16 + hi * 8);
    if constexpr (F32) { SLOAD_F((const float*)cur.K, kb0); VMW(); SWRITE_KF(0); SBAR(); SLOAD_F((const float*)cur.V, kb0); }
    else { SLOAD_H(cur.K, cur.V, kb0); VMW(); SWRITE_HK(0); }
    __syncthreads();
}
template <class TIn, class TOut>
__device__ __forceinline__ void causal_swa_block(const BlockRef<TIn, TOut>& cur, const BlockRef<TIn, TOut>& nxt, int skv, int W, char* lds, Seam<TIn>& S) {
    constexpr bool F32 = same_t<TIn, float>::v;
    int tid_ = threadIdx.x; asm volatile("" : "+v"(tid_)); const int tid = tid_, wid = __builtin_amdgcn_readfirstlane(tid >> 6), lane = tid & 63, r32 = lane & 31, hi = lane >> 5;
    const int j_lo = swa_jlo(cur.P0, W);
    int j_hi = (cur.P0 + QB - 1) / KVBLK + 1; if (j_hi > skv / KVBLK) j_hi = skv / KVBLK;
    const int NT = j_hi - j_lo;
    const int kbn = swa_jlo(nxt.P0, W) * KVBLK;
    const int qlo = cur.P0 + wid * QBLK, qm = qlo + r32 - 4 * hi;
    char* V_lds = lds; char* K_lds = lds + 2 * SHM_V;
    float* ws = (float*)(lds + 2 * SHM_V + 2 * SHM_K) + wid * 64; float* li_l = ws, * al_l = ws + 32;
    float m_reg = -1e30f, l_reg = 0; f32x16 o[4] = {};
    const int sr = tid >> 4, sc = (tid & 15) * 8, vst0 = v_st(sr, sc), vst1 = v_st(32 + sr, sc), kws = KSWZ(sr, sc * 2);
    const int vb0 = (int)(uintptr_t)V_lds + v_rd_base(lane);
    const TIn* Kh = cur.K; const TIn* Vh = cur.V;
#define RESC(a) do { if (__any((a) < 1.f)) { if (hi == 0) al_l[r32] = (a); asm volatile("s_waitcnt lgkmcnt(0)" ::: "memory");              \
                     for (int d_ = 0; d_ < 4; ++d_) for (int r = 0; r < 16; ++r) o[d_][r] *= al_l[crow(r, hi)]; } } while (0)
#define KBASE(t) ((j_lo + (t)) * KVBLK)
#define ACT(t) (KBASE(t) <= qlo + QBLK - 1 && KBASE(t) + KVBLK - 1 >= qlo - W + 1)
#define MASKT(P0_, P1_, t) do { const int kb_ = KBASE(t); if ((!SK || ACT(t)) && (kb_ + KVBLK - 1 > qlo || kb_ <= qlo + QBLK - 1 - W)) mask_tile(P0_, P1_, qm - kb_, (unsigned)W); } while (0)
    constexpr int NQL = F32 ? 16 : 8;
    constexpr bool SK = WSKIP && !F32;
#define SEAM_K0() do { VMWN(NQL); if constexpr (F32) { SWRITE_KF(0); SBAR(); SLOAD_F((const float*)nxt.V, kbn); } else { SWRITE_HK(0); } SBAR(); } while (0)
    f32x16 pA0, pA1, pB0, pB1; float mnA, mnB, alA, alB; bf16x8 pa0, pa1, pa2, pa3;
    if constexpr (F32) { VMW(); SWRITE_VF(0); SBAR(); } else { SWRITE_HV(0); SBAR(); }
    if (NT > 1) { if constexpr (F32) SLOAD_F((const float*)Kh, KBASE(1)); else SLOAD_H(Kh, Vh, KBASE(1)); }
    SBAR(); qkt<0, SK>(pA0, pA1, K_lds, r32, hi, S.qr, ACT(0));
    if constexpr (F32) { if (NT > 1) { VMW(); SWRITE_KF(1); SBAR(); SLOAD_F((const float*)Vh, KBASE(1)); } }
    MASKT(pA0, pA1, 0); partialSM(pA0, pA1, m_reg, mnA, alA);
    if (NT > 1) { VMW(); if constexpr (F32) { SWRITE_VF(1); SBAR(); if (NT > 2) SLOAD_F((const float*)Kh, KBASE(2)); } else SWRITE_H(1); }
    __syncthreads();
#define HALF_STEP(PX0, PX1, mnX, alX, PY0, PY1, alY, t, KB, VB, SB) do {                                                      \
        SBAR(); qkt<KB, SK>(PX0, PX1, K_lds, r32, hi, S.qr, ACT(t));                                             \
        finishSM(PY0, PY1, alY, l_reg, pa0, pa1, pa2, pa3); SBAR();                                                           \
        if ((t) + 1 < NT) { if constexpr (F32) { VMW(); SWRITE_KF(SB); SBAR(); SLOAD_F((const float*)Vh, KBASE((t) + 1)); }  \
                            else { SLOAD_H(Kh, Vh, KBASE((t) + 1)); } SBAR(); }                                               \
        pv_tile<VB, SK>(o, vb0, pa0, pa1, pa2, pa3, ACT((t) - 1)); MASKT(PX0, PX1, (t)); partialSM(PX0, PX1, m_reg, mnX, alX);                                        \
        __syncthreads();                                                                                                      \
        if ((t) + 1 < NT) { VMW(); if constexpr (F32) { SWRITE_VF(SB); SBAR(); if ((t) + 2 < NT) SLOAD_F((const float*)Kh, KBASE((t) + 2)); } \
                            else { SWRITE_H(SB); } }                                                                          \
        RESC(alX); __syncthreads(); } while (0)
    for (int t = 1; t + 1 < NT; t += 2) {
        HALF_STEP(pB0, pB1, mnB, alB, pA0, pA1, alA, t, 1, 0, 0);
        HALF_STEP(pA0, pA1, mnA, alA, pB0, pB1, alB, t + 1, 0, 1, 1);
    }
    const bool even = (NT & 1) == 0;
    if (even) { SBAR(); qkt<1, SK>(pB0, pB1, K_lds, r32, hi, S.qr, ACT(NT - 1)); SBAR(); }
#define QROW(e) (nxt.Q + (size_t)(wid * QBLK + r32) * QPITCH + ((e) >> 1) * 16 + hi * 8 + ((e) & 1) * 4)
    if constexpr (F32) { SLOAD_F((const float*)nxt.K, kbn); SBAR();
#pragma unroll
        for (int e = 0; e < 8; ++e) S.tq[e] = *(const f32x4*)QROW(e); }
    else { SLOAD_H(nxt.K, nxt.V, kbn); SBAR();
#pragma unroll
        for (int d0 = 0; d0 < 8; ++d0) S.qr[d0] = load8<TIn>(nxt.Q + (size_t)(wid * QBLK + r32) * QPITCH + d0 * 16 + hi * 8); }
    SBAR();
    finishSM(pA0, pA1, alA, l_reg, pa0, pa1, pa2, pa3); SBAR();
    if constexpr (F32) {
#pragma unroll
        for (int e = 8; e < 16; ++e) S.tq[e] = *(const f32x4*)QROW(e); SBAR(); }
#undef QROW
    pv_tile<0, SK>(o, vb0, pa0, pa1, pa2, pa3, ACT(even ? NT - 2 : NT - 1));
    if (even) { MASKT(pB0, pB1, NT - 1); partialSM(pB0, pB1, m_reg, mnB, alB); __syncthreads(); RESC(alB);
        finishSM(pB0, pB1, alB, l_reg, pa0, pa1, pa2, pa3); SBAR(); pv_tile<1, SK>(o, vb0, pa0, pa1, pa2, pa3, ACT(NT - 1)); }
    SBAR(); SEAM_K0();
    if (hi == 0) li_l[r32] = l_reg; asm volatile("s_waitcnt lgkmcnt(0)" ::: "memory");
    float rli[16];
#pragma unroll
    for (int r = 0; r < 16; ++r) rli[r] = __builtin_amdgcn_rcpf(li_l[crow(r, hi)]);
    TOut* Ow = cur.O + (size_t)(wid * QBLK) * OPITCH;
#pragma unroll
    for (int r = 0; r < 16; ++r) { const int orow = crow(r, hi);
        if constexpr (same_t<TOut, float>::v) {
#pragma unroll
            for (int d0 = 0; d0 < 4; ++d0) Ow[(size_t)orow * OPITCH + d0 * 32 + r32] = o[d0][r] * rli[r];
        } else {
            typedef unsigned v2u_t __attribute__((ext_vector_type(2)));
            v2u_t w; w.x = cvtpk(o[0][r] * rli[r], o[1][r] * rli[r]); w.y = cvtpk(o[2][r] * rli[r], o[3][r] * rli[r]);
            *(v2u_t*)(Ow + (size_t)orow * OPITCH + r32 * 4) = w; } }
    if constexpr (F32) {
#pragma unroll
        for (int d0 = 0; d0 < 8; ++d0) S.qr[d0] = pack8(S.tq[2 * d0], S.tq[2 * d0 + 1]); }
    __syncthreads();
#undef RESC
#undef KBASE
#undef ACT
#undef MASKT
#undef SEAM_K0
#undef HALF_STEP
}
#undef ROW
#undef VMW
#undef VMWN
#undef SLOAD_H
#undef SWRITE_HK
#undef SWRITE_HV
#undef SWRITE_H
#undef SLOAD_F
#undef SWRITE_KF
#undef SWRITE_VF

}
constexpr int NWAVES = 8;
#ifndef MK_SPLIT
#define MK_SPLIT 0
#endif
constexpr int BATCH = 16, SEQ = 2048, DM = 2048, M = BATCH * SEQ, DEPTH = 2, DFF = 8192;
constexpr int IN_COLS = 6160;
constexpr int NPROJ = 6656;
constexpr int C_GQ = 0, C_GK = 512, C_GV = 1024, C_GG = 2048, C_GATE = 3072, C_DQ = 3584, C_DK = 4608, C_DV = 5632;
constexpr int S_LR = 3072, S_SHIFT = 496;
constexpr int PH_PER_LAYER = 6, N_PHASES = 1 + DEPTH * PH_PER_LAYER;
constexpr float NORM_EPS = 1e-6f, SUBLN_EPS = 1e-5f;
constexpr float GLA_QSCALE = 0.08838834764831845f;

constexpr size_t MiB = 1u << 20;
constexpr size_t WS_CTL = 0, CTL_ZERO_BYTES = 1 * MiB;
constexpr size_t WS_BIAS = 1 * MiB;
constexpr size_t WS_WLRT = 1 * MiB + 256 * 1024;
constexpr size_t WS_W2F = 1 * MiB + 512 * 1024;
constexpr size_t WS_ROPE = 2 * MiB;
constexpr size_t WS_WIN = 18 * MiB;
constexpr size_t WS_WOUT = 70 * MiB;
constexpr size_t WS_WUP = 86 * MiB;
constexpr size_t WS_WDN = 150 * MiB;
constexpr size_t WS_XN = 214 * MiB;
constexpr size_t WS_XB2 = 342 * MiB;
constexpr size_t WS_PROJ = 342 * MiB;
constexpr size_t WS_O = 758 * MiB;
constexpr size_t WS_HID = 470 * MiB;
constexpr size_t WS_SS = 1014 * MiB;
constexpr size_t WS_END = 1019 * MiB;
static_assert(WS_WIN + (size_t)DEPTH * NPROJ * DM * 2 <= WS_WOUT && WS_WOUT + (size_t)DEPTH * DM * DM * 2 <= WS_WUP && WS_WUP + (size_t)DEPTH * DFF * DM * 2 <= WS_WDN && WS_WDN + (size_t)DEPTH * DFF * DM * 2 <= WS_XN, "ws map: weights");
static_assert(WS_XN + (size_t)M * DM * 2 <= WS_PROJ && WS_PROJ + (size_t)M * NPROJ * 2 <= WS_O && WS_O + (size_t)M * 2048 * 4 <= WS_END && WS_HID + (size_t)M * DFF * 2 <= WS_END && WS_XB2 + (size_t)M * DM * 2 <= WS_HID, "ws map: activations");
constexpr int CW_BAR = 4096;
constexpr int CW_VC = 9216;
constexpr int CW_Q = 8192;


constexpr int RING_OFF = 0, RING_BYTES = 131072;
constexpr int LDSCTL_OFF = RING_BYTES, MISC_OFF = LDSCTL_OFF + 320;
constexpr int RED_OFF = RING_BYTES + 1024;
constexpr int LDS_BYTES = 147456;
constexpr int RT_OFF = RED_OFF + 8192;
static_assert(MISC_OFF + 128 <= RED_OFF && RT_OFF + 4096 + 64 <= LDS_BYTES, "LDS map");

#define GAS __attribute__((address_space(1)))
#define LAS __attribute__((address_space(3)))
#define DI __device__ __forceinline__
typedef unsigned short bf16;
typedef unsigned v4u __attribute__((ext_vector_type(4)));
typedef unsigned v2u __attribute__((ext_vector_type(2)));
typedef float f32x4 __attribute__((ext_vector_type(4)));
typedef float f32x2v __attribute__((ext_vector_type(2)));
typedef float f32x16 __attribute__((ext_vector_type(16)));
typedef short bf16x8 __attribute__((ext_vector_type(8)));
typedef short s16x4 __attribute__((ext_vector_type(4)));
typedef __bf16 bf16x2_t __attribute__((ext_vector_type(2)));
typedef GAS unsigned gu32;
#define RLX_AGENT __ATOMIC_RELAXED, __HIP_MEMORY_SCOPE_AGENT
#define LDS_WAIT() asm volatile("s_waitcnt lgkmcnt(0)" ::: "memory")
#define VM_WAIT() asm volatile("s_waitcnt vmcnt(0)" ::: "memory")
DI unsigned pk2(float lo, float hi) { f32x2v v = {lo, hi}; bf16x2_t b = __builtin_convertvector(v, bf16x2_t); return __builtin_bit_cast(unsigned, b); }
DI float bf_lo(unsigned u) { return __uint_as_float(u << 16); }
DI float bf_hi(unsigned u) { return __uint_as_float(u & 0xffff0000u); }
DI int opaque_tid() { int t = threadIdx.x; asm volatile("" : "+v"(t)); return t; }
#define PH_IDS const int tid = opaque_tid(), lane = tid & 63, wave = __builtin_amdgcn_readfirstlane(tid >> 6), gw = (int)blockIdx.x * NWAVES + wave; (void)lane; (void)gw
#define MFMA32(a, b, c) __builtin_amdgcn_mfma_f32_32x32x16_bf16((a), (b), (c), 0, 0, 0)

#define XB_TMO      128
#define XB_XCNT(j)  (256  + 64 * (j))
#define XB_XSUB(j)  (1280 + 64 * (j))
#define XB_XGEN(j)  (2304 + 64 * (j))
#define XB_TOP      3328
#define XB_TOPGEN   3392
#define XCD_BAR_WORDS 3456
#define XB_SPIN_CAP (1u << 18)

__device__ __forceinline__ unsigned xb_ld(unsigned* p)              { return __hip_atomic_load(p, __ATOMIC_RELAXED, __HIP_MEMORY_SCOPE_AGENT); }
__device__ __forceinline__ unsigned xb_add(unsigned* p, unsigned v) { return __hip_atomic_fetch_add(p, v, __ATOMIC_RELAXED, __HIP_MEMORY_SCOPE_AGENT); }
__device__ __forceinline__ unsigned xb_xcc_id() { return (unsigned)__builtin_amdgcn_s_getreg((3 << 11) | 20) & 0xFu; }
#define XB_SPIN(cond, bar) do { unsigned _sp = 0; while (cond) { __builtin_amdgcn_s_sleep(1); \
    if ((++_sp & 255u) == 0u) { if (xb_ld(&(bar)[XB_TMO])) break; if (_sp > XB_SPIN_CAP) { atomicAdd(&(bar)[XB_TMO], 1u); break; } } } } while (0)

struct XcdBarrier {
    unsigned* bar; unsigned x;
    volatile LAS unsigned* st;
};

__device__ __forceinline__ XcdBarrier xcd_barrier_post(unsigned* bar, volatile LAS unsigned* st) {
    XcdBarrier b; b.bar = bar; b.x = xb_xcc_id(); b.st = st;
    if (threadIdx.x == 0) (void)xb_add(&bar[XB_XCNT(b.x)], 1u);
    return b;
}
__device__ __forceinline__ void xcd_barrier_complete(unsigned* bar, unsigned x, unsigned& nloc, unsigned& nx) {
    const unsigned G = gridDim.x * gridDim.y * gridDim.z;
    unsigned sum, cnt, mine, sp = 0u;
    for (;;) {
        sum = 0u; cnt = 0u; mine = 0u;
#pragma unroll
        for (unsigned j = 0; j < 16; ++j) { const unsigned c = xb_ld(&bar[XB_XCNT(j)]); sum += c; cnt += (c > 0u) ? 1u : 0u; mine = (j == x) ? c : mine; }
        if (sum == G) break;
        __builtin_amdgcn_s_sleep(1);
        if ((++sp & 255u) == 0u) { if (xb_ld(&bar[XB_TMO])) break; if (sp > XB_SPIN_CAP) { atomicAdd(&bar[XB_TMO], 1u); break; } }
    }
    nloc = mine > 0u ? mine : 1u; nx = cnt > 0u ? cnt : 1u;
}

__device__ __forceinline__ void xcd_barrier(const XcdBarrier& b) {
    asm volatile("s_waitcnt vmcnt(0)" ::: "memory");
    __syncthreads();
    if (threadIdx.x == 0) {
        unsigned* bar = b.bar;
        __builtin_amdgcn_s_waitcnt(0);
        unsigned nloc = b.st[0], nx = b.st[1];
        if (nloc == 0u) { xcd_barrier_complete(bar, b.x, nloc, nx); b.st[0] = nloc; b.st[1] = nx; }
        const unsigned old = xb_add(&bar[XB_XSUB(b.x)], 1u);
        const unsigned gen = old / nloc;
        if (old + 1u == (gen + 1u) * nloc) {
            __builtin_amdgcn_fence(__ATOMIC_RELEASE, "agent");
            asm volatile("s_waitcnt vmcnt(0)" ::: "memory");
            const unsigned og = xb_add(&bar[XB_TOP], 1u);
            const unsigned tg = og / nx;
            if (og + 1u == (tg + 1u) * nx) xb_add(&bar[XB_TOPGEN], 1u);
            else XB_SPIN(xb_ld(&bar[XB_TOPGEN]) == tg, bar);
            __builtin_amdgcn_fence(__ATOMIC_ACQUIRE, "agent");
            xb_add(&bar[XB_XGEN(b.x)], 1u);
            asm volatile("s_waitcnt vmcnt(0)" ::: "memory");
        } else {
            XB_SPIN(xb_ld(&bar[XB_XGEN(b.x)]) == gen, bar);
            __builtin_amdgcn_fence(__ATOMIC_ACQUIRE, "agent");
            asm volatile("s_waitcnt vmcnt(0)" ::: "memory");
        }
    }
    __syncthreads();
}

struct Args { const void* in[18]; float* out; unsigned char* ws; int ph_lo, ph_hi; };
struct Frame {
    LAS unsigned char* lds;
    volatile LAS unsigned* MISC;
    gu32* ctl;
    int G, NGW;
    unsigned char* ws;
};
enum { I_X = 0, I_POS, I_ATTN_NW, I_WIN, I_GW2, I_GB, I_GLA_NW, I_QNW, I_KNW, I_LQ1, I_LK1, I_LQ2, I_LK2, I_SUBW, I_WOUT, I_MLP_NW, I_WUP, I_WDN };
typedef __attribute__((address_space(4))) const Args* kargs_t;
DI kargs_t kargs() { kargs_t p = (kargs_t)__builtin_amdgcn_kernarg_segment_ptr(); asm volatile("" : "+s"(p)); return p; }
#define INP(T, k) ((const T*)(const GAS T*)kargs()->in[k])
#define OUTP() ((float*)(GAS float*)kargs()->out)
DI GAS unsigned char* ws_opaque(Frame& F) { GAS unsigned char* w = (GAS unsigned char*)F.ws; asm volatile("" : "+s"(w)); return w; }
DI float wave_sum(float v) {
#pragma unroll
    for (int o = 1; o < 64; o <<= 1) v += __shfl_xor(v, o);
    return v;
}

DI void p0_write_tile(bf16* WT, int K, int drow0, int k0, LAS float* scr, int lane, const float* rs) {
    const int c = lane & 7;
    f32x4 s0 = {1.f, 1.f, 1.f, 1.f}, s1 = s0;
    if (rs) { s0 = *(const f32x4*)(rs + k0 + 8 * c); s1 = *(const f32x4*)(rs + k0 + 8 * c + 4); }
    LDS_WAIT(); asm volatile("" ::: "memory");
#pragma unroll
    for (int j = 0; j < 4; ++j) { const int n = (lane >> 3) + 8 * j; const LAS float* s = scr + (8 * c) * 33 + n;
        v4u o; o.x = pk2(s[0 * 33] * s0[0], s[1 * 33] * s0[1]); o.y = pk2(s[2 * 33] * s0[2], s[3 * 33] * s0[3]); o.z = pk2(s[4 * 33] * s1[0], s[5 * 33] * s1[1]); o.w = pk2(s[6 * 33] * s1[2], s[7 * 33] * s1[3]);
        *(GAS v4u*)(WT + (size_t)(drow0 + n) * K + k0 + 8 * c) = o; }
    LDS_WAIT(); asm volatile("" ::: "memory");
}
DI void p0_transpose_tile(const float* W, int SP, int scol, bf16* WT, int K, int drow0, int k0, LAS float* scr, int lane, const float* rs) {
#pragma unroll 8
    for (int i = 0; i < 32; ++i) { const int kk = 2 * i + (lane >> 5); scr[kk * 33 + (lane & 31)] = W[(size_t)(k0 + kk) * SP + scol]; }
    p0_write_tile(WT, K, drow0, k0, scr, lane, rs);
}
DI void p0_gate_tile(const float* W, const float* w2, bf16* WT, int j0, int k0, LAS float* scr, int lane, const float* rs) {
    float w2r[16];
#pragma unroll
    for (int r = 0; r < 16; ++r) w2r[r] = w2[r * 512 + j0 + (lane & 31)];
#pragma unroll 4
    for (int i = 0; i < 32; ++i) { const int kk = 2 * i + (lane >> 5); const f32x4* wr = (const f32x4*)(W + (size_t)(k0 + kk) * IN_COLS + S_LR);
        float a = 0.f;
#pragma unroll
        for (int q = 0; q < 4; ++q) { const f32x4 t = wr[q]; a = fmaf(t.x, w2r[4 * q], a); a = fmaf(t.y, w2r[4 * q + 1], a); a = fmaf(t.z, w2r[4 * q + 2], a); a = fmaf(t.w, w2r[4 * q + 3], a); }
        scr[kk * 33 + (lane & 31)] = a; }
    p0_write_tile(WT, DM, C_GATE + j0, k0, scr, lane, rs);
}
#ifndef GATE_ITEMS
#define GATE_ITEMS 1
#endif
struct WTile { const float* W; bf16* WT; const float* rs; const float* w2; int SP, scol4, K, drow0, dloc_b, dstep, k0, kperm, gate_j0; };
DI void p0_t64_load(const WTile& d, int lane, f32x4 (&v)[16], f32x2v (&sc)[8]) {
    const int kq = lane >> 4;
#pragma unroll
    for (int j = 0; j < 8; ++j) sc[j] = (f32x2v){1.f, 1.f};
    if (d.gate_j0 != -1) return;
    if (d.rs) {
#pragma unroll
        for (int j = 0; j < 8; ++j) sc[j] = *(const GAS f32x2v*)(d.rs + d.k0 + 8 * j + 2 * kq); }
#pragma unroll
    for (int i = 0; i < 16; ++i) { const int k = 8 * (i >> 1) + 2 * kq + (i & 1); int kr = d.k0 + k; if (d.kperm && kr >= 1024) kr = (kr & ~127) + ((kr & 3) << 5) + ((kr & 127) >> 2);
        v[i] = *(const GAS f32x4*)(d.W + (size_t)kr * d.SP + d.scol4); }
}
DI void p0_t64_finish(const WTile& d, int lane, LAS float* scrf, const f32x4 (&v)[16], const f32x2v (&sc)[8]) {
    if (d.gate_j0 == -2) return;
    if (d.gate_j0 >= 0) { p0_gate_tile(d.W, d.w2, d.WT, d.gate_j0, d.k0, scrf, lane, d.rs); p0_gate_tile(d.W, d.w2, d.WT, d.gate_j0 + 32, d.k0, scrf, lane, d.rs); return; }
    LAS unsigned* scr = (LAS unsigned*)scrf; const int kq = lane >> 4;
#pragma unroll
    for (int j = 0; j < 8; ++j) {
        const float s0 = sc[j].x, s1 = sc[j].y;
        const int k2 = 4 * j + kq;
#pragma unroll
        for (int q = 0; q < 4; ++q) scr[(d.dloc_b + q * d.dstep) * 36 + k2] = pk2(v[2 * j][q] * s0, v[2 * j + 1][q] * s1);
    }
    LDS_WAIT(); asm volatile("" ::: "memory");
#pragma unroll
    for (int j2 = 0; j2 < 8; ++j2) { const int n = (lane >> 3) + 8 * j2, c = lane & 7;
        const v4u o = *(const LAS v4u*)(scr + n * 36 + 4 * c);
        *(GAS v4u*)(d.WT + (size_t)(d.drow0 + n) * d.K + d.k0 + 8 * c) = o; }
    LDS_WAIT(); asm volatile("" ::: "memory");
}
DI void sincos_red(float ang, float& s, float& c) {
    const double a = (double)ang; const double kq = __builtin_rint(a * 0.6366197723675814);
    double r = __builtin_fma(-kq, 1.5707963267948966, a); r = __builtin_fma(-kq, 6.123233995736766e-17, r);
    const float x = (float)r, x2 = x * x; const int q = (int)kq & 3;
    const float sp = x + x * x2 * (-1.6666654611e-1f + x2 * (8.3321608736e-3f + x2 * (-1.9515295891e-4f)));
    const float cp = 1.f - 0.5f * x2 + x2 * x2 * (4.166664568298827e-2f + x2 * (-1.388731625493765e-3f + x2 * 2.443315711809948e-5f));
    s = (q == 0) ? sp : (q == 1) ? cp : (q == 2) ? -sp : -cp;
    c = (q == 0) ? cp : (q == 1) ? -sp : (q == 2) ? -cp : sp;
}
#ifndef CONV_IN_MIXER
#define CONV_IN_MIXER 1
#endif
constexpr int P0_NB_IN = NPROJ / 64, P0_I_IN = (DM / 64) * P0_NB_IN, P0_I_OUT = (DM / 64) * (DM / 64), P0_I_UP = (DM / 64) * (DFF / 64), P0_I_DN = (DFF / 64) * (DM / 64), P0_I_LAYER = P0_I_IN + P0_I_OUT + P0_I_UP + P0_I_DN;
DI void p0_wdesc(Frame& F, GAS unsigned char* ws, int L, int r, int lane, WTile& d) {
    constexpr int NB_IN = P0_NB_IN, I_IN = P0_I_IN, I_OUT = P0_I_OUT, I_UP = P0_I_UP;
    bf16* WinT = (bf16*)(ws + WS_WIN); bf16* WoutT = (bf16*)(ws + WS_WOUT); bf16* WupT = (bf16*)(ws + WS_WUP); bf16* WdnT = (bf16*)(ws + WS_WDN);
    const int n4 = lane & 15;
    d.rs = nullptr; d.w2 = nullptr; d.kperm = 0; d.gate_j0 = -1; d.dloc_b = 4 * n4; d.dstep = 1;
    if (r < I_IN) { const int kb = r / NB_IN, nb = r - kb * NB_IN, drow0 = nb * 64;
        d.W = INP(float, I_WIN) + (size_t)L * DM * IN_COLS; d.WT = WinT + (size_t)L * NPROJ * DM; d.rs = INP(float, I_ATTN_NW) + L * DM; d.SP = IN_COLS; d.K = DM; d.drow0 = drow0; d.k0 = kb * 64;
        if (drow0 >= C_GATE && drow0 < C_DQ) { d.gate_j0 = GATE_ITEMS ? -2 : drow0 - C_GATE; d.w2 = INP(float, I_GW2) + (size_t)L * 16 * 512; d.scol4 = 0; }
        else if (drow0 >= C_DQ && drow0 < C_DV) {
            const int hb = (drow0 - C_DQ) & ~127, c0 = (drow0 - C_DQ) & 127;
            d.scol4 = C_DQ - S_SHIFT + hb + (c0 >> 1) + ((n4 >> 3) ? 64 : 0) + 4 * (n4 & 7); d.dloc_b = 8 * (n4 & 7) + (n4 >> 3); d.dstep = 2; }
        else d.scol4 = (drow0 < C_GATE ? drow0 : drow0 - S_SHIFT) + 4 * n4;
        return; }
    r -= I_IN;
    if (r < I_OUT) { const int kb = r / (DM / 64), nb = r % (DM / 64); d.W = INP(float, I_WOUT) + (size_t)L * DM * DM; d.WT = WoutT + (size_t)L * DM * DM; d.SP = DM; d.K = DM; d.scol4 = nb * 64 + 4 * n4; d.drow0 = nb * 64; d.k0 = kb * 64; d.kperm = 1; return; }
    r -= I_OUT;
    if (r < I_UP) { const int kb = r / (DFF / 64), nb = r % (DFF / 64); d.W = INP(float, I_WUP) + (size_t)L * DM * DFF; d.WT = WupT + (size_t)L * DFF * DM; d.rs = INP(float, I_MLP_NW) + L * DM; d.SP = DFF; d.K = DM; d.scol4 = nb * 64 + 4 * n4; d.drow0 = nb * 64; d.k0 = kb * 64; return; }
    r -= I_UP;
    { const int kb = r / (DM / 64), nb = r % (DM / 64); d.W = INP(float, I_WDN) + (size_t)L * DFF * DM; d.WT = WdnT + (size_t)L * DM * DFF; d.SP = DM; d.K = DFF; d.scol4 = nb * 64 + 4 * n4; d.drow0 = nb * 64; d.k0 = kb * 64; }
}
DI void p0_wtile(Frame& F, GAS unsigned char* ws, int L, int r, LAS float* scr, int lane) {
    WTile d; p0_wdesc(F, ws, L, r, lane, d);
    f32x4 v[16]; f32x2v sc[8];
    p0_t64_load(d, lane, v, sc); p0_t64_finish(d, lane, scr, v, sc);
}
constexpr int CONV_TPW = 10, CONV_TPI = 8 * CONV_TPW, CONV_L0 = P0_I_LAYER - P0_I_IN, CONV_TILES = CONV_L0 + (DEPTH - 1) * P0_I_LAYER, N_CONV = CONV_IN_MIXER ? CONV_TILES / CONV_TPI : 0;
static_assert(CONV_TILES % CONV_TPI == 0 && P0_I_IN % 8 == 0, "conversion items tile the list exactly");
DI void conv_item(Frame& F, int c) {
    PH_IDS;
    LAS float* scr = (LAS float*)(F.lds + RING_OFF + wave * 16384);
    GAS unsigned char* ws = ws_opaque(F);
    auto desc = [&](int j, WTile& d) { const int g = c * CONV_TPI + wave + 8 * j;
        if (g < CONV_L0) p0_wdesc(F, ws, 0, P0_I_IN + g, lane, d);
        else { const int g2 = g - CONV_L0, L = 1 + g2 / P0_I_LAYER; p0_wdesc(F, ws, L, g2 - (L - 1) * P0_I_LAYER, lane, d); } };
    WTile dA, dB; f32x4 vA[16], vB[16]; f32x2v sA[8], sB[8];
    desc(0, dA); p0_t64_load(dA, lane, vA, sA);
#pragma unroll 1
    for (int j = 0; j < CONV_TPW; j += 2) {
        desc(j + 1, dB); p0_t64_load(dB, lane, vB, sB);
        p0_t64_finish(dA, lane, scr, vA, sA);
        if (j + 2 < CONV_TPW) { desc(j + 2, dA); p0_t64_load(dA, lane, vA, sA); }
        p0_t64_finish(dB, lane, scr, vB, sB);
    }
}
static_assert(CONV_TPW % 2 == 0, "conv_item pairs tiles");
DI void p0_prologue(Frame& F) {
    PH_IDS;
    LAS float* scr = (LAS float*)(F.lds + RING_OFF + wave * 16384);
    constexpr int I_LAYER = P0_I_LAYER;
    GAS unsigned char* ws = ws_opaque(F);
#pragma unroll 1
    for (int it = gw; it < (CONV_IN_MIXER ? P0_I_IN : DEPTH * I_LAYER); it += F.NGW) { const int L = it / I_LAYER; p0_wtile(F, ws, L, it - L * I_LAYER, scr, lane); }
    const int gt = gw * 64 + lane, NT = F.NGW * 64;
    float* bias = (float*)(ws + WS_BIAS); const float* gate_b = INP(float, I_GB); const int* pos = INP(int, I_POS);
    for (int i = gt; i < DEPTH * NPROJ; i += NT) { const int L = i / NPROJ, c = i - L * NPROJ; bias[i] = (c >= C_GATE && c < C_DQ) ? gate_b[L * 512 + c - C_GATE] : 0.f; }
    if (GATE_ITEMS) {
        bf16* wlrt = (bf16*)(ws + WS_WLRT); bf16* w2f = (bf16*)(ws + WS_W2F);
        for (int i = gt; i < DEPTH * 16 * DM; i += NT) { const int L = i / (16 * DM), r = (i >> 11) & 15, k = i & (DM - 1);
            const float v = INP(float, I_ATTN_NW)[L * DM + k] * INP(float, I_WIN)[((size_t)L * DM + k) * IN_COLS + S_LR + r];
            wlrt[i] = (bf16)(pk2(v, 0.f) & 0xffffu); }
        for (int i = gt; i < DEPTH * 32 * 64 * 4; i += NT) { const int L = i / (32 * 64 * 4), nb = (i >> 8) & 31, ln = (i >> 2) & 63, e = i & 3;
            const float v = INP(float, I_GW2)[(size_t)L * 16 * 512 + (4 * (ln >> 4) + e) * 512 + 16 * nb + (ln & 15)];
            w2f[i] = (bf16)(pk2(v, 0.f) & 0xffffu); }
    }
    unsigned* rope = (unsigned*)(ws + WS_ROPE);
    for (int i = gt; i < M * 64; i += NT) { const int row = i >> 6, f = i & 63;
        const float inv_freq = (float)exp2(-(double)f * (13.287712379549449 / 64.0));
        const float ang = (float)pos[row] * inv_freq; float s, c; sincos_red(ang, s, c);
        rope[i] = (unsigned)__builtin_bit_cast(unsigned short, (_Float16)c) | ((unsigned)__builtin_bit_cast(unsigned short, (_Float16)s) << 16); }
    const float* x = INP(float, I_X); bf16* xb = (bf16*)OUTP(); GAS f32x4* ss0 = (GAS f32x4*)(ws + WS_SS);
    for (int m0 = 4 * gw; m0 < M; m0 += 4 * F.NGW) {
        f32x4 v[4][8]; float s[4] = {0.f, 0.f, 0.f, 0.f};
#pragma unroll
        for (int q = 0; q < 4; ++q) { const GAS f32x4* xr = (const GAS f32x4*)(x + (size_t)(m0 + q) * DM) + lane;
#pragma unroll
            for (int j = 0; j < 8; ++j) v[q][j] = xr[64 * j]; }
#pragma unroll
        for (int q = 0; q < 4; ++q) {
#pragma unroll
            for (int j = 0; j < 8; ++j) s[q] += (v[q][j].x * v[q][j].x + v[q][j].y * v[q][j].y) + (v[q][j].z * v[q][j].z + v[q][j].w * v[q][j].w);
            s[q] = wave_sum(s[q]); if (lane < 2) ss0[2 * (m0 + q) + lane] = (f32x4){lane == 0 ? s[q] : 0.f, 0.f, 0.f, 0.f};
            GAS v2u* o8 = (GAS v2u*)(xb + (size_t)(m0 + q) * DM) + lane;
#pragma unroll
            for (int j = 0; j < 8; ++j) { v2u o; o.x = pk2(v[q][j].x, v[q][j].y); o.y = pk2(v[q][j].z, v[q][j].w); o8[64 * j] = o; } }
    }
}

typedef float f32x4_t __attribute__((ext_vector_type(4)));
DI void gate_item(Frame& F, int L, int item) {
    PH_IDS;
    GAS unsigned char* ws = ws_opaque(F);
    const int t0 = item * 128 + wave * 16, li = lane & 15, lq = lane >> 4;
    const GAS bf16* xa = (const GAS bf16*)OUTP() + (size_t)(t0 + li) * DM + 8 * lq;
    constexpr int WLP = DM * 2 + 16;
    LAS unsigned char* wls = F.lds + RING_OFF;
    { const GAS v4u* src = (const GAS v4u*)(ws + WS_WLRT) + (size_t)L * (16 * DM / 8);
#pragma unroll
      for (int j = 0; j < 8; ++j) { const int q = tid + 512 * j, r = q >> 8, c = q & 255;
          *(LAS v4u*)(wls + r * WLP + c * 16) = src[q]; } }
    __syncthreads();
    const LAS unsigned char* wl = wls + li * WLP + 16 * lq;
    f32x4 acc = {0.f, 0.f, 0.f, 0.f};
#pragma unroll 1
    for (int s0 = 0; s0 < DM / 32; s0 += 16) {
        bf16x8 a[16], b[16];
#pragma unroll
        for (int j = 0; j < 16; ++j) { a[j] = *(const LAS bf16x8*)(wl + 64 * (s0 + j)); b[j] = *(const GAS bf16x8*)(xa + 32 * (s0 + j)); }
        __builtin_amdgcn_sched_barrier(0);
#pragma unroll
        for (int j = 0; j < 16; ++j) acc = __builtin_amdgcn_mfma_f32_16x16x32_bf16(a[j], b[j], acc, 0, 0, 0);
        __builtin_amdgcn_sched_barrier(0);
    }
    const GAS f32x4* ssp = (const GAS f32x4*)((const GAS float*)(ws + WS_SS) + ((size_t)(2 * L) * M + t0 + li) * 8); const f32x4 p0 = ssp[0], p1 = ssp[1];
    const float rstd = __builtin_amdgcn_rsqf((((p0[0] + p0[1]) + (p0[2] + p0[3])) + ((p1[0] + p1[1]) + (p1[2] + p1[3]))) * (1.0f / DM) + NORM_EPS);
    s16x4 lrb; { const unsigned u0 = pk2(acc[0] * rstd, acc[1] * rstd), u1 = pk2(acc[2] * rstd, acc[3] * rstd); lrb = (s16x4){(short)(u0 & 0xffffu), (short)(u0 >> 16), (short)(u1 & 0xffffu), (short)(u1 >> 16)}; }
    const GAS s16x4* w2f = (const GAS s16x4*)(ws + WS_W2F) + (size_t)L * 32 * 64 + lane;
    const GAS float* bias = (const GAS float*)(ws + WS_BIAS) + (size_t)L * NPROJ + C_GATE + 4 * lq;
    GAS bf16* gout = (GAS bf16*)(ws + WS_PROJ) + (size_t)(t0 + li) * NPROJ + C_GATE + 4 * lq;
#pragma unroll 1
    for (int n0 = 0; n0 < 32; n0 += 16) {
        s16x4 w[16]; f32x4 bv[16];
#pragma unroll
        for (int j = 0; j < 16; ++j) { w[j] = w2f[(n0 + j) * 64]; bv[j] = *(const GAS f32x4*)(bias + 16 * (n0 + j)); }
        __builtin_amdgcn_sched_barrier(0);
#pragma unroll
        for (int j = 0; j < 16; ++j) { const f32x4 z = {0.f, 0.f, 0.f, 0.f};
            const f32x4 d = __builtin_amdgcn_mfma_f32_16x16x16bf16_1k(w[j], lrb, z, 0, 0, 0);
            v2u o; o.x = pk2(d[0] + bv[j][0], d[1] + bv[j][1]); o.y = pk2(d[2] + bv[j][2], d[3] + bv[j][3]);
            *(GAS v2u*)(gout + 16 * (n0 + j)) = o; }
    }
    __syncthreads();
}
DI void combine_phase(Frame& F, int L) {
    PH_IDS;
    GAS unsigned char* ws = ws_opaque(F);
    const bf16* O = (const bf16*)(ws + WS_O); bf16* mix = (bf16*)(ws + WS_XN);
    const float* lq1 = INP(float, I_LQ1) + L * 128; const float* lk1 = INP(float, I_LK1) + L * 128; const float* lq2 = INP(float, I_LQ2) + L * 128; const float* lk2 = INP(float, I_LK2) + L * 128;
    const float lam_init = (L == 0) ? 0.2f : 0.35550906759096914f;
    float d1 = lq1[lane] * lk1[lane] + lq1[64 + lane] * lk1[64 + lane];
    float d2 = lq2[lane] * lk2[lane] + lq2[64 + lane] * lk2[64 + lane];
    const float lam = expf(wave_sum(d1)) - expf(wave_sum(d2)) + lam_init;
    const float osc = 1.0f - lam_init;
    f32x4 sw; { const float* swp = INP(float, I_SUBW) + L * 256 + (lane >> 5) * 128 + (lane & 31); sw = (f32x4){swp[0], swp[32], swp[64], swp[96]}; }
    for (int m = gw; m < M; m += F.NGW) {
        const bf16* o = O + (size_t)m * 2048 + 4 * lane;
        v2u a[4], b[4];
#pragma unroll
        for (int h = 0; h < 4; ++h) { a[h] = *(const GAS v2u*)(o + h * 512); b[h] = *(const GAS v2u*)(o + h * 512 + 256); }
#pragma unroll
        for (int h = 0; h < 4; ++h) { const f32x4 av = {bf_lo(a[h].x), bf_hi(a[h].x), bf_lo(a[h].y), bf_hi(a[h].y)}, bv = {bf_lo(b[h].x), bf_hi(b[h].x), bf_lo(b[h].y), bf_hi(b[h].y)}; const f32x4 d = av - bv * lam;
            const float ss = wave_sum((d.x * d.x + d.y * d.y) + (d.z * d.z + d.w * d.w));
            const float r = osc * __builtin_amdgcn_rsqf(ss * (1.f / 256.f) + SUBLN_EPS);
            v2u w; w.x = pk2(d.x * r * sw.x, d.y * r * sw.y); w.y = pk2(d.z * r * sw.z, d.w * r * sw.w);
            *(v2u*)(mix + (size_t)m * DM + 1024 + h * 256 + 4 * lane) = w; } }
}
#ifndef WGM_IN
#define WGM_IN 8
#define WGM_OUT 4
#define WGM_UP 8
#define WGM_DN 4
#endif
#ifndef HID_TILED
#define HID_TILED 1
#endif
#ifndef PROBE_DUP
#define PROBE_DUP 0
#endif

constexpr int G_QT = 0, G_QP = 272, G_KT = 17408, G_KDT = 34816, G_TP = 144, G_VT = 53248, G_AT = 90112, G_DEC = 99328, G_GT = 99840, G_NW = 103936, G_END = 104960, G_OB = 0, G_OP = 1152, G_OC = 144;
static_assert(G_END <= RING_BYTES && 64 * G_OP <= G_DEC, "GLA LDS map");
DI float log_sigmoid_f(float x) { return fminf(x, 0.f) - __logf(1.f + __expf(-fabsf(x))); }
DI bf16x8 lds_frag16(LAS unsigned char* p) { return *(LAS const bf16x8*)p; }
DI bf16x8 lds_frag8x2(LAS unsigned char* p, int second_off) { const s16x4 a = *(LAS const s16x4*)p, b = *(LAS const s16x4*)(p + second_off); return __builtin_shufflevector(a, b, 0, 1, 2, 3, 4, 5, 6, 7); }
#ifndef CONV_EVERY
#define CONV_EVERY (PROBE_DUP == 12 ? 4 : 8)
#endif
#ifndef GLA_SKIP
#define GLA_SKIP 0
#endif
DI void gla_unit(Frame& F, int L, int unit, int skip) {
    PH_IDS;
    const int b = unit >> 2, h = unit & 3;
    LAS unsigned char* lds = F.lds + RING_OFF;
    GAS unsigned char* ws = ws_opaque(F);
    const bf16* pbase = (const bf16*)(ws + WS_PROJ) + (size_t)b * SEQ * NPROJ;
    bf16* mix = (bf16*)(ws + WS_XN);
    const float* nw = INP(float, I_GLA_NW) + L * 256;
    f32x16 S[4];
#pragma unroll
    for (int i = 0; i < 4; ++i)
#pragma unroll
        for (int e = 0; e < 16; ++e) S[i][e] = 0.f;
    if (tid < 256) *(LAS float*)(lds + G_NW + 4 * tid) = nw[tid];
    unsigned gv[8];
#define GLA_LOADG(dst, nn) do { const bf16* r0_ = pbase + (size_t)((nn) * 64 + 8 * wave) * NPROJ + h * 128 + 2 * (tid & 63) + C_GATE; \
        _Pragma("unroll") for (int i = 0; i < 8; ++i) dst[i] = *(const unsigned*)(r0_ + (size_t)i * NPROJ); } while (0)
    GLA_LOADG(gv, 0);
#pragma unroll 1
    for (int n = 0; n < SEQ / 64; ++n) {
        const bf16* prow = pbase + (size_t)(n * 64) * NPROJ;
        int tc = tid; asm volatile("" : "+v"(tc));
        unsigned gvn[8];
#pragma unroll
        for (int i = 0; i < 8; ++i) gvn[i] = 0u;
        {
            const int dp = tc & 63, tg = wave;
            const int vp = tc & 127, tq = tc >> 7;
            unsigned qv[8], kv[8], vv[16];
            { const bf16* r0_ = prow + (size_t)(8 * tg) * NPROJ + h * 128 + 2 * dp;
#pragma unroll
              for (int i = 0; i < 8; ++i) { qv[i] = *(const unsigned*)(r0_ + (size_t)i * NPROJ + C_GQ); kv[i] = *(const unsigned*)(r0_ + (size_t)i * NPROJ + C_GK); }
              const bf16* v0_ = prow + (size_t)(16 * tq) * NPROJ + C_GV + h * 256 + 2 * vp;
#pragma unroll
              for (int i = 0; i < 16; ++i) vv[i] = *(const unsigned*)(v0_ + (size_t)i * NPROJ); }
            if (n + 1 < SEQ / 64) GLA_LOADG(gvn, n + 1);
            float cs0[8], cs1[8]; float a0 = 0.f, a1 = 0.f;
#pragma unroll
            for (int i = 0; i < 8; ++i) { cs0[i] = 0.f; cs1[i] = 0.f; }
            if (!(skip & 16)) {
#pragma unroll
            for (int i = 0; i < 8; ++i) { a0 += log_sigmoid_f(bf_lo(gv[i])) * (1.f / 16.f); a1 += log_sigmoid_f(bf_hi(gv[i])) * (1.f / 16.f); cs0[i] = a0; cs1[i] = a1; } }
            *(LAS f32x2v*)(lds + G_GT + (tg * 128 + 2 * dp) * 4) = (f32x2v){a0, a1};
            __syncthreads();
            if (!(skip & 8)) {
            float p0 = 0.f, p1 = 0.f, t0 = 0.f, t1 = 0.f;
#pragma unroll
            for (int g = 0; g < 8; ++g) { const f32x2v x = *(LAS const f32x2v*)(lds + G_GT + (g * 128 + 2 * dp) * 4); if (g < tg) { p0 += x.x; p1 += x.y; } t0 += x.x; t1 += x.y; }
            v4u kd0, kd1; float kx0[8], kx1[8];
            const float et0 = __expf(t0), et1 = __expf(t1);
#pragma unroll
            for (int i = 0; i < 8; ++i) { const float b0 = p0 + cs0[i], b1 = p1 + cs1[i];
                const float q0 = bf_lo(qv[i]) * GLA_QSCALE * __expf(b0), q1 = bf_hi(qv[i]) * GLA_QSCALE * __expf(b1);
                const float k0 = bf_lo(kv[i]) * __expf(-b0), k1 = bf_hi(kv[i]) * __expf(-b1);
                *(LAS unsigned*)(lds + G_QT + (8 * tg + i) * G_QP + 4 * dp) = pk2(q0, q1);
                *(LAS unsigned*)(lds + G_KT + (8 * tg + i) * G_QP + 4 * dp) = pk2(k0, k1);
                kx0[i] = k0 * et0; kx1[i] = k1 * et1; }
#pragma unroll
            for (int j = 0; j < 4; ++j) { kd0[j] = pk2(kx0[2 * j], kx0[2 * j + 1]); kd1[j] = pk2(kx1[2 * j], kx1[2 * j + 1]); }
            *(LAS v4u*)(lds + G_KDT + (2 * dp) * G_TP + 16 * tg) = kd0; *(LAS v4u*)(lds + G_KDT + (2 * dp + 1) * G_TP + 16 * tg) = kd1;
            if (tg == 0) *(LAS f32x2v*)(lds + G_DEC + 8 * dp) = (f32x2v){et0, et1};
#pragma unroll
            for (int hf = 0; hf < 2; ++hf) { v4u lo4, hi4;
#pragma unroll
                for (int j = 0; j < 4; ++j) { const unsigned x0 = vv[8 * hf + 2 * j], x1 = vv[8 * hf + 2 * j + 1]; lo4[j] = (x0 & 0xffffu) | (x1 << 16); hi4[j] = (x0 >> 16) | (x1 & 0xffff0000u); }
                *(LAS v4u*)(lds + G_VT + (2 * vp) * G_TP + (16 * tq + 8 * hf) * 2) = lo4; *(LAS v4u*)(lds + G_VT + (2 * vp + 1) * G_TP + (16 * tq + 8 * hf) * 2) = hi4; }
            }
        }
        v4u gq[4];
        { const bf16* gp = prow + (size_t)(tc >> 3) * NPROJ + C_GG + h * 256 + 32 * (tc & 7);
#pragma unroll
          for (int j = 0; j < 4; ++j) gq[j] = *(const v4u*)(gp + 8 * j); }
        __syncthreads();
        int t2 = tid; asm volatile("" : "+v"(t2)); const int r = t2 & 31, hh = (t2 >> 5) & 1;
        if (wave < 3 && !(skip & 4)) {
            const int ib = wave ? 1 : 0, jb = wave == 2 ? 1 : 0;
            f32x16 acc;
#pragma unroll
            for (int e = 0; e < 16; ++e) acc[e] = 0.f;
#pragma unroll
            for (int kh = 0; kh < 2; ++kh) { bf16x8 ka[4], qb[4];
#pragma unroll
                for (int k4 = 0; k4 < 4; ++k4) { const int ks = 4 * kh + k4; ka[k4] = lds_frag16(lds + G_KT + (jb * 32 + r) * G_QP + ks * 32 + 16 * hh); qb[k4] = lds_frag16(lds + G_QT + (ib * 32 + r) * G_QP + ks * 32 + 16 * hh); }
                __builtin_amdgcn_sched_barrier(0);
#pragma unroll
                for (int k4 = 0; k4 < 4; ++k4) acc = MFMA32(ka[k4], qb[k4], acc);
                __builtin_amdgcn_sched_barrier(0); }
            const int ci = ib * 32 + r;
#pragma unroll
            for (int g = 0; g < 4; ++g) { const int cj0 = jb * 32 + 8 * g + 4 * hh; float v[4];
#pragma unroll
                for (int e = 0; e < 4; ++e) v[e] = (cj0 + e <= ci) ? acc[4 * g + e] : 0.f;
                *(LAS v2u*)(lds + G_AT + ci * G_TP + cj0 * 2) = (v2u){pk2(v[0], v[1]), pk2(v[2], v[3])}; }
        }
        __syncthreads();
        f32x16 o0, o1;
#pragma unroll
        for (int e = 0; e < 16; ++e) { o0[e] = 0.f; o1[e] = 0.f; }
        if (!(skip & 2)) {
#pragma unroll
        for (int ih = 0; ih < 2; ++ih) {
            bf16x8 qa[2][2][2];
#pragma unroll
            for (int ii = 0; ii < 2; ++ii)
#pragma unroll
                for (int s = 0; s < 2; ++s) { const int d0 = 32 * (2 * ih + ii) + 16 * s + 4 * hh;
                    qa[ii][s][0] = lds_frag8x2(lds + G_QT + r * G_QP + d0 * 2, 16); qa[ii][s][1] = lds_frag8x2(lds + G_QT + (32 + r) * G_QP + d0 * 2, 16); }
            __builtin_amdgcn_sched_barrier(0);
#pragma unroll
            for (int ii = 0; ii < 2; ++ii)
#pragma unroll
                for (int s = 0; s < 2; ++s) { const int i = 2 * ih + ii;
                    v4u pw;
#pragma unroll
                    for (int j = 0; j < 4; ++j) pw[j] = pk2(S[i][8 * s + 2 * j], S[i][8 * s + 2 * j + 1]);
                    const bf16x8 sb = __builtin_bit_cast(bf16x8, pw);
                    o0 = MFMA32(qa[ii][s][0], sb, o0); o1 = MFMA32(qa[ii][s][1], sb, o1); }
            __builtin_amdgcn_sched_barrier(0);
        }
        bf16x8 vf[4], at0[2], at1[4];
#pragma unroll
        for (int ks = 0; ks < 4; ++ks) vf[ks] = lds_frag16(lds + G_VT + (32 * wave + r) * G_TP + ks * 32 + 16 * hh);
#pragma unroll
        for (int ks = 0; ks < 2; ++ks) at0[ks] = lds_frag16(lds + G_AT + r * G_TP + ks * 32 + 16 * hh);
#pragma unroll
        for (int ks = 0; ks < 4; ++ks) at1[ks] = lds_frag16(lds + G_AT + (32 + r) * G_TP + ks * 32 + 16 * hh);
        __builtin_amdgcn_sched_barrier(0);
#pragma unroll
        for (int ks = 0; ks < 2; ++ks) o0 = MFMA32(at0[ks], vf[ks], o0);
#pragma unroll
        for (int ks = 0; ks < 4; ++ks) o1 = MFMA32(at1[ks], vf[ks], o1);
        __builtin_amdgcn_sched_barrier(0);
#pragma unroll
        for (int ih = 0; ih < 2; ++ih) {
            bf16x8 kf[2][4]; f32x4 dc[2][4];
#pragma unroll
            for (int ii = 0; ii < 2; ++ii) { const int i = 2 * ih + ii;
#pragma unroll
                for (int ks = 0; ks < 4; ++ks) kf[ii][ks] = lds_frag16(lds + G_KDT + (32 * i + r) * G_TP + ks * 32 + 16 * hh);
#pragma unroll
                for (int g = 0; g < 4; ++g) dc[ii][g] = *(LAS const f32x4*)(lds + G_DEC + (32 * i + 8 * g + 4 * hh) * 4); }
            __builtin_amdgcn_sched_barrier(0);
#pragma unroll
            for (int ii = 0; ii < 2; ++ii) { const int i = 2 * ih + ii;
#pragma unroll
                for (int g = 0; g < 4; ++g) { S[i][4 * g] *= dc[ii][g].x; S[i][4 * g + 1] *= dc[ii][g].y; S[i][4 * g + 2] *= dc[ii][g].z; S[i][4 * g + 3] *= dc[ii][g].w; }
#pragma unroll
                for (int ks = 0; ks < 4; ++ks) S[i] = MFMA32(kf[ii][ks], vf[ks], S[i]); }
            __builtin_amdgcn_sched_barrier(0);
        }
        }
        __syncthreads();
        if (!(skip & 1)) {
#pragma unroll
        for (int e = 0; e < 16; ++e) { const int c = (e & 3) + 8 * (e >> 2) + 4 * hh;
            *(LAS float*)(lds + G_OB + c * G_OP + wave * G_OC + r * 4) = o0[e]; *(LAS float*)(lds + G_OB + (32 + c) * G_OP + wave * G_OC + r * 4) = o1[e]; }
        }
        __syncthreads();
        if (!(skip & 1))
        {
            int t5 = tid; asm volatile("" : "+v"(t5)); const int c = t5 >> 3, p = t5 & 7;
            f32x4 ov[8]; float ss = 0.f;
#pragma unroll
            for (int j = 0; j < 8; ++j) { ov[j] = *(LAS const f32x4*)(lds + G_OB + c * G_OP + p * G_OC + 16 * j); ss += (ov[j].x * ov[j].x + ov[j].y * ov[j].y) + (ov[j].z * ov[j].z + ov[j].w * ov[j].w); }
            ss += __shfl_xor(ss, 1); ss += __shfl_xor(ss, 2); ss += __shfl_xor(ss, 4);
            const float rstd = 1.0f / sqrtf(ss * (1.f / 256.f) + NORM_EPS);
            bf16* yp = mix + (size_t)(b * SEQ + n * 64 + c) * DM + h * 256 + 32 * p;
#pragma unroll
            for (int j = 0; j < 4; ++j) { const f32x4 w0 = *(LAS const f32x4*)(lds + G_NW + (32 * p + 8 * j) * 4), w1 = *(LAS const f32x4*)(lds + G_NW + (32 * p + 8 * j + 4) * 4); const f32x4 x0 = ov[2 * j], x1 = ov[2 * j + 1];
                float gf[8];
#pragma unroll
                for (int e = 0; e < 4; ++e) { gf[2 * e] = bf_lo(gq[j][e]); gf[2 * e + 1] = bf_hi(gq[j][e]); }
                float y[8];
#pragma unroll
                for (int e = 0; e < 4; ++e) { y[e] = x0[e] * rstd * w0[e]; y[4 + e] = x1[e] * rstd * w1[e]; }
#pragma unroll
                for (int e = 0; e < 8; ++e) y[e] = y[e] * gf[e] * __builtin_amdgcn_rcpf(1.f + __expf(-gf[e]));
                *(v4u*)(yp + 8 * j) = (v4u){pk2(y[0], y[1]), pk2(y[2], y[3]), pk2(y[4], y[5]), pk2(y[6], y[7])}; }
        }
        __syncthreads();
#pragma unroll
        for (int i = 0; i < 8; ++i) gv[i] = gvn[i];
    }
#undef GLA_LOADG
}

typedef swa::BlockRef<swa::bf16, swa::bf16> ABlk;
constexpr int N_GLA = BATCH * 4, N_ATT = BATCH * 16 * (SEQ / 256);
DI ABlk attn_ref(GAS unsigned char* ws, int a) {
    const int qb = (SEQ / 256 - 1) - (a >> 8), rest = a & 255, bb = rest >> 4, vh = rest & 15, hd = vh >> 2, c = (vh >> 1) & 1, vhalf = vh & 1;
    const swa::bf16* proj = (const swa::bf16*)(ws + WS_PROJ); swa::bf16* O = (swa::bf16*)(ws + WS_O);
    ABlk R;
    R.Q = proj + (size_t)(bb * SEQ + qb * 256) * NPROJ + C_DQ + (hd * 2 + c) * 128;
    R.K = proj + (size_t)(bb * SEQ) * NPROJ + C_DK + (hd * 2 + c) * 128;
    R.V = proj + (size_t)(bb * SEQ) * NPROJ + C_DV + hd * 256 + vhalf * 128;
    R.O = O + (size_t)(bb * SEQ + qb * 256) * 2048 + (hd * 2 + c) * 256 + vhalf * 128;
    R.P0 = qb * 256;
    return R;
}
DI int q_next(Frame& F, gu32* head) {
    if (threadIdx.x == 0) F.MISC[16] = __hip_atomic_fetch_add(head, 1u, RLX_AGENT);
    __syncthreads(); const int v = (int)F.MISC[16]; __syncthreads();
    return __builtin_amdgcn_readfirstlane(v);
}
DI void mixer_phase(Frame& F, int qi, int L, char* lds_generic) {
    gu32* head = F.ctl + CW_Q + 64 * qi;
    GAS unsigned char* ws = ws_opaque(F);
    const int G = F.G;
    int it = (int)blockIdx.x;
    const int NCV = (L == 0 && qi == 0) ? N_CONV * (PROBE_DUP == 12 ? 2 : 1) : 0, NCVP = NCV * CONV_EVERY, N_ITEMS = N_GLA + NCV + N_ATT;
    static_assert((long)N_CONV * (PROBE_DUP == 12 ? 2 : 1) * (CONV_EVERY - 1) <= N_ATT, "the conversion items must run out before the attention blocks do");
#define Q_NEXT() (G + q_next(F, head))
#define IS_CONV(p_) ((p_) < NCVP && ((p_) % CONV_EVERY) == 0)
#define ATT_IDX(p_) ((p_) < NCVP ? (p_) - (p_) / CONV_EVERY - 1 : (p_) - NCV)
    while (it < N_GLA) { _Pragma("unroll 1") for (int gr = (PROBE_DUP == 10) ? 1 : 0; gr >= 0; --gr) gla_unit(F, L, it, gr ? GLA_SKIP : 0); it = Q_NEXT(); }
#pragma unroll 1
    while (it < N_ITEMS) {
        const int p = it - N_GLA;
        if (IS_CONV(p)) { conv_item(F, (p / CONV_EVERY) % N_CONV); it = Q_NEXT(); continue; }
        ABlk cur = attn_ref(ws, ATT_IDX(p));
        unsigned pend0 = 0u;
        if (threadIdx.x == 0) pend0 = __hip_atomic_fetch_add(head, 1u, RLX_AGENT);
        swa::Seam<swa::bf16> S;
        swa::causal_swa_prime<swa::bf16, swa::bf16>(cur, SEQ, lds_generic, S);
        if (threadIdx.x == 0) F.MISC[20] = pend0;
        __syncthreads();
        int nx = G + __builtin_amdgcn_readfirstlane((int)F.MISC[20]);
        for (;;) {
            const int pn = nx - N_GLA;
            const bool last = nx >= N_ITEMS || IS_CONV(pn);
            const ABlk nxt = last ? cur : attn_ref(ws, ATT_IDX(pn));
            unsigned pend = 0u;
            if (!last && threadIdx.x == 0) pend = __hip_atomic_fetch_add(head, 1u, RLX_AGENT);
            swa::causal_swa_block<swa::bf16, swa::bf16>(cur, nxt, SEQ, SEQ, lds_generic, S);
            if (last) break;
            if (threadIdx.x == 0) F.MISC[20] = pend;
            __syncthreads();
            cur = nxt; nx = G + __builtin_amdgcn_readfirstlane((int)F.MISC[20]);
        }
        it = nx;
    }
#undef IS_CONV
#undef ATT_IDX
#undef Q_NEXT
}


template <class Sched> DI void rstd_tables(Frame& F, const Sched& S, const float* ss, LAS float* rt) {
    constexpr int RT_SHIFT = Sched::RT_SHIFT, RT_SLOTS = Sched::RT_SLOTS;
    const int t = opaque_tid();
    pg8::Unit u; int tag[RT_SLOTS];
#pragma unroll
    for (int s = 0; s < RT_SLOTS; ++s) tag[s] = -2;
    for (int i = 0; S.next(i, u); ++i) { const int sl = (u.pm >> RT_SHIFT) & (RT_SLOTS - 1);
#pragma unroll
        for (int s = 0; s < RT_SLOTS; ++s) if (s == sl) tag[s] = (tag[s] == -2 || tag[s] == u.pm) ? u.pm : -1; }
#pragma unroll
    for (int slot = 0; slot < RT_SLOTS; ++slot) { const int pm = tag[slot];
        if (pm >= 0 && t < 256) { const f32x4* p = (const f32x4*)(ss + (size_t)(pm * 256 + t) * 8); const f32x4 a = p[0], b = p[1];
            rt[slot * 256 + t] = __builtin_amdgcn_rsqf((((a[0] + a[1]) + (a[2] + a[3])) + ((b[0] + b[1]) + (b[2] + b[3]))) * (1.0f / DM) + NORM_EPS); }
        if (t == 0) ((LAS int*)(rt + RT_SLOTS * 256))[slot] = pm; }
    __syncthreads();
}

DI int virt_c(Frame& F) {
    if (MK_SPLIT) return (int)blockIdx.x;
    bool ok = (F.G % 8) == 0;
#pragma unroll
    for (int j = 0; j < 8; ++j) ok = ok && (__hip_atomic_load(F.ctl + CW_VC + 64 * j, RLX_AGENT) == (unsigned)(F.G / 8));
    const int v = (int)(F.MISC[24] + 8u * F.MISC[25]);
    return __builtin_amdgcn_readfirstlane(ok ? v : (int)blockIdx.x);
}

__global__ void __launch_bounds__(NWAVES * 64, 2) fwd(Args args) {
    extern __shared__ __attribute__((aligned(16))) unsigned char lds[];
    Frame F;
    F.lds = (LAS unsigned char*)lds;
    F.MISC = (volatile LAS unsigned*)(F.lds + MISC_OFF);
    F.G = gridDim.x; F.NGW = F.G * NWAVES;
    F.ws = args.ws; F.ctl = (gu32*)(args.ws + WS_CTL);
    for (int u = threadIdx.x; u < (LDS_BYTES - LDSCTL_OFF) / 4; u += NWAVES * 64) ((LAS unsigned*)(F.lds + LDSCTL_OFF))[u] = 0u;
    __syncthreads();
    if (!MK_SPLIT && threadIdx.x == 0) { const unsigned x = xb_xcc_id(); F.MISC[24] = x; F.MISC[25] = __hip_atomic_fetch_add(F.ctl + CW_VC + 64 * (x & 15u), 1u, RLX_AGENT); }
    XcdBarrier bar; bar.bar = (unsigned*)(F.ctl + CW_BAR); bar.x = 0; bar.st = nullptr;
    if (!MK_SPLIT) bar = xcd_barrier_post((unsigned*)(F.ctl + CW_BAR), F.MISC + 8);
#define GRID_BAR() do { if (!MK_SPLIT) { _Pragma("unroll 1") for (int br_ = (PROBE_DUP == 11) ? 1 : 0; br_ >= 0; --br_) { XcdBarrier b2_ = bar; GAS unsigned* bp_ = (GAS unsigned*)bar.bar; asm volatile("" : "+s"(bp_), "+s"(b2_.x)); b2_.bar = (unsigned*)bp_; xcd_barrier(b2_); } } } while (0)
    const int lo = args.ph_lo, hi = args.ph_hi;
#define IN(k) (lo <= (k) && (k) < hi)
#define BOTH(k) (IN(k) && IN((k) + 1))

#ifndef REV_DN
#define REV_DN 0
#endif
#ifndef STAGGER_US
#define STAGGER_US 0
#endif
#define STAGGER() do { if (STAGGER_US && (blockIdx.x & 1)) { const unsigned long long t0_ = __builtin_amdgcn_s_memrealtime(); while (__builtin_amdgcn_s_memrealtime() - t0_ < (unsigned long long)(STAGGER_US * 100)) __builtin_amdgcn_s_sleep(8); } } while (0)
#define NREP(k) ((PROBE_DUP == (k)) ? 2 : 1)
#define REPLOOP(k) _Pragma("unroll 1") for (int rep = NREP(k) - 1; rep >= 0; --rep)
#define REPBAR() do { if (rep) GRID_BAR(); } while (0)
    if (IN(0)) { REPLOOP(9) { p0_prologue(F); REPBAR(); } if (BOTH(0)) GRID_BAR(); }
    const int vc = (!MK_SPLIT && lo == 0) ? virt_c(F) : (int)blockIdx.x;
#pragma unroll 1
    for (int L = 0; L < DEPTH; ++L) {
        const int pb = 1 + L * PH_PER_LAYER;
        if (IN(pb + 0)) { REPLOOP(2) {
            GAS unsigned char* ws = ws_opaque(F);
            typedef pg8::Gemm<M, NPROJ, DM> GT; typedef pg8::StaticOrder<M, GATE_ITEMS ? NPROJ - 512 : NPROJ, WGM_IN, false, GATE_ITEMS ? C_GATE / 256 : (1 << 30), GATE_ITEMS ? 2 : 0> ST;     GT g{(const bf16*)OUTP(), (const bf16*)(ws + WS_WIN) + (size_t)L * NPROJ * DM}; ST S; S.init(F.G, vc);
            rstd_tables(F, S, (const float*)(ws + WS_SS) + (size_t)(2 * L) * M * 8, (LAS float*)(F.lds + RT_OFF));
            typedef pg8::EpiProj<NPROJ, DM, C_GATE / 256, C_DQ / 256, C_DK / 256, C_DV / 256, ST::RT_SHIFT, ST::RT_SLOTS> ET; ET E{(bf16*)(ws + WS_PROJ), (const float*)(ws + WS_BIAS) + L * NPROJ, (const LAS float*)(F.lds + RT_OFF), (const float*)(ws + WS_SS) + (size_t)(2 * L) * M * 8,
                INP(float, I_QNW) + L * 128, INP(float, I_KNW) + L * 128, (const unsigned*)(ws + WS_ROPE), (LAS float*)(F.lds + RED_OFF)};
            STAGGER(); pg8::gemm_phase<ET, ST, GT, true, true>(F.lds + RING_OFF, g, S, E); if (GATE_ITEMS) { _Pragma("unroll 1") for (int gr_ = NREP(13); gr_ > 0; --gr_) gate_item(F, L, (vc & 7) * 32 + (vc >> 3)); }      REPBAR(); }
            if (BOTH(pb + 0)) GRID_BAR();
        }
        if (IN(pb + 1)) {
            REPLOOP(3) { mixer_phase(F, L + 2 * rep, L, (char*)lds + RING_OFF); REPBAR(); }
            if (BOTH(pb + 1)) GRID_BAR(); }
        if (IN(pb + 2)) { REPLOOP(4) { combine_phase(F, L); REPBAR(); } if (BOTH(pb + 2)) GRID_BAR(); }
        if (IN(pb + 3)) { REPLOOP(5) {
            GAS unsigned char* ws = ws_opaque(F);
            typedef pg8::Gemm<M, DM, DM> GT; typedef pg8::StaticOrder<M, DM, WGM_OUT> ST; GT g{(const bf16*)(ws + WS_XN), (const bf16*)(ws + WS_WOUT) + (size_t)L * DM * DM}; ST S; S.init(F.G, vc);
            typedef pg8::EpiRes<DM, false> ET; ET E{(const bf16*)OUTP(), nullptr, (bf16*)(ws + (rep ? WS_HID : WS_XB2)), (float*)(ws + WS_SS) + (size_t)(rep ? 4 : 2 * L + 1) * M * 8, (LAS float*)(F.lds + RED_OFF)};
            STAGGER(); pg8::gemm_phase<ET, ST, GT, true, true>(F.lds + RING_OFF, g, S, E); REPBAR(); }
            if (BOTH(pb + 3)) GRID_BAR();
        }
        if (IN(pb + 4)) { REPLOOP(7) {
            GAS unsigned char* ws = ws_opaque(F);
            typedef pg8::Gemm<M, DFF, DM> GT; typedef pg8::StaticOrder<M, DFF, WGM_UP> ST; GT g{(const bf16*)(ws + WS_XB2), (const bf16*)(ws + WS_WUP) + (size_t)L * DFF * DM}; ST S; S.init(F.G, vc);
            rstd_tables(F, S, (const float*)(ws + WS_SS) + (size_t)(2 * L + 1) * M * 8, (LAS float*)(F.lds + RT_OFF));
            typedef pg8::EpiBf16<2, DFF, DM, ST::RT_SHIFT, ST::RT_SLOTS, HID_TILED != 0> ET; ET E{(bf16*)(ws + WS_HID), nullptr, (const LAS float*)(F.lds + RT_OFF), (const float*)(ws + WS_SS) + (size_t)(2 * L + 1) * M * 8};
            STAGGER(); pg8::gemm_phase<ET, ST, GT, true, true>(F.lds + RING_OFF, g, S, E); REPBAR(); }
            if (BOTH(pb + 4)) GRID_BAR();
        }
        if (IN(pb + 5)) { REPLOOP(8) {
            GAS unsigned char* ws = ws_opaque(F);
            typedef pg8::Gemm<M, DM, DFF, HID_TILED != 0> GT; typedef pg8::StaticOrder<M, DM, WGM_DN, (REV_DN != 0)> ST; GT g{(const bf16*)(ws + WS_HID), (const bf16*)(ws + WS_WDN) + (size_t)L * DM * DFF}; ST S; S.init(F.G, vc);
            if (L + 1 < DEPTH) { typedef pg8::EpiRes<DM, false> ET; ET E{(const bf16*)(ws + WS_XB2), nullptr, (bf16*)OUTP(), (float*)(ws + WS_SS) + (size_t)(2 * L + 2) * M * 8, (LAS float*)(F.lds + RED_OFF)};
                STAGGER(); pg8::gemm_phase<ET, ST, GT, true, true>(F.lds + RING_OFF, g, S, E); }
            else { typedef pg8::EpiRes<DM, true> ET; ET E{(const bf16*)(ws + WS_XB2), OUTP(), nullptr, nullptr, nullptr};
                STAGGER(); pg8::gemm_phase<ET, ST, GT, true, true>(F.lds + RING_OFF, g, S, E); }
            REPBAR(); }
            if (BOTH(pb + 5)) GRID_BAR();
        }
    }
#undef IN
#undef BOTH
}

extern "C" void kernel_launch(void* const* d_in, const int* in_sizes, int n_in, void* d_out, int out_size, void* d_ws, size_t ws_size, hipStream_t stream) {
    static int grid = 0;
    if (grid == 0) {
        if (n_in != 18 || in_sizes[0] != M * DM || out_size != M * DM || ws_size < WS_END) { fprintf(stderr, "kernel_launch: built for 18 inputs, x/out of %d floats, >= %zu bytes of workspace; got n_in %d, in0 %d, out %d, ws %zu; nothing launched\n", M * DM, (size_t)WS_END, n_in, n_in > 0 ? in_sizes[0] : -1, out_size, ws_size); grid = -1; return; }
        int dev = 0, cus = 0, per_cu = 0;
        if (hipGetDevice(&dev) != hipSuccess || hipDeviceGetAttribute(&cus, hipDeviceAttributeMultiprocessorCount, dev) != hipSuccess) { fprintf(stderr, "kernel_launch: hipGetDevice / hipDeviceGetAttribute failed; nothing launched\n"); grid = -1; return; }
        if (hipFuncSetAttribute((const void*)fwd, hipFuncAttributeMaxDynamicSharedMemorySize, LDS_BYTES) != hipSuccess) { fprintf(stderr, "kernel_launch: hipFuncSetAttribute failed\n"); grid = -1; return; }
        if (hipOccupancyMaxActiveBlocksPerMultiprocessor(&per_cu, (const void*)fwd, NWAVES * 64, LDS_BYTES) != hipSuccess || per_cu < 1) fprintf(stderr, "kernel_launch: note: occupancy query reports %d workgroups per CU\n", per_cu);
        (void)hipGetLastError();
        grid = cus;
        if (cus != 256) { fprintf(stderr, "kernel_launch: built for a 256-CU device (one workgroup per CU; the per-phase row-statistics tables assume the static unit order of a 256-workgroup grid); found %d CUs; nothing launched\n", cus); grid = -1; return; }
    }
    if (grid < 0) return;
    if (hipMemsetAsync((char*)d_ws + WS_CTL, 0, CTL_ZERO_BYTES, stream) != hipSuccess) { fprintf(stderr, "kernel_launch: hipMemsetAsync failed; nothing launched\n"); return; }
    Args a{};
    for (int i = 0; i < 18; ++i) a.in[i] = d_in[i];
    a.out = (float*)d_out; a.ws = (unsigned char*)d_ws;
#if MK_SPLIT
    for (int p = 0; p < N_PHASES; ++p) { a.ph_lo = p; a.ph_hi = p + 1; hipLaunchKernelGGL(fwd, dim3(grid), dim3(NWAVES * 64), LDS_BYTES, stream, a); }
#else
    a.ph_lo = 0; a.ph_hi = N_PHASES; hipLaunchKernelGGL(fwd, dim3(grid), dim3(NWAVES * 64), LDS_BYTES, stream, a);
#endif
    const hipError_t le = hipPeekAtLastError();
    if (le != hipSuccess) fprintf(stderr, "kernel_launch: launch failed: %s\n", hipGetErrorName(le));
}
```

```cpp
#include <hip/hip_runtime.h>
#include <hip/hip_bf16.h>
#include <cstdio>
#include <cstdint>
#include <cmath>
namespace pg8 {
#define PG8_LAS __attribute__((address_space(3)))
typedef unsigned short bf16_t;
typedef short bf16x8 __attribute__((ext_vector_type(8)));
typedef float f32x4 __attribute__((ext_vector_type(4)));
typedef unsigned u32x4 __attribute__((ext_vector_type(4)));
constexpr int BM = 256, BK = 64, HALF = 128, HTB = HALF * BK * 2  , STAGE_BYTES = 8 * HTB, NXCD = 8, WGM = 4;

__host__ __device__ __forceinline__ int lds_byte(int r, int c) { const int st = (r >> 4) * 2 + (c >> 5), rr = r & 15, cc = c & 31, ob = rr * 64 + cc * 2; return st * 1024 + (ob ^ (((ob >> 9) & 1) << 5)); }
__host__ __device__ __forceinline__ void stage_rc(int b, int& R, int& C) { const int st = b / 1024, sb = b % 1024, swz = sb ^ (((sb >> 9) & 1) << 5); R = (st >> 1) * 16 + swz / 64; C = (st & 1) * 32 + (swz % 64) / 2; }
__host__ __device__ __forceinline__ int perm32(int rho) { const int n = rho >> 4, i = rho & 15; return 8 * (i >> 2) + 4 * n + (i & 3); }

struct Unit { int pm, pn; };
template <int M_, int N_, int K_, bool A_TILED_ = false> struct Gemm { const bf16_t* A; const bf16_t* Bt; static constexpr int M = M_, N = N_, K = K_; static constexpr bool A_TILED = A_TILED_; };

template <int M_, int N_, int WGM_ = WGM, bool REV_ = false, int GAP_AT_ = 1 << 30, int GAP_N_ = 0> struct StaticOrder {
    static constexpr int WGM = WGM_, RT_SHIFT = (WGM_ == 2) ? 1 : (WGM_ == 4) ? 2 : (WGM_ == 8) ? 3 : 4, RT_SLOTS = (16 / WGM_) < 1 ? 1 : (16 / WGM_);
    static constexpr int nM = M_ / BM, nN = N_ / BM, nwg = nM * nN;
    int G, c;
    __host__ __device__ void init(int G_, int c_) { G = G_; c = c_; }
    __host__ __device__ bool next(int i, Unit& u) const {
        const int nr = nwg / G; const bool rev = REV_ && (nwg % G) == 0; if (rev && i >= nr) return false;
        const long L = (long)(rev ? nr - 1 - i : i) * G + c; if (L >= nwg) return false;
        int wgid = (int)L; { constexpr int q = nwg / NXCD, r = nwg % NXCD; const int xcd = wgid % NXCD, off = wgid / NXCD; wgid = (xcd < r ? xcd * (q + 1) : r * (q + 1) + (xcd - r) * q) + off; }
        constexpr int nig = WGM * nN; const int gid = wgid / nig, fm = gid * WGM, gsz = (nM - fm) < WGM ? (nM - fm) : WGM;
        u.pm = fm + ((wgid % nig) % gsz); u.pn = (wgid % nig) / gsz; if (u.pn >= GAP_AT_) u.pn += GAP_N_; return true;
    }
    __device__ __forceinline__ void a_ready(const Unit&) const {}
    __device__ __forceinline__ void done(const Unit&) const {}
};
__device__ __forceinline__ unsigned cvt_pk_bf16(float lo, float hi) { unsigned r; asm volatile("v_cvt_pk_bf16_f32 %0, %1, %2" : "=v"(r) : "v"(lo), "v"(hi)); return r; }
typedef float f32x2 __attribute__((ext_vector_type(2)));
#ifndef PG8_NT_STORE
#define PG8_NT_STORE 0
#endif
__device__ __forceinline__ float sum_fq(float s) {
    { auto r = __builtin_amdgcn_permlane16_swap(__float_as_uint(s), __float_as_uint(s), false, false); s = __uint_as_float(r[0]) + __uint_as_float(r[1]); }
    { auto r = __builtin_amdgcn_permlane32_swap(__float_as_uint(s), __float_as_uint(s), false, false); s = __uint_as_float(r[0]) + __uint_as_float(r[1]); }
    return s; }
__device__ __forceinline__ float h2f_lo(unsigned u) { return (float)__builtin_bit_cast(_Float16, (unsigned short)(u & 0xffffu)); }
__device__ __forceinline__ float h2f_hi(unsigned u) { return (float)__builtin_bit_cast(_Float16, (unsigned short)(u >> 16)); }
__device__ __forceinline__ void st16(bf16_t* p, u32x4 w) { if (PG8_NT_STORE) __builtin_nontemporal_store(w, (u32x4*)p); else *(u32x4*)p = w; }
template <int ACT, int ldc, int KN, int RT_SHIFT, int RT_SLOTS, bool OTILED = false> struct EpiBf16 {
    static constexpr bool PERM = true, AFTER_DRAIN = false;
    bf16_t* O; const float* bias; const PG8_LAS float* rt; const float* ss;
    __device__ __forceinline__ void operator()(const f32x4 (&acc)[2][2][4][2], const Unit& u, int wr, int wc, int fr, int fq) const {
        const int row0 = u.pm * BM + wr * 64 + fr; const int col0 = u.pn * BM + wc * 32 + 8 * fq;
        f32x4 bv[2][2];
#pragma unroll
        for (int bj = 0; bj < 2; ++bj)
#pragma unroll
            for (int n = 0; n < 2; ++n) bv[bj][n] = bias ? *(const f32x4*)(bias + col0 + bj * HALF + 4 * n) : (f32x4){0.f, 0.f, 0.f, 0.f};
        float rs[2][4];
#pragma unroll
        for (int ai = 0; ai < 2; ++ai)
#pragma unroll
            for (int m = 0; m < 4; ++m) rs[ai][m] = rt[((u.pm >> RT_SHIFT) & (RT_SLOTS - 1)) * BM + wr * 64 + fr + ai * HALF + m * 16];
        if (((const PG8_LAS int*)(rt + RT_SLOTS * BM))[(u.pm >> RT_SHIFT) & (RT_SLOTS - 1)] != u.pm) {
#pragma unroll
            for (int ai = 0; ai < 2; ++ai)
#pragma unroll
                for (int m = 0; m < 4; ++m) rs[ai][m] = __builtin_nanf("");
        }
#pragma unroll
        for (int ai = 0; ai < 2; ++ai)
#pragma unroll
            for (int m = 0; m < 4; ++m) { bf16_t* rowp = OTILED ? O + ((size_t)(u.pm * (ldc / 64) + u.pn * 4 + (wc >> 1)) * (BM * 64) + (wr * 64 + fr + ai * HALF + m * 16) * 64 + (wc & 1) * 32 + 8 * fq)
                                                                : O + (size_t)(row0 + ai * HALF + m * 16) * ldc + col0;
                const float rstd = rs[ai][m];
#pragma unroll
                for (int bj = 0; bj < 2; ++bj) { f32x4 v0 = acc[ai][bj][m][0] * rstd + bv[bj][0], v1 = acc[ai][bj][m][1] * rstd + bv[bj][1];
                    if (ACT == 2) {
#pragma unroll
                        for (int e = 0; e < 4; ++e) { const float a = fmaxf(v0[e], 0.f), b = fmaxf(v1[e], 0.f); v0[e] = a * a; v1[e] = b * b; } }
                    u32x4 w; w.x = cvt_pk_bf16(v0[0], v0[1]); w.y = cvt_pk_bf16(v0[2], v0[3]); w.z = cvt_pk_bf16(v1[0], v1[1]); w.w = cvt_pk_bf16(v1[2], v1[3]);
                    st16(rowp + (OTILED ? bj * 2 * (BM * 64) : bj * HALF), w); } }
    }
};
template <int ldc, int KN, int PNB, int PNQ, int PNK, int PNV, int RT_SHIFT, int RT_SLOTS> struct EpiProj {
    static constexpr bool PERM = true, AFTER_DRAIN = false;
    bf16_t* O; const float* bias; const PG8_LAS float* rt; const float* ss; const float* qw; const float* kw; const unsigned* rope; PG8_LAS float* red;
    __device__ __forceinline__ void operator()(const f32x4 (&acc)[2][2][4][2], const Unit& u, int wr, int wc, int fr, int fq) const {
        const int row0 = u.pm * BM + wr * 64 + fr; const int col0 = u.pn * BM + wc * 32 + 8 * fq;
        float rs[2][4];
#pragma unroll
        for (int ai = 0; ai < 2; ++ai)
#pragma unroll
            for (int m = 0; m < 4; ++m) rs[ai][m] = rt[((u.pm >> RT_SHIFT) & (RT_SLOTS - 1)) * BM + wr * 64 + fr + ai * HALF + m * 16];
        if (((const PG8_LAS int*)(rt + RT_SLOTS * BM))[(u.pm >> RT_SHIFT) & (RT_SLOTS - 1)] != u.pm) {
#pragma unroll
            for (int ai = 0; ai < 2; ++ai)
#pragma unroll
                for (int m = 0; m < 4; ++m) rs[ai][m] = __builtin_nanf("");
        }
        if (u.pn < PNQ || u.pn >= PNV) {
            f32x4 bv[2][2];
#pragma unroll
            for (int bj = 0; bj < 2; ++bj)
#pragma unroll
                for (int n = 0; n < 2; ++n) bv[bj][n] = (f32x4){0.f, 0.f, 0.f, 0.f};
            if (u.pn >= PNB && u.pn < PNQ) {
#pragma unroll
                for (int bj = 0; bj < 2; ++bj)
#pragma unroll
                    for (int n = 0; n < 2; ++n) bv[bj][n] = *(const f32x4*)(bias + col0 + bj * HALF + 4 * n); }
            asm volatile("" ::: "memory");
#pragma unroll
            for (int ai = 0; ai < 2; ++ai)
#pragma unroll
                for (int m = 0; m < 4; ++m) { bf16_t* rowp = O + (size_t)(row0 + ai * HALF + m * 16) * ldc + col0; const float rstd = rs[ai][m];
#pragma unroll
                    for (int bj = 0; bj < 2; ++bj) { const f32x4 v0 = acc[ai][bj][m][0] * rstd + bv[bj][0], v1 = acc[ai][bj][m][1] * rstd + bv[bj][1];
                        u32x4 w; w.x = cvt_pk_bf16(v0[0], v0[1]); w.y = cvt_pk_bf16(v0[2], v0[3]); w.z = cvt_pk_bf16(v1[0], v1[1]); w.w = cvt_pk_bf16(v1[2], v1[3]);
                        st16(rowp + bj * HALF, w); } }
        } else {
            const float* w = (u.pn < PNK) ? qw : kw; const int i0 = 16 * wc + 4 * fq;
            const f32x4 wlo = *(const f32x4*)(w + i0), whi = *(const f32x4*)(w + 64 + i0);
            u32x4 cs[2][4];
#pragma unroll
            for (int ai = 0; ai < 2; ++ai)
#pragma unroll
                for (int m = 0; m < 4; ++m)
#pragma unroll
                    for (int bj = 0; bj < 2; ++bj) { const f32x4 v0 = acc[ai][bj][m][0] * rs[ai][m], v1 = acc[ai][bj][m][1] * rs[ai][m]; const f32x4 q = v0 * v0 + v1 * v1; float s = (q[0] + q[1]) + (q[2] + q[3]);
                        s = sum_fq(s);
                        if (fq == 0) red[((wr * 64 + fr + ai * HALF + m * 16) * 2 + bj) * 4 + wc] = s; }
            asm volatile("s_waitcnt lgkmcnt(0)" ::: "memory"); __builtin_amdgcn_s_barrier(); asm volatile("" ::: "memory");
#pragma unroll
            for (int ai = 0; ai < 2; ++ai)
#pragma unroll
                for (int m = 0; m < 4; ++m) cs[ai][m] = *(const u32x4*)(rope + (size_t)(row0 + ai * HALF + m * 16) * 64 + i0);
#pragma unroll
            for (int ai = 0; ai < 2; ++ai) {
#pragma unroll
                for (int m = 0; m < 4; ++m) { bf16_t* rowp = O + (size_t)(row0 + ai * HALF + m * 16) * ldc + col0; const u32x4 t = cs[ai][m]; const f32x4 cc = {h2f_lo(t.x), h2f_lo(t.y), h2f_lo(t.z), h2f_lo(t.w)}, sn = {h2f_hi(t.x), h2f_hi(t.y), h2f_hi(t.z), h2f_hi(t.w)};
#pragma unroll
                    for (int bj = 0; bj < 2; ++bj) { const f32x4 p = *(const PG8_LAS f32x4*)(red + ((wr * 64 + fr + ai * HALF + m * 16) * 2 + bj) * 4);
                        const float rh = rs[ai][m] * __builtin_amdgcn_rsqf(((p[0] + p[1]) + (p[2] + p[3])) * (1.0f / 128.0f) + 1e-6f);
                        const f32x4 v0 = acc[ai][bj][m][0] * rh, v1 = acc[ai][bj][m][1] * rh;
                        const float a0 = v0[0] * wlo[0], b0 = v0[1] * whi[0], a1 = v0[2] * wlo[1], b1 = v0[3] * whi[1], a2 = v1[0] * wlo[2], b2 = v1[1] * whi[2], a3 = v1[2] * wlo[3], b3 = v1[3] * whi[3];
                        u32x4 o; o.x = cvt_pk_bf16(a0 * cc[0] - b0 * sn[0], a0 * sn[0] + b0 * cc[0]); o.y = cvt_pk_bf16(a1 * cc[1] - b1 * sn[1], a1 * sn[1] + b1 * cc[1]);
                        o.z = cvt_pk_bf16(a2 * cc[2] - b2 * sn[2], a2 * sn[2] + b2 * cc[2]); o.w = cvt_pk_bf16(a3 * cc[3] - b3 * sn[3], a3 * sn[3] + b3 * cc[3]);
                        st16(rowp + bj * HALF, o); } }
                asm volatile("" ::: "memory");
            }
        }
    }
};
template <int ldc, bool FINAL> struct EpiRes {
    static constexpr bool PERM = true, AFTER_DRAIN = false;
    const bf16_t* base; float* out; bf16_t* xb; float* ss; PG8_LAS float* red;
    __device__ __forceinline__ void operator()(const f32x4 (&acc)[2][2][4][2], const Unit& u, int wr, int wc, int fr, int fq) const {
        const int row0 = u.pm * BM + wr * 64 + fr; const int col0 = u.pn * BM + wc * 32 + 8 * fq;
        u32x4 bq[2][4][2];
#pragma unroll
        for (int ai = 0; ai < 2; ++ai)
#pragma unroll
            for (int m = 0; m < 4; ++m) { const size_t off = (size_t)(row0 + ai * HALF + m * 16) * ldc + col0; bq[ai][m][0] = *(const u32x4*)(base + off); bq[ai][m][1] = *(const u32x4*)(base + off + HALF); }
        asm volatile("" ::: "memory");
#pragma unroll
        for (int ai = 0; ai < 2; ++ai)
#pragma unroll
            for (int m = 0; m < 4; ++m) { const size_t off = (size_t)(row0 + ai * HALF + m * 16) * ldc + col0;
                f32x4 x[2][2];
#pragma unroll
                for (int bj = 0; bj < 2; ++bj) { const u32x4 b = bq[ai][m][bj];
                    x[bj][0] = (f32x4){__uint_as_float(b.x << 16), __uint_as_float(b.x & 0xffff0000u), __uint_as_float(b.y << 16), __uint_as_float(b.y & 0xffff0000u)} + acc[ai][bj][m][0];
                    x[bj][1] = (f32x4){__uint_as_float(b.z << 16), __uint_as_float(b.z & 0xffff0000u), __uint_as_float(b.w << 16), __uint_as_float(b.w & 0xffff0000u)} + acc[ai][bj][m][1]; }
                if constexpr (FINAL) {
                    *(f32x4*)(out + off) = x[0][0]; *(f32x4*)(out + off + 4) = x[0][1]; *(f32x4*)(out + off + HALF) = x[1][0]; *(f32x4*)(out + off + HALF + 4) = x[1][1];
                } else {
                    u32x4 w0, w1; w0.x = cvt_pk_bf16(x[0][0][0], x[0][0][1]); w0.y = cvt_pk_bf16(x[0][0][2], x[0][0][3]); w0.z = cvt_pk_bf16(x[0][1][0], x[0][1][1]); w0.w = cvt_pk_bf16(x[0][1][2], x[0][1][3]);
                    w1.x = cvt_pk_bf16(x[1][0][0], x[1][0][1]); w1.y = cvt_pk_bf16(x[1][0][2], x[1][0][3]); w1.z = cvt_pk_bf16(x[1][1][0], x[1][1][1]); w1.w = cvt_pk_bf16(x[1][1][2], x[1][1][3]);
                    *(u32x4*)(xb + off) = w0; *(u32x4*)(xb + off + HALF) = w1;
                    const f32x4 q = x[0][0] * x[0][0] + x[0][1] * x[0][1] + x[1][0] * x[1][0] + x[1][1] * x[1][1]; float s = (q[0] + q[1]) + (q[2] + q[3]);
                    s = sum_fq(s);
                    if (fq == 0) red[(wr * 64 + fr + ai * HALF + m * 16) * 4 + wc] = s; } }
        if constexpr (!FINAL) {
            asm volatile("s_waitcnt lgkmcnt(0)" ::: "memory"); __builtin_amdgcn_s_barrier(); asm volatile("" ::: "memory");
            const int t = threadIdx.x;
            if (t < BM) { const f32x4 p = *(const PG8_LAS f32x4*)(red + t * 4); ss[(size_t)(u.pm * BM + t) * 8 + u.pn] = (p[0] + p[1]) + (p[2] + p[3]); }
        }
    }
};
template <class Epi, class Sched, class GemmT, bool ALIGN_EPI = false, bool SP2 = false>
__device__ __forceinline__ void gemm_phase(PG8_LAS unsigned char* lds, const GemmT g, const Sched& S, const Epi& E) {
    int tid_ = threadIdx.x; asm volatile("" : "+v"(tid_));
    const int tid = tid_, wid = __builtin_amdgcn_readfirstlane(tid >> 6), lane = tid & 63, wr = wid >> 2, wc = wid & 3, fr = lane & 15, fq = lane >> 4;
    constexpr int K = GemmT::K, nt = K / BK;
    unsigned voffA[2], voffB[2];
#pragma unroll
    for (int i = 0; i < 2; ++i) { int R, C; stage_rc(tid * 16 + i * 8192, R, C); const int Rb = Epi::PERM ? ((R & ~31) + perm32(R & 31)) : R;
        voffA[i] = GemmT::A_TILED ? (unsigned)(R * BK + C) * 2u : (unsigned)(R * K + C) * 2u; voffB[i] = (unsigned)(Rb * K + C) * 2u; }
    constexpr size_t kstep = (size_t)(BK * 2);
    constexpr size_t hstep = (size_t)HALF * K * 2;
    constexpr size_t tstep = 2 * hstep;
    constexpr size_t kstepA = GemmT::A_TILED ? (size_t)BM * BK * 2 : kstep, hstepA = GemmT::A_TILED ? (size_t)HALF * BK * 2 : hstep, tstepA = tstep;
    const unsigned ldsw = (unsigned)wid * 1024u;
    const int aoff = lds_byte(wr * 64 + fr, fq * 8), boff = lds_byte(wc * 32 + fr, fq * 8);
#define PG8_SA(b, h) (((b) * 2 + (h)) * HTB)
#define PG8_SB(b, h) ((4 + (b) * 2 + (h)) * HTB)
#define PG8_STAGE(bufoff, gbase, voff) do { const char* gb_ = (const char*)(gbase); asm volatile("" : "+s"(gb_)); _Pragma("unroll") for (int _i = 0; _i < 2; ++_i) \
        __builtin_amdgcn_global_load_lds((const unsigned*)(gb_ + (voff)[_i]), (PG8_LAS unsigned*)(lds + (bufoff) + ldsw + _i * 8192), 16, 0, 0); } while (0)
#define PG8_VOFFS() asm volatile("" : "+v"(voffA[0]), "+v"(voffA[1]), "+v"(voffB[0]), "+v"(voffB[1]))
#define PG8_LDA(dst, b, h) do { _Pragma("unroll") for (int m = 0; m < 4; ++m) _Pragma("unroll") for (int k = 0; k < 2; ++k) dst[m][k] = *(const PG8_LAS bf16x8*)(lds + PG8_SA(b, h) + aoff + m * 2048 + k * 1024); } while (0)
#define PG8_LDB(dst, b, h) do { _Pragma("unroll") for (int n = 0; n < 2; ++n) _Pragma("unroll") for (int k = 0; k < 2; ++k) dst[n][k] = *(const PG8_LAS bf16x8*)(ldsB_ + ((b) * 2 + (h)) * HTB + n * 2048 + k * 1024); } while (0)
#define PG8_MMA(ai, bj, At, Bt) do { __builtin_amdgcn_s_setprio(1); _Pragma("unroll") for (int m = 0; m < 4; ++m) _Pragma("unroll") for (int n = 0; n < 2; ++n) _Pragma("unroll") for (int k = 0; k < 2; ++k) \
        acc[ai][bj][m][n] = __builtin_amdgcn_mfma_f32_16x16x32_bf16(Bt[n][k], At[m][k], acc[ai][bj][m][n], 0, 0, 0); __builtin_amdgcn_s_setprio(0); } while (0)
#define PG8_WAIT_V(n) asm volatile("s_waitcnt vmcnt(" #n ")" ::: "memory")
#define PG8_WAIT_L(n) asm volatile("s_waitcnt lgkmcnt(" #n ")" ::: "memory")
#define PG8_BAR __builtin_amdgcn_s_barrier()
#define PG8_SCHED __builtin_amdgcn_sched_barrier(0)
    PG8_LAS unsigned char* ldsB_ = lds + 4 * HTB + boff; asm volatile("" : "+v"(ldsB_));
    Unit cur, nxt; int ui = 0;
    if (!S.next(0, cur)) return;
    f32x4 acc[2][2][4][2];
#pragma unroll
    for (int a = 0; a < 2; ++a)
#pragma unroll
        for (int b = 0; b < 2; ++b)
#pragma unroll
            for (int m = 0; m < 4; ++m)
#pragma unroll
                for (int n = 0; n < 2; ++n) acc[a][b][m][n] = (f32x4){0.f, 0.f, 0.f, 0.f};
    bf16x8 At[4][2], B0[2][2], B1[2][2];
    const char* cA = (const char*)g.A + (size_t)cur.pm * tstepA; const char* cB = (const char*)g.Bt + (size_t)cur.pn * tstep;
    S.a_ready(cur);
    { PG8_VOFFS();
    if constexpr (SP2) {
        PG8_STAGE(PG8_SB(0, 0), cB, voffB); PG8_STAGE(PG8_SB(0, 1), cB + hstep, voffB); PG8_STAGE(PG8_SA(0, 0), cA, voffA); PG8_STAGE(PG8_SA(0, 1), cA + hstepA, voffA);
        if (wr == 1) PG8_BAR;
        PG8_WAIT_V(2); PG8_BAR;
        PG8_STAGE(PG8_SB(1, 0), cB + kstep, voffB); PG8_STAGE(PG8_SA(1, 0), cA + kstepA, voffA); PG8_STAGE(PG8_SB(1, 1), cB + hstep + kstep, voffB);
        PG8_WAIT_V(6); PG8_BAR;
    } else {
        PG8_STAGE(PG8_SB(0, 0), cB, voffB); PG8_STAGE(PG8_SA(0, 0), cA, voffA); PG8_STAGE(PG8_SB(0, 1), cB + hstep, voffB); PG8_STAGE(PG8_SA(0, 1), cA + hstepA, voffA);
        if (wr == 1) PG8_BAR;
        PG8_WAIT_V(4); PG8_BAR;
        PG8_STAGE(PG8_SB(1, 0), cB + kstep, voffB); PG8_STAGE(PG8_SA(1, 0), cA + kstepA, voffA); PG8_STAGE(PG8_SB(1, 1), cB + hstep + kstep, voffB);
        PG8_WAIT_V(6); PG8_BAR;
    }
    }
    for (;;) {
        const bool has_next = S.next(ui + 1, nxt);
        const char* nA = has_next ? (const char*)g.A + (size_t)nxt.pm * tstepA : cA; const char* nB = has_next ? (const char*)g.Bt + (size_t)nxt.pn * tstep : cB;
        for (int t = 0; t < nt; t += 2) {
            const bool last = (t == nt - 2);
            PG8_VOFFS();
            const char* a1 = cA + (size_t)(t + 1) * kstepA;
            const char* a2 = last ? nA : cA + (size_t)(t + 2) * kstepA; const char* b2 = last ? nB : cB + (size_t)(t + 2) * kstep;
            const char* a3 = a2 + kstepA; const char* b3 = b2 + kstep;
            if (last && has_next) S.a_ready(nxt);
            if constexpr (SP2) {
            PG8_LDB(B0, 0, 0); PG8_LDB(B1, 0, 1); PG8_SCHED; PG8_LDA(At, 0, 0); PG8_STAGE(PG8_SA(1, 1), a1 + hstepA, voffA);
            PG8_WAIT_V(8); PG8_WAIT_L(0); PG8_BAR; PG8_MMA(0, 0, At, B0); PG8_MMA(0, 1, At, B1); PG8_BAR; PG8_SCHED;
            PG8_LDA(At, 0, 1); PG8_STAGE(PG8_SB(0, 0), b2, voffB); PG8_STAGE(PG8_SB(0, 1), b2 + hstep, voffB); PG8_STAGE(PG8_SA(0, 0), a2, voffA);
            PG8_WAIT_V(8); PG8_WAIT_L(0); PG8_BAR; PG8_MMA(1, 0, At, B0); PG8_MMA(1, 1, At, B1); PG8_BAR; PG8_SCHED;
            PG8_LDB(B0, 1, 0); PG8_LDB(B1, 1, 1); PG8_SCHED; PG8_LDA(At, 1, 0); PG8_STAGE(PG8_SA(0, 1), a2 + hstepA, voffA);
            PG8_WAIT_V(8); PG8_WAIT_L(0); PG8_BAR; PG8_MMA(0, 0, At, B0); PG8_MMA(0, 1, At, B1); PG8_BAR; PG8_SCHED;
            PG8_LDA(At, 1, 1); PG8_STAGE(PG8_SB(1, 0), b3, voffB); PG8_STAGE(PG8_SB(1, 1), b3 + hstep, voffB); PG8_STAGE(PG8_SA(1, 0), a3, voffA);
            PG8_WAIT_V(8); PG8_WAIT_L(0); PG8_BAR; PG8_MMA(1, 0, At, B0); PG8_MMA(1, 1, At, B1); PG8_BAR; PG8_SCHED;
            } else {
            PG8_LDB(B0, 0, 0); PG8_SCHED; PG8_LDA(At, 0, 0); PG8_STAGE(PG8_SA(1, 1), a1 + hstepA, voffA);
            PG8_WAIT_L(8); PG8_BAR; PG8_WAIT_L(0); PG8_MMA(0, 0, At, B0); PG8_BAR; PG8_SCHED;
            PG8_LDB(B1, 0, 1); PG8_STAGE(PG8_SB(0, 0), b2, voffB);
            PG8_BAR; PG8_WAIT_L(0); PG8_MMA(0, 1, At, B1); PG8_BAR;
            PG8_LDA(At, 0, 1); PG8_STAGE(PG8_SA(0, 0), a2, voffA);
            PG8_BAR; PG8_WAIT_L(0); PG8_MMA(1, 0, At, B0); PG8_BAR; PG8_SCHED;
            PG8_STAGE(PG8_SB(0, 1), b2 + hstep, voffB);
            PG8_WAIT_V(6); PG8_BAR; PG8_MMA(1, 1, At, B1); PG8_BAR;
            PG8_LDB(B0, 1, 0); PG8_SCHED; PG8_LDA(At, 1, 0); PG8_STAGE(PG8_SA(0, 1), a2 + hstepA, voffA);
            PG8_WAIT_L(8); PG8_BAR; PG8_WAIT_L(0); PG8_MMA(0, 0, At, B0); PG8_BAR; PG8_SCHED;
            PG8_LDB(B1, 1, 1); PG8_STAGE(PG8_SB(1, 0), b3, voffB);
            PG8_BAR; PG8_WAIT_L(0); PG8_MMA(0, 1, At, B1); PG8_BAR;
            PG8_LDA(At, 1, 1); PG8_STAGE(PG8_SA(1, 0), a3, voffA);
            PG8_BAR; PG8_WAIT_L(0); PG8_MMA(1, 0, At, B0); PG8_BAR; PG8_SCHED;
            PG8_STAGE(PG8_SB(1, 1), b3 + hstep, voffB);
            PG8_WAIT_V(6); PG8_BAR; PG8_MMA(1, 1, At, B1); PG8_BAR;
            }
        }
        if constexpr (ALIGN_EPI) { if (wr == 0) PG8_BAR; }
        if constexpr (!Epi::AFTER_DRAIN) { E(acc, cur, wr, wc, fr, fq); S.done(cur); }
        if (!has_next) break;
#pragma unroll
        for (int a = 0; a < 2; ++a)
#pragma unroll
            for (int b = 0; b < 2; ++b)
#pragma unroll
                for (int m = 0; m < 4; ++m)
#pragma unroll
                    for (int n = 0; n < 2; ++n) acc[a][b][m][n] = (f32x4){0.f, 0.f, 0.f, 0.f};
        cur = nxt; cA = nA; cB = nB; ++ui;
        if constexpr (ALIGN_EPI) { if (wr == 1) PG8_BAR; }
    }
    PG8_WAIT_V(0);
    if constexpr (!ALIGN_EPI) { if (wr == 0) PG8_BAR; }
    PG8_BAR;
    if constexpr (Epi::AFTER_DRAIN) { E.fused(acc, cur, wr, wc, fr, fq, lds, wid, lane); S.done(cur); }
#undef PG8_SA
#undef PG8_SB
#undef PG8_STAGE
#undef PG8_VOFFS
#undef PG8_LDA
#undef PG8_LDB
#undef PG8_MMA
#undef PG8_WAIT_V
#undef PG8_WAIT_L
#undef PG8_BAR
#undef PG8_SCHED
}
}
namespace swa {
constexpr int D = 128;
constexpr int KVPITCH = 6656, QPITCH = 6656, OPITCH = 2048;
constexpr float THR = 8.f;
constexpr bool WSKIP = false;
constexpr float SCALE = 0.08838834764831845f;
constexpr int NW = 8, QBLK = 32, KVBLK = 64, QB = NW * QBLK;
constexpr int SHM_V = KVBLK * D * 2, SHM_K = KVBLK * D * 2;
constexpr int LDS_BYTES = 2 * SHM_V + 2 * SHM_K + NW * 64 * 4;
using bf16 = __hip_bfloat16;
typedef short bf16x8 __attribute__((ext_vector_type(8)));
typedef short s16x4 __attribute__((ext_vector_type(4)));
typedef float f32x16 __attribute__((ext_vector_type(16)));
typedef float f32x4 __attribute__((ext_vector_type(4)));
typedef unsigned u32x4 __attribute__((ext_vector_type(4)));
template <class A, class Bt> struct same_t { static constexpr bool v = false; };
template <class A> struct same_t<A, A> { static constexpr bool v = true; };

#define KSWZ(row, colB) ((row) * 256 + ((colB) ^ (((row) & 7) << 4)))
#define SBAR() __builtin_amdgcn_sched_barrier(0)
__device__ __forceinline__ int v_st(int k, int c) { const int kk = (k & ~0xC) | ((k & 4) << 1) | ((k & 8) >> 1); return ((kk >> 3) * 4 + (c >> 5)) * 512 + ((kk & 7) * 32 + (c & 31)) * 2; }
__device__ __forceinline__ int v_rd_base(int lane) { return ((lane & 3) << 3) | (((lane >> 2) & 3) << 6) | (((lane >> 4) & 1) << 5) | (((lane >> 5) & 1) << 8); }
constexpr int v_rd_off(int d0, int ks, int half) { return d0 * 512 + ks * 4096 + half * 2048; }
__device__ __forceinline__ int crow(int r, int hi) { return (r & 3) + 8 * (r >> 2) + 4 * hi; }
__device__ __forceinline__ unsigned cvtpk(float lo, float hi) {
    unsigned r; asm volatile("v_cvt_pk_bf16_f32 %0, %1, %2" : "=v"(r) : "v"(lo), "v"(hi)); return r;
}
__device__ __forceinline__ bf16x8 pack8(f32x4 a, f32x4 b) {
    u32x4 w = {cvtpk(a[0], a[1]), cvtpk(a[2], a[3]), cvtpk(b[0], b[1]), cvtpk(b[2], b[3])};
    return *reinterpret_cast<bf16x8*>(&w);
}
template <class T> __device__ __forceinline__ bf16x8 load8(const T* p) {
    if constexpr (same_t<T, float>::v) { return pack8(*(const f32x4*)p, *(const f32x4*)(p + 4)); }
    else { return *reinterpret_cast<const bf16x8*>(p); }
}
__device__ __forceinline__ void mask_tile(f32x16& p0, f32x16& p1, int dq, unsigned W) {
    const float NEG = -__builtin_inff();
#pragma unroll
    for (int r = 0; r < 16; ++r) {
        const int c = (r & 3) + 8 * (r >> 2);
        if ((unsigned)(dq - c) >= W) p0[r] = NEG;
        if ((unsigned)(dq - c - 32) >= W) p1[r] = NEG;
    }
}
__device__ __forceinline__ void partialSM(f32x16& p0, f32x16& p1, float& m_reg, float& mn, float& alpha) {
    float pmax = p0[0]; for (int r = 1; r < 16; ++r) pmax = fmaxf(pmax, p0[r]); for (int r = 0; r < 16; ++r) pmax = fmaxf(pmax, p1[r]);
    { auto rr = __builtin_amdgcn_permlane32_swap(__float_as_uint(pmax), __float_as_uint(pmax), false, false);
      pmax = fmaxf(__uint_as_float(rr[0]), __uint_as_float(rr[1])); }
    constexpr float C2 = 1.4426950408889634f * SCALE;
    if (__builtin_expect(__all((pmax - m_reg) * SCALE <= THR), 1)) { mn = m_reg; alpha = 1.f; }
    else { mn = fmaxf(m_reg, pmax); alpha = __builtin_amdgcn_exp2f((m_reg - mn) * C2); m_reg = mn; }
    const float mnL = -mn * C2;
    for (int r = 0; r < 16; ++r) p0[r] = fmaf(p0[r], C2, mnL); for (int r = 0; r < 16; ++r) p1[r] = fmaf(p1[r], C2, mnL);
    for (int r = 0; r < 16; ++r) p0[r] = __builtin_amdgcn_exp2f(p0[r]);
}
__device__ __forceinline__ void finishSM(f32x16& p0, f32x16& p1, float alpha, float& l_reg, bf16x8& pa0, bf16x8& pa1, bf16x8& pa2, bf16x8& pa3) {
    for (int r = 0; r < 16; ++r) p1[r] = __builtin_amdgcn_exp2f(p1[r]);
    float ps = 0; for (int r = 0; r < 16; ++r) ps += p0[r]; for (int r = 0; r < 16; ++r) ps += p1[r];
    { auto rr = __builtin_amdgcn_permlane32_swap(__float_as_uint(ps), __float_as_uint(ps), false, false);
      ps = __uint_as_float(rr[0]) + __uint_as_float(rr[1]); }
    l_reg = l_reg * alpha + ps;
#define PK4(P, B_, OUT) do { unsigned a0 = cvtpk(P[B_+0], P[B_+1]), a1 = cvtpk(P[B_+2], P[B_+3]);                          \
        unsigned b0 = cvtpk(P[B_+4], P[B_+5]), b1 = cvtpk(P[B_+6], P[B_+7]);                                             \
        auto r0 = __builtin_amdgcn_permlane32_swap(a0, b0, false, false); auto r1 = __builtin_amdgcn_permlane32_swap(a1, b1, false, false); \
        u32x4 w = {r0[0], r1[0], r0[1], r1[1]}; OUT = *reinterpret_cast<bf16x8*>(&w); } while (0)
    PK4(p0, 0, pa0); PK4(p0, 8, pa1); PK4(p1, 0, pa2); PK4(p1, 8, pa3);
#undef PK4
}
template <int KB, bool SK>
__device__ __forceinline__ void qkt(f32x16& p0, f32x16& p1, const char* K_lds, int r32, int hi, const bf16x8* qr, bool act) {
    if (SK && !act) { const float NEG = -__builtin_inff();
#pragma unroll
        for (int r = 0; r < 16; ++r) { p0[r] = NEG; p1[r] = NEG; } return; }
    p0 = f32x16{}; p1 = f32x16{};
    const char* kb[4];
#pragma unroll
    for (int dd = 0; dd < 4; ++dd) kb[dd] = K_lds + KB * SHM_K + KSWZ(r32, (dd * 16 + hi * 8) * 2);
#pragma unroll
    for (int d0 = 0; d0 < 8; ++d0) { const char* a = kb[d0 & 3] + (d0 >> 2) * 128;
        bf16x8 b0 = *reinterpret_cast<const bf16x8*>(a);
        bf16x8 b1 = *reinterpret_cast<const bf16x8*>(a + 32 * 256);
        p0 = __builtin_amdgcn_mfma_f32_32x32x16_bf16(b0, qr[d0], p0, 0, 0, 0);
        p1 = __builtin_amdgcn_mfma_f32_32x32x16_bf16(b1, qr[d0], p1, 0, 0, 0); }
}
template <int VB, bool SK>
__device__ __forceinline__ void pv_tile(f32x16* o, int vb0, bf16x8 pa0, bf16x8 pa1, bf16x8 pa2, bf16x8 pa3, bool act) {
    if (SK && !act) return;
#define TRRD(dst, off) asm volatile("ds_read_b64_tr_b16 %0, %1 offset:%2" : "=&v"(dst) : "v"(vb0), "i"(off) : "memory")
#define PV_D0(d0) do { s16x4 l0, l1, l2, l3, h0, h1, h2, h3; constexpr int b_ = VB * SHM_V + v_rd_off(d0, 0, 0);     \
        TRRD(l0, b_); TRRD(h0, b_ + 2048); TRRD(l1, b_ + 4096); TRRD(h1, b_ + 6144); TRRD(l2, b_ + 8192); TRRD(h2, b_ + 10240); TRRD(l3, b_ + 12288); TRRD(h3, b_ + 14336); \
        asm volatile("s_waitcnt lgkmcnt(0)" ::: "memory"); SBAR();                 \
        o[d0] = __builtin_amdgcn_mfma_f32_32x32x16_bf16(pa0, (bf16x8){l0[0], l0[1], l0[2], l0[3], h0[0], h0[1], h0[2], h0[3]}, o[d0], 0, 0, 0);   \
        o[d0] = __builtin_amdgcn_mfma_f32_32x32x16_bf16(pa1, (bf16x8){l1[0], l1[1], l1[2], l1[3], h1[0], h1[1], h1[2], h1[3]}, o[d0], 0, 0, 0);   \
        o[d0] = __builtin_amdgcn_mfma_f32_32x32x16_bf16(pa2, (bf16x8){l2[0], l2[1], l2[2], l2[3], h2[0], h2[1], h2[2], h2[3]}, o[d0], 0, 0, 0);   \
        o[d0] = __builtin_amdgcn_mfma_f32_32x32x16_bf16(pa3, (bf16x8){l3[0], l3[1], l3[2], l3[3], h3[0], h3[1], h3[2], h3[3]}, o[d0], 0, 0, 0); } while (0)
    PV_D0(0); PV_D0(1); PV_D0(2); PV_D0(3);
#undef PV_D0
#undef TRRD
}

template <class TIn, class TOut> struct BlockRef { const TIn* Q; const TIn* K; const TIn* V; TOut* O; int P0; };
template <class TIn> struct Seam {
    bf16x8 qr[8];
    bf16x8 st_v0, st_v1, st_k0, st_k1; f32x4 sf0, sf1, sf2, sf3;
    f32x4 tq[16];
};
__device__ __forceinline__ int swa_jlo(int P0, int W) { const int lowk = P0 - W + 1; return lowk > 0 ? lowk / KVBLK : 0; }
#define ROW(p, k0, rr) ((p) + (size_t)((k0) + (rr)) * KVPITCH + sc)
#define VMW() asm volatile("s_waitcnt vmcnt(0)" ::: "memory")
#define VMWN(n) asm volatile("s_waitcnt vmcnt(%0)" :: "i"(n) : "memory")
#define SLOAD_H(Kp, Vp, k0) do { S.st_v0 = load8<TIn>(ROW(Vp, k0, sr)); S.st_v1 = load8<TIn>(ROW(Vp, k0, 32 + sr));              \
                         S.st_k0 = load8<TIn>(ROW(Kp, k0, sr)); S.st_k1 = load8<TIn>(ROW(Kp, k0, 32 + sr)); } while (0)
#define SWRITE_HK(bf) do { *(bf16x8*)(K_lds + (bf) * SHM_K + kws) = S.st_k0; *(bf16x8*)(K_lds + (bf) * SHM_K + kws + 32 * 256) = S.st_k1; } while (0)
#define SWRITE_HV(bf) do { *(bf16x8*)(V_lds + (bf) * SHM_V + vst0) = S.st_v0; *(bf16x8*)(V_lds + (bf) * SHM_V + vst1) = S.st_v1; } while (0)
#define SWRITE_H(bf) do { SWRITE_HV(bf); SWRITE_HK(bf); } while (0)
#define SLOAD_F(p, k0) do { S.sf0 = *(const f32x4*)ROW(p, k0, sr); S.sf1 = *(const f32x4*)(ROW(p, k0, sr) + 4);                \
                            S.sf2 = *(const f32x4*)ROW(p, k0, 32 + sr); S.sf3 = *(const f32x4*)(ROW(p, k0, 32 + sr) + 4); } while (0)
#define SWRITE_KF(bf) do { *(bf16x8*)(K_lds + (bf) * SHM_K + kws) = pack8(S.sf0, S.sf1); *(bf16x8*)(K_lds + (bf) * SHM_K + kws + 32 * 256) = pack8(S.sf2, S.sf3); } while (0)
#define SWRITE_VF(bf) do { *(bf16x8*)(V_lds + (bf) * SHM_V + vst0) = pack8(S.sf0, S.sf1); *(bf16x8*)(V_lds + (bf) * SHM_V + vst1) = pack8(S.sf2, S.sf3); } while (0)
template <class TIn, class TOut>
__device__ __forceinline__ void causal_swa_prime(const BlockRef<TIn, TOut>& cur, int W, char* lds, Seam<TIn>& S) {
    constexpr bool F32 = same_t<TIn, float>::v;
    int tid_ = threadIdx.x; asm volatile("" : "+v"(tid_)); const int tid = tid_, wid = __builtin_amdgcn_readfirstlane(tid >> 6), lane = tid & 63, r32 = lane & 31, hi = lane >> 5;
    const int sr = tid >> 4, sc = (tid & 15) * 8, kws = KSWZ(sr, sc * 2); char* K_lds = lds + 2 * SHM_V;
    const int kb0 = swa_jlo(cur.P0, W) * KVBLK;
    for (int d0 = 0; d0 < 8; ++d0) S.qr[d0] = load8<TIn>(cur.Q + (size_t)(wid * QBLK + r32) * QPITCH + d0 * 16 + hi * 8);
    if constexpr (F32) { SLOAD_F((const float*)cur.K, kb0); VMW(); SWRITE_KF(0); SBAR(); SLOAD_F((const float*)cur.V, kb0); }
    else { SLOAD_H(cur.K, cur.V, kb0); VMW(); SWRITE_HK(0); }
    __syncthreads();
}
template <class TIn, class TOut>
__device__ __forceinline__ void causal_swa_block(const BlockRef<TIn, TOut>& cur, const BlockRef<TIn, TOut>& nxt, int skv, int W, char* lds, Seam<TIn>& S) {
    constexpr bool F32 = same_t<TIn, float>::v;
    int tid_ = threadIdx.x; asm volatile("" : "+v"(tid_)); const int tid = tid_, wid = __builtin_amdgcn_readfirstlane(tid >> 6), lane = tid & 63, r32 = lane & 31, hi = lane >> 5;
    const int j_lo = swa_jlo(cur.P0, W);
    int j_hi = (cur.P0 + QB - 1) / KVBLK + 1; if (j_hi > skv / KVBLK) j_hi = skv / KVBLK;
    const int NT = j_hi - j_lo;
    const int kbn = swa_jlo(nxt.P0, W) * KVBLK;
    const int qlo = cur.P0 + wid * QBLK, qm = qlo + r32 - 4 * hi;
    char* V_lds = lds; char* K_lds = lds + 2 * SHM_V;
    float* ws = (float*)(lds + 2 * SHM_V + 2 * SHM_K) + wid * 64; float* li_l = ws, * al_l = ws + 32;
    float m_reg = -1e30f, l_reg = 0; f32x16 o[4] = {};
    const int sr = tid >> 4, sc = (tid & 15) * 8, vst0 = v_st(sr, sc), vst1 = v_st(32 + sr, sc), kws = KSWZ(sr, sc * 2);
    const int vb0 = (int)(uintptr_t)V_lds + v_rd_base(lane);
    const TIn* Kh = cur.K; const TIn* Vh = cur.V;
#define RESC(a) do { if (__any((a) < 1.f)) { if (hi == 0) al_l[r32] = (a); asm volatile("s_waitcnt lgkmcnt(0)" ::: "memory");              \
                     for (int d_ = 0; d_ < 4; ++d_) for (int r = 0; r < 16; ++r) o[d_][r] *= al_l[crow(r, hi)]; } } while (0)
#define KBASE(t) ((j_lo + (t)) * KVBLK)
#define ACT(t) (KBASE(t) <= qlo + QBLK - 1 && KBASE(t) + KVBLK - 1 >= qlo - W + 1)
#define MASKT(P0_, P1_, t) do { const int kb_ = KBASE(t); if ((!SK || ACT(t)) && (kb_ + KVBLK - 1 > qlo || kb_ <= qlo + QBLK - 1 - W)) mask_tile(P0_, P1_, qm - kb_, (unsigned)W); } while (0)
    constexpr int NQL = F32 ? 16 : 8;
    constexpr bool SK = WSKIP && !F32;
#define SEAM_K0() do { VMWN(NQL); if constexpr (F32) { SWRITE_KF(0); SBAR(); SLOAD_F((const float*)nxt.V, kbn); } else { SWRITE_HK(0); } SBAR(); } while (0)
    f32x16 pA0, pA1, pB0, pB1; float mnA, mnB, alA, alB; bf16x8 pa0, pa1, pa2, pa3;
    if constexpr (F32) { VMW(); SWRITE_VF(0); SBAR(); } else { SWRITE_HV(0); SBAR(); }
    if (NT > 1) { if constexpr (F32) SLOAD_F((const float*)Kh, KBASE(1)); else SLOAD_H(Kh, Vh, KBASE(1)); }
    SBAR(); qkt<0, SK>(pA0, pA1, K_lds, r32, hi, S.qr, ACT(0));
    if constexpr (F32) { if (NT > 1) { VMW(); SWRITE_KF(1); SBAR(); SLOAD_F((const float*)Vh, KBASE(1)); } }
    MASKT(pA0, pA1, 0); partialSM(pA0, pA1, m_reg, mnA, alA);
    if (NT > 1) { VMW(); if constexpr (F32) { SWRITE_VF(1); SBAR(); if (NT > 2) SLOAD_F((const float*)Kh, KBASE(2)); } else SWRITE_H(1); }
    __syncthreads();
#define HALF_STEP(PX0, PX1, mnX, alX, PY0, PY1, alY, t, KB, VB, SB) do {                                                      \
        SBAR(); qkt<KB, SK>(PX0, PX1, K_lds, r32, hi, S.qr, ACT(t));                                             \
        finishSM(PY0, PY1, alY, l_reg, pa0, pa1, pa2, pa3); SBAR();                                                           \
        if ((t) + 1 < NT) { if constexpr (F32) { VMW(); SWRITE_KF(SB); SBAR(); SLOAD_F((const float*)Vh, KBASE((t) + 1)); }  \
                            else { SLOAD_H(Kh, Vh, KBASE((t) + 1)); } SBAR(); }                                               \
        pv_tile<VB, SK>(o, vb0, pa0, pa1, pa2, pa3, ACT((t) - 1)); MASKT(PX0, PX1, (t)); partialSM(PX0, PX1, m_reg, mnX, alX);                                        \
        __syncthreads();                                                                                                      \
        if ((t) + 1 < NT) { VMW(); if constexpr (F32) { SWRITE_VF(SB); SBAR(); if ((t) + 2 < NT) SLOAD_F((const float*)Kh, KBASE((t) + 2)); } \
                            else { SWRITE_H(SB); } }                                                                          \
        RESC(alX); __syncthreads(); } while (0)
    for (int t = 1; t + 1 < NT; t += 2) {
        HALF_STEP(pB0, pB1, mnB, alB, pA0, pA1, alA, t, 1, 0, 0);
        HALF_STEP(pA0, pA1, mnA, alA, pB0, pB1, alB, t + 1, 0, 1, 1);
    }
    const bool even = (NT & 1) == 0;
    if (even) { SBAR(); qkt<1, SK>(pB0, pB1, K_lds, r32, hi, S.qr, ACT(NT - 1)); SBAR(); }
#define QROW(e) (nxt.Q + (size_t)(wid * QBLK + r32) * QPITCH + ((e) >> 1) * 16 + hi * 8 + ((e) & 1) * 4)
    if constexpr (F32) { SLOAD_F((const float*)nxt.K, kbn); SBAR();
#pragma unroll
        for (int e = 0; e < 8; ++e) S.tq[e] = *(const f32x4*)QROW(e); }
    else { SLOAD_H(nxt.K, nxt.V, kbn); SBAR();
#pragma unroll
        for (int d0 = 0; d0 < 8; ++d0) S.qr[d0] = load8<TIn>(nxt.Q + (size_t)(wid * QBLK + r32) * QPITCH + d0 * 16 + hi * 8); }
    SBAR();
    finishSM(pA0, pA1, alA, l_reg, pa0, pa1, pa2, pa3); SBAR();
    if constexpr (F32) {
#pragma unroll
        for (int e = 8; e < 16; ++e) S.tq[e] = *(const f32x4*)QROW(e); SBAR(); }
#undef QROW
    pv_tile<0, SK>(o, vb0, pa0, pa1, pa2, pa3, ACT(even ? NT - 2 : NT - 1));
    if (even) { MASKT(pB0, pB1, NT - 1); partialSM(pB0, pB1, m_reg, mnB, alB); __syncthreads(); RESC(alB);
        finishSM(pB0, pB1, alB, l_reg, pa0, pa1, pa2, pa3); SBAR(); pv_tile<1, SK>(o, vb0, pa0, pa1, pa2, pa3, ACT(NT - 1)); }
    SBAR(); SEAM_K0();
    if (hi == 0) li_l[r32] = l_reg; asm volatile("s_waitcnt lgkmcnt(0)" ::: "memory");
    float rli[16];
#pragma unroll
    for (int r = 0; r < 16; ++r) rli[r] = __builtin_amdgcn_rcpf(li_l[crow(r, hi)]);
    TOut* Ow = cur.O + (size_t)(wid * QBLK) * OPITCH;
#pragma unroll
    for (int r = 0; r < 16; ++r) { const int orow = crow(r, hi);
        if constexpr (same_t<TOut, float>::v) {
#pragma unroll
            for (int d0 = 0; d0 < 4; ++d0) Ow[(size_t)orow * OPITCH + d0 * 32 + r32] = o[d0][r] * rli[r];
        } else {
            typedef unsigned v2u_t __attribute__((ext_vector_type(2)));
            v2u_t w; w.x = cvtpk(o[0][r] * rli[r], o[1][r] * rli[r]); w.y = cvtpk(o[2][r] * rli[r], o[3][r] * rli[r]);
            *(v2u_t*)(Ow + (size_t)orow * OPITCH + r32 * 4) = w; } }
    if constexpr (F32) {
#pragma unroll
        for (int d0 = 0; d0 < 8; ++d0) S.qr[d0] = pack8(S.tq[2 * d0], S.tq[2 * d0 + 1]); }
    __syncthreads();
#undef RESC
#undef KBASE
#undef ACT
#undef MASKT
#undef SEAM_K0
#undef HALF_STEP
}
#undef ROW
#undef VMW
#undef VMWN
#undef SLOAD_H
#undef SWRITE_HK
#undef SWRITE_HV
#undef SWRITE_H
#undef SLOAD_F
#undef SWRITE_KF
#undef SWRITE_VF

}
constexpr int NWAVES = 8;
#ifndef MK_SPLIT
#define MK_SPLIT 0
#endif
constexpr int BATCH = 16, SEQ = 2048, DM = 2048, M = BATCH * SEQ, DEPTH = 2, DFF = 8192;
constexpr int IN_COLS = 6160;
constexpr int NPROJ = 6656;
constexpr int C_GQ = 0, C_GK = 512, C_GV = 1024, C_GG = 2048, C_GATE = 3072, C_DQ = 3584, C_DK = 4608, C_DV = 5632;
constexpr int S_LR = 3072, S_SHIFT = 496;
constexpr int PH_PER_LAYER = 6, N_PHASES = 1 + DEPTH * PH_PER_LAYER;
constexpr float NORM_EPS = 1e-6f, SUBLN_EPS = 1e-5f;
constexpr float GLA_QSCALE = 0.08838834764831845f;

constexpr size_t MiB = 1u << 20;
constexpr size_t WS_CTL = 0, CTL_ZERO_BYTES = 1 * MiB;
constexpr size_t WS_BIAS = 1 * MiB;
constexpr size_t WS_WLRT = 1 * MiB + 256 * 1024;
constexpr size_t WS_W2F = 1 * MiB + 512 * 1024;
constexpr size_t WS_ROPE = 2 * MiB;
constexpr size_t WS_WIN = 18 * MiB;
constexpr size_t WS_WOUT = 70 * MiB;
constexpr size_t WS_WUP = 86 * MiB;
constexpr size_t WS_WDN = 150 * MiB;
constexpr size_t WS_XN = 214 * MiB;
constexpr size_t WS_XB2 = 342 * MiB;
constexpr size_t WS_PROJ = 342 * MiB;
constexpr size_t WS_O = 758 * MiB;
constexpr size_t WS_HID = 470 * MiB;
constexpr size_t WS_SS = 1014 * MiB;
constexpr size_t WS_END = 1019 * MiB;
static_assert(WS_WIN + (size_t)DEPTH * NPROJ * DM * 2 <= WS_WOUT && WS_WOUT + (size_t)DEPTH * DM * DM * 2 <= WS_WUP && WS_WUP + (size_t)DEPTH * DFF * DM * 2 <= WS_WDN && WS_WDN + (size_t)DEPTH * DFF * DM * 2 <= WS_XN, "ws map: weights");
static_assert(WS_XN + (size_t)M * DM * 2 <= WS_PROJ && WS_PROJ + (size_t)M * NPROJ * 2 <= WS_O && WS_O + (size_t)M * 2048 * 4 <= WS_END && WS_HID + (size_t)M * DFF * 2 <= WS_END && WS_XB2 + (size_t)M * DM * 2 <= WS_HID, "ws map: activations");
constexpr int CW_BAR = 4096;
constexpr int CW_VC = 9216;
constexpr int CW_Q = 8192;


constexpr int RING_OFF = 0, RING_BYTES = 131072;
constexpr int LDSCTL_OFF = RING_BYTES, MISC_OFF = LDSCTL_OFF + 320;
constexpr int RED_OFF = RING_BYTES + 1024;
constexpr int LDS_BYTES = 147456;
constexpr int RT_OFF = RED_OFF + 8192;
static_assert(MISC_OFF + 128 <= RED_OFF && RT_OFF + 4096 + 64 <= LDS_BYTES, "LDS map");

#define GAS __attribute__((address_space(1)))
#define LAS __attribute__((address_space(3)))
#define DI __device__ __forceinline__
typedef unsigned short bf16;
typedef unsigned v4u __attribute__((ext_vector_type(4)));
typedef unsigned v2u __attribute__((ext_vector_type(2)));
typedef float f32x4 __attribute__((ext_vector_type(4)));
typedef float f32x2v __attribute__((ext_vector_type(2)));
typedef float f32x16 __attribute__((ext_vector_type(16)));
typedef short bf16x8 __attribute__((ext_vector_type(8)));
typedef short s16x4 __attribute__((ext_vector_type(4)));
typedef __bf16 bf16x2_t __attribute__((ext_vector_type(2)));
typedef GAS unsigned gu32;
#define RLX_AGENT __ATOMIC_RELAXED, __HIP_MEMORY_SCOPE_AGENT
#define LDS_WAIT() asm volatile("s_waitcnt lgkmcnt(0)" ::: "memory")
#define VM_WAIT() asm volatile("s_waitcnt vmcnt(0)" ::: "memory")
DI unsigned pk2(float lo, float hi) { f32x2v v = {lo, hi}; bf16x2_t b = __builtin_convertvector(v, bf16x2_t); return __builtin_bit_cast(unsigned, b); }
DI float bf_lo(unsigned u) { return __uint_as_float(u << 16); }
DI float bf_hi(unsigned u) { return __uint_as_float(u & 0xffff0000u); }
DI int opaque_tid() { int t = threadIdx.x; asm volatile("" : "+v"(t)); return t; }
#define PH_IDS const int tid = opaque_tid(), lane = tid & 63, wave = __builtin_amdgcn_readfirstlane(tid >> 6), gw = (int)blockIdx.x * NWAVES + wave; (void)lane; (void)gw
#define MFMA32(a, b, c) __builtin_amdgcn_mfma_f32_32x32x16_bf16((a), (b), (c), 0, 0, 0)

#define XB_TMO      128
#define XB_XCNT(j)  (256  + 64 * (j))
#define XB_XSUB(j)  (1280 + 64 * (j))
#define XB_XGEN(j)  (2304 + 64 * (j))
#define XB_TOP      3328
#define XB_TOPGEN   3392
#define XCD_BAR_WORDS 3456
#define XB_SPIN_CAP (1u << 18)

__device__ __forceinline__ unsigned xb_ld(unsigned* p)              { return __hip_atomic_load(p, __ATOMIC_RELAXED, __HIP_MEMORY_SCOPE_AGENT); }
__device__ __forceinline__ unsigned xb_add(unsigned* p, unsigned v) { return __hip_atomic_fetch_add(p, v, __ATOMIC_RELAXED, __HIP_MEMORY_SCOPE_AGENT); }
__device__ __forceinline__ unsigned xb_xcc_id() { return (unsigned)__builtin_amdgcn_s_getreg((3 << 11) | 20) & 0xFu; }
#define XB_SPIN(cond, bar) do { unsigned _sp = 0; while (cond) { __builtin_amdgcn_s_sleep(1); \
    if ((++_sp & 255u) == 0u) { if (xb_ld(&(bar)[XB_TMO])) break; if (_sp > XB_SPIN_CAP) { atomicAdd(&(bar)[XB_TMO], 1u); break; } } } } while (0)

struct XcdBarrier {
    unsigned* bar; unsigned x;
    volatile LAS unsigned* st;
};

__device__ __forceinline__ XcdBarrier xcd_barrier_post(unsigned* bar, volatile LAS unsigned* st) {
    XcdBarrier b; b.bar = bar; b.x = xb_xcc_id(); b.st = st;
    if (threadIdx.x == 0) (void)xb_add(&bar[XB_XCNT(b.x)], 1u);
    return b;
}
__device__ __forceinline__ void xcd_barrier_complete(unsigned* bar, unsigned x, unsigned& nloc, unsigned& nx) {
    const unsigned G = gridDim.x * gridDim.y * gridDim.z;
    unsigned sum, cnt, mine, sp = 0u;
    for (;;) {
        sum = 0u; cnt = 0u; mine = 0u;
#pragma unroll
        for (unsigned j = 0; j < 16; ++j) { const unsigned c = xb_ld(&bar[XB_XCNT(j)]); sum += c; cnt += (c > 0u) ? 1u : 0u; mine = (j == x) ? c : mine; }
        if (sum == G) break;
        __builtin_amdgcn_s_sleep(1);
        if ((++sp & 255u) == 0u) { if (xb_ld(&bar[XB_TMO])) break; if (sp > XB_SPIN_CAP) { atomicAdd(&bar[XB_TMO], 1u); break; } }
    }
    nloc = mine > 0u ? mine : 1u; nx = cnt > 0u ? cnt : 1u;
}

__device__ __forceinline__ void xcd_barrier(const XcdBarrier& b) {
    asm volatile("s_waitcnt vmcnt(0)" ::: "memory");
    __syncthreads();
    if (threadIdx.x == 0) {
        unsigned* bar = b.bar;
        __builtin_amdgcn_s_waitcnt(0);
        unsigned nloc = b.st[0], nx = b.st[1];
        if (nloc == 0u) { xcd_barrier_complete(bar, b.x, nloc, nx); b.st[0] = nloc; b.st[1] = nx; }
        const unsigned old = xb_add(&bar[XB_XSUB(b.x)], 1u);
        const unsigned gen = old / nloc;
        if (old + 1u == (gen + 1u) * nloc) {
            __builtin_amdgcn_fence(__ATOMIC_RELEASE, "agent");
            asm volatile("s_waitcnt vmcnt(0)" ::: "memory");
            const unsigned og = xb_add(&bar[XB_TOP], 1u);
            const unsigned tg = og / nx;
            if (og + 1u == (tg + 1u) * nx) xb_add(&bar[XB_TOPGEN], 1u);
            else XB_SPIN(xb_ld(&bar[XB_TOPGEN]) == tg, bar);
            __builtin_amdgcn_fence(__ATOMIC_ACQUIRE, "agent");
            xb_add(&bar[XB_XGEN(b.x)], 1u);
            asm volatile("s_waitcnt vmcnt(0)" ::: "memory");
        } else {
            XB_SPIN(xb_ld(&bar[XB_XGEN(b.x)]) == gen, bar);
            __builtin_amdgcn_fence(__ATOMIC_ACQUIRE, "agent");
            asm volatile("s_waitcnt vmcnt(0)" ::: "memory");
        }
    }
    __syncthreads();
}

struct Args { const void* in[18]; float* out; unsigned char* ws; int ph_lo, ph_hi; };
struct Frame {
    LAS unsigned char* lds;
    volatile LAS unsigned* MISC;
    gu32* ctl;
    int G, NGW;
    unsigned char* ws;
};
enum { I_X = 0, I_POS, I_ATTN_NW, I_WIN, I_GW2, I_GB, I_GLA_NW, I_QNW, I_KNW, I_LQ1, I_LK1, I_LQ2, I_LK2, I_SUBW, I_WOUT, I_MLP_NW, I_WUP, I_WDN };
typedef __attribute__((address_space(4))) const Args* kargs_t;
DI kargs_t kargs() { kargs_t p = (kargs_t)__builtin_amdgcn_kernarg_segment_ptr(); asm volatile("" : "+s"(p)); return p; }
#define INP(T, k) ((const T*)(const GAS T*)kargs()->in[k])
#define OUTP() ((float*)(GAS float*)kargs()->out)
DI GAS unsigned char* ws_opaque(Frame& F) { GAS unsigned char* w = (GAS unsigned char*)F.ws; asm volatile("" : "+s"(w)); return w; }
DI float wave_sum(float v) {
#pragma unroll
    for (int o = 1; o < 64; o <<= 1) v += __shfl_xor(v, o);
    return v;
}

DI void p0_write_tile(bf16* WT, int K, int drow0, int k0, LAS float* scr, int lane, const float* rs) {
    const int c = lane & 7;
    f32x4 s0 = {1.f, 1.f, 1.f, 1.f}, s1 = s0;
    if (rs) { s0 = *(const f32x4*)(rs + k0 + 8 * c); s1 = *(const f32x4*)(rs + k0 + 8 * c + 4); }
    LDS_WAIT(); asm volatile("" ::: "memory");
#pragma unroll
    for (int j = 0; j < 4; ++j) { const int n = (lane >> 3) + 8 * j; const LAS float* s = scr + (8 * c) * 33 + n;
        v4u o; o.x = pk2(s[0 * 33] * s0[0], s[1 * 33] * s0[1]); o.y = pk2(s[2 * 33] * s0[2], s[3 * 33] * s0[3]); o.z = pk2(s[4 * 33] * s1[0], s[5 * 33] * s1[1]); o.w = pk2(s[6 * 33] * s1[2], s[7 * 33] * s1[3]);
        *(GAS v4u*)(WT + (size_t)(drow0 + n) * K + k0 + 8 * c) = o; }
    LDS_WAIT(); asm volatile("" ::: "memory");
}
DI void p0_transpose_tile(const float* W, int SP, int scol, bf16* WT, int K, int drow0, int k0, LAS float* scr, int lane, const float* rs) {
#pragma unroll 8
    for (int i = 0; i < 32; ++i) { const int kk = 2 * i + (lane >> 5); scr[kk * 33 + (lane & 31)] = W[(size_t)(k0 + kk) * SP + scol]; }
    p0_write_tile(WT, K, drow0, k0, scr, lane, rs);
}
DI void p0_gate_tile(const float* W, const float* w2, bf16* WT, int j0, int k0, LAS float* scr, int lane, const float* rs) {
    float w2r[16];
#pragma unroll
    for (int r = 0; r < 16; ++r) w2r[r] = w2[r * 512 + j0 + (lane & 31)];
#pragma unroll 4
    for (int i = 0; i < 32; ++i) { const int kk = 2 * i + (lane >> 5); const f32x4* wr = (const f32x4*)(W + (size_t)(k0 + kk) * IN_COLS + S_LR);
        float a = 0.f;
#pragma unroll
        for (int q = 0; q < 4; ++q) { const f32x4 t = wr[q]; a = fmaf(t.x, w2r[4 * q], a); a = fmaf(t.y, w2r[4 * q + 1], a); a = fmaf(t.z, w2r[4 * q + 2], a); a = fmaf(t.w, w2r[4 * q + 3], a); }
        scr[kk * 33 + (lane & 31)] = a; }
    p0_write_tile(WT, DM, C_GATE + j0, k0, scr, lane, rs);
}
#ifndef GATE_ITEMS
#define GATE_ITEMS 1
#endif
struct WTile { const float* W; bf16* WT; const float* rs; const float* w2; int SP, scol4, K, drow0, dloc_b, dstep, k0, kperm, gate_j0; };
DI void p0_t64_load(const WTile& d, int lane, f32x4 (&v)[16], f32x2v (&sc)[8]) {
    const int kq = lane >> 4;
#pragma unroll
    for (int j = 0; j < 8; ++j) sc[j] = (f32x2v){1.f, 1.f};
    if (d.gate_j0 != -1) return;
    if (d.rs) {
#pragma unroll
        for (int j = 0; j < 8; ++j) sc[j] = *(const GAS f32x2v*)(d.rs + d.k0 + 8 * j + 2 * kq); }
#pragma unroll
    for (int i = 0; i < 16; ++i) { const int k = 8 * (i >> 1) + 2 * kq + (i & 1); int kr = d.k0 + k; if (d.kperm && kr >= 1024) kr = (kr & ~127) + ((kr & 3) << 5) + ((kr & 127) >> 2);
        v[i] = *(const GAS f32x4*)(d.W + (size_t)kr * d.SP + d.scol4); }
}
DI void p0_t64_finish(const WTile& d, int lane, LAS float* scrf, const f32x4 (&v)[16], const f32x2v (&sc)[8]) {
    if (d.gate_j0 == -2) return;
    if (d.gate_j0 >= 0) { p0_gate_tile(d.W, d.w2, d.WT, d.gate_j0, d.k0, scrf, lane, d.rs); p0_gate_tile(d.W, d.w2, d.WT, d.gate_j0 + 32, d.k0, scrf, lane, d.rs); return; }
    LAS unsigned* scr = (LAS unsigned*)scrf; const int kq = lane >> 4;
#pragma unroll
    for (int j = 0; j < 8; ++j) {
        const float s0 = sc[j].x, s1 = sc[j].y;
        const int k2 = 4 * j + kq;
#pragma unroll
        for (int q = 0; q < 4; ++q) scr[(d.dloc_b + q * d.dstep) * 36 + k2] = pk2(v[2 * j][q] * s0, v[2 * j + 1][q] * s1);
    }
    LDS_WAIT(); asm volatile("" ::: "memory");
#pragma unroll
    for (int j2 = 0; j2 < 8; ++j2) { const int n = (lane >> 3) + 8 * j2, c = lane & 7;
        const v4u o = *(const LAS v4u*)(scr + n * 36 + 4 * c);
        *(GAS v4u*)(d.WT + (size_t)(d.drow0 + n) * d.K + d.k0 + 8 * c) = o; }
    LDS_WAIT(); asm volatile("" ::: "memory");
}
DI void sincos_red(float ang, float& s, float& c) {
    const double a = (double)ang; const double kq = __builtin_rint(a * 0.6366197723675814);
    double r = __builtin_fma(-kq, 1.5707963267948966, a); r = __builtin_fma(-kq, 6.123233995736766e-17, r);
    const float x = (float)r, x2 = x * x; const int q = (int)kq & 3;
    const float sp = x + x * x2 * (-1.6666654611e-1f + x2 * (8.3321608736e-3f + x2 * (-1.9515295891e-4f)));
    const float cp = 1.f - 0.5f * x2 + x2 * x2 * (4.166664568298827e-2f + x2 * (-1.388731625493765e-3f + x2 * 2.443315711809948e-5f));
    s = (q == 0) ? sp : (q == 1) ? cp : (q == 2) ? -sp : -cp;
    c = (q == 0) ? cp : (q == 1) ? -sp : (q == 2) ? -cp : sp;
}
#ifndef CONV_IN_MIXER
#define CONV_IN_MIXER 1
#endif
constexpr int P0_NB_IN = NPROJ / 64, P0_I_IN = (DM / 64) * P0_NB_IN, P0_I_OUT = (DM / 64) * (DM / 64), P0_I_UP = (DM / 64) * (DFF / 64), P0_I_DN = (DFF / 64) * (DM / 64), P0_I_LAYER = P0_I_IN + P0_I_OUT + P0_I_UP + P0_I_DN;
DI void p0_wdesc(Frame& F, GAS unsigned char* ws, int L, int r, int lane, WTile& d) {
    constexpr int NB_IN = P0_NB_IN, I_IN = P0_I_IN, I_OUT = P0_I_OUT, I_UP = P0_I_UP;
    bf16* WinT = (bf16*)(ws + WS_WIN); bf16* WoutT = (bf16*)(ws + WS_WOUT); bf16* WupT = (bf16*)(ws + WS_WUP); bf16* WdnT = (bf16*)(ws + WS_WDN);
    const int n4 = lane & 15;
    d.rs = nullptr; d.w2 = nullptr; d.kperm = 0; d.gate_j0 = -1; d.dloc_b = 4 * n4; d.dstep = 1;
    if (r < I_IN) { const int kb = r / NB_IN, nb = r - kb * NB_IN, drow0 = nb * 64;
        d.W = INP(float, I_WIN) + (size_t)L * DM * IN_COLS; d.WT = WinT + (size_t)L * NPROJ * DM; d.rs = INP(float, I_ATTN_NW) + L * DM; d.SP = IN_COLS; d.K = DM; d.drow0 = drow0; d.k0 = kb * 64;
        if (drow0 >= C_GATE && drow0 < C_DQ) { d.gate_j0 = GATE_ITEMS ? -2 : drow0 - C_GATE; d.w2 = INP(float, I_GW2) + (size_t)L * 16 * 512; d.scol4 = 0; }
        else if (drow0 >= C_DQ && drow0 < C_DV) {
            const int hb = (drow0 - C_DQ) & ~127, c0 = (drow0 - C_DQ) & 127;
            d.scol4 = C_DQ - S_SHIFT + hb + (c0 >> 1) + ((n4 >> 3) ? 64 : 0) + 4 * (n4 & 7); d.dloc_b = 8 * (n4 & 7) + (n4 >> 3); d.dstep = 2; }
        else d.scol4 = (drow0 < C_GATE ? drow0 : drow0 - S_SHIFT) + 4 * n4;
        return; }
    r -= I_IN;
    if (r < I_OUT) { const int kb = r / (DM / 64), nb = r % (DM / 64); d.W = INP(float, I_WOUT) + (size_t)L * DM * DM; d.WT = WoutT + (size_t)L * DM * DM; d.SP = DM; d.K = DM; d.scol4 = nb * 64 + 4 * n4; d.drow0 = nb * 64; d.k0 = kb * 64; d.kperm = 1; return; }
    r -= I_OUT;
    if (r < I_UP) { const int kb = r / (DFF / 64), nb = r % (DFF / 64); d.W = INP(float, I_WUP) + (size_t)L * DM * DFF; d.WT = WupT + (size_t)L * DFF * DM; d.rs = INP(float, I_MLP_NW) + L * DM; d.SP = DFF; d.K = DM; d.scol4 = nb * 64 + 4 * n4; d.drow0 = nb * 64; d.k0 = kb * 64; return; }
    r -= I_UP;
    { const int kb = r / (DM / 64), nb = r % (DM / 64); d.W = INP(float, I_WDN) + (size_t)L * DFF * DM; d.WT = WdnT + (size_t)L * DM * DFF; d.SP = DM; d.K = DFF; d.scol4 = nb * 64 + 4 * n4; d.drow0 = nb * 64; d.k0 = kb * 64; }
}
DI void p0_wtile(Frame& F, GAS unsigned char* ws, int L, int r, LAS float* scr, int lane) {
    WTile d; p0_wdesc(F, ws, L, r, lane, d);
    f32x4 v[16]; f32x2v sc[8];
    p0_t64_load(d, lane, v, sc); p0_t64_finish(d, lane, scr, v, sc);
}
constexpr int CONV_TPW = 10, CONV_TPI = 8 * CONV_TPW, CONV_L0 = P0_I_LAYER - P0_I_IN, CONV_TILES = CONV_L0 + (DEPTH - 1) * P0_I_LAYER, N_CONV = CONV_IN_MIXER ? CONV_TILES / CONV_TPI : 0;
static_assert(CONV_TILES % CONV_TPI == 0 && P0_I_IN % 8 == 0, "conversion items tile the list exactly");
DI void conv_item(Frame& F, int c) {
    PH_IDS;
    LAS float* scr = (LAS float*)(F.lds + RING_OFF + wave * 16384);
    GAS unsigned char* ws = ws_opaque(F);
    auto desc = [&](int j, WTile& d) { const int g = c * CONV_TPI + wave + 8 * j;
        if (g < CONV_L0) p0_wdesc(F, ws, 0, P0_I_IN + g, lane, d);
        else { const int g2 = g - CONV_L0, L = 1 + g2 / P0_I_LAYER; p0_wdesc(F, ws, L, g2 - (L - 1) * P0_I_LAYER, lane, d); } };
    WTile dA, dB; f32x4 vA[16], vB[16]; f32x2v sA[8], sB[8];
    desc(0, dA); p0_t64_load(dA, lane, vA, sA);
#pragma unroll 1
    for (int j = 0; j < CONV_TPW; j += 2) {
        desc(j + 1, dB); p0_t64_load(dB, lane, vB, sB);
        p0_t64_finish(dA, lane, scr, vA, sA);
        if (j + 2 < CONV_TPW) { desc(j + 2, dA); p0_t64_load(dA, lane, vA, sA); }
        p0_t64_finish(dB, lane, scr, vB, sB);
    }
}
static_assert(CONV_TPW % 2 == 0, "conv_item pairs tiles");
DI void p0_prologue(Frame& F) {
    PH_IDS;
    LAS float* scr = (LAS float*)(F.lds + RING_OFF + wave * 16384);
    constexpr int I_LAYER = P0_I_LAYER;
    GAS unsigned char* ws = ws_opaque(F);
#pragma unroll 1
    for (int it = gw; it < (CONV_IN_MIXER ? P0_I_IN : DEPTH * I_LAYER); it += F.NGW) { const int L = it / I_LAYER; p0_wtile(F, ws, L, it - L * I_LAYER, scr, lane); }
    const int gt = gw * 64 + lane, NT = F.NGW * 64;
    float* bias = (float*)(ws + WS_BIAS); const float* gate_b = INP(float, I_GB); const int* pos = INP(int, I_POS);
    for (int i = gt; i < DEPTH * NPROJ; i += NT) { const int L = i / NPROJ, c = i - L * NPROJ; bias[i] = (c >= C_GATE && c < C_DQ) ? gate_b[L * 512 + c - C_GATE] : 0.f; }
    if (GATE_ITEMS) {
        bf16* wlrt = (bf16*)(ws + WS_WLRT); bf16* w2f = (bf16*)(ws + WS_W2F);
        for (int i = gt; i < DEPTH * 16 * DM; i += NT) { const int L = i / (16 * DM), r = (i >> 11) & 15, k = i & (DM - 1);
            const float v = INP(float, I_ATTN_NW)[L * DM + k] * INP(float, I_WIN)[((size_t)L * DM + k) * IN_COLS + S_LR + r];
            wlrt[i] = (bf16)(pk2(v, 0.f) & 0xffffu); }
        for (int i = gt; i < DEPTH * 32 * 64 * 4; i += NT) { const int L = i / (32 * 64 * 4), nb = (i >> 8) & 31, ln = (i >> 2) & 63, e = i & 3;
            const int i_ = ln & 15, ch = 32 * (nb >> 1) + 8 * (i_ >> 2) + 4 * (nb & 1) + (i_ & 3);
            const float v = INP(float, I_GW2)[(size_t)L * 16 * 512 + (4 * (ln >> 4) + e) * 512 + ch];
            w2f[i] = (bf16)(pk2(v, 0.f) & 0xffffu); }
    }
    unsigned* rope = (unsigned*)(ws + WS_ROPE);
    for (int i = gt; i < M * 64; i += NT) { const int row = i >> 6, f = i & 63;
        const float inv_freq = (float)exp2(-(double)f * (13.287712379549449 / 64.0));
        const float ang = (float)pos[row] * inv_freq; float s, c; sincos_red(ang, s, c);
        rope[i] = (unsigned)__builtin_bit_cast(unsigned short, (_Float16)c) | ((unsigned)__builtin_bit_cast(unsigned short, (_Float16)s) << 16); }
    const float* x = INP(float, I_X); bf16* xb = (bf16*)OUTP(); GAS f32x4* ss0 = (GAS f32x4*)(ws + WS_SS);
    for (int m0 = 4 * gw; m0 < M; m0 += 4 * F.NGW) {
        f32x4 v[4][8]; float s[4] = {0.f, 0.f, 0.f, 0.f};
#pragma unroll
        for (int q = 0; q < 4; ++q) { const GAS f32x4* xr = (const GAS f32x4*)(x + (size_t)(m0 + q) * DM) + lane;
#pragma unroll
            for (int j = 0; j < 8; ++j) v[q][j] = xr[64 * j]; }
#pragma unroll
        for (int q = 0; q < 4; ++q) {
#pragma unroll
            for (int j = 0; j < 8; ++j) s[q] += (v[q][j].x * v[q][j].x + v[q][j].y * v[q][j].y) + (v[q][j].z * v[q][j].z + v[q][j].w * v[q][j].w);
            s[q] = wave_sum(s[q]); if (lane < 2) ss0[2 * (m0 + q) + lane] = (f32x4){lane == 0 ? s[q] : 0.f, 0.f, 0.f, 0.f};
            GAS v2u* o8 = (GAS v2u*)(xb + (size_t)(m0 + q) * DM) + lane;
#pragma unroll
            for (int j = 0; j < 8; ++j) { v2u o; o.x = pk2(v[q][j].x, v[q][j].y); o.y = pk2(v[q][j].z, v[q][j].w); o8[64 * j] = o; } }
    }
}

typedef float f32x4_t __attribute__((ext_vector_type(4)));
DI void gate_item(Frame& F, int L, int item) {
    PH_IDS;
    GAS unsigned char* ws = ws_opaque(F);
    const int tok0 = item * 128, li = lane & 15, lq = lane >> 4;
    constexpr int WLP = DM * 2 + 16, XLP = 256 + 16, XB0 = 16 * WLP;
    LAS unsigned char* wls = F.lds + RING_OFF;
    { const GAS v4u* src = (const GAS v4u*)(ws + WS_WLRT) + (size_t)L * (16 * DM / 8);
#pragma unroll
      for (int j = 0; j < 8; ++j) { const int q = tid + 512 * j, r = q >> 8, c = q & 255;
          *(LAS v4u*)(wls + r * WLP + c * 16) = src[q]; } }
    const int ra = tid >> 3, pc = tid & 7;
    const GAS bf16* xsrc = (const GAS bf16*)OUTP() + (size_t)(tok0 + ra) * DM + 8 * pc;
    LAS unsigned char* xdst = wls + XB0 + ra * XLP + pc * 16;
    v4u x[2][2];
#define GI_LOAD(c_) do { _Pragma("unroll") for (int p_ = 0; p_ < 2; ++p_) _Pragma("unroll") for (int h_ = 0; h_ < 2; ++h_) x[p_][h_] = *(const GAS v4u*)(xsrc + (size_t)(64 * p_) * DM + 128 * (c_) + 64 * h_); } while (0)
    GI_LOAD(0);
    const LAS unsigned char* wl = wls + li * WLP + 16 * lq;
    const LAS unsigned char* xl = wls + XB0 + (16 * wave + li) * XLP + 16 * lq;
    f32x4 acc = {0.f, 0.f, 0.f, 0.f};
#pragma unroll 1
    for (int c = 0; c < DM / 128; ++c) {
#pragma unroll
        for (int p_ = 0; p_ < 2; ++p_)
#pragma unroll
            for (int h_ = 0; h_ < 2; ++h_) *(LAS v4u*)(xdst + (64 * p_) * XLP + 128 * h_) = x[p_][h_];
        __syncthreads();
        if (c + 1 < DM / 128) GI_LOAD(c + 1);
        bf16x8 a[4], b[4];
#pragma unroll
        for (int j = 0; j < 4; ++j) { a[j] = *(const LAS bf16x8*)(wl + 256 * c + 64 * j); b[j] = *(const LAS bf16x8*)(xl + 64 * j); }
        __builtin_amdgcn_sched_barrier(0);
#pragma unroll
        for (int j = 0; j < 4; ++j) acc = __builtin_amdgcn_mfma_f32_16x16x32_bf16(a[j], b[j], acc, 0, 0, 0);
        __syncthreads();
    }
#undef GI_LOAD
    const int t0 = tok0 + wave * 16;
    const GAS f32x4* ssp = (const GAS f32x4*)((const GAS float*)(ws + WS_SS) + ((size_t)(2 * L) * M + t0 + li) * 8); const f32x4 p0 = ssp[0], p1 = ssp[1];
    const float rstd = __builtin_amdgcn_rsqf((((p0[0] + p0[1]) + (p0[2] + p0[3])) + ((p1[0] + p1[1]) + (p1[2] + p1[3]))) * (1.0f / DM) + NORM_EPS);
    s16x4 lrb; { const unsigned u0 = pk2(acc[0] * rstd, acc[1] * rstd), u1 = pk2(acc[2] * rstd, acc[3] * rstd); lrb = (s16x4){(short)(u0 & 0xffffu), (short)(u0 >> 16), (short)(u1 & 0xffffu), (short)(u1 >> 16)}; }
    const GAS s16x4* w2f = (const GAS s16x4*)(ws + WS_W2F) + (size_t)L * 32 * 64 + lane;
    const GAS float* bias = (const GAS float*)(ws + WS_BIAS) + (size_t)L * NPROJ + C_GATE + 8 * lq;
    GAS bf16* gout = (GAS bf16*)(ws + WS_PROJ) + (size_t)(t0 + li) * NPROJ + C_GATE + 8 * lq;
#pragma unroll 1
    for (int n0 = 0; n0 < 16; n0 += 8) {
        s16x4 w[16]; f32x4 bv[16];
#pragma unroll
        for (int j = 0; j < 8; ++j) { w[2 * j] = w2f[(2 * (n0 + j)) * 64]; w[2 * j + 1] = w2f[(2 * (n0 + j) + 1) * 64];
            bv[2 * j] = *(const GAS f32x4*)(bias + 32 * (n0 + j)); bv[2 * j + 1] = *(const GAS f32x4*)(bias + 32 * (n0 + j) + 4); }
        __builtin_amdgcn_sched_barrier(0);
#pragma unroll
        for (int j = 0; j < 8; ++j) { const f32x4 z = {0.f, 0.f, 0.f, 0.f};
            const f32x4 d0 = __builtin_amdgcn_mfma_f32_16x16x16bf16_1k(w[2 * j], lrb, z, 0, 0, 0), d1 = __builtin_amdgcn_mfma_f32_16x16x16bf16_1k(w[2 * j + 1], lrb, z, 0, 0, 0);
            v4u o; o.x = pk2(d0[0] + bv[2 * j][0], d0[1] + bv[2 * j][1]); o.y = pk2(d0[2] + bv[2 * j][2], d0[3] + bv[2 * j][3]);
            o.z = pk2(d1[0] + bv[2 * j + 1][0], d1[1] + bv[2 * j + 1][1]); o.w = pk2(d1[2] + bv[2 * j + 1][2], d1[3] + bv[2 * j + 1][3]);
            *(GAS v4u*)(gout + 32 * (n0 + j)) = o; }
    }
    __syncthreads();
}
DI void combine_phase(Frame& F, int L) {
    PH_IDS;
    GAS unsigned char* ws = ws_opaque(F);
    const bf16* O = (const bf16*)(ws + WS_O); bf16* mix = (bf16*)(ws + WS_XN);
    const float* lq1 = INP(float, I_LQ1) + L * 128; const float* lk1 = INP(float, I_LK1) + L * 128; const float* lq2 = INP(float, I_LQ2) + L * 128; const float* lk2 = INP(float, I_LK2) + L * 128;
    const float lam_init = (L == 0) ? 0.2f : 0.35550906759096914f;
    float d1 = lq1[lane] * lk1[lane] + lq1[64 + lane] * lk1[64 + lane];
    float d2 = lq2[lane] * lk2[lane] + lq2[64 + lane] * lk2[64 + lane];
    const float lam = expf(wave_sum(d1)) - expf(wave_sum(d2)) + lam_init;
    const float osc = 1.0f - lam_init;
    f32x4 sw; { const float* swp = INP(float, I_SUBW) + L * 256 + (lane >> 5) * 128 + (lane & 31); sw = (f32x4){swp[0], swp[32], swp[64], swp[96]}; }
    for (int m = gw; m < M; m += F.NGW) {
        const bf16* o = O + (size_t)m * 2048 + 4 * lane;
        v2u a[4], b[4];
#pragma unroll
        for (int h = 0; h < 4; ++h) { a[h] = *(const GAS v2u*)(o + h * 512); b[h] = *(const GAS v2u*)(o + h * 512 + 256); }
#pragma unroll
        for (int h = 0; h < 4; ++h) { const f32x4 av = {bf_lo(a[h].x), bf_hi(a[h].x), bf_lo(a[h].y), bf_hi(a[h].y)}, bv = {bf_lo(b[h].x), bf_hi(b[h].x), bf_lo(b[h].y), bf_hi(b[h].y)}; const f32x4 d = av - bv * lam;
            const float ss = wave_sum((d.x * d.x + d.y * d.y) + (d.z * d.z + d.w * d.w));
            const float r = osc * __builtin_amdgcn_rsqf(ss * (1.f / 256.f) + SUBLN_EPS);
            v2u w; w.x = pk2(d.x * r * sw.x, d.y * r * sw.y); w.y = pk2(d.z * r * sw.z, d.w * r * sw.w);
            *(v2u*)(mix + (size_t)m * DM + 1024 + h * 256 + 4 * lane) = w; } }
}
#ifndef WGM_IN
#define WGM_IN 8
#define WGM_OUT 4
#define WGM_UP 8
#define WGM_DN 4
#endif
#ifndef HID_TILED
#define HID_TILED 1
#endif
#ifndef PROBE_DUP
#define PROBE_DUP 0
#endif

constexpr int G_QT = 0, G_QP = 272, G_KT = 17408, G_KDT = 34816, G_TP = 144, G_VT = 53248, G_AT = 90112, G_DEC = 99328, G_GT = 99840, G_NW = 103936, G_END = 104960, G_OB = 0, G_OP = 1152, G_OC = 144;
static_assert(G_END <= RING_BYTES && 64 * G_OP <= G_DEC, "GLA LDS map");
DI float log_sigmoid_f(float x) { return fminf(x, 0.f) - __logf(1.f + __expf(-fabsf(x))); }
DI bf16x8 lds_frag16(LAS unsigned char* p) { return *(LAS const bf16x8*)p; }
DI bf16x8 lds_frag8x2(LAS unsigned char* p, int second_off) { const s16x4 a = *(LAS const s16x4*)p, b = *(LAS const s16x4*)(p + second_off); return __builtin_shufflevector(a, b, 0, 1, 2, 3, 4, 5, 6, 7); }
#ifndef CONV_EVERY
#define CONV_EVERY (PROBE_DUP == 12 ? 4 : 8)
#endif
#ifndef GLA_SKIP
#define GLA_SKIP 0
#endif
DI void gla_unit(Frame& F, int L, int unit, int skip) {
    PH_IDS;
    const int b = unit >> 2, h = unit & 3;
    LAS unsigned char* lds = F.lds + RING_OFF;
    GAS unsigned char* ws = ws_opaque(F);
    const bf16* pbase = (const bf16*)(ws + WS_PROJ) + (size_t)b * SEQ * NPROJ;
    bf16* mix = (bf16*)(ws + WS_XN);
    const float* nw = INP(float, I_GLA_NW) + L * 256;
    f32x16 S[4];
#pragma unroll
    for (int i = 0; i < 4; ++i)
#pragma unroll
        for (int e = 0; e < 16; ++e) S[i][e] = 0.f;
    if (tid < 256) *(LAS float*)(lds + G_NW + 4 * tid) = nw[tid];
    unsigned gv[8];
#define GLA_LOADG(dst, nn) do { const bf16* r0_ = pbase + (size_t)((nn) * 64 + 8 * wave) * NPROJ + h * 128 + 2 * (tid & 63) + C_GATE; \
        _Pragma("unroll") for (int i = 0; i < 8; ++i) dst[i] = *(const unsigned*)(r0_ + (size_t)i * NPROJ); } while (0)
    GLA_LOADG(gv, 0);
#pragma unroll 1
    for (int n = 0; n < SEQ / 64; ++n) {
        const bf16* prow = pbase + (size_t)(n * 64) * NPROJ;
        int tc = tid; asm volatile("" : "+v"(tc));
        unsigned gvn[8];
#pragma unroll
        for (int i = 0; i < 8; ++i) gvn[i] = 0u;
        {
            const int dp = tc & 63, tg = wave;
            const int vp = tc & 127, tq = tc >> 7;
            unsigned qv[8], kv[8], vv[16];
            { const bf16* r0_ = prow + (size_t)(8 * tg) * NPROJ + h * 128 + 2 * dp;
#pragma unroll
              for (int i = 0; i < 8; ++i) { qv[i] = *(const unsigned*)(r0_ + (size_t)i * NPROJ + C_GQ); kv[i] = *(const unsigned*)(r0_ + (size_t)i * NPROJ + C_GK); }
              const bf16* v0_ = prow + (size_t)(16 * tq) * NPROJ + C_GV + h * 256 + 2 * vp;
#pragma unroll
              for (int i = 0; i < 16; ++i) vv[i] = *(const unsigned*)(v0_ + (size_t)i * NPROJ); }
            if (n + 1 < SEQ / 64) GLA_LOADG(gvn, n + 1);
            float cs0[8], cs1[8]; float a0 = 0.f, a1 = 0.f;
#pragma unroll
            for (int i = 0; i < 8; ++i) { cs0[i] = 0.f; cs1[i] = 0.f; }
            if (!(skip & 16)) {
#pragma unroll
            for (int i = 0; i < 8; ++i) { a0 += log_sigmoid_f(bf_lo(gv[i])) * (1.f / 16.f); a1 += log_sigmoid_f(bf_hi(gv[i])) * (1.f / 16.f); cs0[i] = a0; cs1[i] = a1; } }
            *(LAS f32x2v*)(lds + G_GT + (tg * 128 + 2 * dp) * 4) = (f32x2v){a0, a1};
            __syncthreads();
            if (!(skip & 8)) {
            float p0 = 0.f, p1 = 0.f, t0 = 0.f, t1 = 0.f;
#pragma unroll
            for (int g = 0; g < 8; ++g) { const f32x2v x = *(LAS const f32x2v*)(lds + G_GT + (g * 128 + 2 * dp) * 4); if (g < tg) { p0 += x.x; p1 += x.y; } t0 += x.x; t1 += x.y; }
            v4u kd0, kd1; float kx0[8], kx1[8];
            const float et0 = __expf(t0), et1 = __expf(t1);
#pragma unroll
            for (int i = 0; i < 8; ++i) { const float b0 = p0 + cs0[i], b1 = p1 + cs1[i];
                const float q0 = bf_lo(qv[i]) * GLA_QSCALE * __expf(b0), q1 = bf_hi(qv[i]) * GLA_QSCALE * __expf(b1);
                const float k0 = bf_lo(kv[i]) * __expf(-b0), k1 = bf_hi(kv[i]) * __expf(-b1);
                *(LAS unsigned*)(lds + G_QT + (8 * tg + i) * G_QP + 4 * dp) = pk2(q0, q1);
                *(LAS unsigned*)(lds + G_KT + (8 * tg + i) * G_QP + 4 * dp) = pk2(k0, k1);
                kx0[i] = k0 * et0; kx1[i] = k1 * et1; }
#pragma unroll
            for (int j = 0; j < 4; ++j) { kd0[j] = pk2(kx0[2 * j], kx0[2 * j + 1]); kd1[j] = pk2(kx1[2 * j], kx1[2 * j + 1]); }
            *(LAS v4u*)(lds + G_KDT + (2 * dp) * G_TP + 16 * tg) = kd0; *(LAS v4u*)(lds + G_KDT + (2 * dp + 1) * G_TP + 16 * tg) = kd1;
            if (tg == 0) *(LAS f32x2v*)(lds + G_DEC + 8 * dp) = (f32x2v){et0, et1};
#pragma unroll
            for (int hf = 0; hf < 2; ++hf) { v4u lo4, hi4;
#pragma unroll
                for (int j = 0; j < 4; ++j) { const unsigned x0 = vv[8 * hf + 2 * j], x1 = vv[8 * hf + 2 * j + 1]; lo4[j] = (x0 & 0xffffu) | (x1 << 16); hi4[j] = (x0 >> 16) | (x1 & 0xffff0000u); }
                *(LAS v4u*)(lds + G_VT + (2 * vp) * G_TP + (16 * tq + 8 * hf) * 2) = lo4; *(LAS v4u*)(lds + G_VT + (2 * vp + 1) * G_TP + (16 * tq + 8 * hf) * 2) = hi4; }
            }
        }
        v4u gq[4];
        { const bf16* gp = prow + (size_t)(tc >> 3) * NPROJ + C_GG + h * 256 + 32 * (tc & 7);
#pragma unroll
          for (int j = 0; j < 4; ++j) gq[j] = *(const v4u*)(gp + 8 * j); }
        __syncthreads();
        int t2 = tid; asm volatile("" : "+v"(t2)); const int r = t2 & 31, hh = (t2 >> 5) & 1;
        if (wave < 3 && !(skip & 4)) {
            const int ib = wave ? 1 : 0, jb = wave == 2 ? 1 : 0;
            f32x16 acc;
#pragma unroll
            for (int e = 0; e < 16; ++e) acc[e] = 0.f;
#pragma unroll
            for (int kh = 0; kh < 2; ++kh) { bf16x8 ka[4], qb[4];
#pragma unroll
                for (int k4 = 0; k4 < 4; ++k4) { const int ks = 4 * kh + k4; ka[k4] = lds_frag16(lds + G_KT + (jb * 32 + r) * G_QP + ks * 32 + 16 * hh); qb[k4] = lds_frag16(lds + G_QT + (ib * 32 + r) * G_QP + ks * 32 + 16 * hh); }
                __builtin_amdgcn_sched_barrier(0);
#pragma unroll
                for (int k4 = 0; k4 < 4; ++k4) acc = MFMA32(ka[k4], qb[k4], acc);
                __builtin_amdgcn_sched_barrier(0); }
            const int ci = ib * 32 + r;
#pragma unroll
            for (int g = 0; g < 4; ++g) { const int cj0 = jb * 32 + 8 * g + 4 * hh; float v[4];
#pragma unroll
                for (int e = 0; e < 4; ++e) v[e] = (cj0 + e <= ci) ? acc[4 * g + e] : 0.f;
                *(LAS v2u*)(lds + G_AT + ci * G_TP + cj0 * 2) = (v2u){pk2(v[0], v[1]), pk2(v[2], v[3])}; }
        }
        __syncthreads();
        f32x16 o0, o1;
#pragma unroll
        for (int e = 0; e < 16; ++e) { o0[e] = 0.f; o1[e] = 0.f; }
        if (!(skip & 2)) {
#pragma unroll
        for (int ih = 0; ih < 2; ++ih) {
            bf16x8 qa[2][2][2];
#pragma unroll
            for (int ii = 0; ii < 2; ++ii)
#pragma unroll
                for (int s = 0; s < 2; ++s) { const int d0 = 32 * (2 * ih + ii) + 16 * s + 4 * hh;
                    qa[ii][s][0] = lds_frag8x2(lds + G_QT + r * G_QP + d0 * 2, 16); qa[ii][s][1] = lds_frag8x2(lds + G_QT + (32 + r) * G_QP + d0 * 2, 16); }
            __builtin_amdgcn_sched_barrier(0);
#pragma unroll
            for (int ii = 0; ii < 2; ++ii)
#pragma unroll
                for (int s = 0; s < 2; ++s) { const int i = 2 * ih + ii;
                    v4u pw;
#pragma unroll
                    for (int j = 0; j < 4; ++j) pw[j] = pk2(S[i][8 * s + 2 * j], S[i][8 * s + 2 * j + 1]);
                    const bf16x8 sb = __builtin_bit_cast(bf16x8, pw);
                    o0 = MFMA32(qa[ii][s][0], sb, o0); o1 = MFMA32(qa[ii][s][1], sb, o1); }
            __builtin_amdgcn_sched_barrier(0);
        }
        bf16x8 vf[4], at0[2], at1[4];
#pragma unroll
        for (int ks = 0; ks < 4; ++ks) vf[ks] = lds_frag16(lds + G_VT + (32 * wave + r) * G_TP + ks * 32 + 16 * hh);
#pragma unroll
        for (int ks = 0; ks < 2; ++ks) at0[ks] = lds_frag16(lds + G_AT + r * G_TP + ks * 32 + 16 * hh);
#pragma unroll
        for (int ks = 0; ks < 4; ++ks) at1[ks] = lds_frag16(lds + G_AT + (32 + r) * G_TP + ks * 32 + 16 * hh);
        __builtin_amdgcn_sched_barrier(0);
#pragma unroll
        for (int ks = 0; ks < 2; ++ks) o0 = MFMA32(at0[ks], vf[ks], o0);
#pragma unroll
        for (int ks = 0; ks < 4; ++ks) o1 = MFMA32(at1[ks], vf[ks], o1);
        __builtin_amdgcn_sched_barrier(0);
#pragma unroll
        for (int ih = 0; ih < 2; ++ih) {
            bf16x8 kf[2][4]; f32x4 dc[2][4];
#pragma unroll
            for (int ii = 0; ii < 2; ++ii) { const int i = 2 * ih + ii;
#pragma unroll
                for (int ks = 0; ks < 4; ++ks) kf[ii][ks] = lds_frag16(lds + G_KDT + (32 * i + r) * G_TP + ks * 32 + 16 * hh);
#pragma unroll
                for (int g = 0; g < 4; ++g) dc[ii][g] = *(LAS const f32x4*)(lds + G_DEC + (32 * i + 8 * g + 4 * hh) * 4); }
            __builtin_amdgcn_sched_barrier(0);
#pragma unroll
            for (int ii = 0; ii < 2; ++ii) { const int i = 2 * ih + ii;
#pragma unroll
                for (int g = 0; g < 4; ++g) { S[i][4 * g] *= dc[ii][g].x; S[i][4 * g + 1] *= dc[ii][g].y; S[i][4 * g + 2] *= dc[ii][g].z; S[i][4 * g + 3] *= dc[ii][g].w; }
#pragma unroll
                for (int ks = 0; ks < 4; ++ks) S[i] = MFMA32(kf[ii][ks], vf[ks], S[i]); }
            __builtin_amdgcn_sched_barrier(0);
        }
        }
        __syncthreads();
        if (!(skip & 1)) {
#pragma unroll
        for (int e = 0; e < 16; ++e) { const int c = (e & 3) + 8 * (e >> 2) + 4 * hh;
            *(LAS float*)(lds + G_OB + c * G_OP + wave * G_OC + r * 4) = o0[e]; *(LAS float*)(lds + G_OB + (32 + c) * G_OP + wave * G_OC + r * 4) = o1[e]; }
        }
        __syncthreads();
        if (!(skip & 1))
        {
            int t5 = tid; asm volatile("" : "+v"(t5)); const int c = t5 >> 3, p = t5 & 7;
            f32x4 ov[8]; float ss = 0.f;
#pragma unroll
            for (int j = 0; j < 8; ++j) { ov[j] = *(LAS const f32x4*)(lds + G_OB + c * G_OP + p * G_OC + 16 * j); ss += (ov[j].x * ov[j].x + ov[j].y * ov[j].y) + (ov[j].z * ov[j].z + ov[j].w * ov[j].w); }
            ss += __shfl_xor(ss, 1); ss += __shfl_xor(ss, 2); ss += __shfl_xor(ss, 4);
            const float rstd = 1.0f / sqrtf(ss * (1.f / 256.f) + NORM_EPS);
            bf16* yp = mix + (size_t)(b * SEQ + n * 64 + c) * DM + h * 256 + 32 * p;
#pragma unroll
            for (int j = 0; j < 4; ++j) { const f32x4 w0 = *(LAS const f32x4*)(lds + G_NW + (32 * p + 8 * j) * 4), w1 = *(LAS const f32x4*)(lds + G_NW + (32 * p + 8 * j + 4) * 4); const f32x4 x0 = ov[2 * j], x1 = ov[2 * j + 1];
                float gf[8];
#pragma unroll
                for (int e = 0; e < 4; ++e) { gf[2 * e] = bf_lo(gq[j][e]); gf[2 * e + 1] = bf_hi(gq[j][e]); }
                float y[8];
#pragma unroll
                for (int e = 0; e < 4; ++e) { y[e] = x0[e] * rstd * w0[e]; y[4 + e] = x1[e] * rstd * w1[e]; }
#pragma unroll
                for (int e = 0; e < 8; ++e) y[e] = y[e] * gf[e] * __builtin_amdgcn_rcpf(1.f + __expf(-gf[e]));
                *(v4u*)(yp + 8 * j) = (v4u){pk2(y[0], y[1]), pk2(y[2], y[3]), pk2(y[4], y[5]), pk2(y[6], y[7])}; }
        }
        __syncthreads();
#pragma unroll
        for (int i = 0; i < 8; ++i) gv[i] = gvn[i];
    }
#undef GLA_LOADG
}

typedef swa::BlockRef<swa::bf16, swa::bf16> ABlk;
constexpr int N_GLA = BATCH * 4, N_ATT = BATCH * 16 * (SEQ / 256);
DI ABlk attn_ref(GAS unsigned char* ws, int a) {
    const int qb = (SEQ / 256 - 1) - (a >> 8), rest = a & 255, bb = rest >> 4, vh = rest & 15, hd = vh >> 2, c = (vh >> 1) & 1, vhalf = vh & 1;
    const swa::bf16* proj = (const swa::bf16*)(ws + WS_PROJ); swa::bf16* O = (swa::bf16*)(ws + WS_O);
    ABlk R;
    R.Q = proj + (size_t)(bb * SEQ + qb * 256) * NPROJ + C_DQ + (hd * 2 + c) * 128;
    R.K = proj + (size_t)(bb * SEQ) * NPROJ + C_DK + (hd * 2 + c) * 128;
    R.V = proj + (size_t)(bb * SEQ) * NPROJ + C_DV + hd * 256 + vhalf * 128;
    R.O = O + (size_t)(bb * SEQ + qb * 256) * 2048 + (hd * 2 + c) * 256 + vhalf * 128;
    R.P0 = qb * 256;
    return R;
}
DI int q_next(Frame& F, gu32* head) {
    if (threadIdx.x == 0) F.MISC[16] = __hip_atomic_fetch_add(head, 1u, RLX_AGENT);
    __syncthreads(); const int v = (int)F.MISC[16]; __syncthreads();
    return __builtin_amdgcn_readfirstlane(v);
}
DI void mixer_phase(Frame& F, int qi, int L, char* lds_generic) {
    gu32* head = F.ctl + CW_Q + 64 * qi;
    GAS unsigned char* ws = ws_opaque(F);
    const int G = F.G;
    int it = (int)blockIdx.x;
    const int NCV = (L == 0 && qi == 0) ? N_CONV * (PROBE_DUP == 12 ? 2 : 1) : 0, NCVP = NCV * CONV_EVERY, N_ITEMS = N_GLA + NCV + N_ATT;
    static_assert((long)N_CONV * (PROBE_DUP == 12 ? 2 : 1) * (CONV_EVERY - 1) <= N_ATT, "the conversion items must run out before the attention blocks do");
#define Q_NEXT() (G + q_next(F, head))
#define IS_CONV(p_) ((p_) < NCVP && ((p_) % CONV_EVERY) == 0)
#define ATT_IDX(p_) ((p_) < NCVP ? (p_) - (p_) / CONV_EVERY - 1 : (p_) - NCV)
    while (it < N_GLA) { _Pragma("unroll 1") for (int gr = (PROBE_DUP == 10) ? 1 : 0; gr >= 0; --gr) gla_unit(F, L, it, gr ? GLA_SKIP : 0); it = Q_NEXT(); }
#pragma unroll 1
    while (it < N_ITEMS) {
        const int p = it - N_GLA;
        if (IS_CONV(p)) { conv_item(F, (p / CONV_EVERY) % N_CONV); it = Q_NEXT(); continue; }
        ABlk cur = attn_ref(ws, ATT_IDX(p));
        unsigned pend0 = 0u;
        if (threadIdx.x == 0) pend0 = __hip_atomic_fetch_add(head, 1u, RLX_AGENT);
        swa::Seam<swa::bf16> S;
        swa::causal_swa_prime<swa::bf16, swa::bf16>(cur, SEQ, lds_generic, S);
        if (threadIdx.x == 0) F.MISC[20] = pend0;
        __syncthreads();
        int nx = G + __builtin_amdgcn_readfirstlane((int)F.MISC[20]);
        for (;;) {
            const int pn = nx - N_GLA;
            const bool last = nx >= N_ITEMS || IS_CONV(pn);
            const ABlk nxt = last ? cur : attn_ref(ws, ATT_IDX(pn));
            unsigned pend = 0u;
            if (!last && threadIdx.x == 0) pend = __hip_atomic_fetch_add(head, 1u, RLX_AGENT);
            swa::causal_swa_block<swa::bf16, swa::bf16>(cur, nxt, SEQ, SEQ, lds_generic, S);
            if (last) break;
            if (threadIdx.x == 0) F.MISC[20] = pend;
            __syncthreads();
            cur = nxt; nx = G + __builtin_amdgcn_readfirstlane((int)F.MISC[20]);
        }
        it = nx;
    }
#undef IS_CONV
#undef ATT_IDX
#undef Q_NEXT
}


template <class Sched> DI void rstd_tables(Frame& F, const Sched& S, const float* ss, LAS float* rt) {
    constexpr int RT_SHIFT = Sched::RT_SHIFT, RT_SLOTS = Sched::RT_SLOTS;
    const int t = opaque_tid();
    pg8::Unit u; int tag[RT_SLOTS];
#pragma unroll
    for (int s = 0; s < RT_SLOTS; ++s) tag[s] = -2;
    for (int i = 0; S.next(i, u); ++i) { const int sl = (u.pm >> RT_SHIFT) & (RT_SLOTS - 1);
#pragma unroll
        for (int s = 0; s < RT_SLOTS; ++s) if (s == sl) tag[s] = (tag[s] == -2 || tag[s] == u.pm) ? u.pm : -1; }
#pragma unroll
    for (int slot = 0; slot < RT_SLOTS; ++slot) { const int pm = tag[slot];
        if (pm >= 0 && t < 256) { const f32x4* p = (const f32x4*)(ss + (size_t)(pm * 256 + t) * 8); const f32x4 a = p[0], b = p[1];
            rt[slot * 256 + t] = __builtin_amdgcn_rsqf((((a[0] + a[1]) + (a[2] + a[3])) + ((b[0] + b[1]) + (b[2] + b[3]))) * (1.0f / DM) + NORM_EPS); }
        if (t == 0) ((LAS int*)(rt + RT_SLOTS * 256))[slot] = pm; }
    __syncthreads();
}

DI int virt_c(Frame& F) {
    if (MK_SPLIT) return (int)blockIdx.x;
    bool ok = (F.G % 8) == 0;
#pragma unroll
    for (int j = 0; j < 8; ++j) ok = ok && (__hip_atomic_load(F.ctl + CW_VC + 64 * j, RLX_AGENT) == (unsigned)(F.G / 8));
    const int v = (int)(F.MISC[24] + 8u * F.MISC[25]);
    return __builtin_amdgcn_readfirstlane(ok ? v : (int)blockIdx.x);
}

__global__ void __launch_bounds__(NWAVES * 64, 2) fwd(Args args) {
    extern __shared__ __attribute__((aligned(16))) unsigned char lds[];
    Frame F;
    F.lds = (LAS unsigned char*)lds;
    F.MISC = (volatile LAS unsigned*)(F.lds + MISC_OFF);
    F.G = gridDim.x; F.NGW = F.G * NWAVES;
    F.ws = args.ws; F.ctl = (gu32*)(args.ws + WS_CTL);
    for (int u = threadIdx.x; u < (LDS_BYTES - LDSCTL_OFF) / 4; u += NWAVES * 64) ((LAS unsigned*)(F.lds + LDSCTL_OFF))[u] = 0u;
    __syncthreads();
    if (!MK_SPLIT && threadIdx.x == 0) { const unsigned x = xb_xcc_id(); F.MISC[24] = x; F.MISC[25] = __hip_atomic_fetch_add(F.ctl + CW_VC + 64 * (x & 15u), 1u, RLX_AGENT); }
    XcdBarrier bar; bar.bar = (unsigned*)(F.ctl + CW_BAR); bar.x = 0; bar.st = nullptr;
    if (!MK_SPLIT) bar = xcd_barrier_post((unsigned*)(F.ctl + CW_BAR), F.MISC + 8);
#define GRID_BAR() do { if (!MK_SPLIT) { _Pragma("unroll 1") for (int br_ = (PROBE_DUP == 11) ? 1 : 0; br_ >= 0; --br_) { XcdBarrier b2_ = bar; GAS unsigned* bp_ = (GAS unsigned*)bar.bar; asm volatile("" : "+s"(bp_), "+s"(b2_.x)); b2_.bar = (unsigned*)bp_; xcd_barrier(b2_); } } } while (0)
    const int lo = args.ph_lo, hi = args.ph_hi;
#define IN(k) (lo <= (k) && (k) < hi)
#define BOTH(k) (IN(k) && IN((k) + 1))

#ifndef REV_DN
#define REV_DN 0
#endif
#ifndef STAGGER_US
#define STAGGER_US 0
#endif
#define STAGGER() do { if (STAGGER_US && (blockIdx.x & 1)) { const unsigned long long t0_ = __builtin_amdgcn_s_memrealtime(); while (__builtin_amdgcn_s_memrealtime() - t0_ < (unsigned long long)(STAGGER_US * 100)) __builtin_amdgcn_s_sleep(8); } } while (0)
#define NREP(k) ((PROBE_DUP == (k)) ? 2 : 1)
#define REPLOOP(k) _Pragma("unroll 1") for (int rep = NREP(k) - 1; rep >= 0; --rep)
#define REPBAR() do { if (rep) GRID_BAR(); } while (0)
    if (IN(0)) { REPLOOP(9) { p0_prologue(F); REPBAR(); } if (BOTH(0)) GRID_BAR(); }
    const int vc = (!MK_SPLIT && lo == 0) ? virt_c(F) : (int)blockIdx.x;
#pragma unroll 1
    for (int L = 0; L < DEPTH; ++L) {
        const int pb = 1 + L * PH_PER_LAYER;
        if (IN(pb + 0)) { REPLOOP(2) {
            GAS unsigned char* ws = ws_opaque(F);
            typedef pg8::Gemm<M, NPROJ, DM> GT; typedef pg8::StaticOrder<M, GATE_ITEMS ? NPROJ - 512 : NPROJ, WGM_IN, false, GATE_ITEMS ? C_GATE / 256 : (1 << 30), GATE_ITEMS ? 2 : 0> ST;     GT g{(const bf16*)OUTP(), (const bf16*)(ws + WS_WIN) + (size_t)L * NPROJ * DM}; ST S; S.init(F.G, vc);
            rstd_tables(F, S, (const float*)(ws + WS_SS) + (size_t)(2 * L) * M * 8, (LAS float*)(F.lds + RT_OFF));
            typedef pg8::EpiProj<NPROJ, DM, C_GATE / 256, C_DQ / 256, C_DK / 256, C_DV / 256, ST::RT_SHIFT, ST::RT_SLOTS> ET; ET E{(bf16*)(ws + WS_PROJ), (const float*)(ws + WS_BIAS) + L * NPROJ, (const LAS float*)(F.lds + RT_OFF), (const float*)(ws + WS_SS) + (size_t)(2 * L) * M * 8,
                INP(float, I_QNW) + L * 128, INP(float, I_KNW) + L * 128, (const unsigned*)(ws + WS_ROPE), (LAS float*)(F.lds + RED_OFF)};
            STAGGER(); pg8::gemm_phase<ET, ST, GT, true, true>(F.lds + RING_OFF, g, S, E); if (GATE_ITEMS) { _Pragma("unroll 1") for (int gr_ = NREP(13); gr_ > 0; --gr_) gate_item(F, L, (vc & 7) * 32 + (vc >> 3)); }      REPBAR(); }
            if (BOTH(pb + 0)) GRID_BAR();
        }
        if (IN(pb + 1)) {
            REPLOOP(3) { mixer_phase(F, L + 2 * rep, L, (char*)lds + RING_OFF); REPBAR(); }
            if (BOTH(pb + 1)) GRID_BAR(); }
        if (IN(pb + 2)) { REPLOOP(4) { combine_phase(F, L); REPBAR(); } if (BOTH(pb + 2)) GRID_BAR(); }
        if (IN(pb + 3)) { REPLOOP(5) {
            GAS unsigned char* ws = ws_opaque(F);
            typedef pg8::Gemm<M, DM, DM> GT; typedef pg8::StaticOrder<M, DM, WGM_OUT> ST; GT g{(const bf16*)(ws + WS_XN), (const bf16*)(ws + WS_WOUT) + (size_t)L * DM * DM}; ST S; S.init(F.G, vc);
            typedef pg8::EpiRes<DM, false> ET; ET E{(const bf16*)OUTP(), nullptr, (bf16*)(ws + (rep ? WS_HID : WS_XB2)), (float*)(ws + WS_SS) + (size_t)(rep ? 4 : 2 * L + 1) * M * 8, (LAS float*)(F.lds + RED_OFF)};
            STAGGER(); pg8::gemm_phase<ET, ST, GT, true, true>(F.lds + RING_OFF, g, S, E); REPBAR(); }
            if (BOTH(pb + 3)) GRID_BAR();
        }
        if (IN(pb + 4)) { REPLOOP(7) {
            GAS unsigned char* ws = ws_opaque(F);
            typedef pg8::Gemm<M, DFF, DM> GT; typedef pg8::StaticOrder<M, DFF, WGM_UP> ST; GT g{(const bf16*)(ws + WS_XB2), (const bf16*)(ws + WS_WUP) + (size_t)L * DFF * DM}; ST S; S.init(F.G, vc);
            rstd_tables(F, S, (const float*)(ws + WS_SS) + (size_t)(2 * L + 1) * M * 8, (LAS float*)(F.lds + RT_OFF));
            typedef pg8::EpiBf16<2, DFF, DM, ST::RT_SHIFT, ST::RT_SLOTS, HID_TILED != 0> ET; ET E{(bf16*)(ws + WS_HID), nullptr, (const LAS float*)(F.lds + RT_OFF), (const float*)(ws + WS_SS) + (size_t)(2 * L + 1) * M * 8};
            STAGGER(); pg8::gemm_phase<ET, ST, GT, true, true>(F.lds + RING_OFF, g, S, E); REPBAR(); }
            if (BOTH(pb + 4)) GRID_BAR();
        }
        if (IN(pb + 5)) { REPLOOP(8) {
            GAS unsigned char* ws = ws_opaque(F);
            typedef pg8::Gemm<M, DM, DFF, HID_TILED != 0> GT; typedef pg8::StaticOrder<M, DM, WGM_DN, (REV_DN != 0)> ST; GT g{(const bf16*)(ws + WS_HID), (const bf16*)(ws + WS_WDN) + (size_t)L * DM * DFF}; ST S; S.init(F.G, vc);
            if (L + 1 < DEPTH) { typedef pg8::EpiRes<DM, false> ET; ET E{(const bf16*)(ws + WS_XB2), nullptr, (bf16*)OUTP(), (float*)(ws + WS_SS) + (size_t)(2 * L + 2) * M * 8, (LAS float*)(F.lds + RED_OFF)};
                STAGGER(); pg8::gemm_phase<ET, ST, GT, true, true>(F.lds + RING_OFF, g, S, E); }
            else { typedef pg8::EpiRes<DM, true> ET; ET E{(const bf16*)(ws + WS_XB2), OUTP(), nullptr, nullptr, nullptr};
                STAGGER(); pg8::gemm_phase<ET, ST, GT, true, true>(F.lds + RING_OFF, g, S, E); }
            REPBAR(); }
            if (BOTH(pb + 5)) GRID_BAR();
        }
    }
#undef IN
#undef BOTH
}

extern "C" void kernel_launch(void* const* d_in, const int* in_sizes, int n_in, void* d_out, int out_size, void* d_ws, size_t ws_size, hipStream_t stream) {
    static int grid = 0;
    if (grid == 0) {
        if (n_in != 18 || in_sizes[0] != M * DM || out_size != M * DM || ws_size < WS_END) { fprintf(stderr, "kernel_launch: built for 18 inputs, x/out of %d floats, >= %zu bytes of workspace; got n_in %d, in0 %d, out %d, ws %zu; nothing launched\n", M * DM, (size_t)WS_END, n_in, n_in > 0 ? in_sizes[0] : -1, out_size, ws_size); grid = -1; return; }
        int dev = 0, cus = 0, per_cu = 0;
        if (hipGetDevice(&dev) != hipSuccess || hipDeviceGetAttribute(&cus, hipDeviceAttributeMultiprocessorCount, dev) != hipSuccess) { fprintf(stderr, "kernel_launch: hipGetDevice / hipDeviceGetAttribute failed; nothing launched\n"); grid = -1; return; }
        if (hipFuncSetAttribute((const void*)fwd, hipFuncAttributeMaxDynamicSharedMemorySize, LDS_BYTES) != hipSuccess) { fprintf(stderr, "kernel_launch: hipFuncSetAttribute failed\n"); grid = -1; return; }
        if (hipOccupancyMaxActiveBlocksPerMultiprocessor(&per_cu, (const void*)fwd, NWAVES * 64, LDS_BYTES) != hipSuccess || per_cu < 1) fprintf(stderr, "kernel_launch: note: occupancy query reports %d workgroups per CU\n", per_cu);
        (void)hipGetLastError();
        grid = cus;
        if (cus != 256) { fprintf(stderr, "kernel_launch: built for a 256-CU device (one workgroup per CU; the per-phase row-statistics tables assume the static unit order of a 256-workgroup grid); found %d CUs; nothing launched\n", cus); grid = -1; return; }
    }
    if (grid < 0) return;
    if (hipMemsetAsync((char*)d_ws + WS_CTL, 0, CTL_ZERO_BYTES, stream) != hipSuccess) { fprintf(stderr, "kernel_launch: hipMemsetAsync failed; nothing launched\n"); return; }
    Args a{};
    for (int i = 0; i < 18; ++i) a.in[i] = d_in[i];
    a.out = (float*)d_out; a.ws = (unsigned char*)d_ws;
#if MK_SPLIT
    for (int p = 0; p < N_PHASES; ++p) { a.ph_lo = p; a.ph_hi = p + 1; hipLaunchKernelGGL(fwd, dim3(grid), dim3(NWAVES * 64), LDS_BYTES, stream, a); }
#else
    a.ph_lo = 0; a.ph_hi = N_PHASES; hipLaunchKernelGGL(fwd, dim3(grid), dim3(NWAVES * 64), LDS_BYTES, stream, a);
#endif
    const hipError_t le = hipPeekAtLastError();
    if (le != hipSuccess) fprintf(stderr, "kernel_launch: launch failed: %s\n", hipGetErrorName(le));
}
```
